# Optimizing an MI355X kernel written in HIP

```python
import jax, jax.numpy as jnp
from jax import lax
import numpy as np

D_MODEL = 1024
BATCH = 2
SEQ = 8192
DEPTH = 1
DEC_BATCH = 8
DEC_SEQ = 4096
PAST_LEN = 128

N_HEADS = 8
QK_NOPE = 64
QK_ROPE = 32
QK_HEAD = QK_NOPE + QK_ROPE
V_HEAD = 64
Q_LORA = 384
KV_LORA = 256
ATTN_W = N_HEADS * V_HEAD
ROPE_THETA = 10000.0
Q_BLOCK = 128
FNET_W = D_MODEL - ATTN_W
FNET_GROUPS = 4
FNET_CH = FNET_W // FNET_GROUPS
IN_W = Q_LORA + KV_LORA + QK_ROPE + FNET_W
PEER_HEADS = 8
PEER_NKEYS = 128
PEER_EXPERTS = PEER_NKEYS * PEER_NKEYS
PEER_DKEY = 256
PEER_HALF = PEER_DKEY // 2
PEER_TOPK = 16
PEER_CHUNK = 128
EPS = 1e-6

kernel_name = 'hybrid_mla_fnet_peer_encoder'


def _rmsnorm(x, g):
    xf = x.astype(jnp.float32)
    y = xf * lax.rsqrt(jnp.mean(xf * xf, axis=-1, keepdims=True) + EPS)
    return (y * g.astype(jnp.float32)).astype(x.dtype)


def _rope(x, pos):
    half = QK_ROPE // 2
    freqs = 1.0 / (ROPE_THETA ** (jnp.arange(half, dtype=jnp.float32) / half))
    ang = pos[:, None] * freqs[None, :]
    cos = jnp.cos(ang)[None, :, None, :]
    sin = jnp.sin(ang)[None, :, None, :]
    xf = x.astype(jnp.float32)
    x1, x2 = xf[..., :half], xf[..., half:]
    return jnp.concatenate([x1 * cos - x2 * sin, x2 * cos + x1 * sin], axis=-1).astype(x.dtype)


def _mla(c_q, c_kv, k_r, q_lat_g, w_uq, kv_lat_g, w_ukv, q_head_g, k_head_g):
    B, S, _ = c_q.shape
    q = (_rmsnorm(c_q, q_lat_g) @ w_uq).reshape(B, S, N_HEADS, QK_HEAD)
    kv = (_rmsnorm(c_kv, kv_lat_g) @ w_ukv).reshape(B, S, N_HEADS, QK_NOPE + V_HEAD)
    k_nope, v = kv[..., :QK_NOPE], kv[..., QK_NOPE:]
    k = jnp.concatenate([k_nope, jnp.broadcast_to(k_r[:, :, None, :], (B, S, N_HEADS, QK_ROPE))], axis=-1)
    q = _rmsnorm(q, q_head_g)
    k = _rmsnorm(k, k_head_g)
    pos = jnp.arange(S, dtype=jnp.float32)
    q = jnp.concatenate([q[..., :QK_NOPE], _rope(q[..., QK_NOPE:], pos)], axis=-1)
    k = jnp.concatenate([k[..., :QK_NOPE], _rope(k[..., QK_NOPE:], pos)], axis=-1)
    nb = S // Q_BLOCK
    qb = q.reshape(B, nb, Q_BLOCK, N_HEADS, QK_HEAD).transpose(1, 0, 2, 3, 4)
    scale = QK_HEAD ** -0.5

    def block(qi):
        s = jnp.einsum('bqhd,bkhd->bhqk', qi, k).astype(jnp.float32) * scale
        p = jax.nn.softmax(s, axis=-1).astype(v.dtype)
        return jnp.einsum('bhqk,bkhd->bqhd', p, v)

    o = lax.map(block, qb)
    return o.transpose(1, 0, 2, 3, 4).reshape(B, S, ATTN_W)


def _fnet(f):
    B, S, _ = f.shape
    z = f.reshape(B, S, FNET_GROUPS, FNET_CH).astype(jnp.float32)
    y = jnp.fft.fft2(z, axes=(1, 3), norm='ortho').real
    return y.reshape(B, S, FNET_W).astype(f.dtype)


def _peer(h, w_pq, sub_keys, u, v):
    B, S, D = h.shape
    T = B * S
    t = h.reshape(T, D)
    q = (t @ w_pq).reshape(T, PEER_HEADS, 2, PEER_HALF)
    s = jnp.einsum('thcd,hcnd->thcn', q, sub_keys)
    sv, si = lax.top_k(s, PEER_TOPK)
    cand = (sv[:, :, 0, :, None] + sv[:, :, 1, None, :]).reshape(T, PEER_HEADS, PEER_TOPK * PEER_TOPK)
    cs, ci = lax.top_k(cand, PEER_TOPK)
    i1 = jnp.take_along_axis(si[:, :, 0, :], ci // PEER_TOPK, axis=-1)
    i2 = jnp.take_along_axis(si[:, :, 1, :], ci % PEER_TOPK, axis=-1)
    idx = (i1 * PEER_NKEYS + i2).reshape(T, PEER_HEADS * PEER_TOPK)
    g = jax.nn.softmax(cs.astype(jnp.float32), axis=-1).astype(h.dtype).reshape(T, PEER_HEADS * PEER_TOPK)
    nc = T // PEER_CHUNK
    tc = t.reshape(nc, PEER_CHUNK, D)
    ic = idx.reshape(nc, PEER_CHUNK, PEER_HEADS * PEER_TOPK)
    gc = g.reshape(nc, PEER_CHUNK, PEER_HEADS * PEER_TOPK)

    def retrieve(args):
        xt, it, gt = args
        a = jnp.einsum('td,tkd->tk', xt, u[it])
        a = jax.nn.gelu(a) * gt
        return jnp.einsum('tk,tkd->td', a, v[it])

    out = lax.map(retrieve, (tc, ic, gc))
    return out.reshape(B, S, D)


def _layer(x, attn_norm_g, w_in, q_lat_g, w_uq, kv_lat_g, w_ukv, q_head_g, k_head_g,
           attn_out_g, fnet_out_g, w_out, ffn_norm_g, peer_w_q, peer_sub_keys, peer_u, peer_v):
    h = _rmsnorm(x, attn_norm_g)
    p = h @ w_in
    o0 = Q_LORA
    o1 = o0 + KV_LORA
    o2 = o1 + QK_ROPE
    c_q, c_kv, k_r, f = p[..., :o0], p[..., o0:o1], p[..., o1:o2], p[..., o2:]
    a = _mla(c_q, c_kv, k_r, q_lat_g, w_uq, kv_lat_g, w_ukv, q_head_g, k_head_g)
    fm = _fnet(f)
    mixed = jnp.concatenate([_rmsnorm(a, attn_out_g), _rmsnorm(fm, fnet_out_g)], axis=-1)
    x = x + mixed @ w_out
    x = x + _peer(_rmsnorm(x, ffn_norm_g), peer_w_q, peer_sub_keys, peer_u, peer_v)
    return x


def _trunk(x, attn_norm_g, w_in, q_lat_g, w_uq, kv_lat_g, w_ukv, q_head_g, k_head_g,
           attn_out_g, fnet_out_g, w_out, ffn_norm_g, peer_w_q, peer_sub_keys, peer_u, peer_v):
    for l in range(DEPTH):
        x = _layer(x, attn_norm_g[l], w_in[l], q_lat_g[l], w_uq[l], kv_lat_g[l], w_ukv[l],
                   q_head_g[l], k_head_g[l], attn_out_g[l], fnet_out_g[l], w_out[l],
                   ffn_norm_g[l], peer_w_q[l], peer_sub_keys[l], peer_u[l], peer_v[l])
    return x


def setup_inputs(seed: int = 0) -> dict:
    key = jax.random.key(seed)
    ks = jax.random.split(key, 20)
    f32 = jnp.float32

    def nrm(k, shape, std):
        return jax.random.normal(k, shape, f32) * std

    def gain(k, n):
        return 1.0 + 0.02 * jax.random.normal(k, (DEPTH, n), f32)

    return {
        'x_prompt': jax.random.normal(ks[0], (BATCH, SEQ, D_MODEL), f32),
        'x_sample': jax.random.normal(ks[1], (DEC_BATCH, DEC_SEQ, D_MODEL), f32),
        'attn_norm_g': gain(ks[2], D_MODEL),
        'w_in': nrm(ks[3], (DEPTH, D_MODEL, IN_W), D_MODEL ** -0.5),
        'q_lat_g': gain(ks[4], Q_LORA),
        'w_uq': nrm(ks[5], (DEPTH, Q_LORA, N_HEADS * QK_HEAD), Q_LORA ** -0.5),
        'kv_lat_g': gain(ks[6], KV_LORA),
        'w_ukv': nrm(ks[7], (DEPTH, KV_LORA, N_HEADS * (QK_NOPE + V_HEAD)), KV_LORA ** -0.5),
        'q_head_g': gain(ks[8], QK_HEAD),
        'k_head_g': gain(ks[9], QK_HEAD),
        'attn_out_g': gain(ks[10], ATTN_W),
        'fnet_out_g': gain(ks[11], FNET_W),
        'w_out': nrm(ks[12], (DEPTH, D_MODEL, D_MODEL), D_MODEL ** -0.5),
        'ffn_norm_g': gain(ks[13], D_MODEL),
        'peer_w_q': nrm(ks[14], (DEPTH, D_MODEL, PEER_HEADS * PEER_DKEY), D_MODEL ** -0.5),
        'peer_sub_keys': nrm(ks[15], (DEPTH, PEER_HEADS, 2, PEER_NKEYS, PEER_HALF), PEER_HALF ** -0.5),
        'peer_u': nrm(ks[16], (DEPTH, PEER_EXPERTS, D_MODEL), D_MODEL ** -0.5),
        'peer_v': nrm(ks[17], (DEPTH, PEER_EXPERTS, D_MODEL), (PEER_HEADS * PEER_TOPK) ** -0.5),
    }


def reference(x_prompt, x_sample, attn_norm_g, w_in, q_lat_g, w_uq, kv_lat_g, w_ukv, q_head_g,
              k_head_g, attn_out_g, fnet_out_g, w_out, ffn_norm_g, peer_w_q, peer_sub_keys,
              peer_u, peer_v):
    y_prompt = _trunk(x_prompt, attn_norm_g, w_in, q_lat_g, w_uq, kv_lat_g, w_ukv, q_head_g,
                      k_head_g, attn_out_g, fnet_out_g, w_out, ffn_norm_g, peer_w_q,
                      peer_sub_keys, peer_u, peer_v)
    y_sample = _trunk(x_sample, attn_norm_g, w_in, q_lat_g, w_uq, kv_lat_g, w_ukv, q_head_g,
                      k_head_g, attn_out_g, fnet_out_g, w_out, ffn_norm_g, peer_w_q,
                      peer_sub_keys, peer_u, peer_v)
    return (y_prompt, y_sample)
```

```cpp
#include <hip/hip_runtime.h>
#include <hip/hip_cooperative_groups.h>
#include <stdint.h>
#include <cstdio>
namespace cg = cooperative_groups;

#ifndef MK_COOP
#define MK_COOP 0
#endif

typedef unsigned short u16;
using bf16x8 = __attribute__((ext_vector_type(8))) short;
using f32x16 = __attribute__((ext_vector_type(16))) float;
using f32x4 = __attribute__((ext_vector_type(4))) float;
using f32x2 = __attribute__((ext_vector_type(2))) float;
using u32x4 = __attribute__((ext_vector_type(4))) unsigned;
using u32x2 = __attribute__((ext_vector_type(2))) unsigned;
typedef __bf16 bf2_t __attribute__((ext_vector_type(2)));

#define DI __device__ __forceinline__
#define MFMA(a, b, c) __builtin_amdgcn_mfma_f32_32x32x16_bf16((a), (b), (c), 0, 0, 0)

constexpr int T_TOK = 49152;
constexpr int TP = 16384;
constexpr float EPS = 1e-6f;
constexpr int NTHR = 256;
constexpr int LDS_BYTES = 65536 + 2048;
constexpr int GBUF = 32768;

struct Params {
  const float *x0, *x1, *attn_norm_g, *w_in, *q_lat_g, *w_uq, *kv_lat_g, *w_ukv, *q_head_g, *k_head_g,
      *attn_out_g, *fnet_out_g, *w_out, *ffn_norm_g, *peer_w_q, *peer_sub_keys, *peer_u, *peer_v;
  float* out;
  u16 *WinT, *WuqT, *WukvT, *WoutT, *WpqT, *SK, *Wc, *WA64, *WA32, *WB;
  float *ropec, *ropes, *rstd1, *SSP, *SSA, *SSF, *SS2, *KR;
  u16 *Xb, *CQ, *CKV, *F, *Z1, *Vt, *Q1, *K1, *Qn, *Kn, *G1, *MIX, *X2b, *Qp, *U, *V;
  int* IDX;
  float* G;
};

DI unsigned cvtpk(float lo, float hi) {
  f32x2 v = {lo, hi};
  bf2_t b = __builtin_convertvector(v, bf2_t);
  return __builtin_bit_cast(unsigned, b);
}
DI u16 f2bf(float x) { return (u16)(cvtpk(x, 0.f) & 0xffffu); }
DI float bflo(unsigned w) { return __uint_as_float(w << 16); }
DI float bfhi(unsigned w) { return __uint_as_float(w & 0xffff0000u); }
DI int crow(int i, int h) { return (i & 3) + 8 * (i >> 2) + 4 * h; }
DI float red32(float v) {
  v += __shfl_xor(v, 1); v += __shfl_xor(v, 2); v += __shfl_xor(v, 4); v += __shfl_xor(v, 8); v += __shfl_xor(v, 16);
  return v;
}
DI float wave_sum(float v) { v = red32(v); v += __shfl_xor(v, 32); return v; }
DI const float* xrow(const Params& p, int t) {
  return t < TP ? p.x0 + (size_t)t * 1024 : p.x1 + (size_t)(t - TP) * 1024;
}
DI void tok2seq(int t, int& q, int& S, int& tb) {
  if (t < TP) { q = t >> 13; S = 8192; tb = q << 13; }
  else { int u = (t - TP) >> 12; q = 2 + u; S = 4096; tb = TP + (u << 12); }
}
DI int vblock() { return (blockIdx.x & 7) * (gridDim.x >> 3) + (blockIdx.x >> 3); }
DI float fdot2(unsigned a, unsigned b, float c) {
  return __builtin_amdgcn_fdot2_f32_bf16(__builtin_bit_cast(bf2_t, a), __builtin_bit_cast(bf2_t, b), c, false);
}

DI int swz(int row, int c) { return row * 128 + ((c ^ ((row >> 1) & 7)) << 4); }

template <class AF, class BF>
DI void gemm_mainloop(f32x16 (&acc)[2][2], char* smem, AF arow, BF brow, int k0, int k1) {
  const int tid = threadIdx.x, lane = tid & 63, wave = tid >> 6;
  const int wm = wave >> 1, wn = wave & 1, r = lane & 31, h = lane >> 5;
  const int lrow = tid >> 3, lc = tid & 7;
  const u16* ap[4]; const u16* bp[4];
#pragma unroll
  for (int i = 0; i < 4; ++i) { ap[i] = arow(lrow + 32 * i) + lc * 8; bp[i] = brow(lrow + 32 * i) + lc * 8; }
  u32x4 ra[4], rb[4];
#pragma unroll
  for (int i = 0; i < 4; ++i) { ra[i] = *(const u32x4*)(ap[i] + k0); rb[i] = *(const u32x4*)(bp[i] + k0); }
#pragma unroll
  for (int i = 0; i < 4; ++i) {
    *(u32x4*)(smem + swz(lrow + 32 * i, lc)) = ra[i];
    *(u32x4*)(smem + 16384 + swz(lrow + 32 * i, lc)) = rb[i];
  }
  __syncthreads();
  int cur = 0;
  for (int k = k0; k < k1; k += 64) {
    const bool nxt = (k + 64 < k1);
    if (nxt) {
#pragma unroll
      for (int i = 0; i < 4; ++i) { ra[i] = *(const u32x4*)(ap[i] + k + 64); rb[i] = *(const u32x4*)(bp[i] + k + 64); }
    }
    const char* As = smem + cur * GBUF;
    const char* Bs = As + 16384;
#pragma unroll
    for (int ks = 0; ks < 4; ++ks) {
      bf16x8 af[2], bfr[2];
#pragma unroll
      for (int mi = 0; mi < 2; ++mi) af[mi] = *(const bf16x8*)(As + swz(wm * 64 + mi * 32 + r, ks * 2 + h));
#pragma unroll
      for (int ni = 0; ni < 2; ++ni) bfr[ni] = *(const bf16x8*)(Bs + swz(wn * 64 + ni * 32 + r, ks * 2 + h));
#pragma unroll
      for (int mi = 0; mi < 2; ++mi)
#pragma unroll
        for (int ni = 0; ni < 2; ++ni) acc[mi][ni] = MFMA(af[mi], bfr[ni], acc[mi][ni]);
    }
    if (nxt) {
      char* An = smem + (cur ^ 1) * GBUF;
#pragma unroll
      for (int i = 0; i < 4; ++i) {
        *(u32x4*)(An + swz(lrow + 32 * i, lc)) = ra[i];
        *(u32x4*)(An + 16384 + swz(lrow + 32 * i, lc)) = rb[i];
      }
    }
    __syncthreads();
    cur ^= 1;
  }
}
DI void zero_acc(f32x16 (&acc)[2][2]) {
#pragma unroll
  for (int a = 0; a < 2; ++a)
#pragma unroll
    for (int b = 0; b < 2; ++b)
#pragma unroll
      for (int i = 0; i < 16; ++i) acc[a][b][i] = 0.f;
}
#define WAVE_COORDS                                                        \
  const int tid = threadIdx.x, lane = tid & 63, wave = tid >> 6;           \
  const int wm = wave >> 1, wn = wave & 1, r = lane & 31, h = lane >> 5;   \
  (void)wm; (void)wn; (void)r; (void)h; (void)lane;

template <int MODE>
DI void transpose_w(u16* dst, const float* src, const float* g0, const float* g1, int N, int K, int Nsrc, int gt, int gs) {
  const int items = N * (K >> 3);
  for (int id = gt; id < items; id += gs) {
    const int kc = id / N, n = id - kc * N;
    int col = n; bool valid = true;
    if (MODE == 1) {
      if (n < 640) col = n; else if (n < 1152) col = n + 32; else if (n < 1184) col = 640 + n - 1152; else valid = false;
    }
    float v[8];
#pragma unroll
    for (int j = 0; j < 8; ++j) {
      const int k = kc * 8 + j;
      const float g = (MODE == 2 && k >= 512) ? g1[k - 512] : g0[k];
      v[j] = valid ? src[(size_t)k * Nsrc + col] * g : 0.f;
    }
    u32x4 o = {cvtpk(v[0], v[1]), cvtpk(v[2], v[3]), cvtpk(v[4], v[5]), cvtpk(v[6], v[7])};
    *(u32x4*)(dst + (size_t)n * K + kc * 8) = o;
  }
}

DI void phase0(const Params& p) {
  const int gt = blockIdx.x * NTHR + threadIdx.x, gs = gridDim.x * NTHR;
  const int lane = threadIdx.x & 63, gw = gt >> 6, nw = gs >> 6;
  for (int t = gw; t < T_TOK; t += nw) {
    const float* xr = xrow(p, t);
    f32x4 v[4]; float ss = 0.f;
#pragma unroll
    for (int i = 0; i < 4; ++i) {
      v[i] = *(const f32x4*)(xr + i * 256 + lane * 4);
      ss += v[i][0] * v[i][0] + v[i][1] * v[i][1] + v[i][2] * v[i][2] + v[i][3] * v[i][3];
    }
    ss = wave_sum(ss);
#pragma unroll
    for (int i = 0; i < 4; ++i) {
      u32x2 o = {cvtpk(v[i][0], v[i][1]), cvtpk(v[i][2], v[i][3])};
      *(u32x2*)(p.Xb + (size_t)t * 1024 + i * 256 + lane * 4) = o;
    }
    if (lane == 0) p.rstd1[t] = rsqrtf(ss * (1.f / 1024.f) + EPS);
  }
  transpose_w<1>(p.WinT, p.w_in, p.attn_norm_g, nullptr, 1280, 1024, 1184, gt, gs);
  transpose_w<0>(p.WuqT, p.w_uq, p.q_lat_g, nullptr, 768, 384, 768, gt, gs);
  transpose_w<0>(p.WukvT, p.w_ukv, p.kv_lat_g, nullptr, 1024, 256, 1024, gt, gs);
  transpose_w<2>(p.WoutT, p.w_out, p.attn_out_g, p.fnet_out_g, 1024, 1024, 1024, gt, gs);
  transpose_w<0>(p.WpqT, p.peer_w_q, p.ffn_norm_g, nullptr, 2048, 1024, 2048, gt, gs);
  for (int id = gt; id < 262144 / 4; id += gs) {
    f32x4 v = *(const f32x4*)(p.peer_sub_keys + (size_t)id * 4);
    u32x2 o = {cvtpk(v[0], v[1]), cvtpk(v[2], v[3])};
    *(u32x2*)(p.SK + (size_t)id * 4) = o;
  }
  for (int id = gt; id < 256 * 128; id += gs) {
    const int n = id >> 7, c = id & 127, pp = n >> 7, m = n & 127;
    const float fr = (float)((m * c) & 127) * (1.f / 128.f);
    const float val = (pp == 0 ? __builtin_amdgcn_cosf(fr) : -__builtin_amdgcn_sinf(fr)) * 0.08838834764831845f;
    p.Wc[id] = f2bf(val);
  }
  for (int id = gt; id < 128 * 128; id += gs) {
    const int n = id >> 7, k = id & 127;
    const int k1 = (n >> 6) * 32 + (n & 31), pq = (n >> 5) & 1, pp = k >> 6, s1 = k & 63;
    const float fr = (float)((s1 * k1) & 63) * (1.f / 64.f);
    const float c = __builtin_amdgcn_cosf(fr), s = __builtin_amdgcn_sinf(fr);
    const float val = (pq == 0 ? (pp == 0 ? c : s) : (pp == 0 ? -s : c)) * 0.125f;
    p.WA64[id] = f2bf(val);
  }
  for (int id = gt; id < 128 * 64; id += gs) {
    const int n = id >> 6, k = id & 63;
    const int k1 = n & 31, pq = (n >> 5) & 1, pp = k >> 5, s1 = k & 31;
    const float fr = (float)((s1 * k1) & 31) * (1.f / 32.f);
    const float c = __builtin_amdgcn_cosf(fr), s = __builtin_amdgcn_sinf(fr);
    float val = (pq == 0 ? (pp == 0 ? c : s) : (pp == 0 ? -s : c)) * 0.17677669529663687f;
    if (n >= 64) val = 0.f;
    p.WA32[id] = f2bf(val);
  }
  for (int id = gt; id < 128 * 256; id += gs) {
    const int k2 = id >> 8, k = id & 255, pq = k >> 7, s2 = k & 127;
    const float fr = (float)((s2 * k2) & 127) * (1.f / 128.f);
    const float val = (pq == 0 ? __builtin_amdgcn_cosf(fr) : __builtin_amdgcn_sinf(fr)) * 0.08838834764831845f;
    p.WB[id] = f2bf(val);
  }
  for (int id = gt; id < 8192 * 16; id += gs) {
    const int pos = id >> 4, j = id & 15;
    const float freq = exp2f(-(float)j * (13.287712379549449f / 16.f));
    const double rev = (double)pos * (double)freq * 0.15915494309189535;
    const float fr = (float)(rev - floor(rev));
    p.ropec[id] = __builtin_amdgcn_cosf(fr);
    p.ropes[id] = __builtin_amdgcn_sinf(fr);
  }
}

DI void phase1(const Params& p, char* smem) {
  WAVE_COORDS
  float* rs = (float*)(smem + 65536);
  const int G = gridDim.x;
  for (int tile = vblock(); tile < 384 * 10; tile += G) {
    const int mt = tile / 10, nt = tile - mt * 10, m0 = mt * 128, n0 = nt * 128;
    __syncthreads();
    if (tid < 128) rs[tid] = p.rstd1[m0 + tid];
    f32x16 acc[2][2]; zero_acc(acc);
    const u16* A = p.Xb + (size_t)m0 * 1024; const u16* B = p.WinT + (size_t)n0 * 1024;
    gemm_mainloop(acc, smem, [&](int rr) { return A + (size_t)rr * 1024; }, [&](int rr) { return B + (size_t)rr * 1024; }, 0, 1024);
#pragma unroll
    for (int mi = 0; mi < 2; ++mi)
#pragma unroll
      for (int i = 0; i < 16; ++i) {
        const int row = wm * 64 + mi * 32 + crow(i, h);
        const float sc = rs[row];
        const size_t t = (size_t)(m0 + row);
        float ss = 0.f;
#pragma unroll
        for (int ni = 0; ni < 2; ++ni) {
          const int col = n0 + wn * 64 + ni * 32 + r;
          const float v = acc[mi][ni][i] * sc;
          ss += v * v;
          if (nt < 3) p.CQ[t * 384 + col] = f2bf(v);
          else if (nt < 5) p.CKV[t * 256 + col - 384] = f2bf(v);
          else if (nt < 9) p.F[t * 512 + col - 640] = f2bf(v);
          else if (col < 1184) p.KR[t * 32 + col - 1152] = v;
        }
        if (nt < 5) {
          ss = red32(ss);
          if (r == 0) p.SSP[t * 10 + nt * 2 + wn] = ss;
        }
      }
  }
}

DI void phase2(const Params& p, char* smem) {
  WAVE_COORDS
  float* rs = (float*)(smem + 65536);
  const int G = gridDim.x;
  const int NUQ = 384 * 6, NUKV = 384 * 8, NCH = 384 * 8;
  for (int tile = vblock(); tile < NUQ + NUKV + NCH; tile += G) {
    f32x16 acc[2][2]; zero_acc(acc);
    if (tile < NUQ) {
      const int mt = tile / 6, nt = tile - mt * 6, m0 = mt * 128, n0 = nt * 128;
      __syncthreads();
      if (tid < 128) {
        const float* s = p.SSP + (size_t)(m0 + tid) * 10;
        rs[tid] = rsqrtf((s[0] + s[1] + s[2] + s[3] + s[4] + s[5]) * (1.f / 384.f) + EPS);
      }
      const u16* A = p.CQ + (size_t)m0 * 384; const u16* B = p.WuqT + (size_t)n0 * 384;
      gemm_mainloop(acc, smem, [&](int rr) { return A + (size_t)rr * 384; }, [&](int rr) { return B + (size_t)rr * 384; }, 0, 384);
#pragma unroll
      for (int mi = 0; mi < 2; ++mi)
#pragma unroll
        for (int i = 0; i < 16; ++i) {
          const int row = wm * 64 + mi * 32 + crow(i, h);
          const float sc = rs[row];
#pragma unroll
          for (int ni = 0; ni < 2; ++ni)
            p.Q1[(size_t)(m0 + row) * 768 + n0 + wn * 64 + ni * 32 + r] = f2bf(acc[mi][ni][i] * sc);
        }
    } else if (tile < NUQ + NUKV) {
      const int tl = tile - NUQ;
      const int mt = tl >> 3, hh = tl & 7, m0 = mt * 128;
      int q, S, tb; tok2seq(m0, q, S, tb);
      __syncthreads();
      if (tid < 128) {
        const float* s = p.SSP + (size_t)(m0 + tid) * 10;
        rs[tid] = rsqrtf((s[6] + s[7] + s[8] + s[9]) * (1.f / 256.f) + EPS);
      }
      const u16* A = p.CKV + (size_t)m0 * 256; const u16* B = p.WukvT + (size_t)hh * 128 * 256;
      gemm_mainloop(acc, smem, [&](int rr) { return A + (size_t)rr * 256; }, [&](int rr) { return B + (size_t)rr * 256; }, 0, 256);
      if (wn == 0) {
#pragma unroll
        for (int mi = 0; mi < 2; ++mi)
#pragma unroll
          for (int i = 0; i < 16; ++i) {
            const int row = wm * 64 + mi * 32 + crow(i, h);
            const float sc = rs[row];
#pragma unroll
            for (int ni = 0; ni < 2; ++ni)
              p.K1[(size_t)(m0 + row) * 512 + hh * 64 + ni * 32 + r] = f2bf(acc[mi][ni][i] * sc);
          }
      } else {
        const int s0 = m0 - tb;
#pragma unroll
        for (int mi = 0; mi < 2; ++mi)
#pragma unroll
          for (int g4 = 0; g4 < 4; ++g4) {
            const int row = wm * 64 + mi * 32 + 8 * g4 + 4 * h;
            const f32x4 sc = *(const f32x4*)(rs + row);
#pragma unroll
            for (int ni = 0; ni < 2; ++ni) {
              const int dv = ni * 32 + r;
              u32x2 o = {cvtpk(acc[mi][ni][4 * g4] * sc[0], acc[mi][ni][4 * g4 + 1] * sc[1]),
                         cvtpk(acc[mi][ni][4 * g4 + 2] * sc[2], acc[mi][ni][4 * g4 + 3] * sc[3])};
              *(u32x2*)(p.Vt + (size_t)tb * 512 + (size_t)(hh * 64 + dv) * S + s0 + row) = o;
            }
          }
      }
    } else {
      const int tl = tile - NUQ - NUKV;
      const int pp = tl & 1, g = (tl >> 1) & 3, mt = tl >> 3, m0 = mt * 128;
      int q, S, tb; tok2seq(m0, q, S, tb);
      const int S1 = (q < 2) ? 64 : 32, l1 = (q < 2) ? 6 : 5;
      const int j0 = ((m0 - tb) >> 7) * (128 >> l1);
      const u16* Fb = p.F + (size_t)g * 128;
      const u16* B = p.Wc + (size_t)pp * 128 * 128;
      gemm_mainloop(acc, smem,
                    [&](int rr) { const int s1 = rr & (S1 - 1), s2 = j0 + (rr >> l1); return Fb + (size_t)(tb + s1 * 128 + s2) * 512; },
                    [&](int rr) { return B + (size_t)rr * 128; }, 0, 128);
      u16* Zb = p.Z1 + (size_t)tb * 1024;
#pragma unroll
      for (int mi = 0; mi < 2; ++mi)
#pragma unroll
        for (int g4 = 0; g4 < 4; ++g4) {
          const int rho = wm * 64 + mi * 32 + 8 * g4 + 4 * h;
          const int s1 = rho & (S1 - 1), s2 = j0 + (rho >> l1);
#pragma unroll
          for (int ni = 0; ni < 2; ++ni) {
            const int m = wn * 64 + ni * 32 + r;
            u32x2 o = {cvtpk(acc[mi][ni][4 * g4], acc[mi][ni][4 * g4 + 1]), cvtpk(acc[mi][ni][4 * g4 + 2], acc[mi][ni][4 * g4 + 3])};
            *(u32x2*)(Zb + ((size_t)((g * 128 + m) * 128 + s2) * (2 * S1)) + pp * S1 + s1) = o;
          }
        }
    }
  }
}

DI void phase3(const Params& p, char* smem) {
  WAVE_COORDS
  const int G = gridDim.x;
  for (int tile = vblock(); tile < 5120; tile += G) {
    const int q = tile >> 9, gm = tile & 511;
    const int tb = (q < 2) ? (q << 13) : (TP + ((q - 2) << 12));
    const int S = (q < 2) ? 8192 : 4096, S1 = (q < 2) ? 64 : 32, K = 2 * S1;
    f32x16 acc[2][2]; zero_acc(acc);
    const u16* A = p.Z1 + (size_t)tb * 1024 + (size_t)gm * 128 * K;
    const u16* B = (q < 2) ? p.WA64 : p.WA32;
    gemm_mainloop(acc, smem, [&](int rr) { return A + (size_t)rr * K; }, [&](int rr) { return B + (size_t)rr * K; }, 0, K);
    if (wn * 32 < S1) {
      const int k1 = wn * 32 + r;
      const float invS = 1.f / (float)S;
      u16* Gb = p.G1 + (size_t)tb * 1024 + (size_t)(gm * S1 + k1) * 256;
#pragma unroll
      for (int mi = 0; mi < 2; ++mi)
#pragma unroll
        for (int g4 = 0; g4 < 4; ++g4) {
          const int s2b = wm * 64 + mi * 32 + 8 * g4 + 4 * h;
          float ore[4], oim[4];
#pragma unroll
          for (int j = 0; j < 4; ++j) {
            const int s2 = s2b + j;
            const float fr = (float)((s2 * k1) & (S - 1)) * invS;
            const float c = __builtin_amdgcn_cosf(fr), s = __builtin_amdgcn_sinf(fr);
            const float re = acc[mi][0][4 * g4 + j], im = acc[mi][1][4 * g4 + j];
            ore[j] = re * c + im * s; oim[j] = im * c - re * s;
          }
          u32x2 o0 = {cvtpk(ore[0], ore[1]), cvtpk(ore[2], ore[3])};
          u32x2 o1 = {cvtpk(oim[0], oim[1]), cvtpk(oim[2], oim[3])};
          *(u32x2*)(Gb + s2b) = o0;
          *(u32x2*)(Gb + 128 + s2b) = o1;
        }
    }
  }
  const float QSCALE = 0.10206207261596575f * 1.4426950408889634f;
  for (int chunk = vblock(); chunk < T_TOK * 8 / NTHR; chunk += G) {
    const int id = chunk * NTHR + tid;
    const int t = id >> 3, hh = id & 7;
    int q, S, tb; tok2seq(t, q, S, tb);
    const int s = t - tb;
    const size_t obase = ((size_t)tb * 8 + (size_t)hh * S + s) * 96;
    f32x4 rc[4], rsn[4];
#pragma unroll
    for (int i = 0; i < 4; ++i) { rc[i] = *(const f32x4*)(p.ropec + s * 16 + i * 4); rsn[i] = *(const f32x4*)(p.ropes + s * 16 + i * 4); }
    {
      u32x4 w[12];
      const u16* src = p.Q1 + (size_t)t * 768 + hh * 96;
#pragma unroll
      for (int i = 0; i < 12; ++i) w[i] = *(const u32x4*)(src + i * 8);
      float ss = 0.f;
#pragma unroll
      for (int i = 0; i < 12; ++i)
#pragma unroll
        for (int j = 0; j < 4; ++j) { const float a = bflo(w[i][j]), b = bfhi(w[i][j]); ss += a * a + b * b; }
      const float rinv = rsqrtf(ss * (1.f / 96.f) + EPS);
      u16* dst = p.Qn + obase;
#pragma unroll
      for (int i = 0; i < 8; ++i) {
        u32x4 o;
#pragma unroll
        for (int j = 0; j < 4; ++j) {
          const int d = i * 8 + j * 2;
          o[j] = cvtpk(bflo(w[i][j]) * rinv * p.q_head_g[d] * QSCALE, bfhi(w[i][j]) * rinv * p.q_head_g[d + 1] * QSCALE);
        }
        *(u32x4*)(dst + i * 8) = o;
      }
      float x1[16], x2[16];
#pragma unroll
      for (int i = 0; i < 2; ++i)
#pragma unroll
        for (int j = 0; j < 4; ++j) {
          const int e = i * 8 + j * 2;
          x1[e] = bflo(w[8 + i][j]) * rinv * p.q_head_g[64 + e]; x1[e + 1] = bfhi(w[8 + i][j]) * rinv * p.q_head_g[64 + e + 1];
          x2[e] = bflo(w[10 + i][j]) * rinv * p.q_head_g[80 + e]; x2[e + 1] = bfhi(w[10 + i][j]) * rinv * p.q_head_g[80 + e + 1];
        }
      float o1[16], o2[16];
#pragma unroll
      for (int e = 0; e < 16; ++e) {
        const float c = rc[e >> 2][e & 3], sn = rsn[e >> 2][e & 3];
        o1[e] = (x1[e] * c - x2[e] * sn) * QSCALE; o2[e] = (x2[e] * c + x1[e] * sn) * QSCALE;
      }
#pragma unroll
      for (int i = 0; i < 2; ++i) {
        u32x4 a, b;
#pragma unroll
        for (int j = 0; j < 4; ++j) { a[j] = cvtpk(o1[i * 8 + j * 2], o1[i * 8 + j * 2 + 1]); b[j] = cvtpk(o2[i * 8 + j * 2], o2[i * 8 + j * 2 + 1]); }
        *(u32x4*)(dst + 64 + i * 8) = a;
        *(u32x4*)(dst + 80 + i * 8) = b;
      }
    }
    {
      u32x4 w[8];
      const u16* src = p.K1 + (size_t)t * 512 + hh * 64;
#pragma unroll
      for (int i = 0; i < 8; ++i) w[i] = *(const u32x4*)(src + i * 8);
      f32x4 kr[8];
#pragma unroll
      for (int i = 0; i < 8; ++i) kr[i] = *(const f32x4*)(p.KR + (size_t)t * 32 + i * 4);
      float ss = 0.f;
#pragma unroll
      for (int i = 0; i < 8; ++i)
#pragma unroll
        for (int j = 0; j < 4; ++j) { const float a = bflo(w[i][j]), b = bfhi(w[i][j]); ss += a * a + b * b + kr[i][j] * kr[i][j]; }
      const float rinv = rsqrtf(ss * (1.f / 96.f) + EPS);
      u16* dst = p.Kn + obase;
#pragma unroll
      for (int i = 0; i < 8; ++i) {
        u32x4 o;
#pragma unroll
        for (int j = 0; j < 4; ++j) {
          const int d = i * 8 + j * 2;
          o[j] = cvtpk(bflo(w[i][j]) * rinv * p.k_head_g[d], bfhi(w[i][j]) * rinv * p.k_head_g[d + 1]);
        }
        *(u32x4*)(dst + i * 8) = o;
      }
      float o1[16], o2[16];
#pragma unroll
      for (int e = 0; e < 16; ++e) {
        const float a = kr[e >> 2][e & 3] * rinv * p.k_head_g[64 + e];
        const float b = kr[4 + (e >> 2)][e & 3] * rinv * p.k_head_g[80 + e];
        const float c = rc[e >> 2][e & 3], sn = rsn[e >> 2][e & 3];
        o1[e] = a * c - b * sn; o2[e] = b * c + a * sn;
      }
#pragma unroll
      for (int i = 0; i < 2; ++i) {
        u32x4 a, b;
#pragma unroll
        for (int j = 0; j < 4; ++j) { a[j] = cvtpk(o1[i * 8 + j * 2], o1[i * 8 + j * 2 + 1]); b[j] = cvtpk(o2[i * 8 + j * 2], o2[i * 8 + j * 2 + 1]); }
        *(u32x4*)(dst + 64 + i * 8) = a;
        *(u32x4*)(dst + 80 + i * 8) = b;
      }
    }
  }
}

constexpr int KSTR = 208, VSTR = 136, ABUF = 64 * KSTR + 64 * VSTR;

DI void attn_tile(const Params& p, char* smem, int a) {
  WAVE_COORDS
  int q, hh, qt, S, tb;
  if (a < 1024) { q = a >> 9; hh = (a >> 6) & 7; qt = a & 63; S = 8192; tb = q << 13; }
  else { const int b = a - 1024; q = 2 + (b >> 8); hh = (b >> 5) & 7; qt = b & 31; S = 4096; tb = TP + ((q - 2) << 12); }
  const size_t qkb = ((size_t)tb * 8 + (size_t)hh * S) * 96;
  const u16* Qb = p.Qn + qkb; const u16* Kb = p.Kn + qkb;
  const u16* Vb = p.Vt + (size_t)tb * 512 + (size_t)hh * 64 * S;
  const int qrow = qt * 128 + wave * 32 + r;
  bf16x8 qf[6];
#pragma unroll
  for (int ks = 0; ks < 6; ++ks) qf[ks] = *(const bf16x8*)(Qb + (size_t)qrow * 96 + ks * 16 + h * 8);
  f32x16 o[2];
#pragma unroll
  for (int i = 0; i < 16; ++i) { o[0][i] = 0.f; o[1][i] = 0.f; }
  float mrun = -1e30f, lrun = 0.f;
  int krow_[3], kc_[3], vrow_[2], vc_[2];
#pragma unroll
  for (int i = 0; i < 3; ++i) { const int id = tid + 256 * i; krow_[i] = id / 12; kc_[i] = id - krow_[i] * 12; }
#pragma unroll
  for (int i = 0; i < 2; ++i) { const int id = tid + 256 * i; vrow_[i] = id >> 3; vc_[i] = id & 7; }
  u32x4 rk[3], rv[2];
  const int nkt = S >> 6;
#pragma unroll
  for (int i = 0; i < 3; ++i) rk[i] = *(const u32x4*)(Kb + (size_t)krow_[i] * 96 + kc_[i] * 8);
#pragma unroll
  for (int i = 0; i < 2; ++i) rv[i] = *(const u32x4*)(Vb + (size_t)vrow_[i] * S + vc_[i] * 8);
  __syncthreads();
#pragma unroll
  for (int i = 0; i < 3; ++i) *(u32x4*)(smem + krow_[i] * KSTR + kc_[i] * 16) = rk[i];
#pragma unroll
  for (int i = 0; i < 2; ++i) {
    char* d = smem + 64 * KSTR + vrow_[i] * VSTR + vc_[i] * 16;
    *(u32x2*)d = u32x2{rv[i][0], rv[i][1]}; *(u32x2*)(d + 8) = u32x2{rv[i][2], rv[i][3]};
  }
  __syncthreads();
  int cur = 0;
  for (int kt = 0; kt < nkt; ++kt) {
    const bool nxt = (kt + 1 < nkt);
    if (nxt) {
#pragma unroll
      for (int i = 0; i < 3; ++i) rk[i] = *(const u32x4*)(Kb + (size_t)((kt + 1) * 64 + krow_[i]) * 96 + kc_[i] * 8);
#pragma unroll
      for (int i = 0; i < 2; ++i) rv[i] = *(const u32x4*)(Vb + (size_t)vrow_[i] * S + (kt + 1) * 64 + vc_[i] * 8);
    }
    const char* Ks = smem + cur * ABUF;
    const char* Vs = Ks + 64 * KSTR;
    f32x16 sacc[2];
#pragma unroll
    for (int i = 0; i < 16; ++i) { sacc[0][i] = 0.f; sacc[1][i] = 0.f; }
#pragma unroll
    for (int t2 = 0; t2 < 2; ++t2)
#pragma unroll
      for (int ks = 0; ks < 6; ++ks) {
        const bf16x8 kf = *(const bf16x8*)(Ks + (t2 * 32 + r) * KSTR + ks * 32 + h * 16);
        sacc[t2] = MFMA(kf, qf[ks], sacc[t2]);
      }
    float mx = sacc[0][0];
#pragma unroll
    for (int i = 0; i < 16; ++i) { mx = fmaxf(mx, sacc[0][i]); mx = fmaxf(mx, sacc[1][i]); }
    mx = fmaxf(mx, __shfl_xor(mx, 32));
    const float mnew = fmaxf(mrun, mx);
    const float alpha = __builtin_amdgcn_exp2f(mrun - mnew);
    mrun = mnew;
    lrun *= alpha;
#pragma unroll
    for (int i = 0; i < 16; ++i) { o[0][i] *= alpha; o[1][i] *= alpha; }
    float ps = 0.f;
#pragma unroll
    for (int t2 = 0; t2 < 2; ++t2)
#pragma unroll
      for (int i = 0; i < 16; ++i) { const float e = __builtin_amdgcn_exp2f(sacc[t2][i] - mnew); sacc[t2][i] = e; ps += e; }
    lrun += ps;
    bf16x8 pf[4];
#pragma unroll
    for (int kk = 0; kk < 4; ++kk) {
      const int t2 = kk >> 1, s8 = (kk & 1) * 8;
      u32x4 pk = {cvtpk(sacc[t2][s8], sacc[t2][s8 + 1]), cvtpk(sacc[t2][s8 + 2], sacc[t2][s8 + 3]),
                  cvtpk(sacc[t2][s8 + 4], sacc[t2][s8 + 5]), cvtpk(sacc[t2][s8 + 6], sacc[t2][s8 + 7])};
      pf[kk] = __builtin_bit_cast(bf16x8, pk);
    }
#pragma unroll
    for (int dt = 0; dt < 2; ++dt)
#pragma unroll
      for (int kk = 0; kk < 4; ++kk) {
        const char* vp = Vs + (dt * 32 + r) * VSTR + kk * 32 + h * 8;
        const u32x2 lo = *(const u32x2*)vp, hi = *(const u32x2*)(vp + 16);
        u32x4 vv = {lo[0], lo[1], hi[0], hi[1]};
        o[dt] = MFMA(__builtin_bit_cast(bf16x8, vv), pf[kk], o[dt]);
      }
    if (nxt) {
      char* Kn_ = smem + (cur ^ 1) * ABUF;
#pragma unroll
      for (int i = 0; i < 3; ++i) *(u32x4*)(Kn_ + krow_[i] * KSTR + kc_[i] * 16) = rk[i];
#pragma unroll
      for (int i = 0; i < 2; ++i) {
        char* d = Kn_ + 64 * KSTR + vrow_[i] * VSTR + vc_[i] * 16;
        *(u32x2*)d = u32x2{rv[i][0], rv[i][1]}; *(u32x2*)(d + 8) = u32x2{rv[i][2], rv[i][3]};
      }
    }
    __syncthreads();
    cur ^= 1;
  }
  lrun += __shfl_xor(lrun, 32);
  const float inv = 1.f / lrun;
  float ss = 0.f;
  u16* dst = p.MIX + (size_t)(tb + qrow) * 1024 + hh * 64;
#pragma unroll
  for (int dt = 0; dt < 2; ++dt)
#pragma unroll
    for (int g4 = 0; g4 < 4; ++g4) {
      float v[4];
#pragma unroll
      for (int j = 0; j < 4; ++j) { v[j] = o[dt][4 * g4 + j] * inv; ss += v[j] * v[j]; }
      u32x2 ov = {cvtpk(v[0], v[1]), cvtpk(v[2], v[3])};
      *(u32x2*)(dst + dt * 32 + 8 * g4 + 4 * h) = ov;
    }
  ss += __shfl_xor(ss, 32);
  if (h == 0) p.SSA[(size_t)(tb + qrow) * 8 + hh] = ss;
}

DI void phase4(const Params& p, char* smem) {
  WAVE_COORDS
  const int G = gridDim.x;
  for (int a = vblock(); a < 3072; a += G) attn_tile(p, smem, a);
  for (int tile = vblock(); tile < 1536; tile += G) {
    int q, g, k1, S1, tb;
    if (tile < 512) { q = tile >> 8; g = (tile >> 6) & 3; k1 = tile & 63; S1 = 64; tb = q << 13; }
    else { const int b = tile - 512; q = 2 + (b >> 7); g = (b >> 5) & 3; k1 = b & 31; S1 = 32; tb = TP + ((q - 2) << 12); }
    f32x16 acc[2][2]; zero_acc(acc);
    const u16* A = p.G1 + (size_t)tb * 1024 + ((size_t)(g * 128) * S1 + k1) * 256;
    const u16* B = p.WB;
    const int rstride = S1 * 256;
    gemm_mainloop(acc, smem, [&](int rr) { return A + (size_t)rr * rstride; }, [&](int rr) { return B + (size_t)rr * 256; }, 0, 256);
#pragma unroll
    for (int ni = 0; ni < 2; ++ni) {
      const int k2 = wn * 64 + ni * 32 + r;
      const size_t tok = (size_t)(tb + k1 + S1 * k2);
      float ss = 0.f;
#pragma unroll
      for (int mi = 0; mi < 2; ++mi)
#pragma unroll
        for (int g4 = 0; g4 < 4; ++g4) {
          const int m = wm * 64 + mi * 32 + 8 * g4 + 4 * h;
          float v[4];
#pragma unroll
          for (int j = 0; j < 4; ++j) { v[j] = acc[mi][ni][4 * g4 + j]; ss += v[j] * v[j]; }
          u32x2 ov = {cvtpk(v[0], v[1]), cvtpk(v[2], v[3])};
          *(u32x2*)(p.MIX + tok * 1024 + 512 + g * 128 + m) = ov;
        }
      ss += __shfl_xor(ss, 32);
      if (h == 0) p.SSF[tok * 8 + g * 2 + wm] = ss;
    }
  }
}

DI void phase5(const Params& p, char* smem) {
  WAVE_COORDS
  float* rs = (float*)(smem + 65536);
  const int G = gridDim.x;
  for (int tile = vblock(); tile < 384 * 8; tile += G) {
    const int mt = tile >> 3, nt = tile & 7, m0 = mt * 128, n0 = nt * 128;
    __syncthreads();
    if (tid < 128) {
      const float* sa = p.SSA + (size_t)(m0 + tid) * 8; const float* sf = p.SSF + (size_t)(m0 + tid) * 8;
      const float ra = rsqrtf((sa[0] + sa[1] + sa[2] + sa[3] + sa[4] + sa[5] + sa[6] + sa[7]) * (1.f / 512.f) + EPS);
      const float rf = rsqrtf((sf[0] + sf[1] + sf[2] + sf[3] + sf[4] + sf[5] + sf[6] + sf[7]) * (1.f / 512.f) + EPS);
      rs[tid] = ra / rf; rs[128 + tid] = rf;
    }
    f32x16 acc[2][2]; zero_acc(acc);
    const u16* A = p.MIX + (size_t)m0 * 1024; const u16* B = p.WoutT + (size_t)n0 * 1024;
    auto af = [&](int rr) { return A + (size_t)rr * 1024; };
    auto bfn = [&](int rr) { return B + (size_t)rr * 1024; };
    gemm_mainloop(acc, smem, af, bfn, 0, 512);
#pragma unroll
    for (int mi = 0; mi < 2; ++mi)
#pragma unroll
      for (int i = 0; i < 16; ++i) {
        const float sc = rs[wm * 64 + mi * 32 + crow(i, h)];
        acc[mi][0][i] *= sc; acc[mi][1][i] *= sc;
      }
    gemm_mainloop(acc, smem, af, bfn, 512, 1024);
#pragma unroll
    for (int mi = 0; mi < 2; ++mi)
#pragma unroll
      for (int i = 0; i < 16; ++i) {
        const int row = wm * 64 + mi * 32 + crow(i, h);
        const float sc = rs[128 + row];
        const int t = m0 + row;
        const float* xr = xrow(p, t);
        float ss = 0.f;
#pragma unroll
        for (int ni = 0; ni < 2; ++ni) {
          const int col = n0 + wn * 64 + ni * 32 + r;
          const float v = xr[col] + acc[mi][ni][i] * sc;
          ss += v * v;
          p.out[(size_t)t * 1024 + col] = v;
          p.X2b[(size_t)t * 1024 + col] = f2bf(v);
        }
        ss = red32(ss);
        if (r == 0) p.SS2[(size_t)t * 16 + nt * 2 + wn] = ss;
      }
  }
  const int gt = blockIdx.x * NTHR + threadIdx.x, gs = gridDim.x * NTHR;
  for (int id = gt; id < 16384 * 1024 / 8; id += gs) {
    const int d = (id & 127) * 8;
    const f32x4 a0 = *(const f32x4*)(p.peer_u + (size_t)id * 8), a1 = *(const f32x4*)(p.peer_u + (size_t)id * 8 + 4);
    const f32x4 g0 = *(const f32x4*)(p.ffn_norm_g + d), g1 = *(const f32x4*)(p.ffn_norm_g + d + 4);
    u32x4 o = {cvtpk(a0[0] * g0[0], a0[1] * g0[1]), cvtpk(a0[2] * g0[2], a0[3] * g0[3]),
               cvtpk(a1[0] * g1[0], a1[1] * g1[1]), cvtpk(a1[2] * g1[2], a1[3] * g1[3])};
    *(u32x4*)(p.U + (size_t)id * 8) = o;
    const f32x4 b0 = *(const f32x4*)(p.peer_v + (size_t)id * 8), b1 = *(const f32x4*)(p.peer_v + (size_t)id * 8 + 4);
    u32x4 o2 = {cvtpk(b0[0], b0[1]), cvtpk(b0[2], b0[3]), cvtpk(b1[0], b1[1]), cvtpk(b1[2], b1[3])};
    *(u32x4*)(p.V + (size_t)id * 8) = o2;
  }
}

DI void phase6(const Params& p, char* smem) {
  WAVE_COORDS
  const int G = gridDim.x;
  for (int tile = vblock(); tile < 384 * 16; tile += G) {
    const int mt = tile >> 4, nt = tile & 15, m0 = mt * 128, n0 = nt * 128;
    f32x16 acc[2][2]; zero_acc(acc);
    const u16* A = p.X2b + (size_t)m0 * 1024; const u16* B = p.WpqT + (size_t)n0 * 1024;
    gemm_mainloop(acc, smem, [&](int rr) { return A + (size_t)rr * 1024; }, [&](int rr) { return B + (size_t)rr * 1024; }, 0, 1024);
#pragma unroll
    for (int mi = 0; mi < 2; ++mi)
#pragma unroll
      for (int i = 0; i < 16; ++i) {
        const int row = wm * 64 + mi * 32 + crow(i, h);
#pragma unroll
        for (int ni = 0; ni < 2; ++ni)
          p.Qp[(size_t)(m0 + row) * 2048 + n0 + wn * 64 + ni * 32 + r] = f2bf(acc[mi][ni][i]);
      }
  }
}

DI void ins16(float (&top)[16], float x) {
#pragma unroll
  for (int j = 0; j < 16; ++j) { const float hi = fmaxf(top[j], x); x = fminf(top[j], x); top[j] = hi; }
}
DI float mask7(float x) { return __uint_as_float(__float_as_uint(x) & ~0x7Fu); }

DI void score_top16(const Params& p, int t, int hh, int c, int r, int h, float (&top)[16]) {
  f32x16 acc[4];
#pragma unroll
  for (int n = 0; n < 4; ++n)
#pragma unroll
    for (int i = 0; i < 16; ++i) acc[n][i] = 0.f;
  const u16* qp = p.Qp + (size_t)t * 2048 + (hh * 2 + c) * 128 + h * 8;
  const u16* sk = p.SK + ((size_t)(hh * 2 + c) * 128 + r) * 128 + h * 8;
#pragma unroll
  for (int ks = 0; ks < 8; ++ks) {
    const bf16x8 bq = *(const bf16x8*)(qp + ks * 16);
#pragma unroll
    for (int n = 0; n < 4; ++n) {
      const bf16x8 a = *(const bf16x8*)(sk + n * 4096 + ks * 16);
      acc[n] = MFMA(a, bq, acc[n]);
    }
  }
#pragma unroll
  for (int j = 0; j < 16; ++j) top[j] = __uint_as_float(0xFF800000u);
#pragma unroll
  for (int n = 0; n < 4; ++n)
#pragma unroll
    for (int i = 0; i < 16; ++i) {
      const unsigned key = (__float_as_uint(acc[n][i]) & ~0x7Fu) | (unsigned)(n * 32 + crow(i, h));
      ins16(top, __uint_as_float(key));
    }
  float oth[16];
#pragma unroll
  for (int j = 0; j < 16; ++j) oth[j] = __shfl_xor(top[j], 32);
#pragma unroll
  for (int j = 0; j < 16; ++j) ins16(top, oth[j]);
}

DI void phase7(const Params& p, char* smem) {
  WAVE_COORDS
  const int G = gridDim.x;
  volatile unsigned* lw = (volatile unsigned*)(smem + wave * 1024);
  volatile unsigned char* lb = (volatile unsigned char*)(smem + wave * 1024);
  const float NEG_INF = __uint_as_float(0xFF800000u);
  for (int task = vblock() * 4 + wave; task < 1536 * 8; task += G * 4) {
    const int hh = task & 7, tok0 = (task >> 3) * 32;
    const int t = tok0 + r;
    float L0[16], L1[16];
    score_top16(p, t, hh, 0, r, h, L0);
    score_top16(p, t, hh, 1, r, h, L1);
    float ct[16];
#pragma unroll
    for (int j = 0; j < 16; ++j) ct[j] = NEG_INF;
#define CAND(i, j) { const float v_ = mask7(L0[i]) + mask7(L1[j]); ins16(ct, __uint_as_float((__float_as_uint(v_) & ~0xFFu) | (unsigned)((i) * 16 + (j)))); }
    CAND(0, 0)
    CAND(0, 1)
    CAND(0, 2)
    CAND(0, 3)
    CAND(0, 4)
    CAND(0, 5)
    CAND(0, 6)
    CAND(0, 7)
    CAND(0, 8)
    CAND(0, 9)
    CAND(0, 10)
    CAND(0, 11)
    CAND(0, 12)
    CAND(0, 13)
    CAND(0, 14)
    CAND(0, 15)
    CAND(1, 0)
    CAND(1, 1)
    CAND(1, 2)
    CAND(1, 3)
    CAND(1, 4)
    CAND(1, 5)
    CAND(1, 6)
    CAND(1, 7)
    CAND(2, 0)
    CAND(2, 1)
    CAND(2, 2)
    CAND(2, 3)
    CAND(2, 4)
    CAND(3, 0)
    CAND(3, 1)
    CAND(3, 2)
    CAND(3, 3)
    CAND(4, 0)
    CAND(4, 1)
    CAND(4, 2)
    CAND(5, 0)
    CAND(5, 1)
    CAND(6, 0)
    CAND(6, 1)
    CAND(7, 0)
    CAND(7, 1)
    CAND(8, 0)
    CAND(9, 0)
    CAND(10, 0)
    CAND(11, 0)
    CAND(12, 0)
    CAND(13, 0)
    CAND(14, 0)
    CAND(15, 0)
#undef CAND
    if (h == 0) {
#pragma unroll
      for (int w = 0; w < 4; ++w) {
        unsigned v = 0, v2 = 0;
#pragma unroll
        for (int b = 0; b < 4; ++b) {
          v |= (__float_as_uint(L0[w * 4 + b]) & 0x7Fu) << (8 * b);
          v2 |= (__float_as_uint(L1[w * 4 + b]) & 0x7Fu) << (8 * b);
        }
        lw[r * 8 + w] = v;
        lw[r * 8 + 4 + w] = v2;
      }
    }
    __builtin_amdgcn_wave_barrier();
    const float* s2 = p.SS2 + (size_t)t * 16;
    float ssum = 0.f;
#pragma unroll
    for (int j = 0; j < 16; ++j) ssum += s2[j];
    const float r2 = rsqrtf(ssum * (1.f / 1024.f) + EPS);
    float gv[16];
    const float v0 = __uint_as_float(__float_as_uint(ct[0]) & ~0xFFu) * r2;
    float esum = 0.f;
#pragma unroll
    for (int j = 0; j < 16; ++j) {
      const float vj = __uint_as_float(__float_as_uint(ct[j]) & ~0xFFu) * r2;
      gv[j] = __builtin_amdgcn_exp2f((vj - v0) * 1.4426950408889634f);
      esum += gv[j];
    }
    const float einv = 1.f / esum;
    u32x4 oi[2]; f32x4 og[2];
#pragma unroll
    for (int jj = 0; jj < 8; ++jj) {
      float ka = ct[jj], kb = ct[8 + jj], ga = gv[jj], gb = gv[8 + jj];
      asm volatile("" : "+v"(ka), "+v"(kb), "+v"(ga), "+v"(gb));
      const float key = h ? kb : ka;
      const float g = (h ? gb : ga) * einv;
      const unsigned code = __float_as_uint(key) & 0xFFu;
      const unsigned i1 = lb[r * 32 + (code >> 4)], i2 = lb[r * 32 + 16 + (code & 15)];
      oi[jj >> 2][jj & 3] = i1 * 128 + i2;
      og[jj >> 2][jj & 3] = g;
    }
    int* ip = p.IDX + (size_t)t * 128 + hh * 16 + h * 8;
    float* gp = p.G + (size_t)t * 128 + hh * 16 + h * 8;
    *(u32x4*)ip = oi[0]; *(u32x4*)(ip + 4) = oi[1];
    *(f32x4*)gp = og[0]; *(f32x4*)(gp + 4) = og[1];
    __builtin_amdgcn_wave_barrier();
  }
}

DI float gelu_tanh(float x) {
  const float u = 0.7978845608028654f * (x + 0.044715f * x * x * x);
  const float e = __builtin_amdgcn_exp2f(u * 2.8853900817779268f);
  const float th = 1.f - 2.f * __builtin_amdgcn_rcpf(e + 1.f);
  return 0.5f * x * (1.f + th);
}
DI float dot8(const u32x4& w, const u32x4& x, float acc) {
  acc = fdot2(w[0], x[0], acc); acc = fdot2(w[1], x[1], acc); acc = fdot2(w[2], x[2], acc); acc = fdot2(w[3], x[3], acc);
  return acc;
}

DI void phase8(const Params& p) {
  WAVE_COORDS
  const int G = gridDim.x;
  for (int t = vblock() * 4 + wave; t < T_TOK; t += G * 4) {
    const u16* xr = p.X2b + (size_t)t * 1024;
    const u32x4 xa = *(const u32x4*)(xr + lane * 8), xb = *(const u32x4*)(xr + 512 + lane * 8);
    const float* s2 = p.SS2 + (size_t)t * 16;
    float ssum = 0.f;
#pragma unroll
    for (int j = 0; j < 16; ++j) ssum += s2[j];
    const float r2 = rsqrtf(ssum * (1.f / 1024.f) + EPS);
    float oacc[16];
#pragma unroll
    for (int j = 0; j < 16; ++j) oacc[j] = 0.f;
    for (int c = 0; c < 8; ++c) {
      const int myidx = p.IDX[(size_t)t * 128 + c * 16 + (lane & 15)];
      const float myg = p.G[(size_t)t * 128 + c * 16 + (lane >> 2)];
      float part[16];
#pragma unroll
      for (int j = 0; j < 16; ++j) {
        const int e = __builtin_amdgcn_readlane(myidx, j);
        const u16* ur = p.U + (size_t)e * 1024;
        const u32x4 wa = *(const u32x4*)(ur + lane * 8), wb = *(const u32x4*)(ur + 512 + lane * 8);
        part[j] = dot8(wb, xb, dot8(wa, xa, 0.f));
      }
      const bool b5 = lane & 32, b4 = lane & 16, b3 = lane & 8, b2 = lane & 4;
      float v8[8], v4[4], v2[2], v1;
#pragma unroll
      for (int j = 0; j < 8; ++j) { const float mine = b5 ? part[j + 8] : part[j], send = b5 ? part[j] : part[j + 8]; v8[j] = mine + __shfl_xor(send, 32); }
#pragma unroll
      for (int j = 0; j < 4; ++j) { const float mine = b4 ? v8[j + 4] : v8[j], send = b4 ? v8[j] : v8[j + 4]; v4[j] = mine + __shfl_xor(send, 16); }
#pragma unroll
      for (int j = 0; j < 2; ++j) { const float mine = b3 ? v4[j + 2] : v4[j], send = b3 ? v4[j] : v4[j + 2]; v2[j] = mine + __shfl_xor(send, 8); }
      { const float mine = b2 ? v2[1] : v2[0], send = b2 ? v2[0] : v2[1]; v1 = mine + __shfl_xor(send, 4); }
      v1 += __shfl_xor(v1, 2); v1 += __shfl_xor(v1, 1);
      const float coef = gelu_tanh(v1 * r2) * myg;
#pragma unroll
      for (int j = 0; j < 16; ++j) {
        const int e = __builtin_amdgcn_readlane(myidx, j);
        const float aj = __builtin_bit_cast(float, __builtin_amdgcn_readlane(__builtin_bit_cast(int, coef), 4 * j));
        const unsigned alo = cvtpk(aj, 0.f), ahi = alo << 16;
        const u16* vr = p.V + (size_t)e * 1024;
        const u32x4 wa = *(const u32x4*)(vr + lane * 8), wb = *(const u32x4*)(vr + 512 + lane * 8);
#pragma unroll
        for (int k = 0; k < 4; ++k) {
          oacc[2 * k] = fdot2(wa[k], alo, oacc[2 * k]); oacc[2 * k + 1] = fdot2(wa[k], ahi, oacc[2 * k + 1]);
          oacc[8 + 2 * k] = fdot2(wb[k], alo, oacc[8 + 2 * k]); oacc[8 + 2 * k + 1] = fdot2(wb[k], ahi, oacc[8 + 2 * k + 1]);
        }
      }
    }
    float* op = p.out + (size_t)t * 1024 + lane * 8;
#pragma unroll
    for (int hx = 0; hx < 2; ++hx) {
      f32x4 a = *(f32x4*)(op + hx * 512), b = *(f32x4*)(op + hx * 512 + 4);
#pragma unroll
      for (int k = 0; k < 4; ++k) { a[k] += oacc[hx * 8 + k]; b[k] += oacc[hx * 8 + 4 + k]; }
      *(f32x4*)(op + hx * 512) = a; *(f32x4*)(op + hx * 512 + 4) = b;
    }
  }
}

extern __shared__ __attribute__((aligned(16))) char dyn_smem[];

DI void run_phase(const Params& p, int ph, char* smem) {
  switch (ph) {
    case 0: phase0(p); break;
    case 1: phase1(p, smem); break;
    case 2: phase2(p, smem); break;
    case 3: phase3(p, smem); break;
    case 4: phase4(p, smem); break;
    case 5: phase5(p, smem); break;
    case 6: phase6(p, smem); break;
    case 7: phase7(p, smem); break;
    default: phase8(p); break;
  }
}

#if MK_COOP
__global__ void __launch_bounds__(NTHR, 2) mega_kernel(Params p) {
  cg::grid_group grid = cg::this_grid();
  phase0(p); grid.sync();
  phase1(p, dyn_smem); grid.sync();
  phase2(p, dyn_smem); grid.sync();
  phase3(p, dyn_smem); grid.sync();
  phase4(p, dyn_smem); grid.sync();
  phase5(p, dyn_smem); grid.sync();
  phase6(p, dyn_smem); grid.sync();
  phase7(p, dyn_smem); grid.sync();
  phase8(p);
}
#else
template <int PH>
__global__ void __launch_bounds__(NTHR, 2) phase_kernel(Params p) { run_phase(p, PH, dyn_smem); }
#endif

extern "C" void kernel_launch(void* const* d_in, const int* in_sizes, int n_in, void* d_out, int out_size, void* d_ws,
                              size_t ws_size, hipStream_t stream) {
  Params p{};
  const float* const* in = (const float* const*)d_in;
  p.x0 = in[0]; p.x1 = in[1]; p.attn_norm_g = in[2]; p.w_in = in[3]; p.q_lat_g = in[4]; p.w_uq = in[5];
  p.kv_lat_g = in[6]; p.w_ukv = in[7]; p.q_head_g = in[8]; p.k_head_g = in[9]; p.attn_out_g = in[10];
  p.fnet_out_g = in[11]; p.w_out = in[12]; p.ffn_norm_g = in[13]; p.peer_w_q = in[14]; p.peer_sub_keys = in[15];
  p.peer_u = in[16]; p.peer_v = in[17];
  p.out = (float*)d_out;
  char* ws = (char*)d_ws;
  size_t off = 0;
  auto take = [&](size_t bytes) { char* q = ws + off; off += (bytes + 255) & ~(size_t)255; return q; };
  p.WinT = (u16*)take(1280 * 1024 * 2); p.WuqT = (u16*)take(768 * 384 * 2); p.WukvT = (u16*)take(1024 * 256 * 2);
  p.WoutT = (u16*)take(1024 * 1024 * 2); p.WpqT = (u16*)take(2048 * 1024 * 2); p.SK = (u16*)take(262144 * 2);
  p.Wc = (u16*)take(256 * 128 * 2); p.WA64 = (u16*)take(128 * 128 * 2); p.WA32 = (u16*)take(128 * 64 * 2);
  p.WB = (u16*)take(128 * 256 * 2);
  p.ropec = (float*)take(8192 * 16 * 4); p.ropes = (float*)take(8192 * 16 * 4);
  p.rstd1 = (float*)take((size_t)T_TOK * 4); p.SSP = (float*)take((size_t)T_TOK * 10 * 4);
  p.SSA = (float*)take((size_t)T_TOK * 8 * 4); p.SSF = (float*)take((size_t)T_TOK * 8 * 4);
  p.SS2 = (float*)take((size_t)T_TOK * 16 * 4); p.KR = (float*)take((size_t)T_TOK * 32 * 4);
  const size_t SMALL = 28u << 20;
  char* big = ws + SMALL;
  const size_t MB = 1u << 20;
  char* dsp = (char*)d_out;
  p.Xb = (u16*)(big + 0 * MB);
  p.CQ = (u16*)(big + 96 * MB); p.CKV = (u16*)(big + 132 * MB); p.F = (u16*)(big + 156 * MB);
  p.Z1 = (u16*)(big + 204 * MB);
  p.Vt = (u16*)(big + 300 * MB);
  p.Q1 = (u16*)(dsp + 0 * MB); p.K1 = (u16*)(dsp + 72 * MB);
  p.Qn = (u16*)(big + 0 * MB); p.Kn = (u16*)(dsp + 120 * MB);
  p.G1 = (u16*)(big + 96 * MB);
  p.MIX = (u16*)(big + 204 * MB);
  p.X2b = (u16*)(big + 0 * MB);
  p.Qp = (u16*)(big + 96 * MB);
  p.IDX = (int*)(big + 300 * MB); p.G = (float*)(big + 324 * MB);
  p.U = (u16*)(big + 348 * MB); p.V = (u16*)(big + 380 * MB);

#if MK_COOP
  static int grid_blocks = 0;
  if (!grid_blocks) {
    int dev = 0, cus = 0, per_cu = 0;
    hipGetDevice(&dev);
    hipDeviceGetAttribute(&cus, hipDeviceAttributeMultiprocessorCount, dev);
    hipFuncSetAttribute((const void*)mega_kernel, hipFuncAttributeMaxDynamicSharedMemorySize, LDS_BYTES);
    hipOccupancyMaxActiveBlocksPerMultiprocessor(&per_cu, mega_kernel, NTHR, LDS_BYTES);
    if (per_cu > 2) per_cu = 2;
    grid_blocks = cus * per_cu;
    grid_blocks &= ~7;
  }
  void* args[] = {&p};
  hipError_t e = hipLaunchCooperativeKernel((void*)mega_kernel, dim3(grid_blocks), dim3(NTHR), args, LDS_BYTES, stream);
  if (e != hipSuccess) fprintf(stderr, "cooperative launch failed: %s (grid %d)\n", hipGetErrorString(e), grid_blocks);
#else
  const int GB = 512;
#define LAUNCH(PH)                                                                                                \
  hipFuncSetAttribute((const void*)phase_kernel<PH>, hipFuncAttributeMaxDynamicSharedMemorySize, LDS_BYTES);      \
  phase_kernel<PH><<<GB, NTHR, LDS_BYTES, stream>>>(p);
  LAUNCH(0) LAUNCH(1) LAUNCH(2) LAUNCH(3) LAUNCH(4) LAUNCH(5) LAUNCH(6) LAUNCH(7) LAUNCH(8)
#endif
}
```

```cpp
#include <hip/hip_runtime.h>
#include <hip/hip_cooperative_groups.h>
#include <stdint.h>
#include <cstdio>
namespace cg = cooperative_groups;

#ifndef MK_COOP
#define MK_COOP 1
#endif

typedef unsigned short u16;
using bf16x8 = __attribute__((ext_vector_type(8))) short;
using f32x16 = __attribute__((ext_vector_type(16))) float;
using f32x4 = __attribute__((ext_vector_type(4))) float;
using f32x2 = __attribute__((ext_vector_type(2))) float;
using u32x4 = __attribute__((ext_vector_type(4))) unsigned;
using u32x2 = __attribute__((ext_vector_type(2))) unsigned;
typedef __bf16 bf2_t __attribute__((ext_vector_type(2)));

#define DI __device__ __forceinline__
#define MFMA(a, b, c) __builtin_amdgcn_mfma_f32_32x32x16_bf16((a), (b), (c), 0, 0, 0)

constexpr int T_TOK = 49152;
constexpr int TP = 16384;
constexpr float EPS = 1e-6f;
constexpr int NTHR = 256;
constexpr int LDS_BYTES = 65536 + 2048;
constexpr int GBUF = 32768;
constexpr float USCALE = 512.f, VSCALE = 256.f;

struct Params {
  const float *x0, *x1, *attn_norm_g, *w_in, *q_lat_g, *w_uq, *kv_lat_g, *w_ukv, *q_head_g, *k_head_g,
      *attn_out_g, *fnet_out_g, *w_out, *ffn_norm_g, *peer_w_q, *peer_sub_keys, *peer_u, *peer_v;
  float* out;
  u16 *WinT, *WuqT, *WukvT, *WoutT, *WpqT, *SK, *Wc, *WA64, *WA32, *WB;
  float *ropec, *ropes, *rstd1, *SSP, *SSA, *SSF, *SS2, *KR;
  u16 *Xb, *CQ, *CKV, *F, *Z1, *Vt, *Q1, *K1, *Qn, *Kn, *G1, *MIX, *X2b, *Qp;
  unsigned char *U8, *V8;
  int* IDX;
  float* G;
  unsigned* bar;
  float* misc;
};

DI unsigned cvtpk(float lo, float hi) {
  f32x2 v = {lo, hi};
  bf2_t b = __builtin_convertvector(v, bf2_t);
  return __builtin_bit_cast(unsigned, b);
}
DI u16 f2bf(float x) { return (u16)(cvtpk(x, 0.f) & 0xffffu); }
DI float bflo(unsigned w) { return __uint_as_float(w << 16); }
DI float bfhi(unsigned w) { return __uint_as_float(w & 0xffff0000u); }
DI int crow(int i, int h) { return (i & 3) + 8 * (i >> 2) + 4 * h; }
DI float red32(float v) {
  v += __shfl_xor(v, 1); v += __shfl_xor(v, 2); v += __shfl_xor(v, 4); v += __shfl_xor(v, 8); v += __shfl_xor(v, 16);
  return v;
}
DI float wave_sum(float v) { v = red32(v); v += __shfl_xor(v, 32); return v; }
DI const float* xrow(const Params& p, int t) {
  return t < TP ? p.x0 + (size_t)t * 1024 : p.x1 + (size_t)(t - TP) * 1024;
}
DI void tok2seq(int t, int& q, int& S, int& tb) {
  if (t < TP) { q = t >> 13; S = 8192; tb = q << 13; }
  else { int u = (t - TP) >> 12; q = 2 + u; S = 4096; tb = TP + (u << 12); }
}
DI int vblock() { return (blockIdx.x & 7) * (gridDim.x >> 3) + (blockIdx.x >> 3); }
DI float fdot2(unsigned a, unsigned b, float c) {
  return __builtin_amdgcn_fdot2_f32_bf16(__builtin_bit_cast(bf2_t, a), __builtin_bit_cast(bf2_t, b), c, false);
}

DI int swz(int row, int c) { return row * 128 + ((c ^ ((row >> 1) & 7)) << 4); }

template <bool BATCH = false, class AF, class BF>
DI void gemm_mainloop(f32x16 (&acc)[2][2], char* smem, AF arow, BF brow, int k0, int k1) {
  const int tid = threadIdx.x, lane = tid & 63, wave = tid >> 6;
  const int wm = wave >> 1, wn = wave & 1, r = lane & 31, h = lane >> 5;
  const int lrow = tid >> 3, lc = tid & 7;
  const u16* ap[4]; const u16* bp[4];
#pragma unroll
  for (int i = 0; i < 4; ++i) { ap[i] = arow(lrow + 32 * i) + lc * 8; bp[i] = brow(lrow + 32 * i) + lc * 8; }
  u32x4 ra0[4], rb0[4], ra1[4], rb1[4];
#pragma unroll
  for (int i = 0; i < 4; ++i) { ra0[i] = *(const u32x4*)(ap[i] + k0); rb0[i] = *(const u32x4*)(bp[i] + k0); }
#pragma unroll
  for (int i = 0; i < 4; ++i) {
    *(u32x4*)(smem + swz(lrow + 32 * i, lc)) = ra0[i];
    *(u32x4*)(smem + 16384 + swz(lrow + 32 * i, lc)) = rb0[i];
  }
  if (k0 + 64 < k1) {
#pragma unroll
    for (int i = 0; i < 4; ++i) { ra0[i] = *(const u32x4*)(ap[i] + k0 + 64); rb0[i] = *(const u32x4*)(bp[i] + k0 + 64); }
  }
  __syncthreads();
  int cur = 0;
  auto step = [&](int k, u32x4 (&xa)[4], u32x4 (&xb)[4], u32x4 (&ya)[4], u32x4 (&yb)[4]) {
    if (k + 128 < k1) {
#pragma unroll
      for (int i = 0; i < 4; ++i) { ya[i] = *(const u32x4*)(ap[i] + k + 128); yb[i] = *(const u32x4*)(bp[i] + k + 128); }
    }
    __builtin_amdgcn_sched_barrier(0);
    const char* As = smem + cur * GBUF;
    const char* Bs = As + 16384;
    if (BATCH) {
      bf16x8 af[4][2], bfr[4][2];
#pragma unroll
      for (int ks = 0; ks < 4; ++ks) {
#pragma unroll
        for (int mi = 0; mi < 2; ++mi) af[ks][mi] = *(const bf16x8*)(As + swz(wm * 64 + mi * 32 + r, ks * 2 + h));
#pragma unroll
        for (int ni = 0; ni < 2; ++ni) bfr[ks][ni] = *(const bf16x8*)(Bs + swz(wn * 64 + ni * 32 + r, ks * 2 + h));
      }
      __builtin_amdgcn_sched_barrier(0);
#pragma unroll
      for (int ks = 0; ks < 4; ++ks)
#pragma unroll
        for (int mi = 0; mi < 2; ++mi)
#pragma unroll
          for (int ni = 0; ni < 2; ++ni) acc[mi][ni] = MFMA(af[ks][mi], bfr[ks][ni], acc[mi][ni]);
    } else {
#pragma unroll
      for (int ks = 0; ks < 4; ++ks) {
        bf16x8 af[2], bfr[2];
#pragma unroll
        for (int mi = 0; mi < 2; ++mi) af[mi] = *(const bf16x8*)(As + swz(wm * 64 + mi * 32 + r, ks * 2 + h));
#pragma unroll
        for (int ni = 0; ni < 2; ++ni) bfr[ni] = *(const bf16x8*)(Bs + swz(wn * 64 + ni * 32 + r, ks * 2 + h));
#pragma unroll
        for (int mi = 0; mi < 2; ++mi)
#pragma unroll
          for (int ni = 0; ni < 2; ++ni) acc[mi][ni] = MFMA(af[mi], bfr[ni], acc[mi][ni]);
      }
    }
    __builtin_amdgcn_sched_barrier(0);
    if (k + 64 < k1) {
      char* An = smem + (cur ^ 1) * GBUF;
#pragma unroll
      for (int i = 0; i < 4; ++i) {
        *(u32x4*)(An + swz(lrow + 32 * i, lc)) = xa[i];
        *(u32x4*)(An + 16384 + swz(lrow + 32 * i, lc)) = xb[i];
      }
    }
    __syncthreads();
    cur ^= 1;
  };
#pragma unroll 1
  for (int k = k0; k < k1; k += 128) {
    step(k, ra0, rb0, ra1, rb1);
    if (k + 64 < k1) step(k + 64, ra1, rb1, ra0, rb0);
  }
}
DI void zero_acc(f32x16 (&acc)[2][2]) {
#pragma unroll
  for (int a = 0; a < 2; ++a)
#pragma unroll
    for (int b = 0; b < 2; ++b)
#pragma unroll
      for (int i = 0; i < 16; ++i) acc[a][b][i] = 0.f;
}
#define WAVE_COORDS                                                        \
  const int tid = threadIdx.x, lane = tid & 63, wave = tid >> 6;           \
  const int wm = wave >> 1, wn = wave & 1, r = lane & 31, h = lane >> 5;   \
  (void)wm; (void)wn; (void)r; (void)h; (void)lane;

constexpr int SROW = 272;
template <bool SCALE>
DI void stage_bf16_t(char* smem, f32x16 (&acc)[2][2], const float* rs, int wm, int wn, int r, int h) {
  char* base = smem + (wm * 64 + 4 * h) * SROW + (wn * 64 + r) * 2;
  const float* rb = rs + wm * 64 + 4 * h;
#pragma unroll
  for (int mi = 0; mi < 2; ++mi)
#pragma unroll
    for (int i = 0; i < 16; ++i) {
      const int ro = mi * 32 + (i & 3) + 8 * (i >> 2);
      const float sc = SCALE ? rb[ro] : 1.f;
#pragma unroll
      for (int ni = 0; ni < 2; ++ni)
        *(u16*)(base + ro * SROW + ni * 64) = f2bf(acc[mi][ni][i] * sc);
    }
}
DI void stage_bf16(char* smem, f32x16 (&acc)[2][2], const float* rs, int wm, int wn, int r, int h, int) {
  if (rs) stage_bf16_t<true>(smem, acc, rs, wm, wn, r, h); else stage_bf16_t<false>(smem, acc, rs, wm, wn, r, h);
}
DI float sumsq8(const u32x4& v) {
  float ss = 0.f;
#pragma unroll
  for (int j = 0; j < 4; ++j) { const float a = bflo(v[j]), b = bfhi(v[j]); ss += a * a + b * b; }
  return ss;
}

#define WAVE_COORDS_L                                                      \
  int tid = threadIdx.x; asm volatile("" : "+v"(tid));                     \
  const int lane = tid & 63, wave = tid >> 6;                              \
  const int wm = wave >> 1, wn = wave & 1, r = lane & 31, h = lane >> 5;   \
  (void)wm; (void)wn; (void)r; (void)h; (void)lane;

template <int MODE>
DI void transpose_w(u16* dst, const float* src, const float* g0, const float* g1, int N, int K, int Nsrc, int gt, int gs) {
  const int items = N * (K >> 3);
  for (int id = gt; id < items; id += gs) {
    const int kc = id / N, n = id - kc * N;
    int col = n; bool valid = true;
    if (MODE == 1) {
      if (n < 640) col = n; else if (n < 1152) col = n + 32; else if (n < 1184) col = 640 + n - 1152; else valid = false;
    }
    float v[8];
#pragma unroll
    for (int j = 0; j < 8; ++j) {
      const int k = kc * 8 + j;
      const float g = (MODE == 2 && k >= 512) ? g1[k - 512] : g0[k];
      v[j] = valid ? src[(size_t)k * Nsrc + col] * g : 0.f;
    }
    u32x4 o = {cvtpk(v[0], v[1]), cvtpk(v[2], v[3]), cvtpk(v[4], v[5]), cvtpk(v[6], v[7])};
    *(u32x4*)(dst + (size_t)n * K + kc * 8) = o;
  }
}

DI void phase0(const Params& p) {
  const int gt = blockIdx.x * NTHR + threadIdx.x, gs = gridDim.x * NTHR;
  if (gt == 0) {
    float mq = 0.f, mk = 0.f;
    for (int d = 0; d < 96; ++d) { mq = fmaxf(mq, fabsf(p.q_head_g[d])); mk = fmaxf(mk, fabsf(p.k_head_g[d])); }
    p.misc[0] = 96.f * mq * mk * (0.10206207261596575f * 1.4426950408889634f) * 1.02f;
  }
  const int lane = threadIdx.x & 63, gw = gt >> 6, nw = gs >> 6;
  for (int t = gw; t < T_TOK; t += nw) {
    const float* xr = xrow(p, t);
    f32x4 v[4]; float ss = 0.f;
#pragma unroll
    for (int i = 0; i < 4; ++i) {
      v[i] = *(const f32x4*)(xr + i * 256 + lane * 4);
      ss += v[i][0] * v[i][0] + v[i][1] * v[i][1] + v[i][2] * v[i][2] + v[i][3] * v[i][3];
    }
    ss = wave_sum(ss);
#pragma unroll
    for (int i = 0; i < 4; ++i) {
      u32x2 o = {cvtpk(v[i][0], v[i][1]), cvtpk(v[i][2], v[i][3])};
      *(u32x2*)(p.Xb + (size_t)t * 1024 + i * 256 + lane * 4) = o;
    }
    if (lane == 0) p.rstd1[t] = rsqrtf(ss * (1.f / 1024.f) + EPS);
  }
  transpose_w<1>(p.WinT, p.w_in, p.attn_norm_g, nullptr, 1280, 1024, 1184, gt, gs);
  transpose_w<0>(p.WuqT, p.w_uq, p.q_lat_g, nullptr, 768, 384, 768, gt, gs);
  transpose_w<0>(p.WukvT, p.w_ukv, p.kv_lat_g, nullptr, 1024, 256, 1024, gt, gs);
  transpose_w<2>(p.WoutT, p.w_out, p.attn_out_g, p.fnet_out_g, 1024, 1024, 1024, gt, gs);
  transpose_w<0>(p.WpqT, p.peer_w_q, p.ffn_norm_g, nullptr, 2048, 1024, 2048, gt, gs);
  for (int id = gt; id < 262144 / 4; id += gs) {
    f32x4 v = *(const f32x4*)(p.peer_sub_keys + (size_t)id * 4);
    u32x2 o = {cvtpk(v[0], v[1]), cvtpk(v[2], v[3])};
    *(u32x2*)(p.SK + (size_t)id * 4) = o;
  }
  for (int id = gt; id < 256 * 128; id += gs) {
    const int n = id >> 7, c = id & 127, pp = n >> 7, m = n & 127;
    const float fr = (float)((m * c) & 127) * (1.f / 128.f);
    const float val = (pp == 0 ? __builtin_amdgcn_cosf(fr) : -__builtin_amdgcn_sinf(fr)) * 0.08838834764831845f;
    p.Wc[id] = f2bf(val);
  }
  for (int id = gt; id < 128 * 128; id += gs) {
    const int n = id >> 7, k = id & 127;
    const int k1 = (n >> 6) * 32 + (n & 31), pq = (n >> 5) & 1, pp = k >> 6, s1 = k & 63;
    const float fr = (float)((s1 * k1) & 63) * (1.f / 64.f);
    const float c = __builtin_amdgcn_cosf(fr), s = __builtin_amdgcn_sinf(fr);
    const float val = (pq == 0 ? (pp == 0 ? c : s) : (pp == 0 ? -s : c)) * 0.125f;
    p.WA64[id] = f2bf(val);
  }
  for (int id = gt; id < 128 * 64; id += gs) {
    const int n = id >> 6, k = id & 63;
    const int k1 = n & 31, pq = (n >> 5) & 1, pp = k >> 5, s1 = k & 31;
    const float fr = (float)((s1 * k1) & 31) * (1.f / 32.f);
    const float c = __builtin_amdgcn_cosf(fr), s = __builtin_amdgcn_sinf(fr);
    float val = (pq == 0 ? (pp == 0 ? c : s) : (pp == 0 ? -s : c)) * 0.17677669529663687f;
    if (n >= 64) val = 0.f;
    p.WA32[id] = f2bf(val);
  }
  for (int id = gt; id < 128 * 256; id += gs) {
    const int k2 = id >> 8, k = id & 255, pq = k >> 7, s2 = k & 127;
    const float fr = (float)((s2 * k2) & 127) * (1.f / 128.f);
    const float val = (pq == 0 ? __builtin_amdgcn_cosf(fr) : __builtin_amdgcn_sinf(fr)) * 0.08838834764831845f;
    p.WB[id] = f2bf(val);
  }
  for (int id = gt; id < 8192 * 16; id += gs) {
    const int pos = id >> 4, j = id & 15;
    const float freq = exp2f(-(float)j * (13.287712379549449f / 16.f));
    const double rev = (double)pos * (double)freq * 0.15915494309189535;
    const float fr = (float)(rev - floor(rev));
    p.ropec[id] = __builtin_amdgcn_cosf(fr);
    p.ropes[id] = __builtin_amdgcn_sinf(fr);
  }
}

DI void phase1(const Params& p, char* smem) {
    float* rs = (float*)(smem + 65536);
  const int G = gridDim.x;
  for (int tile = vblock(); tile < 384 * 10; tile += G) {
    WAVE_COORDS_L
    const int mt = tile / 10, nt = tile - mt * 10, m0 = mt * 128, n0 = nt * 128;
    __syncthreads();
    if (tid < 128) rs[tid] = p.rstd1[m0 + tid];
    f32x16 acc[2][2]; zero_acc(acc);
    const u16* A = p.Xb + (size_t)m0 * 1024; const u16* B = p.WinT + (size_t)n0 * 1024;
    gemm_mainloop<true>(acc, smem, [&](int rr) { return A + (size_t)rr * 1024; }, [&](int rr) { return B + (size_t)rr * 1024; }, 0, 1024);
    if (nt == 9) {
      if (wn == 0) {
#pragma unroll
        for (int mi = 0; mi < 2; ++mi)
#pragma unroll
          for (int i = 0; i < 16; ++i) {
            const int ro = mi * 32 + (i & 3) + 8 * (i >> 2);
            p.KR[(size_t)(m0 + wm * 64 + 4 * h + ro) * 32 + r] = acc[mi][0][i] * rs[wm * 64 + 4 * h + ro];
          }
      }
    } else {
      stage_bf16_t<true>(smem, acc, rs, wm, wn, r, h);
      __syncthreads();
      u16* dbase; int dstride, cbase;
      if (nt < 3) { dbase = p.CQ; dstride = 384; cbase = n0; }
      else if (nt < 5) { dbase = p.CKV; dstride = 256; cbase = n0 - 384; }
      else { dbase = p.F; dstride = 512; cbase = n0 - 640; }
#pragma unroll
      for (int j = 0; j < 8; ++j) {
        const int id = tid + 256 * j, row = id >> 4, cc = id & 15;
        const u32x4 v = *(const u32x4*)(smem + row * SROW + cc * 16);
        *(u32x4*)(dbase + (size_t)(m0 + row) * dstride + cbase + cc * 8) = v;
        if (nt < 5) {
          float ss = sumsq8(v);
          ss += __shfl_xor(ss, 1); ss += __shfl_xor(ss, 2); ss += __shfl_xor(ss, 4); ss += __shfl_xor(ss, 8);
          if (cc == 0) p.SSP[(size_t)(m0 + row) * 10 + nt * 2] = ss;
        }
      }
    }
  }
}

DI void phase2(const Params& p, char* smem) {
    float* rs = (float*)(smem + 65536);
  const int G = gridDim.x;
  const int NUQ = 384 * 6, NUKV = 384 * 8, NCH = 384 * 8;
  for (int tile = vblock(); tile < NUQ + NUKV + NCH; tile += G) {
    WAVE_COORDS_L
    f32x16 acc[2][2]; zero_acc(acc);
    __syncthreads();
    if (tile < NUQ) {
      const int mt = tile / 6, nt = tile - mt * 6, m0 = mt * 128, n0 = nt * 128;
      if (tid < 128) {
        const float* s = p.SSP + (size_t)(m0 + tid) * 10;
        rs[tid] = rsqrtf((s[0] + s[2] + s[4]) * (1.f / 384.f) + EPS);
      }
      const u16* A = p.CQ + (size_t)m0 * 384; const u16* B = p.WuqT + (size_t)n0 * 384;
      gemm_mainloop(acc, smem, [&](int rr) { return A + (size_t)rr * 384; }, [&](int rr) { return B + (size_t)rr * 384; }, 0, 384);
      stage_bf16_t<true>(smem, acc, rs, wm, wn, r, h);
      __syncthreads();
#pragma unroll
      for (int j = 0; j < 8; ++j) {
        const int id = tid + 256 * j, row = id >> 4, cc = id & 15;
        *(u32x4*)(p.Q1 + (size_t)(m0 + row) * 768 + n0 + cc * 8) = *(const u32x4*)(smem + row * SROW + cc * 16);
      }
    } else if (tile < NUQ + NUKV) {
      const int tl = tile - NUQ;
      const int mt = tl >> 3, hh = tl & 7, m0 = mt * 128;
      int q, S, tb; tok2seq(m0, q, S, tb);
      if (tid < 128) {
        const float* s = p.SSP + (size_t)(m0 + tid) * 10;
        rs[tid] = rsqrtf((s[6] + s[8]) * (1.f / 256.f) + EPS);
      }
      const u16* A = p.CKV + (size_t)m0 * 256; const u16* B = p.WukvT + (size_t)hh * 128 * 256;
      gemm_mainloop(acc, smem, [&](int rr) { return A + (size_t)rr * 256; }, [&](int rr) { return B + (size_t)rr * 256; }, 0, 256);
      if (wn == 0) {
#pragma unroll
        for (int mi = 0; mi < 2; ++mi)
#pragma unroll
          for (int i = 0; i < 16; ++i) {
            const int ro = mi * 32 + (i & 3) + 8 * (i >> 2);
            const float sc = (rs + wm * 64 + 4 * h)[ro];
#pragma unroll
            for (int ni = 0; ni < 2; ++ni) *(u16*)(smem + (wm * 64 + 4 * h) * SROW + r * 2 + ro * SROW + ni * 64) = f2bf(acc[mi][ni][i] * sc);
          }
      } else {
        const int s0 = m0 - tb;
#pragma unroll
        for (int mi = 0; mi < 2; ++mi)
#pragma unroll
          for (int g4 = 0; g4 < 4; ++g4) {
            const int row = wm * 64 + mi * 32 + 8 * g4 + 4 * h;
            const f32x4 sc = *(const f32x4*)(rs + row);
#pragma unroll
            for (int ni = 0; ni < 2; ++ni) {
              const int dv = ni * 32 + r;
              u32x2 o = {cvtpk(acc[mi][ni][4 * g4] * sc[0], acc[mi][ni][4 * g4 + 1] * sc[1]),
                         cvtpk(acc[mi][ni][4 * g4 + 2] * sc[2], acc[mi][ni][4 * g4 + 3] * sc[3])};
              *(u32x2*)(p.Vt + (size_t)tb * 512 + (size_t)(hh * 64 + dv) * S + s0 + row) = o;
            }
            __builtin_amdgcn_sched_barrier(0);
          }
      }
      __syncthreads();
#pragma unroll
      for (int j = 0; j < 4; ++j) {
        const int id = tid + 256 * j, row = id >> 3, cc = id & 7;
        *(u32x4*)(p.K1 + (size_t)(m0 + row) * 512 + hh * 64 + cc * 8) = *(const u32x4*)(smem + row * SROW + cc * 16);
      }
    } else {
      const int tl = tile - NUQ - NUKV;
      const int pp = tl & 1, g = (tl >> 1) & 3, mt = tl >> 3, m0 = mt * 128;
      int q, S, tb; tok2seq(m0, q, S, tb);
      const int S1 = (q < 2) ? 64 : 32, l1 = (q < 2) ? 6 : 5;
      const int j0 = ((m0 - tb) >> 7) * (128 >> l1);
      const u16* Fb = p.F + (size_t)g * 128;
      const u16* B = p.Wc + (size_t)pp * 128 * 128;
      gemm_mainloop(acc, smem,
                    [&](int rr) { const int s1 = rr & (S1 - 1), s2 = j0 + (rr >> l1); return Fb + (size_t)(tb + s1 * 128 + s2) * 512; },
                    [&](int rr) { return B + (size_t)rr * 128; }, 0, 128);
      u16* Zb = p.Z1 + (size_t)tb * 1024;
#pragma unroll
      for (int mi = 0; mi < 2; ++mi)
#pragma unroll
        for (int g4 = 0; g4 < 4; ++g4) {
          const int rho = wm * 64 + mi * 32 + 8 * g4 + 4 * h;
          const int s1 = rho & (S1 - 1), s2 = j0 + (rho >> l1);
#pragma unroll
          for (int ni = 0; ni < 2; ++ni) {
            const int m = wn * 64 + ni * 32 + r;
            u32x2 o = {cvtpk(acc[mi][ni][4 * g4], acc[mi][ni][4 * g4 + 1]), cvtpk(acc[mi][ni][4 * g4 + 2], acc[mi][ni][4 * g4 + 3])};
            *(u32x2*)(Zb + ((size_t)((g * 128 + m) * 128 + s2) * (2 * S1)) + pp * S1 + s1) = o;
          }
          __builtin_amdgcn_sched_barrier(0);
        }
    }
  }
}

DI void phase3(const Params& p, char* smem) {
    const int G = gridDim.x;
  for (int tile = vblock(); tile < 5120; tile += G) {
    WAVE_COORDS_L
    const int q = tile >> 9, gm = tile & 511;
    const int tb = (q < 2) ? (q << 13) : (TP + ((q - 2) << 12));
    const int S = (q < 2) ? 8192 : 4096, S1 = (q < 2) ? 64 : 32, K = 2 * S1;
    f32x16 acc[2][2]; zero_acc(acc);
    const u16* A = p.Z1 + (size_t)tb * 1024 + (size_t)gm * 128 * K;
    const u16* B = (q < 2) ? p.WA64 : p.WA32;
    gemm_mainloop(acc, smem, [&](int rr) { return A + (size_t)rr * K; }, [&](int rr) { return B + (size_t)rr * K; }, 0, K);
    if (wn * 32 < S1) {
      const int k1 = wn * 32 + r;
      const float invS = 1.f / (float)S;
      u16* Gb = p.G1 + (size_t)tb * 1024 + (size_t)(gm * S1 + k1) * 256;
#pragma unroll
      for (int mi = 0; mi < 2; ++mi)
#pragma unroll
        for (int g4 = 0; g4 < 4; ++g4) {
          const int s2b = wm * 64 + mi * 32 + 8 * g4 + 4 * h;
          float ore[4], oim[4];
#pragma unroll
          for (int j = 0; j < 4; ++j) {
            const int s2 = s2b + j;
            const float fr = (float)((s2 * k1) & (S - 1)) * invS;
            const float c = __builtin_amdgcn_cosf(fr), s = __builtin_amdgcn_sinf(fr);
            const float re = acc[mi][0][4 * g4 + j], im = acc[mi][1][4 * g4 + j];
            ore[j] = re * c + im * s; oim[j] = im * c - re * s;
          }
          u32x2 o0 = {cvtpk(ore[0], ore[1]), cvtpk(ore[2], ore[3])};
          u32x2 o1 = {cvtpk(oim[0], oim[1]), cvtpk(oim[2], oim[3])};
          *(u32x2*)(Gb + s2b) = o0;
          *(u32x2*)(Gb + 128 + s2b) = o1;
        }
    }
  }
  const float QSCALE = 0.10206207261596575f * 1.4426950408889634f;
  for (int chunk = vblock(); chunk < T_TOK * 8 / NTHR; chunk += G) {
    WAVE_COORDS_L
    const int id = chunk * NTHR + tid;
    const int t = id >> 3, hh = id & 7;
    int q, S, tb; tok2seq(t, q, S, tb);
    const int s = t - tb;
    const size_t obase = ((size_t)tb * 8 + (size_t)hh * S + s) * 96;
    const float* rcp = p.ropec + s * 16; const float* rsp = p.ropes + s * 16;
    {
      u32x4 w[12];
      const u16* src = p.Q1 + (size_t)t * 768 + hh * 96;
#pragma unroll
      for (int i = 0; i < 12; ++i) w[i] = *(const u32x4*)(src + i * 8);
      float ss = 0.f;
#pragma unroll
      for (int i = 0; i < 12; ++i)
#pragma unroll
        for (int j = 0; j < 4; ++j) { const float a = bflo(w[i][j]), b = bfhi(w[i][j]); ss += a * a + b * b; }
      const float rinv = rsqrtf(ss * (1.f / 96.f) + EPS);
      u16* dst = p.Qn + obase;
#pragma unroll
      for (int i = 0; i < 8; ++i) {
        u32x4 o;
#pragma unroll
        for (int j = 0; j < 4; ++j) {
          const int d = i * 8 + j * 2;
          o[j] = cvtpk(bflo(w[i][j]) * rinv * p.q_head_g[d] * QSCALE, bfhi(w[i][j]) * rinv * p.q_head_g[d + 1] * QSCALE);
        }
        *(u32x4*)(dst + i * 8) = o;
      }
      float x1[16], x2[16];
#pragma unroll
      for (int i = 0; i < 2; ++i)
#pragma unroll
        for (int j = 0; j < 4; ++j) {
          const int e = i * 8 + j * 2;
          x1[e] = bflo(w[8 + i][j]) * rinv * p.q_head_g[64 + e]; x1[e + 1] = bfhi(w[8 + i][j]) * rinv * p.q_head_g[64 + e + 1];
          x2[e] = bflo(w[10 + i][j]) * rinv * p.q_head_g[80 + e]; x2[e + 1] = bfhi(w[10 + i][j]) * rinv * p.q_head_g[80 + e + 1];
        }
      float o1[16], o2[16];
#pragma unroll
      for (int e = 0; e < 16; ++e) {
        const float c = rcp[e], sn = rsp[e];
        o1[e] = (x1[e] * c - x2[e] * sn) * QSCALE; o2[e] = (x2[e] * c + x1[e] * sn) * QSCALE;
      }
#pragma unroll
      for (int i = 0; i < 2; ++i) {
        u32x4 a, b;
#pragma unroll
        for (int j = 0; j < 4; ++j) { a[j] = cvtpk(o1[i * 8 + j * 2], o1[i * 8 + j * 2 + 1]); b[j] = cvtpk(o2[i * 8 + j * 2], o2[i * 8 + j * 2 + 1]); }
        *(u32x4*)(dst + 64 + i * 8) = a;
        *(u32x4*)(dst + 80 + i * 8) = b;
      }
    }
    __builtin_amdgcn_sched_barrier(0);
    {
      u32x4 w[8];
      const u16* src = p.K1 + (size_t)t * 512 + hh * 64;
#pragma unroll
      for (int i = 0; i < 8; ++i) w[i] = *(const u32x4*)(src + i * 8);
      f32x4 kr[8];
#pragma unroll
      for (int i = 0; i < 8; ++i) kr[i] = *(const f32x4*)(p.KR + (size_t)t * 32 + i * 4);
      float ss = 0.f;
#pragma unroll
      for (int i = 0; i < 8; ++i)
#pragma unroll
        for (int j = 0; j < 4; ++j) { const float a = bflo(w[i][j]), b = bfhi(w[i][j]); ss += a * a + b * b + kr[i][j] * kr[i][j]; }
      const float rinv = rsqrtf(ss * (1.f / 96.f) + EPS);
      u16* dst = p.Kn + obase;
#pragma unroll
      for (int i = 0; i < 8; ++i) {
        u32x4 o;
#pragma unroll
        for (int j = 0; j < 4; ++j) {
          const int d = i * 8 + j * 2;
          o[j] = cvtpk(bflo(w[i][j]) * rinv * p.k_head_g[d], bfhi(w[i][j]) * rinv * p.k_head_g[d + 1]);
        }
        *(u32x4*)(dst + i * 8) = o;
      }
      float o1[16], o2[16];
#pragma unroll
      for (int e = 0; e < 16; ++e) {
        const float a = kr[e >> 2][e & 3] * rinv * p.k_head_g[64 + e];
        const float b = kr[4 + (e >> 2)][e & 3] * rinv * p.k_head_g[80 + e];
        const float c = rcp[e], sn = rsp[e];
        o1[e] = a * c - b * sn; o2[e] = b * c + a * sn;
      }
#pragma unroll
      for (int i = 0; i < 2; ++i) {
        u32x4 a, b;
#pragma unroll
        for (int j = 0; j < 4; ++j) { a[j] = cvtpk(o1[i * 8 + j * 2], o1[i * 8 + j * 2 + 1]); b[j] = cvtpk(o2[i * 8 + j * 2], o2[i * 8 + j * 2 + 1]); }
        *(u32x4*)(dst + 64 + i * 8) = a;
        *(u32x4*)(dst + 80 + i * 8) = b;
      }
    }
  }
}

constexpr int KSTR = 208, VSTR = 136, ABUF = 64 * KSTR + 64 * VSTR;

DI void attn_tile(const Params& p, char* smem, int a) {
  WAVE_COORDS
  int q, hh, qt, S, tb;
  if (a < 1024) { q = a >> 9; hh = (a >> 6) & 7; qt = a & 63; S = 8192; tb = q << 13; }
  else { const int b = a - 1024; q = 2 + (b >> 8); hh = (b >> 5) & 7; qt = b & 31; S = 4096; tb = TP + ((q - 2) << 12); }
  const size_t qkb = ((size_t)tb * 8 + (size_t)hh * S) * 96;
  const u16* Qb = p.Qn + qkb; const u16* Kb = p.Kn + qkb;
  const u16* Vb = p.Vt + (size_t)tb * 512 + (size_t)hh * 64 * S;
  const int qrow = qt * 128 + wave * 32 + r;
  bf16x8 qf[6];
#pragma unroll
  for (int ks = 0; ks < 6; ++ks) qf[ks] = *(const bf16x8*)(Qb + (size_t)qrow * 96 + ks * 16 + h * 8);
  f32x16 o[2];
#pragma unroll
  for (int i = 0; i < 16; ++i) { o[0][i] = 0.f; o[1][i] = 0.f; }
  float mrun = -1e30f, lrun = 0.f;
  int krow_[3], kc_[3], vrow_[2], vc_[2];
#pragma unroll
  for (int i = 0; i < 3; ++i) { const int id = tid + 256 * i; krow_[i] = id / 12; kc_[i] = id - krow_[i] * 12; }
#pragma unroll
  for (int i = 0; i < 2; ++i) { const int id = tid + 256 * i; vrow_[i] = id >> 3; vc_[i] = id & 7; }
  u32x4 rk[3], rv[2];
  const int nkt = S >> 6;
#pragma unroll
  for (int i = 0; i < 3; ++i) rk[i] = *(const u32x4*)(Kb + (size_t)krow_[i] * 96 + kc_[i] * 8);
#pragma unroll
  for (int i = 0; i < 2; ++i) rv[i] = *(const u32x4*)(Vb + (size_t)vrow_[i] * S + vc_[i] * 8);
  __syncthreads();
#pragma unroll
  for (int i = 0; i < 3; ++i) *(u32x4*)(smem + krow_[i] * KSTR + kc_[i] * 16) = rk[i];
#pragma unroll
  for (int i = 0; i < 2; ++i) {
    char* d = smem + 64 * KSTR + vrow_[i] * VSTR + vc_[i] * 16;
    *(u32x2*)d = u32x2{rv[i][0], rv[i][1]}; *(u32x2*)(d + 8) = u32x2{rv[i][2], rv[i][3]};
  }
  __syncthreads();
  int cur = 0;
  for (int kt = 0; kt < nkt; ++kt) {
    const bool nxt = (kt + 1 < nkt);
    if (nxt) {
#pragma unroll
      for (int i = 0; i < 3; ++i) rk[i] = *(const u32x4*)(Kb + (size_t)((kt + 1) * 64 + krow_[i]) * 96 + kc_[i] * 8);
#pragma unroll
      for (int i = 0; i < 2; ++i) rv[i] = *(const u32x4*)(Vb + (size_t)vrow_[i] * S + (kt + 1) * 64 + vc_[i] * 8);
    }
    __builtin_amdgcn_sched_barrier(0);
    const char* Ks = smem + cur * ABUF;
    const char* Vs = Ks + 64 * KSTR;
    f32x16 sacc[2];
#pragma unroll
    for (int i = 0; i < 16; ++i) { sacc[0][i] = 0.f; sacc[1][i] = 0.f; }
#pragma unroll
    for (int t2 = 0; t2 < 2; ++t2)
#pragma unroll
      for (int ks = 0; ks < 6; ++ks) {
        const bf16x8 kf = *(const bf16x8*)(Ks + (t2 * 32 + r) * KSTR + ks * 32 + h * 16);
        sacc[t2] = MFMA(kf, qf[ks], sacc[t2]);
      }
    float mx = sacc[0][0];
#pragma unroll
    for (int i = 0; i < 16; ++i) { mx = fmaxf(mx, sacc[0][i]); mx = fmaxf(mx, sacc[1][i]); }
    mx = fmaxf(mx, __shfl_xor(mx, 32));
    const float mnew = fmaxf(mrun, mx);
    const float alpha = __builtin_amdgcn_exp2f(mrun - mnew);
    mrun = mnew;
    lrun *= alpha;
#pragma unroll
    for (int i = 0; i < 16; ++i) { o[0][i] *= alpha; o[1][i] *= alpha; }
    float ps = 0.f;
#pragma unroll
    for (int t2 = 0; t2 < 2; ++t2)
#pragma unroll
      for (int i = 0; i < 16; ++i) { const float e = __builtin_amdgcn_exp2f(sacc[t2][i] - mnew); sacc[t2][i] = e; ps += e; }
    lrun += ps;
    bf16x8 pf[4];
#pragma unroll
    for (int kk = 0; kk < 4; ++kk) {
      const int t2 = kk >> 1, s8 = (kk & 1) * 8;
      u32x4 pk = {cvtpk(sacc[t2][s8], sacc[t2][s8 + 1]), cvtpk(sacc[t2][s8 + 2], sacc[t2][s8 + 3]),
                  cvtpk(sacc[t2][s8 + 4], sacc[t2][s8 + 5]), cvtpk(sacc[t2][s8 + 6], sacc[t2][s8 + 7])};
      pf[kk] = __builtin_bit_cast(bf16x8, pk);
    }
#pragma unroll
    for (int dt = 0; dt < 2; ++dt)
#pragma unroll
      for (int kk = 0; kk < 4; ++kk) {
        const char* vp = Vs + (dt * 32 + r) * VSTR + kk * 32 + h * 8;
        const u32x2 lo = *(const u32x2*)vp, hi = *(const u32x2*)(vp + 16);
        u32x4 vv = {lo[0], lo[1], hi[0], hi[1]};
        o[dt] = MFMA(__builtin_bit_cast(bf16x8, vv), pf[kk], o[dt]);
      }
    __builtin_amdgcn_sched_barrier(0);
    if (nxt) {
      char* Kn_ = smem + (cur ^ 1) * ABUF;
#pragma unroll
      for (int i = 0; i < 3; ++i) *(u32x4*)(Kn_ + krow_[i] * KSTR + kc_[i] * 16) = rk[i];
#pragma unroll
      for (int i = 0; i < 2; ++i) {
        char* d = Kn_ + 64 * KSTR + vrow_[i] * VSTR + vc_[i] * 16;
        *(u32x2*)d = u32x2{rv[i][0], rv[i][1]}; *(u32x2*)(d + 8) = u32x2{rv[i][2], rv[i][3]};
      }
    }
    __syncthreads();
    cur ^= 1;
  }
  lrun += __shfl_xor(lrun, 32);
  const float inv = 1.f / lrun;
  float ss = 0.f;
  u16* dst = p.MIX + (size_t)(tb + qrow) * 1024 + hh * 64;
#pragma unroll
  for (int dt = 0; dt < 2; ++dt)
#pragma unroll
    for (int g4 = 0; g4 < 4; ++g4) {
      float v[4];
#pragma unroll
      for (int j = 0; j < 4; ++j) { v[j] = o[dt][4 * g4 + j] * inv; ss += v[j] * v[j]; }
      u32x2 ov = {cvtpk(v[0], v[1]), cvtpk(v[2], v[3])};
      *(u32x2*)(dst + dt * 32 + 8 * g4 + 4 * h) = ov;
    }
  ss += __shfl_xor(ss, 32);
  if (h == 0) p.SSA[(size_t)(tb + qrow) * 8 + hh] = ss;
}

constexpr int VSTR2 = 144, ABUF2 = 64 * KSTR + 64 * VSTR2;
DI float swapmax32(float v) {
  auto rr = __builtin_amdgcn_permlane32_swap(__float_as_uint(v), __float_as_uint(v), false, false);
  return fmaxf(__uint_as_float(rr[0]), __uint_as_float(rr[1]));
}
DI float swapsum32(float v) {
  auto rr = __builtin_amdgcn_permlane32_swap(__float_as_uint(v), __float_as_uint(v), false, false);
  return __uint_as_float(rr[0]) + __uint_as_float(rr[1]);
}
template <bool RUNMAX>
DI void attn_tile2(const Params& p, char* smem, int a) {
  WAVE_COORDS_L
  int q, hh, qt, S, tb;
  if (a < 512) { q = a >> 8; hh = (a >> 5) & 7; qt = a & 31; S = 8192; tb = q << 13; }
  else { const int b = a - 512; q = 2 + (b >> 7); hh = (b >> 4) & 7; qt = b & 15; S = 4096; tb = TP + ((q - 2) << 12); }
  const size_t qkb = ((size_t)tb * 8 + (size_t)hh * S) * 96;
  const u16* Qb = p.Qn + qkb; const u16* Kb = p.Kn + qkb;
  const u16* Vb = p.Vt + (size_t)tb * 512 + (size_t)hh * 64 * S;
  const int qrow0 = qt * 256 + wave * 64 + r;
  bf16x8 qf[2][6];
#pragma unroll
  for (int g = 0; g < 2; ++g)
#pragma unroll
    for (int ks = 0; ks < 6; ++ks) qf[g][ks] = *(const bf16x8*)(Qb + (size_t)(qrow0 + 32 * g) * 96 + ks * 16 + h * 8);
  f32x16 o[2][2];
#pragma unroll
  for (int i = 0; i < 16; ++i) { o[0][0][i] = 0.f; o[0][1][i] = 0.f; o[1][0][i] = 0.f; o[1][1][i] = 0.f; }
  float mrun[2] = {-1e30f, -1e30f}, lrun[2] = {0.f, 0.f};
  int klds_[3], vlds_[2];
#pragma unroll
  for (int i = 0; i < 3; ++i) { const int id = tid + 256 * i; const int kr = id / 12; klds_[i] = kr * KSTR + (id - kr * 12) * 16; }
#pragma unroll
  for (int i = 0; i < 2; ++i) { const int vc = tid & 7; vlds_[i] = 64 * KSTR + ((tid >> 3) + 32 * i) * VSTR2 + (vc >> 1) * 32 + (vc & 1) * 8; }
  const u16* Kg = Kb + tid * 8;
  const u16* Vg = Vb + (size_t)(tid >> 3) * S + (tid & 7) * 8;
  u32x4 rk[3], rv[2];
  const int nkt = S >> 6;
#pragma unroll
  for (int i = 0; i < 3; ++i) rk[i] = *(const u32x4*)(Kg + i * 2048);
#pragma unroll
  for (int i = 0; i < 2; ++i) rv[i] = *(const u32x4*)(Vg + (size_t)(32 * i) * S);
  __syncthreads();
  auto put = [&](char* base) {
#pragma unroll
    for (int i = 0; i < 3; ++i) *(u32x4*)(base + klds_[i]) = rk[i];
#pragma unroll
    for (int i = 0; i < 2; ++i) {
      char* d = base + vlds_[i];
      *(u32x2*)d = u32x2{rv[i][0], rv[i][1]}; *(u32x2*)(d + 16) = u32x2{rv[i][2], rv[i][3]};
    }
  };
  put(smem);
  __syncthreads();
  int cur = 0;
#pragma unroll 1
  for (int kt = 0; kt < nkt; ++kt) {
    const bool nxt = (kt + 1 < nkt);
    if (nxt) {
#pragma unroll
      for (int i = 0; i < 3; ++i) rk[i] = *(const u32x4*)(Kg + (size_t)(kt + 1) * 6144 + i * 2048);
#pragma unroll
      for (int i = 0; i < 2; ++i) rv[i] = *(const u32x4*)(Vg + (size_t)(32 * i) * S + (kt + 1) * 64);
    }
    __builtin_amdgcn_sched_barrier(0);
    const char* Ks = smem + cur * ABUF2;
    const char* Vs = Ks + 64 * KSTR;
#pragma unroll
    for (int t2 = 0; t2 < 2; ++t2) {
      f32x16 sacc[2];
#pragma unroll
      for (int i = 0; i < 16; ++i) { sacc[0][i] = 0.f; sacc[1][i] = 0.f; }
#pragma unroll
      for (int kb = 0; kb < 2; ++kb) {
        bf16x8 kf[3];
#pragma unroll
        for (int ks = 0; ks < 3; ++ks) kf[ks] = *(const bf16x8*)(Ks + (t2 * 32 + r) * KSTR + (kb * 3 + ks) * 32 + h * 16);
#pragma unroll
        for (int ks = 0; ks < 3; ++ks) {
          sacc[0] = MFMA(kf[ks], qf[0][kb * 3 + ks], sacc[0]);
          sacc[1] = MFMA(kf[ks], qf[1][kb * 3 + ks], sacc[1]);
        }
      }
      __builtin_amdgcn_sched_barrier(0);
      bf16x8 pf[2][2];
#pragma unroll
      for (int g = 0; g < 2; ++g) {
        float ps = 0.f;
        if (RUNMAX) {
        float mx = sacc[g][0];
#pragma unroll
        for (int i = 1; i < 16; ++i) mx = fmaxf(mx, sacc[g][i]);
        mx = swapmax32(mx);
        const float mnew = fmaxf(mrun[g], mx);
        if (__ballot(mnew > mrun[g]) != 0ull) {
          const float alpha = __builtin_amdgcn_exp2f(mrun[g] - mnew);
          lrun[g] *= alpha;
#pragma unroll
          for (int i = 0; i < 16; ++i) { o[g][0][i] *= alpha; o[g][1][i] *= alpha; }
          mrun[g] = mnew;
        }
#pragma unroll
        for (int i = 0; i < 16; ++i) { const float e = __builtin_amdgcn_exp2f(sacc[g][i] - mrun[g]); sacc[g][i] = e; ps += e; }
        } else {
#pragma unroll
          for (int i = 0; i < 16; ++i) sacc[g][i] = __builtin_amdgcn_exp2f(sacc[g][i]);
        }
#pragma unroll
        for (int s = 0; s < 2; ++s) {
          const int s8 = s * 8;
          u32x4 pk = {cvtpk(sacc[g][s8], sacc[g][s8 + 1]), cvtpk(sacc[g][s8 + 2], sacc[g][s8 + 3]),
                      cvtpk(sacc[g][s8 + 4], sacc[g][s8 + 5]), cvtpk(sacc[g][s8 + 6], sacc[g][s8 + 7])};
          pf[g][s] = __builtin_bit_cast(bf16x8, pk);
          if (!RUNMAX) {
#pragma unroll
            for (int w = 0; w < 4; ++w) ps = fdot2(pk[w], 0x3F803F80u, ps);
          }
        }
        lrun[g] += ps;
      }
      __builtin_amdgcn_sched_barrier(0);
#pragma unroll
      for (int dt = 0; dt < 2; ++dt) {
        bf16x8 vf[2];
#pragma unroll
        for (int s = 0; s < 2; ++s) vf[s] = *(const bf16x8*)(Vs + (dt * 32 + r) * VSTR2 + (t2 * 2 + s) * 32 + h * 16);
#pragma unroll
        for (int s = 0; s < 2; ++s) {
          o[0][dt] = MFMA(vf[s], pf[0][s], o[0][dt]);
          o[1][dt] = MFMA(vf[s], pf[1][s], o[1][dt]);
        }
      }
    }
    __builtin_amdgcn_sched_barrier(0);
    if (nxt) put(smem + (cur ^ 1) * ABUF2);
    __syncthreads();
    cur ^= 1;
  }
#pragma unroll
  for (int g = 0; g < 2; ++g) {
    const float lsum = swapsum32(lrun[g]);
    const float inv = 1.f / lsum;
    const int qrow = qrow0 + 32 * g;
    float ss = 0.f;
    u16* dst = p.MIX + (size_t)(tb + qrow) * 1024 + hh * 64;
#pragma unroll
    for (int dt = 0; dt < 2; ++dt)
#pragma unroll
      for (int g4 = 0; g4 < 4; ++g4) {
        float v[4];
#pragma unroll
        for (int jj = 0; jj < 4; ++jj) { v[jj] = o[g][dt][4 * g4 + jj] * inv; ss += v[jj] * v[jj]; }
        u32x2 ov = {cvtpk(v[0], v[1]), cvtpk(v[2], v[3])};
        *(u32x2*)(dst + dt * 32 + 8 * g4 + 4 * h) = ov;
      }
    ss = swapsum32(ss);
    if (h == 0) p.SSA[(size_t)(tb + qrow) * 8 + hh] = ss;
  }
}

DI void phase4(const Params& p, char* smem) {
    const int G = gridDim.x;
  if (p.misc[0] > 64.f) { for (int a = vblock(); a < 1536; a += G) attn_tile2<true>(p, smem, a); }
  else { for (int a = vblock(); a < 1536; a += G) attn_tile2<false>(p, smem, a); }
  for (int tile = vblock(); tile < 1536; tile += G) {
    WAVE_COORDS_L
    int q, g, k1, S1, tb;
    if (tile < 512) { q = tile >> 8; g = (tile >> 6) & 3; k1 = tile & 63; S1 = 64; tb = q << 13; }
    else { const int b = tile - 512; q = 2 + (b >> 7); g = (b >> 5) & 3; k1 = b & 31; S1 = 32; tb = TP + ((q - 2) << 12); }
    f32x16 acc[2][2]; zero_acc(acc);
    const u16* A = p.G1 + (size_t)tb * 1024 + ((size_t)(g * 128) * S1 + k1) * 256;
    const u16* B = p.WB;
    const int rstride = S1 * 256;
    gemm_mainloop(acc, smem, [&](int rr) { return A + (size_t)rr * rstride; }, [&](int rr) { return B + (size_t)rr * 256; }, 0, 256);
#pragma unroll
    for (int ni = 0; ni < 2; ++ni) {
      const int k2 = wn * 64 + ni * 32 + r;
      const size_t tok = (size_t)(tb + k1 + S1 * k2);
      float ss = 0.f;
#pragma unroll
      for (int mi = 0; mi < 2; ++mi)
#pragma unroll
        for (int g4 = 0; g4 < 4; ++g4) {
          const int m = wm * 64 + mi * 32 + 8 * g4 + 4 * h;
          float v[4];
#pragma unroll
          for (int j = 0; j < 4; ++j) { v[j] = acc[mi][ni][4 * g4 + j]; ss += v[j] * v[j]; }
          u32x2 ov = {cvtpk(v[0], v[1]), cvtpk(v[2], v[3])};
          *(u32x2*)(p.MIX + tok * 1024 + 512 + g * 128 + m) = ov;
        }
      ss += __shfl_xor(ss, 32);
      if (h == 0) p.SSF[tok * 8 + g * 2 + wm] = ss;
    }
  }
}

DI void phase5(const Params& p, char* smem) {
    float* rs = (float*)(smem + 65536);
  const int G = gridDim.x;
  for (int tile = vblock(); tile < 384 * 8; tile += G) {
    WAVE_COORDS_L
    const int mt = tile >> 3, nt = tile & 7, m0 = mt * 128, n0 = nt * 128;
    __syncthreads();
    if (tid < 128) {
      const float* sa = p.SSA + (size_t)(m0 + tid) * 8; const float* sf = p.SSF + (size_t)(m0 + tid) * 8;
      const float ra = rsqrtf((sa[0] + sa[1] + sa[2] + sa[3] + sa[4] + sa[5] + sa[6] + sa[7]) * (1.f / 512.f) + EPS);
      const float rf = rsqrtf((sf[0] + sf[1] + sf[2] + sf[3] + sf[4] + sf[5] + sf[6] + sf[7]) * (1.f / 512.f) + EPS);
      rs[tid] = ra / rf; rs[128 + tid] = rf;
    }
    f32x16 acc[2][2]; zero_acc(acc);
    const u16* A = p.MIX + (size_t)m0 * 1024; const u16* B = p.WoutT + (size_t)n0 * 1024;
    auto af = [&](int rr) { return A + (size_t)rr * 1024; };
    auto bfn = [&](int rr) { return B + (size_t)rr * 1024; };
    gemm_mainloop<true>(acc, smem, af, bfn, 0, 512);
    {
      const float* rb = rs + wm * 64 + 4 * h;
#pragma unroll
      for (int mi = 0; mi < 2; ++mi)
#pragma unroll
        for (int i = 0; i < 16; ++i) {
          const float sc = rb[mi * 32 + (i & 3) + 8 * (i >> 2)];
          acc[mi][0][i] *= sc; acc[mi][1][i] *= sc;
        }
    }
    gemm_mainloop<true>(acc, smem, af, bfn, 512, 1024);
    {
      const float* rb = rs + 128 + wm * 64 + 4 * h;
      char* sb = smem + (wm * 64 + 4 * h) * 512 + (wn * 64 + r) * 4;
#pragma unroll
      for (int mi = 0; mi < 2; ++mi)
#pragma unroll
        for (int i = 0; i < 16; ++i) {
          const int ro = mi * 32 + (i & 3) + 8 * (i >> 2);
          const float sc = rb[ro];
#pragma unroll
          for (int ni = 0; ni < 2; ++ni) *(float*)(sb + ro * 512 + ni * 128) = acc[mi][ni][i] * sc;
        }
    }
    __syncthreads();
#pragma unroll 4
    for (int j = 0; j < 16; ++j) {
      const int id = tid + 256 * j, row = id >> 5, cc = id & 31;
      const int t = m0 + row, col = n0 + cc * 4;
      f32x4 v = *(const f32x4*)(smem + row * 512 + cc * 16);
      const f32x4 xv = *(const f32x4*)(xrow(p, t) + col);
      v[0] += xv[0]; v[1] += xv[1]; v[2] += xv[2]; v[3] += xv[3];
      *(f32x4*)(p.out + (size_t)t * 1024 + col) = v;
      u32x2 ob = {cvtpk(v[0], v[1]), cvtpk(v[2], v[3])};
      *(u32x2*)(p.X2b + (size_t)t * 1024 + col) = ob;
      float ss = v[0] * v[0] + v[1] * v[1] + v[2] * v[2] + v[3] * v[3];
      ss = red32(ss);
      if (cc == 0) p.SS2[(size_t)t * 16 + nt] = ss;
    }
  }
  const int gt = blockIdx.x * NTHR + threadIdx.x, gs = gridDim.x * NTHR;
  for (int id = gt; id < 16384 * 1024 / 16; id += gs) {
    const int d = (id & 63) * 16;
    u32x4 ou, ov;
#pragma unroll
    for (int k = 0; k < 4; ++k) {
      const f32x4 a = *(const f32x4*)(p.peer_u + (size_t)id * 16 + k * 4);
      const f32x4 g = *(const f32x4*)(p.ffn_norm_g + d + k * 4);
      const f32x4 b = *(const f32x4*)(p.peer_v + (size_t)id * 16 + k * 4);
      float u0 = fminf(fmaxf(a[0] * g[0] * USCALE, -448.f), 448.f), u1 = fminf(fmaxf(a[1] * g[1] * USCALE, -448.f), 448.f);
      float u2 = fminf(fmaxf(a[2] * g[2] * USCALE, -448.f), 448.f), u3 = fminf(fmaxf(a[3] * g[3] * USCALE, -448.f), 448.f);
      float v0 = fminf(fmaxf(b[0] * VSCALE, -448.f), 448.f), v1 = fminf(fmaxf(b[1] * VSCALE, -448.f), 448.f);
      float v2 = fminf(fmaxf(b[2] * VSCALE, -448.f), 448.f), v3 = fminf(fmaxf(b[3] * VSCALE, -448.f), 448.f);
      int pu = __builtin_amdgcn_cvt_pk_fp8_f32(u0, u1, 0, false); pu = __builtin_amdgcn_cvt_pk_fp8_f32(u2, u3, pu, true);
      int pv = __builtin_amdgcn_cvt_pk_fp8_f32(v0, v1, 0, false); pv = __builtin_amdgcn_cvt_pk_fp8_f32(v2, v3, pv, true);
      ou[k] = (unsigned)pu; ov[k] = (unsigned)pv;
    }
    {
      const int e = id >> 6, ch = id & 63;
      const size_t o = ((size_t)(ch >> 3) * 16384 + e) * 128 + (ch & 7) * 16;
      *(u32x4*)(p.U8 + o) = ou;
      *(u32x4*)(p.V8 + o) = ov;
    }
  }
}

DI void phase6(const Params& p, char* smem) {
    const int G = gridDim.x;
  for (int tile = vblock(); tile < 384 * 16; tile += G) {
    WAVE_COORDS_L
    const int mt = tile >> 4, nt = tile & 15, m0 = mt * 128, n0 = nt * 128;
    f32x16 acc[2][2]; zero_acc(acc);
    __syncthreads();
    const u16* A = p.X2b + (size_t)m0 * 1024; const u16* B = p.WpqT + (size_t)n0 * 1024;
    gemm_mainloop<true>(acc, smem, [&](int rr) { return A + (size_t)rr * 1024; }, [&](int rr) { return B + (size_t)rr * 1024; }, 0, 1024);
    stage_bf16_t<false>(smem, acc, nullptr, wm, wn, r, h);
    __syncthreads();
#pragma unroll
    for (int j = 0; j < 8; ++j) {
      const int id = tid + 256 * j, row = id >> 4, cc = id & 15;
      *(u32x4*)(p.Qp + (size_t)(m0 + row) * 2048 + n0 + cc * 8) = *(const u32x4*)(smem + row * SROW + cc * 16);
    }
  }
}

DI void ins16(float (&top)[16], float x) {
#pragma unroll
  for (int j = 0; j < 16; ++j) { const float hi = fmaxf(top[j], x); x = fminf(top[j], x); top[j] = hi; }
}
DI float mask7(float x) { return __uint_as_float(__float_as_uint(x) & ~0x7Fu); }

#define CE16(a, b) { const float hi_ = fmaxf(a, b); b = fminf(a, b); a = hi_; }
DI void sort16_desc(float (&x)[16]) {
  CE16(x[0], x[1])
  CE16(x[3], x[2])
  CE16(x[4], x[5])
  CE16(x[7], x[6])
  CE16(x[8], x[9])
  CE16(x[11], x[10])
  CE16(x[12], x[13])
  CE16(x[15], x[14])
  CE16(x[0], x[2])
  CE16(x[1], x[3])
  CE16(x[6], x[4])
  CE16(x[7], x[5])
  CE16(x[8], x[10])
  CE16(x[9], x[11])
  CE16(x[14], x[12])
  CE16(x[15], x[13])
  CE16(x[0], x[1])
  CE16(x[2], x[3])
  CE16(x[5], x[4])
  CE16(x[7], x[6])
  CE16(x[8], x[9])
  CE16(x[10], x[11])
  CE16(x[13], x[12])
  CE16(x[15], x[14])
  CE16(x[0], x[4])
  CE16(x[1], x[5])
  CE16(x[2], x[6])
  CE16(x[3], x[7])
  CE16(x[12], x[8])
  CE16(x[13], x[9])
  CE16(x[14], x[10])
  CE16(x[15], x[11])
  CE16(x[0], x[2])
  CE16(x[1], x[3])
  CE16(x[4], x[6])
  CE16(x[5], x[7])
  CE16(x[10], x[8])
  CE16(x[11], x[9])
  CE16(x[14], x[12])
  CE16(x[15], x[13])
  CE16(x[0], x[1])
  CE16(x[2], x[3])
  CE16(x[4], x[5])
  CE16(x[6], x[7])
  CE16(x[9], x[8])
  CE16(x[11], x[10])
  CE16(x[13], x[12])
  CE16(x[15], x[14])
  CE16(x[0], x[8])
  CE16(x[1], x[9])
  CE16(x[2], x[10])
  CE16(x[3], x[11])
  CE16(x[4], x[12])
  CE16(x[5], x[13])
  CE16(x[6], x[14])
  CE16(x[7], x[15])
  CE16(x[0], x[4])
  CE16(x[1], x[5])
  CE16(x[2], x[6])
  CE16(x[3], x[7])
  CE16(x[8], x[12])
  CE16(x[9], x[13])
  CE16(x[10], x[14])
  CE16(x[11], x[15])
  CE16(x[0], x[2])
  CE16(x[1], x[3])
  CE16(x[4], x[6])
  CE16(x[5], x[7])
  CE16(x[8], x[10])
  CE16(x[9], x[11])
  CE16(x[12], x[14])
  CE16(x[13], x[15])
  CE16(x[0], x[1])
  CE16(x[2], x[3])
  CE16(x[4], x[5])
  CE16(x[6], x[7])
  CE16(x[8], x[9])
  CE16(x[10], x[11])
  CE16(x[12], x[13])
  CE16(x[14], x[15])
}
DI void bmerge16_desc(float (&x)[16]) {
  CE16(x[0], x[8])
  CE16(x[1], x[9])
  CE16(x[2], x[10])
  CE16(x[3], x[11])
  CE16(x[4], x[12])
  CE16(x[5], x[13])
  CE16(x[6], x[14])
  CE16(x[7], x[15])
  CE16(x[0], x[4])
  CE16(x[1], x[5])
  CE16(x[2], x[6])
  CE16(x[3], x[7])
  CE16(x[8], x[12])
  CE16(x[9], x[13])
  CE16(x[10], x[14])
  CE16(x[11], x[15])
  CE16(x[0], x[2])
  CE16(x[1], x[3])
  CE16(x[4], x[6])
  CE16(x[5], x[7])
  CE16(x[8], x[10])
  CE16(x[9], x[11])
  CE16(x[12], x[14])
  CE16(x[13], x[15])
  CE16(x[0], x[1])
  CE16(x[2], x[3])
  CE16(x[4], x[5])
  CE16(x[6], x[7])
  CE16(x[8], x[9])
  CE16(x[10], x[11])
  CE16(x[12], x[13])
  CE16(x[14], x[15])
}
DI void top16_merge(float (&A)[16], const float (&B)[16]) {
#pragma unroll
  for (int i = 0; i < 16; ++i) A[i] = fmaxf(A[i], B[15 - i]);
  bmerge16_desc(A);
}

DI void score_top16(const Params& p, int t, int hh, int c, int r, int h, float (&top)[16]) {
  f32x16 acc[4];
#pragma unroll
  for (int n = 0; n < 4; ++n)
#pragma unroll
    for (int i = 0; i < 16; ++i) acc[n][i] = 0.f;
  const u16* qp = p.Qp + (size_t)t * 2048 + (hh * 2 + c) * 128 + h * 8;
  const u16* sk = p.SK + ((size_t)(hh * 2 + c) * 128 + r) * 128 + h * 8;
#pragma unroll
  for (int ks = 0; ks < 8; ++ks) {
    const bf16x8 bq = *(const bf16x8*)(qp + ks * 16);
#pragma unroll
    for (int n = 0; n < 4; ++n) {
      const bf16x8 a = *(const bf16x8*)(sk + n * 4096 + ks * 16);
      acc[n] = MFMA(a, bq, acc[n]);
    }
  }
  float k1[16], k2[16], k3[16];
#pragma unroll
  for (int i = 0; i < 16; ++i) {
    const unsigned ci = (unsigned)crow(i, h);
    top[i] = __uint_as_float((__float_as_uint(acc[0][i]) & ~0x7Fu) | ci);
    k1[i] = __uint_as_float((__float_as_uint(acc[1][i]) & ~0x7Fu) | (32u + ci));
    k2[i] = __uint_as_float((__float_as_uint(acc[2][i]) & ~0x7Fu) | (64u + ci));
    k3[i] = __uint_as_float((__float_as_uint(acc[3][i]) & ~0x7Fu) | (96u + ci));
  }
  sort16_desc(top); sort16_desc(k1); sort16_desc(k2); sort16_desc(k3);
  top16_merge(top, k1); top16_merge(k2, k3); top16_merge(top, k2);
  float oth[16];
#pragma unroll
  for (int j = 0; j < 16; ++j) oth[j] = __shfl_xor(top[j], 32);
  top16_merge(top, oth);
}

DI void phase7(const Params& p, char* smem) {
  WAVE_COORDS
  const int G = gridDim.x;
  volatile unsigned* lw = (volatile unsigned*)(smem + wave * 1024);
  volatile unsigned char* lb = (volatile unsigned char*)(smem + wave * 1024);
  const float NEG_INF = __uint_as_float(0xFF800000u);
  for (int task = vblock() * 4 + wave; task < 1536 * 8; task += G * 4) {
    const int hh = task & 7, tok0 = (task >> 3) * 32;
    const int t = tok0 + r;
    float L0[16], L1[16];
    score_top16(p, t, hh, 0, r, h, L0);
    score_top16(p, t, hh, 1, r, h, L1);
    float ct[16], cb[16];
    {
      float ck[50];
    ck[0] = __uint_as_float((__float_as_uint(mask7(L0[0]) + mask7(L1[0])) & ~0xFFu) | 0u);
    ck[1] = __uint_as_float((__float_as_uint(mask7(L0[0]) + mask7(L1[1])) & ~0xFFu) | 1u);
    ck[2] = __uint_as_float((__float_as_uint(mask7(L0[0]) + mask7(L1[2])) & ~0xFFu) | 2u);
    ck[3] = __uint_as_float((__float_as_uint(mask7(L0[0]) + mask7(L1[3])) & ~0xFFu) | 3u);
    ck[4] = __uint_as_float((__float_as_uint(mask7(L0[0]) + mask7(L1[4])) & ~0xFFu) | 4u);
    ck[5] = __uint_as_float((__float_as_uint(mask7(L0[0]) + mask7(L1[5])) & ~0xFFu) | 5u);
    ck[6] = __uint_as_float((__float_as_uint(mask7(L0[0]) + mask7(L1[6])) & ~0xFFu) | 6u);
    ck[7] = __uint_as_float((__float_as_uint(mask7(L0[0]) + mask7(L1[7])) & ~0xFFu) | 7u);
    ck[8] = __uint_as_float((__float_as_uint(mask7(L0[0]) + mask7(L1[8])) & ~0xFFu) | 8u);
    ck[9] = __uint_as_float((__float_as_uint(mask7(L0[0]) + mask7(L1[9])) & ~0xFFu) | 9u);
    ck[10] = __uint_as_float((__float_as_uint(mask7(L0[0]) + mask7(L1[10])) & ~0xFFu) | 10u);
    ck[11] = __uint_as_float((__float_as_uint(mask7(L0[0]) + mask7(L1[11])) & ~0xFFu) | 11u);
    ck[12] = __uint_as_float((__float_as_uint(mask7(L0[0]) + mask7(L1[12])) & ~0xFFu) | 12u);
    ck[13] = __uint_as_float((__float_as_uint(mask7(L0[0]) + mask7(L1[13])) & ~0xFFu) | 13u);
    ck[14] = __uint_as_float((__float_as_uint(mask7(L0[0]) + mask7(L1[14])) & ~0xFFu) | 14u);
    ck[15] = __uint_as_float((__float_as_uint(mask7(L0[0]) + mask7(L1[15])) & ~0xFFu) | 15u);
    ck[16] = __uint_as_float((__float_as_uint(mask7(L0[1]) + mask7(L1[0])) & ~0xFFu) | 16u);
    ck[17] = __uint_as_float((__float_as_uint(mask7(L0[1]) + mask7(L1[1])) & ~0xFFu) | 17u);
    ck[18] = __uint_as_float((__float_as_uint(mask7(L0[1]) + mask7(L1[2])) & ~0xFFu) | 18u);
    ck[19] = __uint_as_float((__float_as_uint(mask7(L0[1]) + mask7(L1[3])) & ~0xFFu) | 19u);
    ck[20] = __uint_as_float((__float_as_uint(mask7(L0[1]) + mask7(L1[4])) & ~0xFFu) | 20u);
    ck[21] = __uint_as_float((__float_as_uint(mask7(L0[1]) + mask7(L1[5])) & ~0xFFu) | 21u);
    ck[22] = __uint_as_float((__float_as_uint(mask7(L0[1]) + mask7(L1[6])) & ~0xFFu) | 22u);
    ck[23] = __uint_as_float((__float_as_uint(mask7(L0[1]) + mask7(L1[7])) & ~0xFFu) | 23u);
    ck[24] = __uint_as_float((__float_as_uint(mask7(L0[2]) + mask7(L1[0])) & ~0xFFu) | 32u);
    ck[25] = __uint_as_float((__float_as_uint(mask7(L0[2]) + mask7(L1[1])) & ~0xFFu) | 33u);
    ck[26] = __uint_as_float((__float_as_uint(mask7(L0[2]) + mask7(L1[2])) & ~0xFFu) | 34u);
    ck[27] = __uint_as_float((__float_as_uint(mask7(L0[2]) + mask7(L1[3])) & ~0xFFu) | 35u);
    ck[28] = __uint_as_float((__float_as_uint(mask7(L0[2]) + mask7(L1[4])) & ~0xFFu) | 36u);
    ck[29] = __uint_as_float((__float_as_uint(mask7(L0[3]) + mask7(L1[0])) & ~0xFFu) | 48u);
    ck[30] = __uint_as_float((__float_as_uint(mask7(L0[3]) + mask7(L1[1])) & ~0xFFu) | 49u);
    ck[31] = __uint_as_float((__float_as_uint(mask7(L0[3]) + mask7(L1[2])) & ~0xFFu) | 50u);
    ck[32] = __uint_as_float((__float_as_uint(mask7(L0[3]) + mask7(L1[3])) & ~0xFFu) | 51u);
    ck[33] = __uint_as_float((__float_as_uint(mask7(L0[4]) + mask7(L1[0])) & ~0xFFu) | 64u);
    ck[34] = __uint_as_float((__float_as_uint(mask7(L0[4]) + mask7(L1[1])) & ~0xFFu) | 65u);
    ck[35] = __uint_as_float((__float_as_uint(mask7(L0[4]) + mask7(L1[2])) & ~0xFFu) | 66u);
    ck[36] = __uint_as_float((__float_as_uint(mask7(L0[5]) + mask7(L1[0])) & ~0xFFu) | 80u);
    ck[37] = __uint_as_float((__float_as_uint(mask7(L0[5]) + mask7(L1[1])) & ~0xFFu) | 81u);
    ck[38] = __uint_as_float((__float_as_uint(mask7(L0[6]) + mask7(L1[0])) & ~0xFFu) | 96u);
    ck[39] = __uint_as_float((__float_as_uint(mask7(L0[6]) + mask7(L1[1])) & ~0xFFu) | 97u);
    ck[40] = __uint_as_float((__float_as_uint(mask7(L0[7]) + mask7(L1[0])) & ~0xFFu) | 112u);
    ck[41] = __uint_as_float((__float_as_uint(mask7(L0[7]) + mask7(L1[1])) & ~0xFFu) | 113u);
    ck[42] = __uint_as_float((__float_as_uint(mask7(L0[8]) + mask7(L1[0])) & ~0xFFu) | 128u);
    ck[43] = __uint_as_float((__float_as_uint(mask7(L0[9]) + mask7(L1[0])) & ~0xFFu) | 144u);
    ck[44] = __uint_as_float((__float_as_uint(mask7(L0[10]) + mask7(L1[0])) & ~0xFFu) | 160u);
    ck[45] = __uint_as_float((__float_as_uint(mask7(L0[11]) + mask7(L1[0])) & ~0xFFu) | 176u);
    ck[46] = __uint_as_float((__float_as_uint(mask7(L0[12]) + mask7(L1[0])) & ~0xFFu) | 192u);
    ck[47] = __uint_as_float((__float_as_uint(mask7(L0[13]) + mask7(L1[0])) & ~0xFFu) | 208u);
    ck[48] = __uint_as_float((__float_as_uint(mask7(L0[14]) + mask7(L1[0])) & ~0xFFu) | 224u);
    ck[49] = __uint_as_float((__float_as_uint(mask7(L0[15]) + mask7(L1[0])) & ~0xFFu) | 240u);
      const float NINF = __uint_as_float(0xFF800000u);
#pragma unroll
      for (int q = 0; q < 25; ++q) {
        float a_ = ck[q], b_ = ck[25 + q];
        asm volatile("" : "+v"(a_), "+v"(b_));
        const float m = h ? b_ : a_;
        if (q < 16) ct[q] = m; else cb[q - 16] = m;
      }
#pragma unroll
      for (int q = 9; q < 16; ++q) cb[q] = NINF;
      sort16_desc(ct); sort16_desc(cb);
      top16_merge(ct, cb);
#pragma unroll
      for (int q = 0; q < 16; ++q) cb[q] = __shfl_xor(ct[q], 32);
      top16_merge(ct, cb);
    }
    if (h == 0) {
#pragma unroll
      for (int w = 0; w < 4; ++w) {
        unsigned v = 0, v2 = 0;
#pragma unroll
        for (int b = 0; b < 4; ++b) {
          v |= (__float_as_uint(L0[w * 4 + b]) & 0x7Fu) << (8 * b);
          v2 |= (__float_as_uint(L1[w * 4 + b]) & 0x7Fu) << (8 * b);
        }
        lw[r * 8 + w] = v;
        lw[r * 8 + 4 + w] = v2;
      }
    }
    __builtin_amdgcn_wave_barrier();
    const float* s2 = p.SS2 + (size_t)t * 16;
    float ssum = 0.f;
#pragma unroll
    for (int j = 0; j < 8; ++j) ssum += s2[j];
    const float r2 = rsqrtf(ssum * (1.f / 1024.f) + EPS);
    float gv[16];
    const float v0 = __uint_as_float(__float_as_uint(ct[0]) & ~0xFFu) * r2;
    float esum = 0.f;
#pragma unroll
    for (int j = 0; j < 16; ++j) {
      const float vj = __uint_as_float(__float_as_uint(ct[j]) & ~0xFFu) * r2;
      gv[j] = __builtin_amdgcn_exp2f((vj - v0) * 1.4426950408889634f);
      esum += gv[j];
    }
    const float einv = 1.f / esum;
    u32x4 oi[2]; f32x4 og[2];
#pragma unroll
    for (int jj = 0; jj < 8; ++jj) {
      float ka = ct[jj], kb = ct[8 + jj], ga = gv[jj], gb = gv[8 + jj];
      asm volatile("" : "+v"(ka), "+v"(kb), "+v"(ga), "+v"(gb));
      const float key = h ? kb : ka;
      const float g = (h ? gb : ga) * einv;
      const unsigned code = __float_as_uint(key) & 0xFFu;
      const unsigned i1 = lb[r * 32 + (code >> 4)], i2 = lb[r * 32 + 16 + (code & 15)];
      oi[jj >> 2][jj & 3] = i1 * 128 + i2;
      og[jj >> 2][jj & 3] = g;
    }
    int* ip = p.IDX + (size_t)t * 128 + hh * 16 + h * 8;
    float* gp = p.G + (size_t)t * 128 + hh * 16 + h * 8;
    *(u32x4*)ip = oi[0]; *(u32x4*)(ip + 4) = oi[1];
    *(f32x4*)gp = og[0]; *(f32x4*)(gp + 4) = og[1];
    __builtin_amdgcn_wave_barrier();
  }
}

DI float gelu_tanh(float x) {
  const float u = 0.7978845608028654f * (x + 0.044715f * x * x * x);
  const float e = __builtin_amdgcn_exp2f(u * 2.8853900817779268f);
  const float th = 1.f - 2.f * __builtin_amdgcn_rcpf(e + 1.f);
  return 0.5f * x * (1.f + th);
}
DI float dot16_fp8(const u32x4& w, const u32x4& xa, const u32x4& xb) {
  float acc = 0.f;
#pragma unroll
  for (int k = 0; k < 4; ++k) {
    const bf2_t b0 = __builtin_amdgcn_cvt_scalef32_pk_bf16_fp8(w[k], 1.0f, false);
    const bf2_t b1 = __builtin_amdgcn_cvt_scalef32_pk_bf16_fp8(w[k], 1.0f, true);
    const unsigned x0 = (k < 2) ? xa[2 * k] : xb[2 * k - 4], x1 = (k < 2) ? xa[2 * k + 1] : xb[2 * k - 3];
    acc = __builtin_amdgcn_fdot2_f32_bf16(b0, __builtin_bit_cast(bf2_t, x0), acc, false);
    acc = __builtin_amdgcn_fdot2_f32_bf16(b1, __builtin_bit_cast(bf2_t, x1), acc, false);
  }
  return acc;
}

template <int CTRL>
DI float dppf(float x) { return __uint_as_float(__builtin_amdgcn_update_dpp(0u, __float_as_uint(x), CTRL, 0xF, 0xF, false)); }
DI float swap32sum(float a, float b) {
  auto rr = __builtin_amdgcn_permlane32_swap(__float_as_uint(a), __float_as_uint(b), false, false);
  return __uint_as_float(rr[0]) + __uint_as_float(rr[1]);
}
DI float swap16sum(float a, float b) {
  auto rr = __builtin_amdgcn_permlane16_swap(__float_as_uint(a), __float_as_uint(b), false, false);
  return __uint_as_float(rr[0]) + __uint_as_float(rr[1]);
}
struct P8Buf { u32x4 w[16]; u32x4 xa, xb; };

DI void p8_load_idx(const Params& p, int t, int j, u32x4 (&ix)[4]) {
  const int* ip = p.IDX + (size_t)t * 128 + j * 16;
#pragma unroll
  for (int q = 0; q < 4; ++q) ix[q] = *(const u32x4*)(ip + q * 4);
}
DI void p8_load_rows(const unsigned char* tab, int s, int cc, const u32x4 (&ix)[4], u32x4 (&w)[16]) {
  const unsigned char* base = tab + (size_t)s * (16384 * 128) + cc * 16;
#pragma unroll
  for (int i = 0; i < 16; ++i) w[i] = *(const u32x4*)(base + (size_t)ix[i >> 2][i & 3] * 128);
}

DI void phase8(const Params& p, char* smem, const int tbase) {
  WAVE_COORDS
  const int G = gridDim.x;
  const int gw = vblock() * 4 + wave, NW = G * 4;
  const int j = lane >> 3, cc = lane & 7;
  const bool b0 = lane & 1, b1 = lane & 2, b2 = lane & 4, b3 = lane & 8, b4 = lane & 16, b5 = lane & 32;
  f32x2* part = (f32x2*)(smem + wave * 12288) + lane;
  const float* coefl = (const float*)(smem + wave * 12288);
  const int ntok_all = (T_TOK - gw + NW - 1) / NW;
  const int ntok = min(24, ntok_all - tbase);
  const int gw0 = gw + tbase * NW;
  if (ntok <= 0) return;
  for (int s = 0; s < 8; ++s) {
    u32x4 ixA[4], ixB[4];
    u32x4 wA[16], wB[16];
    u32x4 xaA, xbA, xaB, xbB;
    auto issue = [&](int i, u32x4 (&ix)[4], u32x4 (&w)[16], u32x4& xa, u32x4& xb) {
      const int t = gw0 + i * NW;
      const u16* xr = p.X2b + (size_t)t * 1024 + s * 128 + cc * 16;
      xa = *(const u32x4*)xr; xb = *(const u32x4*)(xr + 8);
      p8_load_rows(p.U8, s, cc, ix, w);
    };
    auto compute = [&](int i, u32x4 (&w)[16], u32x4& xa, u32x4& xb) {
      float d[16];
#pragma unroll
      for (int q = 0; q < 16; ++q) d[q] = dot16_fp8(w[q], xa, xb);
      float v8[8], v4[4], v2[2];
#pragma unroll
      for (int m = 0; m < 8; ++m) { const float mine = b2 ? d[m + 8] : d[m], send = b2 ? d[m] : d[m + 8]; v8[m] = mine + dppf<0x141>(send); }
#pragma unroll
      for (int m = 0; m < 4; ++m) { const float mine = b1 ? v8[m + 4] : v8[m], send = b1 ? v8[m] : v8[m + 4]; v4[m] = mine + dppf<0x4E>(send); }
#pragma unroll
      for (int m = 0; m < 2; ++m) { const float mine = b0 ? v4[m + 2] : v4[m], send = b0 ? v4[m] : v4[m + 2]; v2[m] = mine + dppf<0xB1>(send); }
      f32x2 acc = {v2[0], v2[1]};
      if (s > 0) { const f32x2 o = part[i * 64]; acc[0] += o[0]; acc[1] += o[1]; }
      part[i * 64] = acc;
    };
    p8_load_idx(p, gw0, j, ixA);
    issue(0, ixA, wA, xaA, xbA);
    if (ntok > 1) p8_load_idx(p, gw0 + NW, j, ixB);
#pragma unroll 1
    for (int i = 0; i < ntok; i += 2) {
      if (i + 1 < ntok) issue(i + 1, ixB, wB, xaB, xbB);
      if (i + 2 < ntok) p8_load_idx(p, gw0 + (i + 2) * NW, j, ixA);
      __builtin_amdgcn_sched_barrier(0);
      compute(i, wA, xaA, xbA);
      __builtin_amdgcn_sched_barrier(0);
      if (i + 1 < ntok) {
        if (i + 2 < ntok) issue(i + 2, ixA, wA, xaA, xbA);
        if (i + 3 < ntok) p8_load_idx(p, gw0 + (i + 3) * NW, j, ixB);
        __builtin_amdgcn_sched_barrier(0);
        compute(i + 1, wB, xaB, xbB);
        __builtin_amdgcn_sched_barrier(0);
      }
    }
  }
  for (int i = 0; i < ntok; ++i) {
    const int t = gw0 + i * NW;
    const float* s2 = p.SS2 + (size_t)t * 16;
    float ssum = 0.f;
#pragma unroll
    for (int q = 0; q < 8; ++q) ssum += s2[q];
    const float r2 = rsqrtf(ssum * (1.f / 1024.f) + EPS) * (1.f / USCALE);
    const f32x2 g = *(const f32x2*)(p.G + (size_t)t * 128 + lane * 2);
    f32x2 a = part[i * 64];
    a[0] = gelu_tanh(a[0] * r2) * g[0] * (1.f / VSCALE);
    a[1] = gelu_tanh(a[1] * r2) * g[1] * (1.f / VSCALE);
    part[i * 64] = a;
  }
  asm volatile("" ::: "memory");
  __builtin_amdgcn_wave_barrier();
  for (int s = 0; s < 8; ++s) {
    u32x4 ixA[4], ixB[4];
    u32x4 wA[16], wB[16];
    auto compute = [&](int i, u32x4 (&w)[16]) {
      const int t = gw0 + i * NW;
      const float* cp = coefl + i * 128 + j * 16;
      f32x4 cf[4];
#pragma unroll
      for (int q = 0; q < 4; ++q) cf[q] = *(const f32x4*)(cp + q * 4);
      f32x2 acc2[8];
#pragma unroll
      for (int e = 0; e < 8; ++e) acc2[e] = f32x2{0.f, 0.f};
#pragma unroll
      for (int q = 0; q < 16; ++q) {
        const float cq = cf[q >> 2][q & 3];
        const f32x2 c2 = {cq, cq};
#pragma unroll
        for (int k = 0; k < 4; ++k) {
          const f32x2 lo = __builtin_amdgcn_cvt_pk_f32_fp8((int)w[q][k], false);
          const f32x2 hi = __builtin_amdgcn_cvt_pk_f32_fp8((int)w[q][k], true);
          acc2[2 * k] = __builtin_elementwise_fma(lo, c2, acc2[2 * k]);
          acc2[2 * k + 1] = __builtin_elementwise_fma(hi, c2, acc2[2 * k + 1]);
        }
      }
      float acc[16];
#pragma unroll
      for (int e = 0; e < 8; ++e) { acc[2 * e] = acc2[e][0]; acc[2 * e + 1] = acc2[e][1]; }
      float v8[8], v4[4], v2[2];
#pragma unroll
      for (int m = 0; m < 8; ++m) v8[m] = swap32sum(acc[m], acc[m + 8]);
#pragma unroll
      for (int m = 0; m < 4; ++m) v4[m] = swap16sum(v8[m], v8[m + 4]);
#pragma unroll
      for (int m = 0; m < 2; ++m) { const float mine = b3 ? v4[m + 2] : v4[m], send = b3 ? v4[m] : v4[m + 2]; v2[m] = mine + dppf<0x128>(send); }
      float* op = p.out + (size_t)t * 1024 + s * 128 + cc * 16 + 2 * j;
      f32x2 o = *(f32x2*)op;
      o[0] += v2[0]; o[1] += v2[1];
      *(f32x2*)op = o;
    };
    p8_load_idx(p, gw0, j, ixA);
    p8_load_rows(p.V8, s, cc, ixA, wA);
    if (ntok > 1) p8_load_idx(p, gw0 + NW, j, ixB);
#pragma unroll 1
    for (int i = 0; i < ntok; i += 2) {
      if (i + 1 < ntok) p8_load_rows(p.V8, s, cc, ixB, wB);
      if (i + 2 < ntok) p8_load_idx(p, gw0 + (i + 2) * NW, j, ixA);
      __builtin_amdgcn_sched_barrier(0);
      compute(i, wA);
      __builtin_amdgcn_sched_barrier(0);
      if (i + 1 < ntok) {
        if (i + 2 < ntok) p8_load_rows(p.V8, s, cc, ixA, wA);
        if (i + 3 < ntok) p8_load_idx(p, gw0 + (i + 3) * NW, j, ixB);
        __builtin_amdgcn_sched_barrier(0);
        compute(i + 1, wB);
        __builtin_amdgcn_sched_barrier(0);
      }
    }
  }
  asm volatile("" ::: "memory");
  __builtin_amdgcn_wave_barrier();
}

extern __shared__ __attribute__((aligned(16))) char dyn_smem[];

DI void run_phase(const Params& p, int ph, char* smem) {
  switch (ph) {
    case 0: phase0(p); break;
    case 1: phase1(p, smem); break;
    case 2: phase2(p, smem); break;
    case 3: phase3(p, smem); break;
    case 4: phase4(p, smem); break;
    case 5: phase5(p, smem); break;
    case 6: phase6(p, smem); break;
    case 7: phase7(p, smem); break;
    default: phase8(p, smem, 0); break;
  }
}


#define XB_TMO      128
#define XB_XCNT(j)  (256  + 64 * (j))
#define XB_XSUB(j)  (1280 + 64 * (j))
#define XB_XGEN(j)  (2304 + 64 * (j))
#define XB_TOP      3328
#define XB_TOPGEN   3392
#define XCD_BAR_WORDS 3456
#define XB_SPIN_CAP (1u << 22)
#define LAS __attribute__((address_space(3)))
DI unsigned xb_ld(unsigned* p) { return __hip_atomic_load(p, __ATOMIC_RELAXED, __HIP_MEMORY_SCOPE_AGENT); }
DI unsigned xb_add(unsigned* p, unsigned v) { return __hip_atomic_fetch_add(p, v, __ATOMIC_RELAXED, __HIP_MEMORY_SCOPE_AGENT); }
DI unsigned xb_xcc_id() { return (unsigned)__builtin_amdgcn_s_getreg((3 << 11) | 20) & 0xFu; }
#define XB_SPIN(cond, bar) do { unsigned _sp = 0; while (cond) { __builtin_amdgcn_s_sleep(1); \
    if ((++_sp & 255u) == 0u) { if (xb_ld(&(bar)[XB_TMO])) break; if (_sp > XB_SPIN_CAP) { atomicAdd(&(bar)[XB_TMO], 1u); break; } } } } while (0)
struct XcdBarrier { unsigned* bar; unsigned x; volatile LAS unsigned* st; };
DI XcdBarrier xcd_barrier_post(unsigned* bar, volatile LAS unsigned* st) {
  XcdBarrier b; b.bar = bar; b.x = xb_xcc_id(); b.st = st;
  if (threadIdx.x == 0) (void)xb_add(&bar[XB_XCNT(b.x)], 1u);
  return b;
}
DI void xcd_barrier_complete(unsigned* bar, unsigned x, unsigned& nloc, unsigned& nx) {
  const unsigned G = gridDim.x * gridDim.y * gridDim.z;
  unsigned sum, cnt, mine, sp = 0u;
  for (;;) {
    sum = 0u; cnt = 0u; mine = 0u;
#pragma unroll
    for (unsigned j = 0; j < 16; ++j) { const unsigned c = xb_ld(&bar[XB_XCNT(j)]); sum += c; cnt += (c > 0u) ? 1u : 0u; mine = (j == x) ? c : mine; }
    if (sum == G) break;
    __builtin_amdgcn_s_sleep(1);
    if ((++sp & 255u) == 0u) { if (xb_ld(&bar[XB_TMO])) break; if (sp > XB_SPIN_CAP) { atomicAdd(&bar[XB_TMO], 1u); break; } }
  }
  nloc = mine > 0u ? mine : 1u; nx = cnt > 0u ? cnt : 1u;
}
DI void xcd_barrier(const XcdBarrier& b) {
  asm volatile("s_waitcnt vmcnt(0)" ::: "memory");
  __syncthreads();
  if (threadIdx.x == 0) {
    unsigned* bar = b.bar;
    __builtin_amdgcn_s_waitcnt(0);
    unsigned nloc = b.st[0], nx = b.st[1];
    if (nloc == 0u) { xcd_barrier_complete(bar, b.x, nloc, nx); b.st[0] = nloc; b.st[1] = nx; }
    const unsigned old = xb_add(&bar[XB_XSUB(b.x)], 1u);
    const unsigned gen = old / nloc;
    if (old + 1u == (gen + 1u) * nloc) {
      __builtin_amdgcn_fence(__ATOMIC_RELEASE, "agent");
      asm volatile("s_waitcnt vmcnt(0)" ::: "memory");
      const unsigned og = xb_add(&bar[XB_TOP], 1u);
      const unsigned tg = og / nx;
      if (og + 1u == (tg + 1u) * nx) xb_add(&bar[XB_TOPGEN], 1u);
      else XB_SPIN(xb_ld(&bar[XB_TOPGEN]) == tg, bar);
      __builtin_amdgcn_fence(__ATOMIC_ACQUIRE, "agent");
      xb_add(&bar[XB_XGEN(b.x)], 1u);
      asm volatile("s_waitcnt vmcnt(0)" ::: "memory");
    } else {
      XB_SPIN(xb_ld(&bar[XB_XGEN(b.x)]) == gen, bar);
      __builtin_amdgcn_fence(__ATOMIC_ACQUIRE, "agent");
      asm volatile("s_waitcnt vmcnt(0)" ::: "memory");
    }
  }
  __syncthreads();
}

#if MK_COOP
__global__ void __launch_bounds__(NTHR, 2) mega_kernel(Params p) {
  cg::grid_group grid = cg::this_grid();
#ifndef PROBE_PH
#define PROBE_PH -1
#endif
  volatile LAS unsigned* st = (volatile LAS unsigned*)(dyn_smem + 65536 + 1024);
  if (threadIdx.x < 4) st[threadIdx.x] = 0u;
  for (int i = blockIdx.x * NTHR + threadIdx.x; i < XCD_BAR_WORDS; i += gridDim.x * NTHR) p.bar[i] = 0u;
  phase0(p);
  grid.sync();
  XcdBarrier xb = xcd_barrier_post(p.bar, st);
#define RUNP(k, call) call; xcd_barrier(xb); if (PROBE_PH == k) { call; xcd_barrier(xb); }
  RUNP(1, phase1(p, dyn_smem))
  RUNP(2, phase2(p, dyn_smem))
  RUNP(3, phase3(p, dyn_smem))
  RUNP(4, phase4(p, dyn_smem))
  RUNP(5, phase5(p, dyn_smem))
  RUNP(6, phase6(p, dyn_smem))
  RUNP(7, phase7(p, dyn_smem))
  for (int tb8 = 0; tb8 * (int)gridDim.x * 4 < T_TOK; tb8 += 24) phase8(p, dyn_smem, tb8);
}
#else
template <int PH>
__global__ void __launch_bounds__(NTHR, 2) phase_kernel(Params p) { run_phase(p, PH, dyn_smem); }
#endif

extern "C" void kernel_launch(void* const* d_in, const int* in_sizes, int n_in, void* d_out, int out_size, void* d_ws,
                              size_t ws_size, hipStream_t stream) {
  Params p{};
  const float* const* in = (const float* const*)d_in;
  p.x0 = in[0]; p.x1 = in[1]; p.attn_norm_g = in[2]; p.w_in = in[3]; p.q_lat_g = in[4]; p.w_uq = in[5];
  p.kv_lat_g = in[6]; p.w_ukv = in[7]; p.q_head_g = in[8]; p.k_head_g = in[9]; p.attn_out_g = in[10];
  p.fnet_out_g = in[11]; p.w_out = in[12]; p.ffn_norm_g = in[13]; p.peer_w_q = in[14]; p.peer_sub_keys = in[15];
  p.peer_u = in[16]; p.peer_v = in[17];
  p.out = (float*)d_out;
  char* ws = (char*)d_ws;
  size_t off = 0;
  auto take = [&](size_t bytes) { char* q = ws + off; off += (bytes + 255) & ~(size_t)255; return q; };
  p.WinT = (u16*)take(1280 * 1024 * 2); p.WuqT = (u16*)take(768 * 384 * 2); p.WukvT = (u16*)take(1024 * 256 * 2);
  p.WoutT = (u16*)take(1024 * 1024 * 2); p.WpqT = (u16*)take(2048 * 1024 * 2); p.SK = (u16*)take(262144 * 2);
  p.Wc = (u16*)take(256 * 128 * 2); p.WA64 = (u16*)take(128 * 128 * 2); p.WA32 = (u16*)take(128 * 64 * 2);
  p.WB = (u16*)take(128 * 256 * 2);
  p.ropec = (float*)take(8192 * 16 * 4); p.ropes = (float*)take(8192 * 16 * 4);
  p.rstd1 = (float*)take((size_t)T_TOK * 4); p.SSP = (float*)take((size_t)T_TOK * 10 * 4);
  p.SSA = (float*)take((size_t)T_TOK * 8 * 4); p.SSF = (float*)take((size_t)T_TOK * 8 * 4);
  p.SS2 = (float*)take((size_t)T_TOK * 16 * 4); p.KR = (float*)take((size_t)T_TOK * 32 * 4);
  p.bar = (unsigned*)take(XCD_BAR_WORDS * 4);
  p.misc = (float*)take(256);
  const size_t SMALL = 28u << 20;
  char* big = ws + SMALL;
  const size_t MB = 1u << 20;
  char* dsp = (char*)d_out;
  p.Xb = (u16*)(big + 0 * MB);
  p.CQ = (u16*)(big + 96 * MB); p.CKV = (u16*)(big + 132 * MB); p.F = (u16*)(big + 156 * MB);
  p.Z1 = (u16*)(big + 204 * MB);
  p.Vt = (u16*)(big + 300 * MB);
  p.Q1 = (u16*)(dsp + 0 * MB); p.K1 = (u16*)(dsp + 72 * MB);
  p.Qn = (u16*)(big + 0 * MB); p.Kn = (u16*)(dsp + 120 * MB);
  p.G1 = (u16*)(big + 96 * MB);
  p.MIX = (u16*)(big + 204 * MB);
  p.X2b = (u16*)(big + 0 * MB);
  p.Qp = (u16*)(big + 96 * MB);
  p.IDX = (int*)(big + 300 * MB); p.G = (float*)(big + 324 * MB);
  p.U8 = (unsigned char*)(big + 348 * MB); p.V8 = (unsigned char*)(big + 364 * MB);

#if MK_COOP
  static int grid_blocks = 0;
  if (!grid_blocks) {
    int dev = 0, cus = 0, per_cu = 0;
    hipGetDevice(&dev);
    hipDeviceGetAttribute(&cus, hipDeviceAttributeMultiprocessorCount, dev);
    hipFuncSetAttribute((const void*)mega_kernel, hipFuncAttributeMaxDynamicSharedMemorySize, LDS_BYTES);
    hipOccupancyMaxActiveBlocksPerMultiprocessor(&per_cu, mega_kernel, NTHR, LDS_BYTES);
    if (per_cu > 2) per_cu = 2;
    grid_blocks = cus * per_cu;
    grid_blocks &= ~7;
  }
  void* args[] = {&p};
  hipError_t e = hipLaunchCooperativeKernel((void*)mega_kernel, dim3(grid_blocks), dim3(NTHR), args, LDS_BYTES, stream);
  if (e != hipSuccess) fprintf(stderr, "cooperative launch failed: %s (grid %d)\n", hipGetErrorString(e), grid_blocks);
#else
  const int GB = 512;
#define LAUNCH(PH)                                                                                                \
  hipFuncSetAttribute((const void*)phase_kernel<PH>, hipFuncAttributeMaxDynamicSharedMemorySize, LDS_BYTES);      \
  phase_kernel<PH><<<GB, NTHR, LDS_BYTES, stream>>>(p);
  LAUNCH(0) LAUNCH(1) LAUNCH(2) LAUNCH(3) LAUNCH(4) LAUNCH(5) LAUNCH(6) LAUNCH(7) LAUNCH(8)
#endif
}
```

```cpp
#include <hip/hip_runtime.h>
#include <hip/hip_cooperative_groups.h>
#include <stdint.h>
#include <cstdio>
namespace cg = cooperative_groups;

#ifndef MK_COOP
#define MK_COOP 1
#endif

typedef unsigned short u16;
using bf16x8 = __attribute__((ext_vector_type(8))) short;
using f32x16 = __attribute__((ext_vector_type(16))) float;
using f32x4 = __attribute__((ext_vector_type(4))) float;
using f32x2 = __attribute__((ext_vector_type(2))) float;
using u32x4 = __attribute__((ext_vector_type(4))) unsigned;
using u32x2 = __attribute__((ext_vector_type(2))) unsigned;
typedef __bf16 bf2_t __attribute__((ext_vector_type(2)));

#define DI __device__ __forceinline__
#define MFMA(a, b, c) __builtin_amdgcn_mfma_f32_32x32x16_bf16((a), (b), (c), 0, 0, 0)

constexpr int T_TOK = 49152;
constexpr int TP = 16384;
constexpr float EPS = 1e-6f;
constexpr int NTHR = 256;
constexpr int LDS_BYTES = 65536 + 2048;
constexpr int GBUF = 32768;
constexpr float USCALE = 512.f, VSCALE = 256.f;

struct Params {
  const float *x0, *x1, *attn_norm_g, *w_in, *q_lat_g, *w_uq, *kv_lat_g, *w_ukv, *q_head_g, *k_head_g,
      *attn_out_g, *fnet_out_g, *w_out, *ffn_norm_g, *peer_w_q, *peer_sub_keys, *peer_u, *peer_v;
  float* out;
  u16 *WinT, *WuqT, *WukvT, *WoutT, *WpqT, *SK, *Wc, *WA64, *WA32, *WB;
  float *ropec, *ropes, *rstd1, *SSP, *SSA, *SSF, *SS2, *KR;
  u16 *Xb, *CQ, *CKV, *F, *Z1, *Vt, *Q1, *K1, *Qn, *Kn, *G1, *MIX, *X2b, *Qp;
  unsigned char *U8, *V8;
  int* IDX;
  float* G;
  unsigned* bar;
  float* misc;
};

DI unsigned cvtpk(float lo, float hi) {
  f32x2 v = {lo, hi};
  bf2_t b = __builtin_convertvector(v, bf2_t);
  return __builtin_bit_cast(unsigned, b);
}
DI u16 f2bf(float x) { return (u16)(cvtpk(x, 0.f) & 0xffffu); }
DI float bflo(unsigned w) { return __uint_as_float(w << 16); }
DI float bfhi(unsigned w) { return __uint_as_float(w & 0xffff0000u); }
DI int crow(int i, int h) { return (i & 3) + 8 * (i >> 2) + 4 * h; }
DI float red32(float v) {
  v += __shfl_xor(v, 1); v += __shfl_xor(v, 2); v += __shfl_xor(v, 4); v += __shfl_xor(v, 8); v += __shfl_xor(v, 16);
  return v;
}
DI float wave_sum(float v) { v = red32(v); v += __shfl_xor(v, 32); return v; }
DI const float* xrow(const Params& p, int t) {
  return t < TP ? p.x0 + (size_t)t * 1024 : p.x1 + (size_t)(t - TP) * 1024;
}
DI void tok2seq(int t, int& q, int& S, int& tb) {
  if (t < TP) { q = t >> 13; S = 8192; tb = q << 13; }
  else { int u = (t - TP) >> 12; q = 2 + u; S = 4096; tb = TP + (u << 12); }
}
DI int vblock() { return (blockIdx.x & 7) * (gridDim.x >> 3) + (blockIdx.x >> 3); }
DI float fdot2(unsigned a, unsigned b, float c) {
  return __builtin_amdgcn_fdot2_f32_bf16(__builtin_bit_cast(bf2_t, a), __builtin_bit_cast(bf2_t, b), c, false);
}

DI int swz(int row, int c) { return row * 128 + ((c ^ ((row >> 1) & 7)) << 4); }

template <bool BATCH = false, class AF, class BF>
DI void gemm_mainloop(f32x16 (&acc)[2][2], char* smem, AF arow, BF brow, int k0, int k1) {
  const int tid = threadIdx.x, lane = tid & 63, wave = tid >> 6;
  const int wm = wave >> 1, wn = wave & 1, r = lane & 31, h = lane >> 5;
  const int lrow = tid >> 3, lc = tid & 7;
  const u16* ap[4]; const u16* bp[4];
#pragma unroll
  for (int i = 0; i < 4; ++i) { ap[i] = arow(lrow + 32 * i) + lc * 8; bp[i] = brow(lrow + 32 * i) + lc * 8; }
  u32x4 ra0[4], rb0[4], ra1[4], rb1[4];
#pragma unroll
  for (int i = 0; i < 4; ++i) { ra0[i] = *(const u32x4*)(ap[i] + k0); rb0[i] = *(const u32x4*)(bp[i] + k0); }
#pragma unroll
  for (int i = 0; i < 4; ++i) {
    *(u32x4*)(smem + swz(lrow + 32 * i, lc)) = ra0[i];
    *(u32x4*)(smem + 16384 + swz(lrow + 32 * i, lc)) = rb0[i];
  }
  if (k0 + 64 < k1) {
#pragma unroll
    for (int i = 0; i < 4; ++i) { ra0[i] = *(const u32x4*)(ap[i] + k0 + 64); rb0[i] = *(const u32x4*)(bp[i] + k0 + 64); }
  }
  __syncthreads();
  int cur = 0;
  auto step = [&](int k, u32x4 (&xa)[4], u32x4 (&xb)[4], u32x4 (&ya)[4], u32x4 (&yb)[4]) {
    if (k + 128 < k1) {
#pragma unroll
      for (int i = 0; i < 4; ++i) { ya[i] = *(const u32x4*)(ap[i] + k + 128); yb[i] = *(const u32x4*)(bp[i] + k + 128); }
    }
    __builtin_amdgcn_sched_barrier(0);
    const char* As = smem + cur * GBUF;
    const char* Bs = As + 16384;
    if (BATCH) {
      bf16x8 af[4][2], bfr[4][2];
#pragma unroll
      for (int ks = 0; ks < 4; ++ks) {
#pragma unroll
        for (int mi = 0; mi < 2; ++mi) af[ks][mi] = *(const bf16x8*)(As + swz(wm * 64 + mi * 32 + r, ks * 2 + h));
#pragma unroll
        for (int ni = 0; ni < 2; ++ni) bfr[ks][ni] = *(const bf16x8*)(Bs + swz(wn * 64 + ni * 32 + r, ks * 2 + h));
      }
      __builtin_amdgcn_sched_barrier(0);
#pragma unroll
      for (int ks = 0; ks < 4; ++ks)
#pragma unroll
        for (int mi = 0; mi < 2; ++mi)
#pragma unroll
          for (int ni = 0; ni < 2; ++ni) acc[mi][ni] = MFMA(af[ks][mi], bfr[ks][ni], acc[mi][ni]);
    } else {
#pragma unroll
      for (int ks = 0; ks < 4; ++ks) {
        bf16x8 af[2], bfr[2];
#pragma unroll
        for (int mi = 0; mi < 2; ++mi) af[mi] = *(const bf16x8*)(As + swz(wm * 64 + mi * 32 + r, ks * 2 + h));
#pragma unroll
        for (int ni = 0; ni < 2; ++ni) bfr[ni] = *(const bf16x8*)(Bs + swz(wn * 64 + ni * 32 + r, ks * 2 + h));
#pragma unroll
        for (int mi = 0; mi < 2; ++mi)
#pragma unroll
          for (int ni = 0; ni < 2; ++ni) acc[mi][ni] = MFMA(af[mi], bfr[ni], acc[mi][ni]);
      }
    }
    __builtin_amdgcn_sched_barrier(0);
    if (k + 64 < k1) {
      char* An = smem + (cur ^ 1) * GBUF;
#pragma unroll
      for (int i = 0; i < 4; ++i) {
        *(u32x4*)(An + swz(lrow + 32 * i, lc)) = xa[i];
        *(u32x4*)(An + 16384 + swz(lrow + 32 * i, lc)) = xb[i];
      }
    }
    __syncthreads();
    cur ^= 1;
  };
#pragma unroll 1
  for (int k = k0; k < k1; k += 128) {
    step(k, ra0, rb0, ra1, rb1);
    if (k + 64 < k1) step(k + 64, ra1, rb1, ra0, rb0);
  }
}
DI void zero_acc(f32x16 (&acc)[2][2]) {
#pragma unroll
  for (int a = 0; a < 2; ++a)
#pragma unroll
    for (int b = 0; b < 2; ++b)
#pragma unroll
      for (int i = 0; i < 16; ++i) acc[a][b][i] = 0.f;
}
#define WAVE_COORDS                                                        \
  const int tid = threadIdx.x, lane = tid & 63, wave = tid >> 6;           \
  const int wm = wave >> 1, wn = wave & 1, r = lane & 31, h = lane >> 5;   \
  (void)wm; (void)wn; (void)r; (void)h; (void)lane;

constexpr int SROW = 272;
template <bool SCALE>
DI void stage_bf16_t(char* smem, f32x16 (&acc)[2][2], const float* rs, int wm, int wn, int r, int h) {
  char* base = smem + (wm * 64 + 4 * h) * SROW + (wn * 64 + r) * 2;
  const float* rb = rs + wm * 64 + 4 * h;
#pragma unroll
  for (int mi = 0; mi < 2; ++mi)
#pragma unroll
    for (int i = 0; i < 16; ++i) {
      const int ro = mi * 32 + (i & 3) + 8 * (i >> 2);
      const float sc = SCALE ? rb[ro] : 1.f;
#pragma unroll
      for (int ni = 0; ni < 2; ++ni)
        *(u16*)(base + ro * SROW + ni * 64) = f2bf(acc[mi][ni][i] * sc);
    }
}
DI void stage_bf16(char* smem, f32x16 (&acc)[2][2], const float* rs, int wm, int wn, int r, int h, int) {
  if (rs) stage_bf16_t<true>(smem, acc, rs, wm, wn, r, h); else stage_bf16_t<false>(smem, acc, rs, wm, wn, r, h);
}
DI float sumsq8(const u32x4& v) {
  float ss = 0.f;
#pragma unroll
  for (int j = 0; j < 4; ++j) { const float a = bflo(v[j]), b = bfhi(v[j]); ss += a * a + b * b; }
  return ss;
}

#define WAVE_COORDS_L                                                      \
  int tid = threadIdx.x; asm volatile("" : "+v"(tid));                     \
  const int lane = tid & 63, wave = tid >> 6;                              \
  const int wm = wave >> 1, wn = wave & 1, r = lane & 31, h = lane >> 5;   \
  (void)wm; (void)wn; (void)r; (void)h; (void)lane;

template <int MODE>
DI void transpose_w(u16* dst, const float* src, const float* g0, const float* g1, int N, int K, int Nsrc, int gt, int gs) {
  const int items = N * (K >> 3);
  for (int id = gt; id < items; id += gs) {
    const int kc = id / N, n = id - kc * N;
    int col = n; bool valid = true;
    if (MODE == 1) {
      if (n < 640) col = n; else if (n < 1152) col = n + 32; else if (n < 1184) col = 640 + n - 1152; else valid = false;
    }
    float v[8];
#pragma unroll
    for (int j = 0; j < 8; ++j) {
      const int k = kc * 8 + j;
      const float g = (MODE == 2 && k >= 512) ? g1[k - 512] : g0[k];
      v[j] = valid ? src[(size_t)k * Nsrc + col] * g : 0.f;
    }
    u32x4 o = {cvtpk(v[0], v[1]), cvtpk(v[2], v[3]), cvtpk(v[4], v[5]), cvtpk(v[6], v[7])};
    *(u32x4*)(dst + (size_t)n * K + kc * 8) = o;
  }
}

DI void phase0(const Params& p) {
  const int gt = blockIdx.x * NTHR + threadIdx.x, gs = gridDim.x * NTHR;
  if (gt == 0) {
    float mq = 0.f, mk = 0.f;
    for (int d = 0; d < 96; ++d) { mq = fmaxf(mq, fabsf(p.q_head_g[d])); mk = fmaxf(mk, fabsf(p.k_head_g[d])); }
    p.misc[0] = 96.f * mq * mk * (0.10206207261596575f * 1.4426950408889634f) * 1.02f;
  }
  const int lane = threadIdx.x & 63, gw = gt >> 6, nw = gs >> 6;
  for (int t = gw; t < T_TOK; t += nw) {
    const float* xr = xrow(p, t);
    f32x4 v[4]; float ss = 0.f;
#pragma unroll
    for (int i = 0; i < 4; ++i) {
      v[i] = *(const f32x4*)(xr + i * 256 + lane * 4);
      ss += v[i][0] * v[i][0] + v[i][1] * v[i][1] + v[i][2] * v[i][2] + v[i][3] * v[i][3];
    }
    ss = wave_sum(ss);
#pragma unroll
    for (int i = 0; i < 4; ++i) {
      u32x2 o = {cvtpk(v[i][0], v[i][1]), cvtpk(v[i][2], v[i][3])};
      *(u32x2*)(p.Xb + (size_t)t * 1024 + i * 256 + lane * 4) = o;
    }
    if (lane == 0) p.rstd1[t] = rsqrtf(ss * (1.f / 1024.f) + EPS);
  }
  transpose_w<1>(p.WinT, p.w_in, p.attn_norm_g, nullptr, 1280, 1024, 1184, gt, gs);
  transpose_w<0>(p.WuqT, p.w_uq, p.q_lat_g, nullptr, 768, 384, 768, gt, gs);
  transpose_w<0>(p.WukvT, p.w_ukv, p.kv_lat_g, nullptr, 1024, 256, 1024, gt, gs);
  transpose_w<2>(p.WoutT, p.w_out, p.attn_out_g, p.fnet_out_g, 1024, 1024, 1024, gt, gs);
  transpose_w<0>(p.WpqT, p.peer_w_q, p.ffn_norm_g, nullptr, 2048, 1024, 2048, gt, gs);
  for (int id = gt; id < 262144 / 4; id += gs) {
    f32x4 v = *(const f32x4*)(p.peer_sub_keys + (size_t)id * 4);
    u32x2 o = {cvtpk(v[0], v[1]), cvtpk(v[2], v[3])};
    *(u32x2*)(p.SK + (size_t)id * 4) = o;
  }
  for (int id = gt; id < 256 * 128; id += gs) {
    const int n = id >> 7, c = id & 127, pp = n >> 7, m = n & 127;
    const float fr = (float)((m * c) & 127) * (1.f / 128.f);
    const float val = (pp == 0 ? __builtin_amdgcn_cosf(fr) : -__builtin_amdgcn_sinf(fr)) * 0.08838834764831845f;
    p.Wc[id] = f2bf(val);
  }
  for (int id = gt; id < 128 * 128; id += gs) {
    const int n = id >> 7, k = id & 127;
    const int k1 = (n >> 6) * 32 + (n & 31), pq = (n >> 5) & 1, pp = k >> 6, s1 = k & 63;
    const float fr = (float)((s1 * k1) & 63) * (1.f / 64.f);
    const float c = __builtin_amdgcn_cosf(fr), s = __builtin_amdgcn_sinf(fr);
    const float val = (pq == 0 ? (pp == 0 ? c : s) : (pp == 0 ? -s : c)) * 0.125f;
    p.WA64[id] = f2bf(val);
  }
  for (int id = gt; id < 128 * 64; id += gs) {
    const int n = id >> 6, k = id & 63;
    const int k1 = n & 31, pq = (n >> 5) & 1, pp = k >> 5, s1 = k & 31;
    const float fr = (float)((s1 * k1) & 31) * (1.f / 32.f);
    const float c = __builtin_amdgcn_cosf(fr), s = __builtin_amdgcn_sinf(fr);
    float val = (pq == 0 ? (pp == 0 ? c : s) : (pp == 0 ? -s : c)) * 0.17677669529663687f;
    if (n >= 64) val = 0.f;
    p.WA32[id] = f2bf(val);
  }
  for (int id = gt; id < 128 * 256; id += gs) {
    const int k2 = id >> 8, k = id & 255, pq = k >> 7, s2 = k & 127;
    const float fr = (float)((s2 * k2) & 127) * (1.f / 128.f);
    const float val = (pq == 0 ? __builtin_amdgcn_cosf(fr) : __builtin_amdgcn_sinf(fr)) * 0.08838834764831845f;
    p.WB[id] = f2bf(val);
  }
  for (int id = gt; id < 8192 * 16; id += gs) {
    const int pos = id >> 4, j = id & 15;
    const float freq = exp2f(-(float)j * (13.287712379549449f / 16.f));
    const double rev = (double)pos * (double)freq * 0.15915494309189535;
    const float fr = (float)(rev - floor(rev));
    p.ropec[id] = __builtin_amdgcn_cosf(fr);
    p.ropes[id] = __builtin_amdgcn_sinf(fr);
  }
}

DI void phase1(const Params& p, char* smem) {
    float* rs = (float*)(smem + 65536);
  const int G = gridDim.x;
  for (int tile = vblock(); tile < 384 * 10; tile += G) {
    WAVE_COORDS_L
    const int mt = tile / 10, nt = tile - mt * 10, m0 = mt * 128, n0 = nt * 128;
    __syncthreads();
    if (tid < 128) rs[tid] = p.rstd1[m0 + tid];
    f32x16 acc[2][2]; zero_acc(acc);
    const u16* A = p.Xb + (size_t)m0 * 1024; const u16* B = p.WinT + (size_t)n0 * 1024;
    gemm_mainloop<true>(acc, smem, [&](int rr) { return A + (size_t)rr * 1024; }, [&](int rr) { return B + (size_t)rr * 1024; }, 0, 1024);
    if (nt == 9) {
      if (wn == 0) {
#pragma unroll
        for (int mi = 0; mi < 2; ++mi)
#pragma unroll
          for (int i = 0; i < 16; ++i) {
            const int ro = mi * 32 + (i & 3) + 8 * (i >> 2);
            p.KR[(size_t)(m0 + wm * 64 + 4 * h + ro) * 32 + r] = acc[mi][0][i] * rs[wm * 64 + 4 * h + ro];
          }
      }
    } else {
      stage_bf16_t<true>(smem, acc, rs, wm, wn, r, h);
      __syncthreads();
      u16* dbase; int dstride, cbase;
      if (nt < 3) { dbase = p.CQ; dstride = 384; cbase = n0; }
      else if (nt < 5) { dbase = p.CKV; dstride = 256; cbase = n0 - 384; }
      else { dbase = p.F; dstride = 512; cbase = n0 - 640; }
#pragma unroll
      for (int j = 0; j < 8; ++j) {
        const int id = tid + 256 * j, row = id >> 4, cc = id & 15;
        const u32x4 v = *(const u32x4*)(smem + row * SROW + cc * 16);
        *(u32x4*)(dbase + (size_t)(m0 + row) * dstride + cbase + cc * 8) = v;
        if (nt < 5) {
          float ss = sumsq8(v);
          ss += __shfl_xor(ss, 1); ss += __shfl_xor(ss, 2); ss += __shfl_xor(ss, 4); ss += __shfl_xor(ss, 8);
          if (cc == 0) p.SSP[(size_t)(m0 + row) * 10 + nt * 2] = ss;
        }
      }
    }
  }
}

DI void phase2(const Params& p, char* smem) {
    float* rs = (float*)(smem + 65536);
  const int G = gridDim.x;
  const int NUQ = 384 * 6, NUKV = 384 * 8, NCH = 384 * 8;
  for (int tile = vblock(); tile < NUQ + NUKV + NCH; tile += G) {
    WAVE_COORDS_L
    f32x16 acc[2][2]; zero_acc(acc);
    __syncthreads();
    if (tile < NUQ) {
      const int mt = tile / 6, nt = tile - mt * 6, m0 = mt * 128, n0 = nt * 128;
      if (tid < 128) {
        const float* s = p.SSP + (size_t)(m0 + tid) * 10;
        rs[tid] = rsqrtf((s[0] + s[2] + s[4]) * (1.f / 384.f) + EPS);
      }
      const u16* A = p.CQ + (size_t)m0 * 384; const u16* B = p.WuqT + (size_t)n0 * 384;
      gemm_mainloop(acc, smem, [&](int rr) { return A + (size_t)rr * 384; }, [&](int rr) { return B + (size_t)rr * 384; }, 0, 384);
      stage_bf16_t<true>(smem, acc, rs, wm, wn, r, h);
      __syncthreads();
#pragma unroll
      for (int j = 0; j < 8; ++j) {
        const int id = tid + 256 * j, row = id >> 4, cc = id & 15;
        *(u32x4*)(p.Q1 + (size_t)(m0 + row) * 768 + n0 + cc * 8) = *(const u32x4*)(smem + row * SROW + cc * 16);
      }
    } else if (tile < NUQ + NUKV) {
      const int tl = tile - NUQ;
      const int mt = tl >> 3, hh = tl & 7, m0 = mt * 128;
      int q, S, tb; tok2seq(m0, q, S, tb);
      if (tid < 128) {
        const float* s = p.SSP + (size_t)(m0 + tid) * 10;
        rs[tid] = rsqrtf((s[6] + s[8]) * (1.f / 256.f) + EPS);
      }
      const u16* A = p.CKV + (size_t)m0 * 256; const u16* B = p.WukvT + (size_t)hh * 128 * 256;
      gemm_mainloop(acc, smem, [&](int rr) { return A + (size_t)rr * 256; }, [&](int rr) { return B + (size_t)rr * 256; }, 0, 256);
      if (wn == 0) {
#pragma unroll
        for (int mi = 0; mi < 2; ++mi)
#pragma unroll
          for (int i = 0; i < 16; ++i) {
            const int ro = mi * 32 + (i & 3) + 8 * (i >> 2);
            const float sc = (rs + wm * 64 + 4 * h)[ro];
#pragma unroll
            for (int ni = 0; ni < 2; ++ni) *(u16*)(smem + (wm * 64 + 4 * h) * SROW + r * 2 + ro * SROW + ni * 64) = f2bf(acc[mi][ni][i] * sc);
          }
      } else {
        const int s0 = m0 - tb;
#pragma unroll
        for (int mi = 0; mi < 2; ++mi)
#pragma unroll
          for (int g4 = 0; g4 < 4; ++g4) {
            const int row = wm * 64 + mi * 32 + 8 * g4 + 4 * h;
            const f32x4 sc = *(const f32x4*)(rs + row);
#pragma unroll
            for (int ni = 0; ni < 2; ++ni) {
              const int dv = ni * 32 + r;
              u32x2 o = {cvtpk(acc[mi][ni][4 * g4] * sc[0], acc[mi][ni][4 * g4 + 1] * sc[1]),
                         cvtpk(acc[mi][ni][4 * g4 + 2] * sc[2], acc[mi][ni][4 * g4 + 3] * sc[3])};
              *(u32x2*)(p.Vt + (size_t)tb * 512 + (size_t)(hh * 64 + dv) * S + s0 + row) = o;
            }
            __builtin_amdgcn_sched_barrier(0);
          }
      }
      __syncthreads();
#pragma unroll
      for (int j = 0; j < 4; ++j) {
        const int id = tid + 256 * j, row = id >> 3, cc = id & 7;
        *(u32x4*)(p.K1 + (size_t)(m0 + row) * 512 + hh * 64 + cc * 8) = *(const u32x4*)(smem + row * SROW + cc * 16);
      }
    } else {
      const int tl = tile - NUQ - NUKV;
      const int pp = tl & 1, g = (tl >> 1) & 3, mt = tl >> 3, m0 = mt * 128;
      int q, S, tb; tok2seq(m0, q, S, tb);
      const int S1 = (q < 2) ? 64 : 32, l1 = (q < 2) ? 6 : 5;
      const int j0 = ((m0 - tb) >> 7) * (128 >> l1);
      const u16* Fb = p.F + (size_t)g * 128;
      const u16* B = p.Wc + (size_t)pp * 128 * 128;
      gemm_mainloop(acc, smem,
                    [&](int rr) { const int s1 = rr & (S1 - 1), s2 = j0 + (rr >> l1); return Fb + (size_t)(tb + s1 * 128 + s2) * 512; },
                    [&](int rr) { return B + (size_t)rr * 128; }, 0, 128);
      u16* Zb = p.Z1 + (size_t)tb * 1024;
#pragma unroll
      for (int mi = 0; mi < 2; ++mi)
#pragma unroll
        for (int g4 = 0; g4 < 4; ++g4) {
          const int rho = wm * 64 + mi * 32 + 8 * g4 + 4 * h;
          const int s1 = rho & (S1 - 1), s2 = j0 + (rho >> l1);
#pragma unroll
          for (int ni = 0; ni < 2; ++ni) {
            const int m = wn * 64 + ni * 32 + r;
            u32x2 o = {cvtpk(acc[mi][ni][4 * g4], acc[mi][ni][4 * g4 + 1]), cvtpk(acc[mi][ni][4 * g4 + 2], acc[mi][ni][4 * g4 + 3])};
            *(u32x2*)(Zb + ((size_t)((g * 128 + m) * 128 + s2) * (2 * S1)) + pp * S1 + s1) = o;
          }
          __builtin_amdgcn_sched_barrier(0);
        }
    }
  }
}

DI void phase3(const Params& p, char* smem) {
    const int G = gridDim.x;
  for (int tile = vblock(); tile < 5120; tile += G) {
    WAVE_COORDS_L
    const int q = tile >> 9, gm = tile & 511;
    const int tb = (q < 2) ? (q << 13) : (TP + ((q - 2) << 12));
    const int S = (q < 2) ? 8192 : 4096, S1 = (q < 2) ? 64 : 32, K = 2 * S1;
    f32x16 acc[2][2]; zero_acc(acc);
    const u16* A = p.Z1 + (size_t)tb * 1024 + (size_t)gm * 128 * K;
    const u16* B = (q < 2) ? p.WA64 : p.WA32;
    gemm_mainloop(acc, smem, [&](int rr) { return A + (size_t)rr * K; }, [&](int rr) { return B + (size_t)rr * K; }, 0, K);
    if (wn * 32 < S1) {
      const int k1 = wn * 32 + r;
      const float invS = 1.f / (float)S;
      u16* Gb = p.G1 + (size_t)tb * 1024 + (size_t)(gm * S1 + k1) * 256;
#pragma unroll
      for (int mi = 0; mi < 2; ++mi)
#pragma unroll
        for (int g4 = 0; g4 < 4; ++g4) {
          const int s2b = wm * 64 + mi * 32 + 8 * g4 + 4 * h;
          float ore[4], oim[4];
#pragma unroll
          for (int j = 0; j < 4; ++j) {
            const int s2 = s2b + j;
            const float fr = (float)((s2 * k1) & (S - 1)) * invS;
            const float c = __builtin_amdgcn_cosf(fr), s = __builtin_amdgcn_sinf(fr);
            const float re = acc[mi][0][4 * g4 + j], im = acc[mi][1][4 * g4 + j];
            ore[j] = re * c + im * s; oim[j] = im * c - re * s;
          }
          u32x2 o0 = {cvtpk(ore[0], ore[1]), cvtpk(ore[2], ore[3])};
          u32x2 o1 = {cvtpk(oim[0], oim[1]), cvtpk(oim[2], oim[3])};
          *(u32x2*)(Gb + s2b) = o0;
          *(u32x2*)(Gb + 128 + s2b) = o1;
        }
    }
  }
  const float QSCALE = 0.10206207261596575f * 1.4426950408889634f;
  for (int chunk = vblock(); chunk < T_TOK * 8 / NTHR; chunk += G) {
    WAVE_COORDS_L
    const int id = chunk * NTHR + tid;
    const int t = id >> 3, hh = id & 7;
    int q, S, tb; tok2seq(t, q, S, tb);
    const int s = t - tb;
    const size_t obase = ((size_t)tb * 8 + (size_t)hh * S + s) * 96;
    const float* rcp = p.ropec + s * 16; const float* rsp = p.ropes + s * 16;
    {
      u32x4 w[12];
      const u16* src = p.Q1 + (size_t)t * 768 + hh * 96;
#pragma unroll
      for (int i = 0; i < 12; ++i) w[i] = *(const u32x4*)(src + i * 8);
      float ss = 0.f;
#pragma unroll
      for (int i = 0; i < 12; ++i)
#pragma unroll
        for (int j = 0; j < 4; ++j) { const float a = bflo(w[i][j]), b = bfhi(w[i][j]); ss += a * a + b * b; }
      const float rinv = rsqrtf(ss * (1.f / 96.f) + EPS);
      u16* dst = p.Qn + obase;
#pragma unroll
      for (int i = 0; i < 8; ++i) {
        u32x4 o;
#pragma unroll
        for (int j = 0; j < 4; ++j) {
          const int d = i * 8 + j * 2;
          o[j] = cvtpk(bflo(w[i][j]) * rinv * p.q_head_g[d] * QSCALE, bfhi(w[i][j]) * rinv * p.q_head_g[d + 1] * QSCALE);
        }
        *(u32x4*)(dst + i * 8) = o;
      }
      float x1[16], x2[16];
#pragma unroll
      for (int i = 0; i < 2; ++i)
#pragma unroll
        for (int j = 0; j < 4; ++j) {
          const int e = i * 8 + j * 2;
          x1[e] = bflo(w[8 + i][j]) * rinv * p.q_head_g[64 + e]; x1[e + 1] = bfhi(w[8 + i][j]) * rinv * p.q_head_g[64 + e + 1];
          x2[e] = bflo(w[10 + i][j]) * rinv * p.q_head_g[80 + e]; x2[e + 1] = bfhi(w[10 + i][j]) * rinv * p.q_head_g[80 + e + 1];
        }
      float o1[16], o2[16];
#pragma unroll
      for (int e = 0; e < 16; ++e) {
        const float c = rcp[e], sn = rsp[e];
        o1[e] = (x1[e] * c - x2[e] * sn) * QSCALE; o2[e] = (x2[e] * c + x1[e] * sn) * QSCALE;
      }
#pragma unroll
      for (int i = 0; i < 2; ++i) {
        u32x4 a, b;
#pragma unroll
        for (int j = 0; j < 4; ++j) { a[j] = cvtpk(o1[i * 8 + j * 2], o1[i * 8 + j * 2 + 1]); b[j] = cvtpk(o2[i * 8 + j * 2], o2[i * 8 + j * 2 + 1]); }
        *(u32x4*)(dst + 64 + i * 8) = a;
        *(u32x4*)(dst + 80 + i * 8) = b;
      }
    }
    __builtin_amdgcn_sched_barrier(0);
    {
      u32x4 w[8];
      const u16* src = p.K1 + (size_t)t * 512 + hh * 64;
#pragma unroll
      for (int i = 0; i < 8; ++i) w[i] = *(const u32x4*)(src + i * 8);
      f32x4 kr[8];
#pragma unroll
      for (int i = 0; i < 8; ++i) kr[i] = *(const f32x4*)(p.KR + (size_t)t * 32 + i * 4);
      float ss = 0.f;
#pragma unroll
      for (int i = 0; i < 8; ++i)
#pragma unroll
        for (int j = 0; j < 4; ++j) { const float a = bflo(w[i][j]), b = bfhi(w[i][j]); ss += a * a + b * b + kr[i][j] * kr[i][j]; }
      const float rinv = rsqrtf(ss * (1.f / 96.f) + EPS);
      u16* dst = p.Kn + obase;
#pragma unroll
      for (int i = 0; i < 8; ++i) {
        u32x4 o;
#pragma unroll
        for (int j = 0; j < 4; ++j) {
          const int d = i * 8 + j * 2;
          o[j] = cvtpk(bflo(w[i][j]) * rinv * p.k_head_g[d], bfhi(w[i][j]) * rinv * p.k_head_g[d + 1]);
        }
        *(u32x4*)(dst + i * 8) = o;
      }
      float o1[16], o2[16];
#pragma unroll
      for (int e = 0; e < 16; ++e) {
        const float a = kr[e >> 2][e & 3] * rinv * p.k_head_g[64 + e];
        const float b = kr[4 + (e >> 2)][e & 3] * rinv * p.k_head_g[80 + e];
        const float c = rcp[e], sn = rsp[e];
        o1[e] = a * c - b * sn; o2[e] = b * c + a * sn;
      }
#pragma unroll
      for (int i = 0; i < 2; ++i) {
        u32x4 a, b;
#pragma unroll
        for (int j = 0; j < 4; ++j) { a[j] = cvtpk(o1[i * 8 + j * 2], o1[i * 8 + j * 2 + 1]); b[j] = cvtpk(o2[i * 8 + j * 2], o2[i * 8 + j * 2 + 1]); }
        *(u32x4*)(dst + 64 + i * 8) = a;
        *(u32x4*)(dst + 80 + i * 8) = b;
      }
    }
  }
}

constexpr int KSTR = 208, VSTR = 136, ABUF = 64 * KSTR + 64 * VSTR;

DI void attn_tile(const Params& p, char* smem, int a) {
  WAVE_COORDS
  int q, hh, qt, S, tb;
  if (a < 1024) { q = a >> 9; hh = (a >> 6) & 7; qt = a & 63; S = 8192; tb = q << 13; }
  else { const int b = a - 1024; q = 2 + (b >> 8); hh = (b >> 5) & 7; qt = b & 31; S = 4096; tb = TP + ((q - 2) << 12); }
  const size_t qkb = ((size_t)tb * 8 + (size_t)hh * S) * 96;
  const u16* Qb = p.Qn + qkb; const u16* Kb = p.Kn + qkb;
  const u16* Vb = p.Vt + (size_t)tb * 512 + (size_t)hh * 64 * S;
  const int qrow = qt * 128 + wave * 32 + r;
  bf16x8 qf[6];
#pragma unroll
  for (int ks = 0; ks < 6; ++ks) qf[ks] = *(const bf16x8*)(Qb + (size_t)qrow * 96 + ks * 16 + h * 8);
  f32x16 o[2];
#pragma unroll
  for (int i = 0; i < 16; ++i) { o[0][i] = 0.f; o[1][i] = 0.f; }
  float mrun = -1e30f, lrun = 0.f;
  int krow_[3], kc_[3], vrow_[2], vc_[2];
#pragma unroll
  for (int i = 0; i < 3; ++i) { const int id = tid + 256 * i; krow_[i] = id / 12; kc_[i] = id - krow_[i] * 12; }
#pragma unroll
  for (int i = 0; i < 2; ++i) { const int id = tid + 256 * i; vrow_[i] = id >> 3; vc_[i] = id & 7; }
  u32x4 rk[3], rv[2];
  const int nkt = S >> 6;
#pragma unroll
  for (int i = 0; i < 3; ++i) rk[i] = *(const u32x4*)(Kb + (size_t)krow_[i] * 96 + kc_[i] * 8);
#pragma unroll
  for (int i = 0; i < 2; ++i) rv[i] = *(const u32x4*)(Vb + (size_t)vrow_[i] * S + vc_[i] * 8);
  __syncthreads();
#pragma unroll
  for (int i = 0; i < 3; ++i) *(u32x4*)(smem + krow_[i] * KSTR + kc_[i] * 16) = rk[i];
#pragma unroll
  for (int i = 0; i < 2; ++i) {
    char* d = smem + 64 * KSTR + vrow_[i] * VSTR + vc_[i] * 16;
    *(u32x2*)d = u32x2{rv[i][0], rv[i][1]}; *(u32x2*)(d + 8) = u32x2{rv[i][2], rv[i][3]};
  }
  __syncthreads();
  int cur = 0;
  for (int kt = 0; kt < nkt; ++kt) {
    const bool nxt = (kt + 1 < nkt);
    if (nxt) {
#pragma unroll
      for (int i = 0; i < 3; ++i) rk[i] = *(const u32x4*)(Kb + (size_t)((kt + 1) * 64 + krow_[i]) * 96 + kc_[i] * 8);
#pragma unroll
      for (int i = 0; i < 2; ++i) rv[i] = *(const u32x4*)(Vb + (size_t)vrow_[i] * S + (kt + 1) * 64 + vc_[i] * 8);
    }
    __builtin_amdgcn_sched_barrier(0);
    const char* Ks = smem + cur * ABUF;
    const char* Vs = Ks + 64 * KSTR;
    f32x16 sacc[2];
#pragma unroll
    for (int i = 0; i < 16; ++i) { sacc[0][i] = 0.f; sacc[1][i] = 0.f; }
#pragma unroll
    for (int t2 = 0; t2 < 2; ++t2)
#pragma unroll
      for (int ks = 0; ks < 6; ++ks) {
        const bf16x8 kf = *(const bf16x8*)(Ks + (t2 * 32 + r) * KSTR + ks * 32 + h * 16);
        sacc[t2] = MFMA(kf, qf[ks], sacc[t2]);
      }
    float mx = sacc[0][0];
#pragma unroll
    for (int i = 0; i < 16; ++i) { mx = fmaxf(mx, sacc[0][i]); mx = fmaxf(mx, sacc[1][i]); }
    mx = fmaxf(mx, __shfl_xor(mx, 32));
    const float mnew = fmaxf(mrun, mx);
    const float alpha = __builtin_amdgcn_exp2f(mrun - mnew);
    mrun = mnew;
    lrun *= alpha;
#pragma unroll
    for (int i = 0; i < 16; ++i) { o[0][i] *= alpha; o[1][i] *= alpha; }
    float ps = 0.f;
#pragma unroll
    for (int t2 = 0; t2 < 2; ++t2)
#pragma unroll
      for (int i = 0; i < 16; ++i) { const float e = __builtin_amdgcn_exp2f(sacc[t2][i] - mnew); sacc[t2][i] = e; ps += e; }
    lrun += ps;
    bf16x8 pf[4];
#pragma unroll
    for (int kk = 0; kk < 4; ++kk) {
      const int t2 = kk >> 1, s8 = (kk & 1) * 8;
      u32x4 pk = {cvtpk(sacc[t2][s8], sacc[t2][s8 + 1]), cvtpk(sacc[t2][s8 + 2], sacc[t2][s8 + 3]),
                  cvtpk(sacc[t2][s8 + 4], sacc[t2][s8 + 5]), cvtpk(sacc[t2][s8 + 6], sacc[t2][s8 + 7])};
      pf[kk] = __builtin_bit_cast(bf16x8, pk);
    }
#pragma unroll
    for (int dt = 0; dt < 2; ++dt)
#pragma unroll
      for (int kk = 0; kk < 4; ++kk) {
        const char* vp = Vs + (dt * 32 + r) * VSTR + kk * 32 + h * 8;
        const u32x2 lo = *(const u32x2*)vp, hi = *(const u32x2*)(vp + 16);
        u32x4 vv = {lo[0], lo[1], hi[0], hi[1]};
        o[dt] = MFMA(__builtin_bit_cast(bf16x8, vv), pf[kk], o[dt]);
      }
    __builtin_amdgcn_sched_barrier(0);
    if (nxt) {
      char* Kn_ = smem + (cur ^ 1) * ABUF;
#pragma unroll
      for (int i = 0; i < 3; ++i) *(u32x4*)(Kn_ + krow_[i] * KSTR + kc_[i] * 16) = rk[i];
#pragma unroll
      for (int i = 0; i < 2; ++i) {
        char* d = Kn_ + 64 * KSTR + vrow_[i] * VSTR + vc_[i] * 16;
        *(u32x2*)d = u32x2{rv[i][0], rv[i][1]}; *(u32x2*)(d + 8) = u32x2{rv[i][2], rv[i][3]};
      }
    }
    __syncthreads();
    cur ^= 1;
  }
  lrun += __shfl_xor(lrun, 32);
  const float inv = 1.f / lrun;
  float ss = 0.f;
  u16* dst = p.MIX + (size_t)(tb + qrow) * 1024 + hh * 64;
#pragma unroll
  for (int dt = 0; dt < 2; ++dt)
#pragma unroll
    for (int g4 = 0; g4 < 4; ++g4) {
      float v[4];
#pragma unroll
      for (int j = 0; j < 4; ++j) { v[j] = o[dt][4 * g4 + j] * inv; ss += v[j] * v[j]; }
      u32x2 ov = {cvtpk(v[0], v[1]), cvtpk(v[2], v[3])};
      *(u32x2*)(dst + dt * 32 + 8 * g4 + 4 * h) = ov;
    }
  ss += __shfl_xor(ss, 32);
  if (h == 0) p.SSA[(size_t)(tb + qrow) * 8 + hh] = ss;
}

constexpr int VSTR2 = 144, ABUF2 = 64 * KSTR + 64 * VSTR2;
DI float swapmax32(float v) {
  auto rr = __builtin_amdgcn_permlane32_swap(__float_as_uint(v), __float_as_uint(v), false, false);
  return fmaxf(__uint_as_float(rr[0]), __uint_as_float(rr[1]));
}
DI float swapsum32(float v) {
  auto rr = __builtin_amdgcn_permlane32_swap(__float_as_uint(v), __float_as_uint(v), false, false);
  return __uint_as_float(rr[0]) + __uint_as_float(rr[1]);
}
template <bool RUNMAX>
DI void attn_tile2(const Params& p, char* smem, int a) {
  WAVE_COORDS_L
  int q, hh, qt, S, tb;
  if (a < 512) { q = a >> 8; hh = (a >> 5) & 7; qt = a & 31; S = 8192; tb = q << 13; }
  else { const int b = a - 512; q = 2 + (b >> 7); hh = (b >> 4) & 7; qt = b & 15; S = 4096; tb = TP + ((q - 2) << 12); }
  const size_t qkb = ((size_t)tb * 8 + (size_t)hh * S) * 96;
  const u16* Qb = p.Qn + qkb; const u16* Kb = p.Kn + qkb;
  const u16* Vb = p.Vt + (size_t)tb * 512 + (size_t)hh * 64 * S;
  const int qrow0 = qt * 256 + wave * 64 + r;
  bf16x8 qf[2][6];
#pragma unroll
  for (int g = 0; g < 2; ++g)
#pragma unroll
    for (int ks = 0; ks < 6; ++ks) qf[g][ks] = *(const bf16x8*)(Qb + (size_t)(qrow0 + 32 * g) * 96 + ks * 16 + h * 8);
  f32x16 o[2][2];
#pragma unroll
  for (int i = 0; i < 16; ++i) { o[0][0][i] = 0.f; o[0][1][i] = 0.f; o[1][0][i] = 0.f; o[1][1][i] = 0.f; }
  float mrun[2] = {-1e30f, -1e30f}, lrun[2] = {0.f, 0.f};
  int klds_[3], vlds_[2];
#pragma unroll
  for (int i = 0; i < 3; ++i) { const int id = tid + 256 * i; const int kr = id / 12; klds_[i] = kr * KSTR + (id - kr * 12) * 16; }
#pragma unroll
  for (int i = 0; i < 2; ++i) { const int vc = tid & 7; vlds_[i] = 64 * KSTR + ((tid >> 3) + 32 * i) * VSTR2 + (vc >> 1) * 32 + (vc & 1) * 8; }
  const u16* Kg = Kb + tid * 8;
  const u16* Vg = Vb + (size_t)(tid >> 3) * S + (tid & 7) * 8;
  u32x4 rk[3], rv[2];
  const int nkt = S >> 6;
#pragma unroll
  for (int i = 0; i < 3; ++i) rk[i] = *(const u32x4*)(Kg + i * 2048);
#pragma unroll
  for (int i = 0; i < 2; ++i) rv[i] = *(const u32x4*)(Vg + (size_t)(32 * i) * S);
  __syncthreads();
  auto put = [&](char* base) {
#pragma unroll
    for (int i = 0; i < 3; ++i) *(u32x4*)(base + klds_[i]) = rk[i];
#pragma unroll
    for (int i = 0; i < 2; ++i) {
      char* d = base + vlds_[i];
      *(u32x2*)d = u32x2{rv[i][0], rv[i][1]}; *(u32x2*)(d + 16) = u32x2{rv[i][2], rv[i][3]};
    }
  };
  put(smem);
  __syncthreads();
  int cur = 0;
#pragma unroll 1
  for (int kt = 0; kt < nkt; ++kt) {
    const bool nxt = (kt + 1 < nkt);
    if (nxt) {
#pragma unroll
      for (int i = 0; i < 3; ++i) rk[i] = *(const u32x4*)(Kg + (size_t)(kt + 1) * 6144 + i * 2048);
#pragma unroll
      for (int i = 0; i < 2; ++i) rv[i] = *(const u32x4*)(Vg + (size_t)(32 * i) * S + (kt + 1) * 64);
    }
    __builtin_amdgcn_sched_barrier(0);
    const char* Ks = smem + cur * ABUF2;
    const char* Vs = Ks + 64 * KSTR;
#pragma unroll
    for (int t2 = 0; t2 < 2; ++t2) {
      f32x16 sacc[2];
#pragma unroll
      for (int i = 0; i < 16; ++i) { sacc[0][i] = 0.f; sacc[1][i] = 0.f; }
#pragma unroll
      for (int kb = 0; kb < 2; ++kb) {
        bf16x8 kf[3];
#pragma unroll
        for (int ks = 0; ks < 3; ++ks) kf[ks] = *(const bf16x8*)(Ks + (t2 * 32 + r) * KSTR + (kb * 3 + ks) * 32 + h * 16);
#pragma unroll
        for (int ks = 0; ks < 3; ++ks) {
          sacc[0] = MFMA(kf[ks], qf[0][kb * 3 + ks], sacc[0]);
          sacc[1] = MFMA(kf[ks], qf[1][kb * 3 + ks], sacc[1]);
        }
      }
      __builtin_amdgcn_sched_barrier(0);
      bf16x8 pf[2][2];
#pragma unroll
      for (int g = 0; g < 2; ++g) {
        float ps = 0.f;
        if (RUNMAX) {
        float mx = sacc[g][0];
#pragma unroll
        for (int i = 1; i < 16; ++i) mx = fmaxf(mx, sacc[g][i]);
        mx = swapmax32(mx);
        const float mnew = fmaxf(mrun[g], mx);
        if (__ballot(mnew > mrun[g]) != 0ull) {
          const float alpha = __builtin_amdgcn_exp2f(mrun[g] - mnew);
          lrun[g] *= alpha;
#pragma unroll
          for (int i = 0; i < 16; ++i) { o[g][0][i] *= alpha; o[g][1][i] *= alpha; }
          mrun[g] = mnew;
        }
#pragma unroll
        for (int i = 0; i < 16; ++i) { const float e = __builtin_amdgcn_exp2f(sacc[g][i] - mrun[g]); sacc[g][i] = e; ps += e; }
        } else {
#pragma unroll
          for (int i = 0; i < 16; ++i) sacc[g][i] = __builtin_amdgcn_exp2f(sacc[g][i]);
        }
#pragma unroll
        for (int s = 0; s < 2; ++s) {
          const int s8 = s * 8;
          u32x4 pk = {cvtpk(sacc[g][s8], sacc[g][s8 + 1]), cvtpk(sacc[g][s8 + 2], sacc[g][s8 + 3]),
                      cvtpk(sacc[g][s8 + 4], sacc[g][s8 + 5]), cvtpk(sacc[g][s8 + 6], sacc[g][s8 + 7])};
          pf[g][s] = __builtin_bit_cast(bf16x8, pk);
          if (!RUNMAX) {
#pragma unroll
            for (int w = 0; w < 4; ++w) ps = fdot2(pk[w], 0x3F803F80u, ps);
          }
        }
        lrun[g] += ps;
      }
      __builtin_amdgcn_sched_barrier(0);
#pragma unroll
      for (int dt = 0; dt < 2; ++dt) {
        bf16x8 vf[2];
#pragma unroll
        for (int s = 0; s < 2; ++s) vf[s] = *(const bf16x8*)(Vs + (dt * 32 + r) * VSTR2 + (t2 * 2 + s) * 32 + h * 16);
#pragma unroll
        for (int s = 0; s < 2; ++s) {
          o[0][dt] = MFMA(vf[s], pf[0][s], o[0][dt]);
          o[1][dt] = MFMA(vf[s], pf[1][s], o[1][dt]);
        }
      }
    }
    __builtin_amdgcn_sched_barrier(0);
    if (nxt) put(smem + (cur ^ 1) * ABUF2);
    __syncthreads();
    cur ^= 1;
  }
#pragma unroll
  for (int g = 0; g < 2; ++g) {
    const float lsum = swapsum32(lrun[g]);
    const float inv = 1.f / lsum;
    const int qrow = qrow0 + 32 * g;
    float ss = 0.f;
    u16* dst = p.MIX + (size_t)(tb + qrow) * 1024 + hh * 64;
#pragma unroll
    for (int dt = 0; dt < 2; ++dt)
#pragma unroll
      for (int g4 = 0; g4 < 4; ++g4) {
        float v[4];
#pragma unroll
        for (int jj = 0; jj < 4; ++jj) { v[jj] = o[g][dt][4 * g4 + jj] * inv; ss += v[jj] * v[jj]; }
        u32x2 ov = {cvtpk(v[0], v[1]), cvtpk(v[2], v[3])};
        *(u32x2*)(dst + dt * 32 + 8 * g4 + 4 * h) = ov;
      }
    ss = swapsum32(ss);
    if (h == 0) p.SSA[(size_t)(tb + qrow) * 8 + hh] = ss;
  }
}

DI void phase4(const Params& p, char* smem) {
    const int G = gridDim.x;
  if (p.misc[0] > 64.f) { for (int a = vblock(); a < 1536; a += G) attn_tile2<true>(p, smem, a); }
  else { for (int a = vblock(); a < 1536; a += G) attn_tile2<false>(p, smem, a); }
  for (int tile = vblock(); tile < 1536; tile += G) {
    WAVE_COORDS_L
    int q, g, k1, S1, tb;
    if (tile < 512) { q = tile >> 8; g = (tile >> 6) & 3; k1 = tile & 63; S1 = 64; tb = q << 13; }
    else { const int b = tile - 512; q = 2 + (b >> 7); g = (b >> 5) & 3; k1 = b & 31; S1 = 32; tb = TP + ((q - 2) << 12); }
    f32x16 acc[2][2]; zero_acc(acc);
    const u16* A = p.G1 + (size_t)tb * 1024 + ((size_t)(g * 128) * S1 + k1) * 256;
    const u16* B = p.WB;
    const int rstride = S1 * 256;
    gemm_mainloop(acc, smem, [&](int rr) { return A + (size_t)rr * rstride; }, [&](int rr) { return B + (size_t)rr * 256; }, 0, 256);
#pragma unroll
    for (int ni = 0; ni < 2; ++ni) {
      const int k2 = wn * 64 + ni * 32 + r;
      const size_t tok = (size_t)(tb + k1 + S1 * k2);
      float ss = 0.f;
#pragma unroll
      for (int mi = 0; mi < 2; ++mi)
#pragma unroll
        for (int g4 = 0; g4 < 4; ++g4) {
          const int m = wm * 64 + mi * 32 + 8 * g4 + 4 * h;
          float v[4];
#pragma unroll
          for (int j = 0; j < 4; ++j) { v[j] = acc[mi][ni][4 * g4 + j]; ss += v[j] * v[j]; }
          u32x2 ov = {cvtpk(v[0], v[1]), cvtpk(v[2], v[3])};
          *(u32x2*)(p.MIX + tok * 1024 + 512 + g * 128 + m) = ov;
        }
      ss += __shfl_xor(ss, 32);
      if (h == 0) p.SSF[tok * 8 + g * 2 + wm] = ss;
    }
  }
}

DI void phase5(const Params& p, char* smem) {
    float* rs = (float*)(smem + 65536);
  const int G = gridDim.x;
  for (int tile = vblock(); tile < 384 * 8; tile += G) {
    WAVE_COORDS_L
    const int mt = tile >> 3, nt = tile & 7, m0 = mt * 128, n0 = nt * 128;
    __syncthreads();
    if (tid < 128) {
      const float* sa = p.SSA + (size_t)(m0 + tid) * 8; const float* sf = p.SSF + (size_t)(m0 + tid) * 8;
      const float ra = rsqrtf((sa[0] + sa[1] + sa[2] + sa[3] + sa[4] + sa[5] + sa[6] + sa[7]) * (1.f / 512.f) + EPS);
      const float rf = rsqrtf((sf[0] + sf[1] + sf[2] + sf[3] + sf[4] + sf[5] + sf[6] + sf[7]) * (1.f / 512.f) + EPS);
      rs[tid] = ra / rf; rs[128 + tid] = rf;
    }
    f32x16 acc[2][2]; zero_acc(acc);
    const u16* A = p.MIX + (size_t)m0 * 1024; const u16* B = p.WoutT + (size_t)n0 * 1024;
    auto af = [&](int rr) { return A + (size_t)rr * 1024; };
    auto bfn = [&](int rr) { return B + (size_t)rr * 1024; };
    gemm_mainloop<true>(acc, smem, af, bfn, 0, 512);
    {
      const float* rb = rs + wm * 64 + 4 * h;
#pragma unroll
      for (int mi = 0; mi < 2; ++mi)
#pragma unroll
        for (int i = 0; i < 16; ++i) {
          const float sc = rb[mi * 32 + (i & 3) + 8 * (i >> 2)];
          acc[mi][0][i] *= sc; acc[mi][1][i] *= sc;
        }
    }
    gemm_mainloop<true>(acc, smem, af, bfn, 512, 1024);
    {
      const float* rb = rs + 128 + wm * 64 + 4 * h;
      char* sb = smem + (wm * 64 + 4 * h) * 512 + (wn * 64 + r) * 4;
#pragma unroll
      for (int mi = 0; mi < 2; ++mi)
#pragma unroll
        for (int i = 0; i < 16; ++i) {
          const int ro = mi * 32 + (i & 3) + 8 * (i >> 2);
          const float sc = rb[ro];
#pragma unroll
          for (int ni = 0; ni < 2; ++ni) *(float*)(sb + ro * 512 + ni * 128) = acc[mi][ni][i] * sc;
        }
    }
    __syncthreads();
#pragma unroll 4
    for (int j = 0; j < 16; ++j) {
      const int id = tid + 256 * j, row = id >> 5, cc = id & 31;
      const int t = m0 + row, col = n0 + cc * 4;
      f32x4 v = *(const f32x4*)(smem + row * 512 + cc * 16);
      const f32x4 xv = *(const f32x4*)(xrow(p, t) + col);
      v[0] += xv[0]; v[1] += xv[1]; v[2] += xv[2]; v[3] += xv[3];
      *(f32x4*)(p.out + (size_t)t * 1024 + col) = v;
      u32x2 ob = {cvtpk(v[0], v[1]), cvtpk(v[2], v[3])};
      *(u32x2*)(p.X2b + (size_t)t * 1024 + col) = ob;
      float ss = v[0] * v[0] + v[1] * v[1] + v[2] * v[2] + v[3] * v[3];
      ss = red32(ss);
      if (cc == 0) p.SS2[(size_t)t * 16 + nt] = ss;
    }
  }
  const int gt = blockIdx.x * NTHR + threadIdx.x, gs = gridDim.x * NTHR;
  for (int id = gt; id < 16384 * 1024 / 16; id += gs) {
    const int d = (id & 63) * 16;
    u32x4 ou, ov;
#pragma unroll
    for (int k = 0; k < 4; ++k) {
      const f32x4 a = *(const f32x4*)(p.peer_u + (size_t)id * 16 + k * 4);
      const f32x4 g = *(const f32x4*)(p.ffn_norm_g + d + k * 4);
      const f32x4 b = *(const f32x4*)(p.peer_v + (size_t)id * 16 + k * 4);
      float u0 = fminf(fmaxf(a[0] * g[0] * USCALE, -448.f), 448.f), u1 = fminf(fmaxf(a[1] * g[1] * USCALE, -448.f), 448.f);
      float u2 = fminf(fmaxf(a[2] * g[2] * USCALE, -448.f), 448.f), u3 = fminf(fmaxf(a[3] * g[3] * USCALE, -448.f), 448.f);
      float v0 = fminf(fmaxf(b[0] * VSCALE, -448.f), 448.f), v1 = fminf(fmaxf(b[1] * VSCALE, -448.f), 448.f);
      float v2 = fminf(fmaxf(b[2] * VSCALE, -448.f), 448.f), v3 = fminf(fmaxf(b[3] * VSCALE, -448.f), 448.f);
      int pu = __builtin_amdgcn_cvt_pk_fp8_f32(u0, u1, 0, false); pu = __builtin_amdgcn_cvt_pk_fp8_f32(u2, u3, pu, true);
      int pv = __builtin_amdgcn_cvt_pk_fp8_f32(v0, v1, 0, false); pv = __builtin_amdgcn_cvt_pk_fp8_f32(v2, v3, pv, true);
      ou[k] = (unsigned)pu; ov[k] = (unsigned)pv;
    }
    {
      const int e = id >> 6, ch = id & 63;
      const size_t o = ((size_t)(ch >> 3) * 16384 + e) * 128 + (ch & 7) * 16;
      *(u32x4*)(p.U8 + o) = ou;
      *(u32x4*)(p.V8 + o) = ov;
    }
  }
}

DI void phase6(const Params& p, char* smem) {
    const int G = gridDim.x;
  for (int tile = vblock(); tile < 384 * 16; tile += G) {
    WAVE_COORDS_L
    const int mt = tile >> 4, nt = tile & 15, m0 = mt * 128, n0 = nt * 128;
    f32x16 acc[2][2]; zero_acc(acc);
    __syncthreads();
    const u16* A = p.X2b + (size_t)m0 * 1024; const u16* B = p.WpqT + (size_t)n0 * 1024;
    gemm_mainloop<true>(acc, smem, [&](int rr) { return A + (size_t)rr * 1024; }, [&](int rr) { return B + (size_t)rr * 1024; }, 0, 1024);
    stage_bf16_t<false>(smem, acc, nullptr, wm, wn, r, h);
    __syncthreads();
#pragma unroll
    for (int j = 0; j < 8; ++j) {
      const int id = tid + 256 * j, row = id >> 4, cc = id & 15;
      *(u32x4*)(p.Qp + (size_t)(m0 + row) * 2048 + n0 + cc * 8) = *(const u32x4*)(smem + row * SROW + cc * 16);
    }
  }
}

DI void ins16(float (&top)[16], float x) {
#pragma unroll
  for (int j = 0; j < 16; ++j) { const float hi = fmaxf(top[j], x); x = fminf(top[j], x); top[j] = hi; }
}
DI float mask7(float x) { return __uint_as_float(__float_as_uint(x) & ~0x7Fu); }

#define CE16(a, b) { const float hi_ = fmaxf(a, b); b = fminf(a, b); a = hi_; }
DI void sort16_desc(float (&x)[16]) {
  CE16(x[0], x[1])
  CE16(x[3], x[2])
  CE16(x[4], x[5])
  CE16(x[7], x[6])
  CE16(x[8], x[9])
  CE16(x[11], x[10])
  CE16(x[12], x[13])
  CE16(x[15], x[14])
  CE16(x[0], x[2])
  CE16(x[1], x[3])
  CE16(x[6], x[4])
  CE16(x[7], x[5])
  CE16(x[8], x[10])
  CE16(x[9], x[11])
  CE16(x[14], x[12])
  CE16(x[15], x[13])
  CE16(x[0], x[1])
  CE16(x[2], x[3])
  CE16(x[5], x[4])
  CE16(x[7], x[6])
  CE16(x[8], x[9])
  CE16(x[10], x[11])
  CE16(x[13], x[12])
  CE16(x[15], x[14])
  CE16(x[0], x[4])
  CE16(x[1], x[5])
  CE16(x[2], x[6])
  CE16(x[3], x[7])
  CE16(x[12], x[8])
  CE16(x[13], x[9])
  CE16(x[14], x[10])
  CE16(x[15], x[11])
  CE16(x[0], x[2])
  CE16(x[1], x[3])
  CE16(x[4], x[6])
  CE16(x[5], x[7])
  CE16(x[10], x[8])
  CE16(x[11], x[9])
  CE16(x[14], x[12])
  CE16(x[15], x[13])
  CE16(x[0], x[1])
  CE16(x[2], x[3])
  CE16(x[4], x[5])
  CE16(x[6], x[7])
  CE16(x[9], x[8])
  CE16(x[11], x[10])
  CE16(x[13], x[12])
  CE16(x[15], x[14])
  CE16(x[0], x[8])
  CE16(x[1], x[9])
  CE16(x[2], x[10])
  CE16(x[3], x[11])
  CE16(x[4], x[12])
  CE16(x[5], x[13])
  CE16(x[6], x[14])
  CE16(x[7], x[15])
  CE16(x[0], x[4])
  CE16(x[1], x[5])
  CE16(x[2], x[6])
  CE16(x[3], x[7])
  CE16(x[8], x[12])
  CE16(x[9], x[13])
  CE16(x[10], x[14])
  CE16(x[11], x[15])
  CE16(x[0], x[2])
  CE16(x[1], x[3])
  CE16(x[4], x[6])
  CE16(x[5], x[7])
  CE16(x[8], x[10])
  CE16(x[9], x[11])
  CE16(x[12], x[14])
  CE16(x[13], x[15])
  CE16(x[0], x[1])
  CE16(x[2], x[3])
  CE16(x[4], x[5])
  CE16(x[6], x[7])
  CE16(x[8], x[9])
  CE16(x[10], x[11])
  CE16(x[12], x[13])
  CE16(x[14], x[15])
}
DI void bmerge16_desc(float (&x)[16]) {
  CE16(x[0], x[8])
  CE16(x[1], x[9])
  CE16(x[2], x[10])
  CE16(x[3], x[11])
  CE16(x[4], x[12])
  CE16(x[5], x[13])
  CE16(x[6], x[14])
  CE16(x[7], x[15])
  CE16(x[0], x[4])
  CE16(x[1], x[5])
  CE16(x[2], x[6])
  CE16(x[3], x[7])
  CE16(x[8], x[12])
  CE16(x[9], x[13])
  CE16(x[10], x[14])
  CE16(x[11], x[15])
  CE16(x[0], x[2])
  CE16(x[1], x[3])
  CE16(x[4], x[6])
  CE16(x[5], x[7])
  CE16(x[8], x[10])
  CE16(x[9], x[11])
  CE16(x[12], x[14])
  CE16(x[13], x[15])
  CE16(x[0], x[1])
  CE16(x[2], x[3])
  CE16(x[4], x[5])
  CE16(x[6], x[7])
  CE16(x[8], x[9])
  CE16(x[10], x[11])
  CE16(x[12], x[13])
  CE16(x[14], x[15])
}
DI void top16_merge(float (&A)[16], const float (&B)[16]) {
#pragma unroll
  for (int i = 0; i < 16; ++i) A[i] = fmaxf(A[i], B[15 - i]);
  bmerge16_desc(A);
}

DI void score_top16(const Params& p, int t, int hh, int c, int r, int h, float (&top)[16]) {
  f32x16 acc[4];
#pragma unroll
  for (int n = 0; n < 4; ++n)
#pragma unroll
    for (int i = 0; i < 16; ++i) acc[n][i] = 0.f;
  const u16* qp = p.Qp + (size_t)t * 2048 + (hh * 2 + c) * 128 + h * 8;
  const u16* sk = p.SK + ((size_t)(hh * 2 + c) * 128 + r) * 128 + h * 8;
  bf16x8 bq[8];
#pragma unroll
  for (int ks = 0; ks < 8; ++ks) bq[ks] = *(const bf16x8*)(qp + ks * 16);
#pragma unroll
  for (int n = 0; n < 4; ++n) {
    bf16x8 fa[8];
#pragma unroll
    for (int ks = 0; ks < 8; ++ks) fa[ks] = *(const bf16x8*)(sk + n * 4096 + ks * 16);
    __builtin_amdgcn_sched_barrier(0);
#pragma unroll
    for (int ks = 0; ks < 8; ++ks) acc[n] = MFMA(fa[ks], bq[ks], acc[n]);
    __builtin_amdgcn_sched_barrier(0);
  }
  float k1[16], k2[16], k3[16];
#pragma unroll
  for (int i = 0; i < 16; ++i) {
    const unsigned ci = (unsigned)crow(i, h);
    top[i] = __uint_as_float((__float_as_uint(acc[0][i]) & ~0x7Fu) | ci);
    k1[i] = __uint_as_float((__float_as_uint(acc[1][i]) & ~0x7Fu) | (32u + ci));
    k2[i] = __uint_as_float((__float_as_uint(acc[2][i]) & ~0x7Fu) | (64u + ci));
    k3[i] = __uint_as_float((__float_as_uint(acc[3][i]) & ~0x7Fu) | (96u + ci));
  }
  sort16_desc(top); sort16_desc(k1); sort16_desc(k2); sort16_desc(k3);
  top16_merge(top, k1); top16_merge(k2, k3); top16_merge(top, k2);
  float oth[16];
#pragma unroll
  for (int j = 0; j < 16; ++j) oth[j] = __shfl_xor(top[j], 32);
  top16_merge(top, oth);
}

DI void phase7(const Params& p, char* smem) {
  WAVE_COORDS
  const int G = gridDim.x;
  volatile unsigned* lw = (volatile unsigned*)(smem + wave * 1024);
  volatile unsigned char* lb = (volatile unsigned char*)(smem + wave * 1024);
  const float NEG_INF = __uint_as_float(0xFF800000u);
  for (int task = vblock() * 4 + wave; task < 1536 * 8; task += G * 4) {
    const int hh = task & 7, tok0 = (task >> 3) * 32;
    const int t = tok0 + r;
    float L0[16], L1[16];
    score_top16(p, t, hh, 0, r, h, L0);
    score_top16(p, t, hh, 1, r, h, L1);
    float ct[16], cb[16];
    {
      float ck[50];
    ck[0] = __uint_as_float((__float_as_uint(mask7(L0[0]) + mask7(L1[0])) & ~0xFFu) | 0u);
    ck[1] = __uint_as_float((__float_as_uint(mask7(L0[0]) + mask7(L1[1])) & ~0xFFu) | 1u);
    ck[2] = __uint_as_float((__float_as_uint(mask7(L0[0]) + mask7(L1[2])) & ~0xFFu) | 2u);
    ck[3] = __uint_as_float((__float_as_uint(mask7(L0[0]) + mask7(L1[3])) & ~0xFFu) | 3u);
    ck[4] = __uint_as_float((__float_as_uint(mask7(L0[0]) + mask7(L1[4])) & ~0xFFu) | 4u);
    ck[5] = __uint_as_float((__float_as_uint(mask7(L0[0]) + mask7(L1[5])) & ~0xFFu) | 5u);
    ck[6] = __uint_as_float((__float_as_uint(mask7(L0[0]) + mask7(L1[6])) & ~0xFFu) | 6u);
    ck[7] = __uint_as_float((__float_as_uint(mask7(L0[0]) + mask7(L1[7])) & ~0xFFu) | 7u);
    ck[8] = __uint_as_float((__float_as_uint(mask7(L0[0]) + mask7(L1[8])) & ~0xFFu) | 8u);
    ck[9] = __uint_as_float((__float_as_uint(mask7(L0[0]) + mask7(L1[9])) & ~0xFFu) | 9u);
    ck[10] = __uint_as_float((__float_as_uint(mask7(L0[0]) + mask7(L1[10])) & ~0xFFu) | 10u);
    ck[11] = __uint_as_float((__float_as_uint(mask7(L0[0]) + mask7(L1[11])) & ~0xFFu) | 11u);
    ck[12] = __uint_as_float((__float_as_uint(mask7(L0[0]) + mask7(L1[12])) & ~0xFFu) | 12u);
    ck[13] = __uint_as_float((__float_as_uint(mask7(L0[0]) + mask7(L1[13])) & ~0xFFu) | 13u);
    ck[14] = __uint_as_float((__float_as_uint(mask7(L0[0]) + mask7(L1[14])) & ~0xFFu) | 14u);
    ck[15] = __uint_as_float((__float_as_uint(mask7(L0[0]) + mask7(L1[15])) & ~0xFFu) | 15u);
    ck[16] = __uint_as_float((__float_as_uint(mask7(L0[1]) + mask7(L1[0])) & ~0xFFu) | 16u);
    ck[17] = __uint_as_float((__float_as_uint(mask7(L0[1]) + mask7(L1[1])) & ~0xFFu) | 17u);
    ck[18] = __uint_as_float((__float_as_uint(mask7(L0[1]) + mask7(L1[2])) & ~0xFFu) | 18u);
    ck[19] = __uint_as_float((__float_as_uint(mask7(L0[1]) + mask7(L1[3])) & ~0xFFu) | 19u);
    ck[20] = __uint_as_float((__float_as_uint(mask7(L0[1]) + mask7(L1[4])) & ~0xFFu) | 20u);
    ck[21] = __uint_as_float((__float_as_uint(mask7(L0[1]) + mask7(L1[5])) & ~0xFFu) | 21u);
    ck[22] = __uint_as_float((__float_as_uint(mask7(L0[1]) + mask7(L1[6])) & ~0xFFu) | 22u);
    ck[23] = __uint_as_float((__float_as_uint(mask7(L0[1]) + mask7(L1[7])) & ~0xFFu) | 23u);
    ck[24] = __uint_as_float((__float_as_uint(mask7(L0[2]) + mask7(L1[0])) & ~0xFFu) | 32u);
    ck[25] = __uint_as_float((__float_as_uint(mask7(L0[2]) + mask7(L1[1])) & ~0xFFu) | 33u);
    ck[26] = __uint_as_float((__float_as_uint(mask7(L0[2]) + mask7(L1[2])) & ~0xFFu) | 34u);
    ck[27] = __uint_as_float((__float_as_uint(mask7(L0[2]) + mask7(L1[3])) & ~0xFFu) | 35u);
    ck[28] = __uint_as_float((__float_as_uint(mask7(L0[2]) + mask7(L1[4])) & ~0xFFu) | 36u);
    ck[29] = __uint_as_float((__float_as_uint(mask7(L0[3]) + mask7(L1[0])) & ~0xFFu) | 48u);
    ck[30] = __uint_as_float((__float_as_uint(mask7(L0[3]) + mask7(L1[1])) & ~0xFFu) | 49u);
    ck[31] = __uint_as_float((__float_as_uint(mask7(L0[3]) + mask7(L1[2])) & ~0xFFu) | 50u);
    ck[32] = __uint_as_float((__float_as_uint(mask7(L0[3]) + mask7(L1[3])) & ~0xFFu) | 51u);
    ck[33] = __uint_as_float((__float_as_uint(mask7(L0[4]) + mask7(L1[0])) & ~0xFFu) | 64u);
    ck[34] = __uint_as_float((__float_as_uint(mask7(L0[4]) + mask7(L1[1])) & ~0xFFu) | 65u);
    ck[35] = __uint_as_float((__float_as_uint(mask7(L0[4]) + mask7(L1[2])) & ~0xFFu) | 66u);
    ck[36] = __uint_as_float((__float_as_uint(mask7(L0[5]) + mask7(L1[0])) & ~0xFFu) | 80u);
    ck[37] = __uint_as_float((__float_as_uint(mask7(L0[5]) + mask7(L1[1])) & ~0xFFu) | 81u);
    ck[38] = __uint_as_float((__float_as_uint(mask7(L0[6]) + mask7(L1[0])) & ~0xFFu) | 96u);
    ck[39] = __uint_as_float((__float_as_uint(mask7(L0[6]) + mask7(L1[1])) & ~0xFFu) | 97u);
    ck[40] = __uint_as_float((__float_as_uint(mask7(L0[7]) + mask7(L1[0])) & ~0xFFu) | 112u);
    ck[41] = __uint_as_float((__float_as_uint(mask7(L0[7]) + mask7(L1[1])) & ~0xFFu) | 113u);
    ck[42] = __uint_as_float((__float_as_uint(mask7(L0[8]) + mask7(L1[0])) & ~0xFFu) | 128u);
    ck[43] = __uint_as_float((__float_as_uint(mask7(L0[9]) + mask7(L1[0])) & ~0xFFu) | 144u);
    ck[44] = __uint_as_float((__float_as_uint(mask7(L0[10]) + mask7(L1[0])) & ~0xFFu) | 160u);
    ck[45] = __uint_as_float((__float_as_uint(mask7(L0[11]) + mask7(L1[0])) & ~0xFFu) | 176u);
    ck[46] = __uint_as_float((__float_as_uint(mask7(L0[12]) + mask7(L1[0])) & ~0xFFu) | 192u);
    ck[47] = __uint_as_float((__float_as_uint(mask7(L0[13]) + mask7(L1[0])) & ~0xFFu) | 208u);
    ck[48] = __uint_as_float((__float_as_uint(mask7(L0[14]) + mask7(L1[0])) & ~0xFFu) | 224u);
    ck[49] = __uint_as_float((__float_as_uint(mask7(L0[15]) + mask7(L1[0])) & ~0xFFu) | 240u);
      const float NINF = __uint_as_float(0xFF800000u);
#pragma unroll
      for (int q = 0; q < 25; ++q) {
        float a_ = ck[q], b_ = ck[25 + q];
        asm volatile("" : "+v"(a_), "+v"(b_));
        const float m = h ? b_ : a_;
        if (q < 16) ct[q] = m; else cb[q - 16] = m;
      }
#pragma unroll
      for (int q = 9; q < 16; ++q) cb[q] = NINF;
      sort16_desc(ct); sort16_desc(cb);
      top16_merge(ct, cb);
#pragma unroll
      for (int q = 0; q < 16; ++q) cb[q] = __shfl_xor(ct[q], 32);
      top16_merge(ct, cb);
    }
    if (h == 0) {
#pragma unroll
      for (int w = 0; w < 4; ++w) {
        unsigned v = 0, v2 = 0;
#pragma unroll
        for (int b = 0; b < 4; ++b) {
          v |= (__float_as_uint(L0[w * 4 + b]) & 0x7Fu) << (8 * b);
          v2 |= (__float_as_uint(L1[w * 4 + b]) & 0x7Fu) << (8 * b);
        }
        lw[r * 8 + w] = v;
        lw[r * 8 + 4 + w] = v2;
      }
    }
    __builtin_amdgcn_wave_barrier();
    const float* s2 = p.SS2 + (size_t)t * 16;
    float ssum = 0.f;
#pragma unroll
    for (int j = 0; j < 8; ++j) ssum += s2[j];
    const float r2 = rsqrtf(ssum * (1.f / 1024.f) + EPS);
    float gv[16];
    const float v0 = __uint_as_float(__float_as_uint(ct[0]) & ~0xFFu) * r2;
    float esum = 0.f;
#pragma unroll
    for (int j = 0; j < 16; ++j) {
      const float vj = __uint_as_float(__float_as_uint(ct[j]) & ~0xFFu) * r2;
      gv[j] = __builtin_amdgcn_exp2f((vj - v0) * 1.4426950408889634f);
      esum += gv[j];
    }
    const float einv = 1.f / esum;
    u32x4 oi[2]; f32x4 og[2];
#pragma unroll
    for (int jj = 0; jj < 8; ++jj) {
      float ka = ct[jj], kb = ct[8 + jj], ga = gv[jj], gb = gv[8 + jj];
      asm volatile("" : "+v"(ka), "+v"(kb), "+v"(ga), "+v"(gb));
      const float key = h ? kb : ka;
      const float g = (h ? gb : ga) * einv;
      const unsigned code = __float_as_uint(key) & 0xFFu;
      const unsigned i1 = lb[r * 32 + (code >> 4)], i2 = lb[r * 32 + 16 + (code & 15)];
      oi[jj >> 2][jj & 3] = i1 * 128 + i2;
      og[jj >> 2][jj & 3] = g;
    }
    int* ip = p.IDX + (size_t)t * 128 + hh * 16 + h * 8;
    float* gp = p.G + (size_t)t * 128 + hh * 16 + h * 8;
    *(u32x4*)ip = oi[0]; *(u32x4*)(ip + 4) = oi[1];
    *(f32x4*)gp = og[0]; *(f32x4*)(gp + 4) = og[1];
    __builtin_amdgcn_wave_barrier();
  }
}

DI float gelu_tanh(float x) {
  const float u = 0.7978845608028654f * (x + 0.044715f * x * x * x);
  const float e = __builtin_amdgcn_exp2f(u * 2.8853900817779268f);
  const float th = 1.f - 2.f * __builtin_amdgcn_rcpf(e + 1.f);
  return 0.5f * x * (1.f + th);
}
DI float dot16_fp8(const u32x4& w, const u32x4& xa, const u32x4& xb) {
  float acc = 0.f;
#pragma unroll
  for (int k = 0; k < 4; ++k) {
    const bf2_t b0 = __builtin_amdgcn_cvt_scalef32_pk_bf16_fp8(w[k], 1.0f, false);
    const bf2_t b1 = __builtin_amdgcn_cvt_scalef32_pk_bf16_fp8(w[k], 1.0f, true);
    const unsigned x0 = (k < 2) ? xa[2 * k] : xb[2 * k - 4], x1 = (k < 2) ? xa[2 * k + 1] : xb[2 * k - 3];
    acc = __builtin_amdgcn_fdot2_f32_bf16(b0, __builtin_bit_cast(bf2_t, x0), acc, false);
    acc = __builtin_amdgcn_fdot2_f32_bf16(b1, __builtin_bit_cast(bf2_t, x1), acc, false);
  }
  return acc;
}

template <int CTRL>
DI float dppf(float x) { return __uint_as_float(__builtin_amdgcn_update_dpp(0u, __float_as_uint(x), CTRL, 0xF, 0xF, false)); }
DI float swap32sum(float a, float b) {
  auto rr = __builtin_amdgcn_permlane32_swap(__float_as_uint(a), __float_as_uint(b), false, false);
  return __uint_as_float(rr[0]) + __uint_as_float(rr[1]);
}
DI float swap16sum(float a, float b) {
  auto rr = __builtin_amdgcn_permlane16_swap(__float_as_uint(a), __float_as_uint(b), false, false);
  return __uint_as_float(rr[0]) + __uint_as_float(rr[1]);
}
struct P8Buf { u32x4 w[16]; u32x4 xa, xb; };

DI void p8_load_idx(const Params& p, int t, int j, u32x4 (&ix)[4]) {
  const int* ip = p.IDX + (size_t)t * 128 + j * 16;
#pragma unroll
  for (int q = 0; q < 4; ++q) ix[q] = *(const u32x4*)(ip + q * 4);
}
DI void p8_load_rows(const unsigned char* tab, int s, int cc, const u32x4 (&ix)[4], u32x4 (&w)[16]) {
  const unsigned char* base = tab + (size_t)s * (16384 * 128) + cc * 16;
#pragma unroll
  for (int i = 0; i < 16; ++i) w[i] = *(const u32x4*)(base + (size_t)ix[i >> 2][i & 3] * 128);
}

DI void phase8(const Params& p, char* smem, const int tbase) {
  WAVE_COORDS
  const int G = gridDim.x;
  const int gw = vblock() * 4 + wave, NW = G * 4;
  const int j = lane >> 3, cc = lane & 7;
  const bool b0 = lane & 1, b1 = lane & 2, b2 = lane & 4, b3 = lane & 8, b4 = lane & 16, b5 = lane & 32;
  f32x2* part = (f32x2*)(smem + wave * 12288) + lane;
  const float* coefl = (const float*)(smem + wave * 12288);
  const int ntok_all = (T_TOK - gw + NW - 1) / NW;
  const int ntok = min(24, ntok_all - tbase);
  const int gw0 = gw + tbase * NW;
  if (ntok <= 0) return;
  for (int s = 0; s < 8; ++s) {
    u32x4 ixA[4], ixB[4];
    u32x4 wA[16], wB[16];
    u32x4 xaA, xbA, xaB, xbB;
    auto issue = [&](int i, u32x4 (&ix)[4], u32x4 (&w)[16], u32x4& xa, u32x4& xb) {
      const int t = gw0 + i * NW;
      const u16* xr = p.X2b + (size_t)t * 1024 + s * 128 + cc * 16;
      xa = *(const u32x4*)xr; xb = *(const u32x4*)(xr + 8);
      p8_load_rows(p.U8, s, cc, ix, w);
    };
    auto compute = [&](int i, u32x4 (&w)[16], u32x4& xa, u32x4& xb) {
      float d[16];
#pragma unroll
      for (int q = 0; q < 16; ++q) d[q] = dot16_fp8(w[q], xa, xb);
      float v8[8], v4[4], v2[2];
#pragma unroll
      for (int m = 0; m < 8; ++m) { const float mine = b2 ? d[m + 8] : d[m], send = b2 ? d[m] : d[m + 8]; v8[m] = mine + dppf<0x141>(send); }
#pragma unroll
      for (int m = 0; m < 4; ++m) { const float mine = b1 ? v8[m + 4] : v8[m], send = b1 ? v8[m] : v8[m + 4]; v4[m] = mine + dppf<0x4E>(send); }
#pragma unroll
      for (int m = 0; m < 2; ++m) { const float mine = b0 ? v4[m + 2] : v4[m], send = b0 ? v4[m] : v4[m + 2]; v2[m] = mine + dppf<0xB1>(send); }
      f32x2 acc = {v2[0], v2[1]};
      if (s > 0) { const f32x2 o = part[i * 64]; acc[0] += o[0]; acc[1] += o[1]; }
      part[i * 64] = acc;
    };
    p8_load_idx(p, gw0, j, ixA);
    issue(0, ixA, wA, xaA, xbA);
    if (ntok > 1) p8_load_idx(p, gw0 + NW, j, ixB);
#pragma unroll 1
    for (int i = 0; i < ntok; i += 2) {
      if (i + 1 < ntok) issue(i + 1, ixB, wB, xaB, xbB);
      if (i + 2 < ntok) p8_load_idx(p, gw0 + (i + 2) * NW, j, ixA);
      __builtin_amdgcn_sched_barrier(0);
      compute(i, wA, xaA, xbA);
      __builtin_amdgcn_sched_barrier(0);
      if (i + 1 < ntok) {
        if (i + 2 < ntok) issue(i + 2, ixA, wA, xaA, xbA);
        if (i + 3 < ntok) p8_load_idx(p, gw0 + (i + 3) * NW, j, ixB);
        __builtin_amdgcn_sched_barrier(0);
        compute(i + 1, wB, xaB, xbB);
        __builtin_amdgcn_sched_barrier(0);
      }
    }
  }
  for (int i = 0; i < ntok; ++i) {
    const int t = gw0 + i * NW;
    const float* s2 = p.SS2 + (size_t)t * 16;
    float ssum = 0.f;
#pragma unroll
    for (int q = 0; q < 8; ++q) ssum += s2[q];
    const float r2 = rsqrtf(ssum * (1.f / 1024.f) + EPS) * (1.f / USCALE);
    const f32x2 g = *(const f32x2*)(p.G + (size_t)t * 128 + lane * 2);
    f32x2 a = part[i * 64];
    a[0] = gelu_tanh(a[0] * r2) * g[0] * (1.f / VSCALE);
    a[1] = gelu_tanh(a[1] * r2) * g[1] * (1.f / VSCALE);
    part[i * 64] = a;
  }
  asm volatile("" ::: "memory");
  __builtin_amdgcn_wave_barrier();
  for (int s = 0; s < 8; ++s) {
    u32x4 ixA[4], ixB[4];
    u32x4 wA[16], wB[16];
    auto compute = [&](int i, u32x4 (&w)[16]) {
      const int t = gw0 + i * NW;
      const float* cp = coefl + i * 128 + j * 16;
      f32x4 cf[4];
#pragma unroll
      for (int q = 0; q < 4; ++q) cf[q] = *(const f32x4*)(cp + q * 4);
      f32x2 acc2[8];
#pragma unroll
      for (int e = 0; e < 8; ++e) acc2[e] = f32x2{0.f, 0.f};
#pragma unroll
      for (int q = 0; q < 16; ++q) {
        const float cq = cf[q >> 2][q & 3];
        const f32x2 c2 = {cq, cq};
#pragma unroll
        for (int k = 0; k < 4; ++k) {
          const f32x2 lo = __builtin_amdgcn_cvt_pk_f32_fp8((int)w[q][k], false);
          const f32x2 hi = __builtin_amdgcn_cvt_pk_f32_fp8((int)w[q][k], true);
          acc2[2 * k] = __builtin_elementwise_fma(lo, c2, acc2[2 * k]);
          acc2[2 * k + 1] = __builtin_elementwise_fma(hi, c2, acc2[2 * k + 1]);
        }
      }
      float acc[16];
#pragma unroll
      for (int e = 0; e < 8; ++e) { acc[2 * e] = acc2[e][0]; acc[2 * e + 1] = acc2[e][1]; }
      float v8[8], v4[4], v2[2];
#pragma unroll
      for (int m = 0; m < 8; ++m) v8[m] = swap32sum(acc[m], acc[m + 8]);
#pragma unroll
      for (int m = 0; m < 4; ++m) v4[m] = swap16sum(v8[m], v8[m + 4]);
#pragma unroll
      for (int m = 0; m < 2; ++m) { const float mine = b3 ? v4[m + 2] : v4[m], send = b3 ? v4[m] : v4[m + 2]; v2[m] = mine + dppf<0x128>(send); }
      float* op = p.out + (size_t)t * 1024 + s * 128 + cc * 16 + 2 * j;
      f32x2 o = *(f32x2*)op;
      o[0] += v2[0]; o[1] += v2[1];
      *(f32x2*)op = o;
    };
    p8_load_idx(p, gw0, j, ixA);
    p8_load_rows(p.V8, s, cc, ixA, wA);
    if (ntok > 1) p8_load_idx(p, gw0 + NW, j, ixB);
#pragma unroll 1
    for (int i = 0; i < ntok; i += 2) {
      if (i + 1 < ntok) p8_load_rows(p.V8, s, cc, ixB, wB);
      if (i + 2 < ntok) p8_load_idx(p, gw0 + (i + 2) * NW, j, ixA);
      __builtin_amdgcn_sched_barrier(0);
      compute(i, wA);
      __builtin_amdgcn_sched_barrier(0);
      if (i + 1 < ntok) {
        if (i + 2 < ntok) p8_load_rows(p.V8, s, cc, ixA, wA);
        if (i + 3 < ntok) p8_load_idx(p, gw0 + (i + 3) * NW, j, ixB);
        __builtin_amdgcn_sched_barrier(0);
        compute(i + 1, wB);
        __builtin_amdgcn_sched_barrier(0);
      }
    }
  }
  asm volatile("" ::: "memory");
  __builtin_amdgcn_wave_barrier();
}

extern __shared__ __attribute__((aligned(16))) char dyn_smem[];

DI void run_phase(const Params& p, int ph, char* smem) {
  switch (ph) {
    case 0: phase0(p); break;
    case 1: phase1(p, smem); break;
    case 2: phase2(p, smem); break;
    case 3: phase3(p, smem); break;
    case 4: phase4(p, smem); break;
    case 5: phase5(p, smem); break;
    case 6: phase6(p, smem); break;
    case 7: phase7(p, smem); break;
    default: phase8(p, smem, 0); break;
  }
}


#define XB_TMO      128
#define XB_XCNT(j)  (256  + 64 * (j))
#define XB_XSUB(j)  (1280 + 64 * (j))
#define XB_XGEN(j)  (2304 + 64 * (j))
#define XB_TOP      3328
#define XB_TOPGEN   3392
#define XCD_BAR_WORDS 3456
#define XB_SPIN_CAP (1u << 22)
#define LAS __attribute__((address_space(3)))
DI unsigned xb_ld(unsigned* p) { return __hip_atomic_load(p, __ATOMIC_RELAXED, __HIP_MEMORY_SCOPE_AGENT); }
DI unsigned xb_add(unsigned* p, unsigned v) { return __hip_atomic_fetch_add(p, v, __ATOMIC_RELAXED, __HIP_MEMORY_SCOPE_AGENT); }
DI unsigned xb_xcc_id() { return (unsigned)__builtin_amdgcn_s_getreg((3 << 11) | 20) & 0xFu; }
#define XB_SPIN(cond, bar) do { unsigned _sp = 0; while (cond) { __builtin_amdgcn_s_sleep(1); \
    if ((++_sp & 255u) == 0u) { if (xb_ld(&(bar)[XB_TMO])) break; if (_sp > XB_SPIN_CAP) { atomicAdd(&(bar)[XB_TMO], 1u); break; } } } } while (0)
struct XcdBarrier { unsigned* bar; unsigned x; volatile LAS unsigned* st; };
DI XcdBarrier xcd_barrier_post(unsigned* bar, volatile LAS unsigned* st) {
  XcdBarrier b; b.bar = bar; b.x = xb_xcc_id(); b.st = st;
  if (threadIdx.x == 0) (void)xb_add(&bar[XB_XCNT(b.x)], 1u);
  return b;
}
DI void xcd_barrier_complete(unsigned* bar, unsigned x, unsigned& nloc, unsigned& nx) {
  const unsigned G = gridDim.x * gridDim.y * gridDim.z;
  unsigned sum, cnt, mine, sp = 0u;
  for (;;) {
    sum = 0u; cnt = 0u; mine = 0u;
#pragma unroll
    for (unsigned j = 0; j < 16; ++j) { const unsigned c = xb_ld(&bar[XB_XCNT(j)]); sum += c; cnt += (c > 0u) ? 1u : 0u; mine = (j == x) ? c : mine; }
    if (sum == G) break;
    __builtin_amdgcn_s_sleep(1);
    if ((++sp & 255u) == 0u) { if (xb_ld(&bar[XB_TMO])) break; if (sp > XB_SPIN_CAP) { atomicAdd(&bar[XB_TMO], 1u); break; } }
  }
  nloc = mine > 0u ? mine : 1u; nx = cnt > 0u ? cnt : 1u;
}
DI void xcd_barrier(const XcdBarrier& b) {
  asm volatile("s_waitcnt vmcnt(0)" ::: "memory");
  __syncthreads();
  if (threadIdx.x == 0) {
    unsigned* bar = b.bar;
    __builtin_amdgcn_s_waitcnt(0);
    unsigned nloc = b.st[0], nx = b.st[1];
    if (nloc == 0u) { xcd_barrier_complete(bar, b.x, nloc, nx); b.st[0] = nloc; b.st[1] = nx; }
    const unsigned old = xb_add(&bar[XB_XSUB(b.x)], 1u);
    const unsigned gen = old / nloc;
    if (old + 1u == (gen + 1u) * nloc) {
      __builtin_amdgcn_fence(__ATOMIC_RELEASE, "agent");
      asm volatile("s_waitcnt vmcnt(0)" ::: "memory");
      const unsigned og = xb_add(&bar[XB_TOP], 1u);
      const unsigned tg = og / nx;
      if (og + 1u == (tg + 1u) * nx) xb_add(&bar[XB_TOPGEN], 1u);
      else XB_SPIN(xb_ld(&bar[XB_TOPGEN]) == tg, bar);
      __builtin_amdgcn_fence(__ATOMIC_ACQUIRE, "agent");
      xb_add(&bar[XB_XGEN(b.x)], 1u);
      asm volatile("s_waitcnt vmcnt(0)" ::: "memory");
    } else {
      XB_SPIN(xb_ld(&bar[XB_XGEN(b.x)]) == gen, bar);
      __builtin_amdgcn_fence(__ATOMIC_ACQUIRE, "agent");
      asm volatile("s_waitcnt vmcnt(0)" ::: "memory");
    }
  }
  __syncthreads();
}

#if MK_COOP
__global__ void __launch_bounds__(NTHR, 2) mega_kernel(Params p) {
  cg::grid_group grid = cg::this_grid();
#ifndef PROBE_PH
#define PROBE_PH -1
#endif
  volatile LAS unsigned* st = (volatile LAS unsigned*)(dyn_smem + 65536 + 1024);
  if (threadIdx.x < 4) st[threadIdx.x] = 0u;
  for (int i = blockIdx.x * NTHR + threadIdx.x; i < XCD_BAR_WORDS; i += gridDim.x * NTHR) p.bar[i] = 0u;
  phase0(p);
  grid.sync();
  XcdBarrier xb = xcd_barrier_post(p.bar, st);
#define RUNP(k, call) call; xcd_barrier(xb); if (PROBE_PH == k) { call; xcd_barrier(xb); }
  RUNP(1, phase1(p, dyn_smem))
  RUNP(2, phase2(p, dyn_smem))
  RUNP(3, phase3(p, dyn_smem))
  RUNP(4, phase4(p, dyn_smem))
  RUNP(5, phase5(p, dyn_smem))
  RUNP(6, phase6(p, dyn_smem))
  RUNP(7, phase7(p, dyn_smem))
  for (int tb8 = 0; tb8 * (int)gridDim.x * 4 < T_TOK; tb8 += 24) phase8(p, dyn_smem, tb8);
}
#else
template <int PH>
__global__ void __launch_bounds__(NTHR, 2) phase_kernel(Params p) { run_phase(p, PH, dyn_smem); }
#endif

extern "C" void kernel_launch(void* const* d_in, const int* in_sizes, int n_in, void* d_out, int out_size, void* d_ws,
                              size_t ws_size, hipStream_t stream) {
  Params p{};
  const float* const* in = (const float* const*)d_in;
  p.x0 = in[0]; p.x1 = in[1]; p.attn_norm_g = in[2]; p.w_in = in[3]; p.q_lat_g = in[4]; p.w_uq = in[5];
  p.kv_lat_g = in[6]; p.w_ukv = in[7]; p.q_head_g = in[8]; p.k_head_g = in[9]; p.attn_out_g = in[10];
  p.fnet_out_g = in[11]; p.w_out = in[12]; p.ffn_norm_g = in[13]; p.peer_w_q = in[14]; p.peer_sub_keys = in[15];
  p.peer_u = in[16]; p.peer_v = in[17];
  p.out = (float*)d_out;
  char* ws = (char*)d_ws;
  size_t off = 0;
  auto take = [&](size_t bytes) { char* q = ws + off; off += (bytes + 255) & ~(size_t)255; return q; };
  p.WinT = (u16*)take(1280 * 1024 * 2); p.WuqT = (u16*)take(768 * 384 * 2); p.WukvT = (u16*)take(1024 * 256 * 2);
  p.WoutT = (u16*)take(1024 * 1024 * 2); p.WpqT = (u16*)take(2048 * 1024 * 2); p.SK = (u16*)take(262144 * 2);
  p.Wc = (u16*)take(256 * 128 * 2); p.WA64 = (u16*)take(128 * 128 * 2); p.WA32 = (u16*)take(128 * 64 * 2);
  p.WB = (u16*)take(128 * 256 * 2);
  p.ropec = (float*)take(8192 * 16 * 4); p.ropes = (float*)take(8192 * 16 * 4);
  p.rstd1 = (float*)take((size_t)T_TOK * 4); p.SSP = (float*)take((size_t)T_TOK * 10 * 4);
  p.SSA = (float*)take((size_t)T_TOK * 8 * 4); p.SSF = (float*)take((size_t)T_TOK * 8 * 4);
  p.SS2 = (float*)take((size_t)T_TOK * 16 * 4); p.KR = (float*)take((size_t)T_TOK * 32 * 4);
  p.bar = (unsigned*)take(XCD_BAR_WORDS * 4);
  p.misc = (float*)take(256);
  const size_t SMALL = 28u << 20;
  char* big = ws + SMALL;
  const size_t MB = 1u << 20;
  char* dsp = (char*)d_out;
  p.Xb = (u16*)(big + 0 * MB);
  p.CQ = (u16*)(big + 96 * MB); p.CKV = (u16*)(big + 132 * MB); p.F = (u16*)(big + 156 * MB);
  p.Z1 = (u16*)(big + 204 * MB);
  p.Vt = (u16*)(big + 300 * MB);
  p.Q1 = (u16*)(dsp + 0 * MB); p.K1 = (u16*)(dsp + 72 * MB);
  p.Qn = (u16*)(big + 0 * MB); p.Kn = (u16*)(dsp + 120 * MB);
  p.G1 = (u16*)(big + 96 * MB);
  p.MIX = (u16*)(big + 204 * MB);
  p.X2b = (u16*)(big + 0 * MB);
  p.Qp = (u16*)(big + 96 * MB);
  p.IDX = (int*)(big + 300 * MB); p.G = (float*)(big + 324 * MB);
  p.U8 = (unsigned char*)(big + 348 * MB); p.V8 = (unsigned char*)(big + 364 * MB);

#if MK_COOP
  static int grid_blocks = 0;
  if (!grid_blocks) {
    int dev = 0, cus = 0, per_cu = 0;
    hipGetDevice(&dev);
    hipDeviceGetAttribute(&cus, hipDeviceAttributeMultiprocessorCount, dev);
    hipFuncSetAttribute((const void*)mega_kernel, hipFuncAttributeMaxDynamicSharedMemorySize, LDS_BYTES);
    hipOccupancyMaxActiveBlocksPerMultiprocessor(&per_cu, mega_kernel, NTHR, LDS_BYTES);
    if (per_cu > 2) per_cu = 2;
    grid_blocks = cus * per_cu;
    grid_blocks &= ~7;
  }
  void* args[] = {&p};
  hipError_t e = hipLaunchCooperativeKernel((void*)mega_kernel, dim3(grid_blocks), dim3(NTHR), args, LDS_BYTES, stream);
  if (e != hipSuccess) fprintf(stderr, "cooperative launch failed: %s (grid %d)\n", hipGetErrorString(e), grid_blocks);
#else
  const int GB = 512;
#define LAUNCH(PH)                                                                                                \
  hipFuncSetAttribute((const void*)phase_kernel<PH>, hipFuncAttributeMaxDynamicSharedMemorySize, LDS_BYTES);      \
  phase_kernel<PH><<<GB, NTHR, LDS_BYTES, stream>>>(p);
  LAUNCH(0) LAUNCH(1) LAUNCH(2) LAUNCH(3) LAUNCH(4) LAUNCH(5) LAUNCH(6) LAUNCH(7) LAUNCH(8)
#endif
}
```

```cpp
#include <hip/hip_runtime.h>
#include <hip/hip_cooperative_groups.h>
#include <stdint.h>
#include <cstdio>
namespace cg = cooperative_groups;

#ifndef MK_COOP
#define MK_COOP 1
#endif

typedef unsigned short u16;
using bf16x8 = __attribute__((ext_vector_type(8))) short;
using f32x16 = __attribute__((ext_vector_type(16))) float;
using f32x4 = __attribute__((ext_vector_type(4))) float;
using f32x2 = __attribute__((ext_vector_type(2))) float;
using u32x4 = __attribute__((ext_vector_type(4))) unsigned;
using u32x2 = __attribute__((ext_vector_type(2))) unsigned;
typedef __bf16 bf2_t __attribute__((ext_vector_type(2)));

#define DI __device__ __forceinline__
#define MFMA(a, b, c) __builtin_amdgcn_mfma_f32_32x32x16_bf16((a), (b), (c), 0, 0, 0)

constexpr int T_TOK = 49152;
constexpr int TP = 16384;
constexpr float EPS = 1e-6f;
constexpr int NTHR = 256;
constexpr int LDS_BYTES = 65536 + 6144;
constexpr int GBUF = 32768;
constexpr float USCALE = 512.f, VSCALE = 256.f;

struct Params {
  const float *x0, *x1, *attn_norm_g, *w_in, *q_lat_g, *w_uq, *kv_lat_g, *w_ukv, *q_head_g, *k_head_g,
      *attn_out_g, *fnet_out_g, *w_out, *ffn_norm_g, *peer_w_q, *peer_sub_keys, *peer_u, *peer_v;
  float* out;
  u16 *WinT, *WuqT, *WukvT, *WoutT, *WpqT, *SK, *Wc, *WA64, *WA32, *WB;
  float *ropec, *ropes, *rstd1, *SSP, *SSA, *SSF, *SS2, *KR;
  u16 *Xb, *CQ, *CKV, *F, *Z1, *Vt, *Q1, *K1, *Qn, *Kn, *G1, *MIX, *X2b, *Qp;
  unsigned char *U8, *V8;
  int* IDX;
  float* G;
  unsigned* bar;
  float* misc;
};

DI unsigned cvtpk(float lo, float hi) {
  f32x2 v = {lo, hi};
  bf2_t b = __builtin_convertvector(v, bf2_t);
  return __builtin_bit_cast(unsigned, b);
}
DI u16 f2bf(float x) { return (u16)(cvtpk(x, 0.f) & 0xffffu); }
DI float bflo(unsigned w) { return __uint_as_float(w << 16); }
DI float bfhi(unsigned w) { return __uint_as_float(w & 0xffff0000u); }
DI int crow(int i, int h) { return (i & 3) + 8 * (i >> 2) + 4 * h; }
DI float red32(float v) {
  v += __shfl_xor(v, 1); v += __shfl_xor(v, 2); v += __shfl_xor(v, 4); v += __shfl_xor(v, 8); v += __shfl_xor(v, 16);
  return v;
}
DI float wave_sum(float v) { v = red32(v); v += __shfl_xor(v, 32); return v; }
DI const float* xrow(const Params& p, int t) {
  return t < TP ? p.x0 + (size_t)t * 1024 : p.x1 + (size_t)(t - TP) * 1024;
}
DI void tok2seq(int t, int& q, int& S, int& tb) {
  if (t < TP) { q = t >> 13; S = 8192; tb = q << 13; }
  else { int u = (t - TP) >> 12; q = 2 + u; S = 4096; tb = TP + (u << 12); }
}
DI int vblock() { return (blockIdx.x & 7) * (gridDim.x >> 3) + (blockIdx.x >> 3); }
DI float fdot2(unsigned a, unsigned b, float c) {
  return __builtin_amdgcn_fdot2_f32_bf16(__builtin_bit_cast(bf2_t, a), __builtin_bit_cast(bf2_t, b), c, false);
}

DI int swz(int row, int c) { return row * 128 + ((c ^ ((row >> 1) & 7)) << 4); }

template <bool BATCH = false, class AF, class BF>
DI void gemm_mainloop(f32x16 (&acc)[2][2], char* smem, AF arow, BF brow, int k0, int k1) {
  const int tid = threadIdx.x, lane = tid & 63, wave = tid >> 6;
  const int wm = wave >> 1, wn = wave & 1, r = lane & 31, h = lane >> 5;
  const int lrow = tid >> 3, lc = tid & 7;
  const u16* ap[4]; const u16* bp[4];
#pragma unroll
  for (int i = 0; i < 4; ++i) { ap[i] = arow(lrow + 32 * i) + lc * 8; bp[i] = brow(lrow + 32 * i) + lc * 8; }
  u32x4 ra0[4], rb0[4], ra1[4], rb1[4];
#pragma unroll
  for (int i = 0; i < 4; ++i) { ra0[i] = *(const u32x4*)(ap[i] + k0); rb0[i] = *(const u32x4*)(bp[i] + k0); }
#pragma unroll
  for (int i = 0; i < 4; ++i) {
    *(u32x4*)(smem + swz(lrow + 32 * i, lc)) = ra0[i];
    *(u32x4*)(smem + 16384 + swz(lrow + 32 * i, lc)) = rb0[i];
  }
  if (k0 + 64 < k1) {
#pragma unroll
    for (int i = 0; i < 4; ++i) { ra0[i] = *(const u32x4*)(ap[i] + k0 + 64); rb0[i] = *(const u32x4*)(bp[i] + k0 + 64); }
  }
  __syncthreads();
  int cur = 0;
  auto step = [&](int k, u32x4 (&xa)[4], u32x4 (&xb)[4], u32x4 (&ya)[4], u32x4 (&yb)[4]) {
    if (k + 128 < k1) {
#pragma unroll
      for (int i = 0; i < 4; ++i) { ya[i] = *(const u32x4*)(ap[i] + k + 128); yb[i] = *(const u32x4*)(bp[i] + k + 128); }
    }
    __builtin_amdgcn_sched_barrier(0);
    const char* As = smem + cur * GBUF;
    const char* Bs = As + 16384;
    if (BATCH) {
      bf16x8 af[4][2], bfr[4][2];
#pragma unroll
      for (int ks = 0; ks < 4; ++ks) {
#pragma unroll
        for (int mi = 0; mi < 2; ++mi) af[ks][mi] = *(const bf16x8*)(As + swz(wm * 64 + mi * 32 + r, ks * 2 + h));
#pragma unroll
        for (int ni = 0; ni < 2; ++ni) bfr[ks][ni] = *(const bf16x8*)(Bs + swz(wn * 64 + ni * 32 + r, ks * 2 + h));
      }
      __builtin_amdgcn_sched_barrier(0);
#pragma unroll
      for (int ks = 0; ks < 4; ++ks)
#pragma unroll
        for (int mi = 0; mi < 2; ++mi)
#pragma unroll
          for (int ni = 0; ni < 2; ++ni) acc[mi][ni] = MFMA(af[ks][mi], bfr[ks][ni], acc[mi][ni]);
    } else {
#pragma unroll
      for (int ks = 0; ks < 4; ++ks) {
        bf16x8 af[2], bfr[2];
#pragma unroll
        for (int mi = 0; mi < 2; ++mi) af[mi] = *(const bf16x8*)(As + swz(wm * 64 + mi * 32 + r, ks * 2 + h));
#pragma unroll
        for (int ni = 0; ni < 2; ++ni) bfr[ni] = *(const bf16x8*)(Bs + swz(wn * 64 + ni * 32 + r, ks * 2 + h));
#pragma unroll
        for (int mi = 0; mi < 2; ++mi)
#pragma unroll
          for (int ni = 0; ni < 2; ++ni) acc[mi][ni] = MFMA(af[mi], bfr[ni], acc[mi][ni]);
      }
    }
    __builtin_amdgcn_sched_barrier(0);
    if (k + 64 < k1) {
      char* An = smem + (cur ^ 1) * GBUF;
#pragma unroll
      for (int i = 0; i < 4; ++i) {
        *(u32x4*)(An + swz(lrow + 32 * i, lc)) = xa[i];
        *(u32x4*)(An + 16384 + swz(lrow + 32 * i, lc)) = xb[i];
      }
    }
    __syncthreads();
    cur ^= 1;
  };
#pragma unroll 1
  for (int k = k0; k < k1; k += 128) {
    step(k, ra0, rb0, ra1, rb1);
    if (k + 64 < k1) step(k + 64, ra1, rb1, ra0, rb0);
  }
}
DI void zero_acc(f32x16 (&acc)[2][2]) {
#pragma unroll
  for (int a = 0; a < 2; ++a)
#pragma unroll
    for (int b = 0; b < 2; ++b)
#pragma unroll
      for (int i = 0; i < 16; ++i) acc[a][b][i] = 0.f;
}
#define WAVE_COORDS                                                        \
  const int tid = threadIdx.x, lane = tid & 63, wave = tid >> 6;           \
  const int wm = wave >> 1, wn = wave & 1, r = lane & 31, h = lane >> 5;   \
  (void)wm; (void)wn; (void)r; (void)h; (void)lane;

constexpr int SROW = 272;
template <bool SCALE>
DI void stage_bf16_t(char* smem, f32x16 (&acc)[2][2], const float* rs, int wm, int wn, int r, int h) {
  char* base = smem + (wm * 64 + 4 * h) * SROW + (wn * 64 + r) * 2;
  const float* rb = rs + wm * 64 + 4 * h;
#pragma unroll
  for (int mi = 0; mi < 2; ++mi)
#pragma unroll
    for (int i = 0; i < 16; ++i) {
      const int ro = mi * 32 + (i & 3) + 8 * (i >> 2);
      const float sc = SCALE ? rb[ro] : 1.f;
#pragma unroll
      for (int ni = 0; ni < 2; ++ni)
        *(u16*)(base + ro * SROW + ni * 64) = f2bf(acc[mi][ni][i] * sc);
    }
}
DI void stage_bf16(char* smem, f32x16 (&acc)[2][2], const float* rs, int wm, int wn, int r, int h, int) {
  if (rs) stage_bf16_t<true>(smem, acc, rs, wm, wn, r, h); else stage_bf16_t<false>(smem, acc, rs, wm, wn, r, h);
}
DI float sumsq8(const u32x4& v) {
  float ss = 0.f;
#pragma unroll
  for (int j = 0; j < 4; ++j) { const float a = bflo(v[j]), b = bfhi(v[j]); ss += a * a + b * b; }
  return ss;
}

#define WAVE_COORDS_L                                                      \
  int tid = threadIdx.x; asm volatile("" : "+v"(tid));                     \
  const int lane = tid & 63, wave = tid >> 6;                              \
  const int wm = wave >> 1, wn = wave & 1, r = lane & 31, h = lane >> 5;   \
  (void)wm; (void)wn; (void)r; (void)h; (void)lane;

template <int MODE>
DI void transpose_w(u16* dst, const float* src, const float* g0, const float* g1, int N, int K, int Nsrc, int gt, int gs) {
  const int items = N * (K >> 3);
  for (int id = gt; id < items; id += gs) {
    const int kc = id / N, n = id - kc * N;
    int col = n; bool valid = true;
    if (MODE == 1) {
      if (n < 640) col = n; else if (n < 1152) col = n + 32; else if (n < 1184) col = 640 + n - 1152; else valid = false;
    }
    float v[8];
#pragma unroll
    for (int j = 0; j < 8; ++j) {
      const int k = kc * 8 + j;
      const float g = (MODE == 2 && k >= 512) ? g1[k - 512] : g0[k];
      v[j] = valid ? src[(size_t)k * Nsrc + col] * g : 0.f;
    }
    u32x4 o = {cvtpk(v[0], v[1]), cvtpk(v[2], v[3]), cvtpk(v[4], v[5]), cvtpk(v[6], v[7])};
    *(u32x4*)(dst + (size_t)n * K + kc * 8) = o;
  }
}

DI void phase0(const Params& p) {
  const int gt = blockIdx.x * NTHR + threadIdx.x, gs = gridDim.x * NTHR;
  if (gt == 0) {
    float mq = 0.f, mk = 0.f;
    for (int d = 0; d < 96; ++d) { mq = fmaxf(mq, fabsf(p.q_head_g[d])); mk = fmaxf(mk, fabsf(p.k_head_g[d])); }
    p.misc[0] = 96.f * mq * mk * (0.10206207261596575f * 1.4426950408889634f) * 1.02f;
  }
  const int lane = threadIdx.x & 63, gw = gt >> 6, nw = gs >> 6;
  for (int t = gw; t < T_TOK; t += nw) {
    const float* xr = xrow(p, t);
    f32x4 v[4]; float ss = 0.f;
#pragma unroll
    for (int i = 0; i < 4; ++i) {
      v[i] = *(const f32x4*)(xr + i * 256 + lane * 4);
      ss += v[i][0] * v[i][0] + v[i][1] * v[i][1] + v[i][2] * v[i][2] + v[i][3] * v[i][3];
    }
    ss = wave_sum(ss);
#pragma unroll
    for (int i = 0; i < 4; ++i) {
      u32x2 o = {cvtpk(v[i][0], v[i][1]), cvtpk(v[i][2], v[i][3])};
      *(u32x2*)(p.Xb + (size_t)t * 1024 + i * 256 + lane * 4) = o;
    }
    if (lane == 0) p.rstd1[t] = rsqrtf(ss * (1.f / 1024.f) + EPS);
  }
  transpose_w<1>(p.WinT, p.w_in, p.attn_norm_g, nullptr, 1280, 1024, 1184, gt, gs);
  transpose_w<0>(p.WuqT, p.w_uq, p.q_lat_g, nullptr, 768, 384, 768, gt, gs);
  transpose_w<0>(p.WukvT, p.w_ukv, p.kv_lat_g, nullptr, 1024, 256, 1024, gt, gs);
  transpose_w<2>(p.WoutT, p.w_out, p.attn_out_g, p.fnet_out_g, 1024, 1024, 1024, gt, gs);
  transpose_w<0>(p.WpqT, p.peer_w_q, p.ffn_norm_g, nullptr, 2048, 1024, 2048, gt, gs);
  for (int id = gt; id < 262144 / 4; id += gs) {
    f32x4 v = *(const f32x4*)(p.peer_sub_keys + (size_t)id * 4);
    u32x2 o = {cvtpk(v[0], v[1]), cvtpk(v[2], v[3])};
    *(u32x2*)(p.SK + (size_t)id * 4) = o;
  }
  for (int id = gt; id < 256 * 128; id += gs) {
    const int n = id >> 7, c = id & 127, pp = n >> 7, m = n & 127;
    const float fr = (float)((m * c) & 127) * (1.f / 128.f);
    const float val = (pp == 0 ? __builtin_amdgcn_cosf(fr) : -__builtin_amdgcn_sinf(fr)) * 0.08838834764831845f;
    p.Wc[id] = f2bf(val);
  }
  for (int id = gt; id < 128 * 128; id += gs) {
    const int n = id >> 7, k = id & 127;
    const int k1 = (n >> 6) * 32 + (n & 31), pq = (n >> 5) & 1, pp = k >> 6, s1 = k & 63;
    const float fr = (float)((s1 * k1) & 63) * (1.f / 64.f);
    const float c = __builtin_amdgcn_cosf(fr), s = __builtin_amdgcn_sinf(fr);
    const float val = (pq == 0 ? (pp == 0 ? c : s) : (pp == 0 ? -s : c)) * 0.125f;
    p.WA64[id] = f2bf(val);
  }
  for (int id = gt; id < 128 * 64; id += gs) {
    const int n = id >> 6, k = id & 63;
    const int k1 = n & 31, pq = (n >> 5) & 1, pp = k >> 5, s1 = k & 31;
    const float fr = (float)((s1 * k1) & 31) * (1.f / 32.f);
    const float c = __builtin_amdgcn_cosf(fr), s = __builtin_amdgcn_sinf(fr);
    float val = (pq == 0 ? (pp == 0 ? c : s) : (pp == 0 ? -s : c)) * 0.17677669529663687f;
    if (n >= 64) val = 0.f;
    p.WA32[id] = f2bf(val);
  }
  for (int id = gt; id < 128 * 256; id += gs) {
    const int k2 = id >> 8, k = id & 255, pq = k >> 7, s2 = k & 127;
    const float fr = (float)((s2 * k2) & 127) * (1.f / 128.f);
    const float val = (pq == 0 ? __builtin_amdgcn_cosf(fr) : __builtin_amdgcn_sinf(fr)) * 0.08838834764831845f;
    p.WB[id] = f2bf(val);
  }
  for (int id = gt; id < 8192 * 16; id += gs) {
    const int pos = id >> 4, j = id & 15;
    const float freq = exp2f(-(float)j * (13.287712379549449f / 16.f));
    const double rev = (double)pos * (double)freq * 0.15915494309189535;
    const float fr = (float)(rev - floor(rev));
    p.ropec[id] = __builtin_amdgcn_cosf(fr);
    p.ropes[id] = __builtin_amdgcn_sinf(fr);
  }
}

DI void phase1(const Params& p, char* smem) {
    float* rs = (float*)(smem + 65536);
  const int G = gridDim.x;
  for (int tile = vblock(); tile < 384 * 10; tile += G) {
    WAVE_COORDS_L
    const int mt = tile / 10, nt = tile - mt * 10, m0 = mt * 128, n0 = nt * 128;
    __syncthreads();
    if (tid < 128) rs[tid] = p.rstd1[m0 + tid];
    f32x16 acc[2][2]; zero_acc(acc);
    const u16* A = p.Xb + (size_t)m0 * 1024; const u16* B = p.WinT + (size_t)n0 * 1024;
    gemm_mainloop<true>(acc, smem, [&](int rr) { return A + (size_t)rr * 1024; }, [&](int rr) { return B + (size_t)rr * 1024; }, 0, 1024);
    if (nt == 9) {
      if (wn == 0) {
#pragma unroll
        for (int mi = 0; mi < 2; ++mi)
#pragma unroll
          for (int i = 0; i < 16; ++i) {
            const int ro = mi * 32 + (i & 3) + 8 * (i >> 2);
            p.KR[(size_t)(m0 + wm * 64 + 4 * h + ro) * 32 + r] = acc[mi][0][i] * rs[wm * 64 + 4 * h + ro];
          }
      }
    } else {
      stage_bf16_t<true>(smem, acc, rs, wm, wn, r, h);
      __syncthreads();
      u16* dbase; int dstride, cbase;
      if (nt < 3) { dbase = p.CQ; dstride = 384; cbase = n0; }
      else if (nt < 5) { dbase = p.CKV; dstride = 256; cbase = n0 - 384; }
      else { dbase = p.F; dstride = 512; cbase = n0 - 640; }
#pragma unroll
      for (int j = 0; j < 8; ++j) {
        const int id = tid + 256 * j, row = id >> 4, cc = id & 15;
        const u32x4 v = *(const u32x4*)(smem + row * SROW + cc * 16);
        *(u32x4*)(dbase + (size_t)(m0 + row) * dstride + cbase + cc * 8) = v;
        if (nt < 5) {
          float ss = sumsq8(v);
          ss += __shfl_xor(ss, 1); ss += __shfl_xor(ss, 2); ss += __shfl_xor(ss, 4); ss += __shfl_xor(ss, 8);
          if (cc == 0) p.SSP[(size_t)(m0 + row) * 10 + nt * 2] = ss;
        }
      }
    }
  }
}

DI void phase2(const Params& p, char* smem) {
    float* rs = (float*)(smem + 65536);
  const int G = gridDim.x;
  const int NUQ = 384 * 6, NUKV = 384 * 8, NCH = 384 * 8;
  for (int tile = vblock(); tile < NUQ + NUKV + NCH; tile += G) {
    WAVE_COORDS_L
    f32x16 acc[2][2]; zero_acc(acc);
    __syncthreads();
    if (tile < NUQ) {
      const int mt = tile / 6, nt = tile - mt * 6, m0 = mt * 128, n0 = nt * 128;
      if (tid < 128) {
        const float* s = p.SSP + (size_t)(m0 + tid) * 10;
        rs[tid] = rsqrtf((s[0] + s[2] + s[4]) * (1.f / 384.f) + EPS);
      }
      const u16* A = p.CQ + (size_t)m0 * 384; const u16* B = p.WuqT + (size_t)n0 * 384;
      gemm_mainloop(acc, smem, [&](int rr) { return A + (size_t)rr * 384; }, [&](int rr) { return B + (size_t)rr * 384; }, 0, 384);
      stage_bf16_t<true>(smem, acc, rs, wm, wn, r, h);
      __syncthreads();
#pragma unroll
      for (int j = 0; j < 8; ++j) {
        const int id = tid + 256 * j, row = id >> 4, cc = id & 15;
        *(u32x4*)(p.Q1 + (size_t)(m0 + row) * 768 + n0 + cc * 8) = *(const u32x4*)(smem + row * SROW + cc * 16);
      }
    } else if (tile < NUQ + NUKV) {
      const int tl = tile - NUQ;
      const int mt = tl >> 3, hh = tl & 7, m0 = mt * 128;
      int q, S, tb; tok2seq(m0, q, S, tb);
      if (tid < 128) {
        const float* s = p.SSP + (size_t)(m0 + tid) * 10;
        rs[tid] = rsqrtf((s[6] + s[8]) * (1.f / 256.f) + EPS);
      }
      const u16* A = p.CKV + (size_t)m0 * 256; const u16* B = p.WukvT + (size_t)hh * 128 * 256;
      gemm_mainloop(acc, smem, [&](int rr) { return A + (size_t)rr * 256; }, [&](int rr) { return B + (size_t)rr * 256; }, 0, 256);
      if (wn == 0) {
#pragma unroll
        for (int mi = 0; mi < 2; ++mi)
#pragma unroll
          for (int i = 0; i < 16; ++i) {
            const int ro = mi * 32 + (i & 3) + 8 * (i >> 2);
            const float sc = (rs + wm * 64 + 4 * h)[ro];
#pragma unroll
            for (int ni = 0; ni < 2; ++ni) *(u16*)(smem + (wm * 64 + 4 * h) * SROW + r * 2 + ro * SROW + ni * 64) = f2bf(acc[mi][ni][i] * sc);
          }
      } else {
        const int s0 = m0 - tb;
#pragma unroll
        for (int mi = 0; mi < 2; ++mi)
#pragma unroll
          for (int g4 = 0; g4 < 4; ++g4) {
            const int row = wm * 64 + mi * 32 + 8 * g4 + 4 * h;
            const f32x4 sc = *(const f32x4*)(rs + row);
#pragma unroll
            for (int ni = 0; ni < 2; ++ni) {
              const int dv = ni * 32 + r;
              u32x2 o = {cvtpk(acc[mi][ni][4 * g4] * sc[0], acc[mi][ni][4 * g4 + 1] * sc[1]),
                         cvtpk(acc[mi][ni][4 * g4 + 2] * sc[2], acc[mi][ni][4 * g4 + 3] * sc[3])};
              *(u32x2*)(p.Vt + (size_t)tb * 512 + (size_t)(hh * 64 + dv) * S + s0 + row) = o;
            }
            __builtin_amdgcn_sched_barrier(0);
          }
      }
      __syncthreads();
#pragma unroll
      for (int j = 0; j < 4; ++j) {
        const int id = tid + 256 * j, row = id >> 3, cc = id & 7;
        *(u32x4*)(p.K1 + (size_t)(m0 + row) * 512 + hh * 64 + cc * 8) = *(const u32x4*)(smem + row * SROW + cc * 16);
      }
    } else {
      const int tl = tile - NUQ - NUKV;
      const int pp = tl & 1, g = (tl >> 1) & 3, mt = tl >> 3, m0 = mt * 128;
      int q, S, tb; tok2seq(m0, q, S, tb);
      const int S1 = (q < 2) ? 64 : 32, l1 = (q < 2) ? 6 : 5;
      const int j0 = ((m0 - tb) >> 7) * (128 >> l1);
      const u16* Fb = p.F + (size_t)g * 128;
      const u16* B = p.Wc + (size_t)pp * 128 * 128;
      gemm_mainloop(acc, smem,
                    [&](int rr) { const int s1 = rr & (S1 - 1), s2 = j0 + (rr >> l1); return Fb + (size_t)(tb + s1 * 128 + s2) * 512; },
                    [&](int rr) { return B + (size_t)rr * 128; }, 0, 128);
      u16* Zb = p.Z1 + (size_t)tb * 1024;
#pragma unroll
      for (int mi = 0; mi < 2; ++mi)
#pragma unroll
        for (int g4 = 0; g4 < 4; ++g4) {
          const int rho = wm * 64 + mi * 32 + 8 * g4 + 4 * h;
          const int s1 = rho & (S1 - 1), s2 = j0 + (rho >> l1);
#pragma unroll
          for (int ni = 0; ni < 2; ++ni) {
            const int m = wn * 64 + ni * 32 + r;
            u32x2 o = {cvtpk(acc[mi][ni][4 * g4], acc[mi][ni][4 * g4 + 1]), cvtpk(acc[mi][ni][4 * g4 + 2], acc[mi][ni][4 * g4 + 3])};
            *(u32x2*)(Zb + ((size_t)((g * 128 + m) * 128 + s2) * (2 * S1)) + pp * S1 + s1) = o;
          }
          __builtin_amdgcn_sched_barrier(0);
        }
    }
  }
}

DI void phase3(const Params& p, char* smem) {
    const int G = gridDim.x;
  for (int tile = vblock(); tile < 5120; tile += G) {
    WAVE_COORDS_L
    const int q = tile >> 9, gm = tile & 511;
    const int tb = (q < 2) ? (q << 13) : (TP + ((q - 2) << 12));
    const int S = (q < 2) ? 8192 : 4096, S1 = (q < 2) ? 64 : 32, K = 2 * S1;
    f32x16 acc[2][2]; zero_acc(acc);
    const u16* A = p.Z1 + (size_t)tb * 1024 + (size_t)gm * 128 * K;
    const u16* B = (q < 2) ? p.WA64 : p.WA32;
    gemm_mainloop(acc, smem, [&](int rr) { return A + (size_t)rr * K; }, [&](int rr) { return B + (size_t)rr * K; }, 0, K);
    if (wn * 32 < S1) {
      const int k1 = wn * 32 + r;
      const float invS = 1.f / (float)S;
      u16* Gb = p.G1 + (size_t)tb * 1024 + (size_t)(gm * S1 + k1) * 256;
#pragma unroll
      for (int mi = 0; mi < 2; ++mi)
#pragma unroll
        for (int g4 = 0; g4 < 4; ++g4) {
          const int s2b = wm * 64 + mi * 32 + 8 * g4 + 4 * h;
          float ore[4], oim[4];
#pragma unroll
          for (int j = 0; j < 4; ++j) {
            const int s2 = s2b + j;
            const float fr = (float)((s2 * k1) & (S - 1)) * invS;
            const float c = __builtin_amdgcn_cosf(fr), s = __builtin_amdgcn_sinf(fr);
            const float re = acc[mi][0][4 * g4 + j], im = acc[mi][1][4 * g4 + j];
            ore[j] = re * c + im * s; oim[j] = im * c - re * s;
          }
          u32x2 o0 = {cvtpk(ore[0], ore[1]), cvtpk(ore[2], ore[3])};
          u32x2 o1 = {cvtpk(oim[0], oim[1]), cvtpk(oim[2], oim[3])};
          *(u32x2*)(Gb + s2b) = o0;
          *(u32x2*)(Gb + 128 + s2b) = o1;
        }
    }
  }
  const float QSCALE = 0.10206207261596575f * 1.4426950408889634f;
  for (int chunk = vblock(); chunk < T_TOK * 8 / NTHR; chunk += G) {
    WAVE_COORDS_L
    const int id = chunk * NTHR + tid;
    const int t = id >> 3, hh = id & 7;
    int q, S, tb; tok2seq(t, q, S, tb);
    const int s = t - tb;
    const size_t obase = ((size_t)tb * 8 + (size_t)hh * S + s) * 96;
    const float* rcp = p.ropec + s * 16; const float* rsp = p.ropes + s * 16;
    {
      u32x4 w[12];
      const u16* src = p.Q1 + (size_t)t * 768 + hh * 96;
#pragma unroll
      for (int i = 0; i < 12; ++i) w[i] = *(const u32x4*)(src + i * 8);
      float ss = 0.f;
#pragma unroll
      for (int i = 0; i < 12; ++i)
#pragma unroll
        for (int j = 0; j < 4; ++j) { const float a = bflo(w[i][j]), b = bfhi(w[i][j]); ss += a * a + b * b; }
      const float rinv = rsqrtf(ss * (1.f / 96.f) + EPS);
      u16* dst = p.Qn + obase;
#pragma unroll
      for (int i = 0; i < 8; ++i) {
        u32x4 o;
#pragma unroll
        for (int j = 0; j < 4; ++j) {
          const int d = i * 8 + j * 2;
          o[j] = cvtpk(bflo(w[i][j]) * rinv * p.q_head_g[d] * QSCALE, bfhi(w[i][j]) * rinv * p.q_head_g[d + 1] * QSCALE);
        }
        *(u32x4*)(dst + i * 8) = o;
      }
      float x1[16], x2[16];
#pragma unroll
      for (int i = 0; i < 2; ++i)
#pragma unroll
        for (int j = 0; j < 4; ++j) {
          const int e = i * 8 + j * 2;
          x1[e] = bflo(w[8 + i][j]) * rinv * p.q_head_g[64 + e]; x1[e + 1] = bfhi(w[8 + i][j]) * rinv * p.q_head_g[64 + e + 1];
          x2[e] = bflo(w[10 + i][j]) * rinv * p.q_head_g[80 + e]; x2[e + 1] = bfhi(w[10 + i][j]) * rinv * p.q_head_g[80 + e + 1];
        }
      float o1[16], o2[16];
#pragma unroll
      for (int e = 0; e < 16; ++e) {
        const float c = rcp[e], sn = rsp[e];
        o1[e] = (x1[e] * c - x2[e] * sn) * QSCALE; o2[e] = (x2[e] * c + x1[e] * sn) * QSCALE;
      }
#pragma unroll
      for (int i = 0; i < 2; ++i) {
        u32x4 a, b;
#pragma unroll
        for (int j = 0; j < 4; ++j) { a[j] = cvtpk(o1[i * 8 + j * 2], o1[i * 8 + j * 2 + 1]); b[j] = cvtpk(o2[i * 8 + j * 2], o2[i * 8 + j * 2 + 1]); }
        *(u32x4*)(dst + 64 + i * 8) = a;
        *(u32x4*)(dst + 80 + i * 8) = b;
      }
    }
    __builtin_amdgcn_sched_barrier(0);
    {
      u32x4 w[8];
      const u16* src = p.K1 + (size_t)t * 512 + hh * 64;
#pragma unroll
      for (int i = 0; i < 8; ++i) w[i] = *(const u32x4*)(src + i * 8);
      f32x4 kr[8];
#pragma unroll
      for (int i = 0; i < 8; ++i) kr[i] = *(const f32x4*)(p.KR + (size_t)t * 32 + i * 4);
      float ss = 0.f;
#pragma unroll
      for (int i = 0; i < 8; ++i)
#pragma unroll
        for (int j = 0; j < 4; ++j) { const float a = bflo(w[i][j]), b = bfhi(w[i][j]); ss += a * a + b * b + kr[i][j] * kr[i][j]; }
      const float rinv = rsqrtf(ss * (1.f / 96.f) + EPS);
      u16* dst = p.Kn + obase;
#pragma unroll
      for (int i = 0; i < 8; ++i) {
        u32x4 o;
#pragma unroll
        for (int j = 0; j < 4; ++j) {
          const int d = i * 8 + j * 2;
          o[j] = cvtpk(bflo(w[i][j]) * rinv * p.k_head_g[d], bfhi(w[i][j]) * rinv * p.k_head_g[d + 1]);
        }
        *(u32x4*)(dst + i * 8) = o;
      }
      float o1[16], o2[16];
#pragma unroll
      for (int e = 0; e < 16; ++e) {
        const float a = kr[e >> 2][e & 3] * rinv * p.k_head_g[64 + e];
        const float b = kr[4 + (e >> 2)][e & 3] * rinv * p.k_head_g[80 + e];
        const float c = rcp[e], sn = rsp[e];
        o1[e] = a * c - b * sn; o2[e] = b * c + a * sn;
      }
#pragma unroll
      for (int i = 0; i < 2; ++i) {
        u32x4 a, b;
#pragma unroll
        for (int j = 0; j < 4; ++j) { a[j] = cvtpk(o1[i * 8 + j * 2], o1[i * 8 + j * 2 + 1]); b[j] = cvtpk(o2[i * 8 + j * 2], o2[i * 8 + j * 2 + 1]); }
        *(u32x4*)(dst + 64 + i * 8) = a;
        *(u32x4*)(dst + 80 + i * 8) = b;
      }
    }
  }
}

constexpr int KSTR = 208, VSTR = 136, ABUF = 64 * KSTR + 64 * VSTR;

DI void attn_tile(const Params& p, char* smem, int a) {
  WAVE_COORDS
  int q, hh, qt, S, tb;
  if (a < 1024) { q = a >> 9; hh = (a >> 6) & 7; qt = a & 63; S = 8192; tb = q << 13; }
  else { const int b = a - 1024; q = 2 + (b >> 8); hh = (b >> 5) & 7; qt = b & 31; S = 4096; tb = TP + ((q - 2) << 12); }
  const size_t qkb = ((size_t)tb * 8 + (size_t)hh * S) * 96;
  const u16* Qb = p.Qn + qkb; const u16* Kb = p.Kn + qkb;
  const u16* Vb = p.Vt + (size_t)tb * 512 + (size_t)hh * 64 * S;
  const int qrow = qt * 128 + wave * 32 + r;
  bf16x8 qf[6];
#pragma unroll
  for (int ks = 0; ks < 6; ++ks) qf[ks] = *(const bf16x8*)(Qb + (size_t)qrow * 96 + ks * 16 + h * 8);
  f32x16 o[2];
#pragma unroll
  for (int i = 0; i < 16; ++i) { o[0][i] = 0.f; o[1][i] = 0.f; }
  float mrun = -1e30f, lrun = 0.f;
  int krow_[3], kc_[3], vrow_[2], vc_[2];
#pragma unroll
  for (int i = 0; i < 3; ++i) { const int id = tid + 256 * i; krow_[i] = id / 12; kc_[i] = id - krow_[i] * 12; }
#pragma unroll
  for (int i = 0; i < 2; ++i) { const int id = tid + 256 * i; vrow_[i] = id >> 3; vc_[i] = id & 7; }
  u32x4 rk[3], rv[2];
  const int nkt = S >> 6;
#pragma unroll
  for (int i = 0; i < 3; ++i) rk[i] = *(const u32x4*)(Kb + (size_t)krow_[i] * 96 + kc_[i] * 8);
#pragma unroll
  for (int i = 0; i < 2; ++i) rv[i] = *(const u32x4*)(Vb + (size_t)vrow_[i] * S + vc_[i] * 8);
  __syncthreads();
#pragma unroll
  for (int i = 0; i < 3; ++i) *(u32x4*)(smem + krow_[i] * KSTR + kc_[i] * 16) = rk[i];
#pragma unroll
  for (int i = 0; i < 2; ++i) {
    char* d = smem + 64 * KSTR + vrow_[i] * VSTR + vc_[i] * 16;
    *(u32x2*)d = u32x2{rv[i][0], rv[i][1]}; *(u32x2*)(d + 8) = u32x2{rv[i][2], rv[i][3]};
  }
  __syncthreads();
  int cur = 0;
  for (int kt = 0; kt < nkt; ++kt) {
    const bool nxt = (kt + 1 < nkt);
    if (nxt) {
#pragma unroll
      for (int i = 0; i < 3; ++i) rk[i] = *(const u32x4*)(Kb + (size_t)((kt + 1) * 64 + krow_[i]) * 96 + kc_[i] * 8);
#pragma unroll
      for (int i = 0; i < 2; ++i) rv[i] = *(const u32x4*)(Vb + (size_t)vrow_[i] * S + (kt + 1) * 64 + vc_[i] * 8);
    }
    __builtin_amdgcn_sched_barrier(0);
    const char* Ks = smem + cur * ABUF;
    const char* Vs = Ks + 64 * KSTR;
    f32x16 sacc[2];
#pragma unroll
    for (int i = 0; i < 16; ++i) { sacc[0][i] = 0.f; sacc[1][i] = 0.f; }
#pragma unroll
    for (int t2 = 0; t2 < 2; ++t2)
#pragma unroll
      for (int ks = 0; ks < 6; ++ks) {
        const bf16x8 kf = *(const bf16x8*)(Ks + (t2 * 32 + r) * KSTR + ks * 32 + h * 16);
        sacc[t2] = MFMA(kf, qf[ks], sacc[t2]);
      }
    float mx = sacc[0][0];
#pragma unroll
    for (int i = 0; i < 16; ++i) { mx = fmaxf(mx, sacc[0][i]); mx = fmaxf(mx, sacc[1][i]); }
    mx = fmaxf(mx, __shfl_xor(mx, 32));
    const float mnew = fmaxf(mrun, mx);
    const float alpha = __builtin_amdgcn_exp2f(mrun - mnew);
    mrun = mnew;
    lrun *= alpha;
#pragma unroll
    for (int i = 0; i < 16; ++i) { o[0][i] *= alpha; o[1][i] *= alpha; }
    float ps = 0.f;
#pragma unroll
    for (int t2 = 0; t2 < 2; ++t2)
#pragma unroll
      for (int i = 0; i < 16; ++i) { const float e = __builtin_amdgcn_exp2f(sacc[t2][i] - mnew); sacc[t2][i] = e; ps += e; }
    lrun += ps;
    bf16x8 pf[4];
#pragma unroll
    for (int kk = 0; kk < 4; ++kk) {
      const int t2 = kk >> 1, s8 = (kk & 1) * 8;
      u32x4 pk = {cvtpk(sacc[t2][s8], sacc[t2][s8 + 1]), cvtpk(sacc[t2][s8 + 2], sacc[t2][s8 + 3]),
                  cvtpk(sacc[t2][s8 + 4], sacc[t2][s8 + 5]), cvtpk(sacc[t2][s8 + 6], sacc[t2][s8 + 7])};
      pf[kk] = __builtin_bit_cast(bf16x8, pk);
    }
#pragma unroll
    for (int dt = 0; dt < 2; ++dt)
#pragma unroll
      for (int kk = 0; kk < 4; ++kk) {
        const char* vp = Vs + (dt * 32 + r) * VSTR + kk * 32 + h * 8;
        const u32x2 lo = *(const u32x2*)vp, hi = *(const u32x2*)(vp + 16);
        u32x4 vv = {lo[0], lo[1], hi[0], hi[1]};
        o[dt] = MFMA(__builtin_bit_cast(bf16x8, vv), pf[kk], o[dt]);
      }
    __builtin_amdgcn_sched_barrier(0);
    if (nxt) {
      char* Kn_ = smem + (cur ^ 1) * ABUF;
#pragma unroll
      for (int i = 0; i < 3; ++i) *(u32x4*)(Kn_ + krow_[i] * KSTR + kc_[i] * 16) = rk[i];
#pragma unroll
      for (int i = 0; i < 2; ++i) {
        char* d = Kn_ + 64 * KSTR + vrow_[i] * VSTR + vc_[i] * 16;
        *(u32x2*)d = u32x2{rv[i][0], rv[i][1]}; *(u32x2*)(d + 8) = u32x2{rv[i][2], rv[i][3]};
      }
    }
    __syncthreads();
    cur ^= 1;
  }
  lrun += __shfl_xor(lrun, 32);
  const float inv = 1.f / lrun;
  float ss = 0.f;
  u16* dst = p.MIX + (size_t)(tb + qrow) * 1024 + hh * 64;
#pragma unroll
  for (int dt = 0; dt < 2; ++dt)
#pragma unroll
    for (int g4 = 0; g4 < 4; ++g4) {
      float v[4];
#pragma unroll
      for (int j = 0; j < 4; ++j) { v[j] = o[dt][4 * g4 + j] * inv; ss += v[j] * v[j]; }
      u32x2 ov = {cvtpk(v[0], v[1]), cvtpk(v[2], v[3])};
      *(u32x2*)(dst + dt * 32 + 8 * g4 + 4 * h) = ov;
    }
  ss += __shfl_xor(ss, 32);
  if (h == 0) p.SSA[(size_t)(tb + qrow) * 8 + hh] = ss;
}

constexpr int VSTR2 = 144, ABUF2 = 64 * KSTR + 64 * VSTR2;
DI float swapmax32(float v) {
  auto rr = __builtin_amdgcn_permlane32_swap(__float_as_uint(v), __float_as_uint(v), false, false);
  return fmaxf(__uint_as_float(rr[0]), __uint_as_float(rr[1]));
}
DI float swapsum32(float v) {
  auto rr = __builtin_amdgcn_permlane32_swap(__float_as_uint(v), __float_as_uint(v), false, false);
  return __uint_as_float(rr[0]) + __uint_as_float(rr[1]);
}
template <bool RUNMAX>
DI void attn_tile2(const Params& p, char* smem, int a) {
  WAVE_COORDS_L
  int q, hh, qt, S, tb;
  if (a < 512) { q = a >> 8; hh = (a >> 5) & 7; qt = a & 31; S = 8192; tb = q << 13; }
  else { const int b = a - 512; q = 2 + (b >> 7); hh = (b >> 4) & 7; qt = b & 15; S = 4096; tb = TP + ((q - 2) << 12); }
  const size_t qkb = ((size_t)tb * 8 + (size_t)hh * S) * 96;
  const u16* Qb = p.Qn + qkb; const u16* Kb = p.Kn + qkb;
  const u16* Vb = p.Vt + (size_t)tb * 512 + (size_t)hh * 64 * S;
  const int qrow0 = qt * 256 + wave * 64 + r;
  bf16x8 qf[2][6];
#pragma unroll
  for (int g = 0; g < 2; ++g)
#pragma unroll
    for (int ks = 0; ks < 6; ++ks) qf[g][ks] = *(const bf16x8*)(Qb + (size_t)(qrow0 + 32 * g) * 96 + ks * 16 + h * 8);
  f32x16 o[2][2];
#pragma unroll
  for (int i = 0; i < 16; ++i) { o[0][0][i] = 0.f; o[0][1][i] = 0.f; o[1][0][i] = 0.f; o[1][1][i] = 0.f; }
  float mrun[2] = {-1e30f, -1e30f}, lrun[2] = {0.f, 0.f};
  int klds_[3], vlds_[2];
#pragma unroll
  for (int i = 0; i < 3; ++i) { const int id = tid + 256 * i; const int kr = id / 12; klds_[i] = kr * KSTR + (id - kr * 12) * 16; }
#pragma unroll
  for (int i = 0; i < 2; ++i) { const int vc = tid & 7; vlds_[i] = 64 * KSTR + ((tid >> 3) + 32 * i) * VSTR2 + (vc >> 1) * 32 + (vc & 1) * 8; }
  const u16* Kg = Kb + tid * 8;
  const u16* Vg = Vb + (size_t)(tid >> 3) * S + (tid & 7) * 8;
  u32x4 rk[3], rv[2];
  const int nkt = S >> 6;
#pragma unroll
  for (int i = 0; i < 3; ++i) rk[i] = *(const u32x4*)(Kg + i * 2048);
#pragma unroll
  for (int i = 0; i < 2; ++i) rv[i] = *(const u32x4*)(Vg + (size_t)(32 * i) * S);
  __syncthreads();
  auto put = [&](char* base) {
#pragma unroll
    for (int i = 0; i < 3; ++i) *(u32x4*)(base + klds_[i]) = rk[i];
#pragma unroll
    for (int i = 0; i < 2; ++i) {
      char* d = base + vlds_[i];
      *(u32x2*)d = u32x2{rv[i][0], rv[i][1]}; *(u32x2*)(d + 16) = u32x2{rv[i][2], rv[i][3]};
    }
  };
  put(smem);
  __syncthreads();
  int cur = 0;
#pragma unroll 1
  for (int kt = 0; kt < nkt; ++kt) {
    const bool nxt = (kt + 1 < nkt);
    if (nxt) {
#pragma unroll
      for (int i = 0; i < 3; ++i) rk[i] = *(const u32x4*)(Kg + (size_t)(kt + 1) * 6144 + i * 2048);
#pragma unroll
      for (int i = 0; i < 2; ++i) rv[i] = *(const u32x4*)(Vg + (size_t)(32 * i) * S + (kt + 1) * 64);
    }
    __builtin_amdgcn_sched_barrier(0);
    const char* Ks = smem + cur * ABUF2;
    const char* Vs = Ks + 64 * KSTR;
#pragma unroll
    for (int t2 = 0; t2 < 2; ++t2) {
      f32x16 sacc[2];
#pragma unroll
      for (int i = 0; i < 16; ++i) { sacc[0][i] = 0.f; sacc[1][i] = 0.f; }
#pragma unroll
      for (int kb = 0; kb < 2; ++kb) {
        bf16x8 kf[3];
#pragma unroll
        for (int ks = 0; ks < 3; ++ks) kf[ks] = *(const bf16x8*)(Ks + (t2 * 32 + r) * KSTR + (kb * 3 + ks) * 32 + h * 16);
#pragma unroll
        for (int ks = 0; ks < 3; ++ks) {
          sacc[0] = MFMA(kf[ks], qf[0][kb * 3 + ks], sacc[0]);
          sacc[1] = MFMA(kf[ks], qf[1][kb * 3 + ks], sacc[1]);
        }
      }
      __builtin_amdgcn_sched_barrier(0);
      bf16x8 pf[2][2];
#pragma unroll
      for (int g = 0; g < 2; ++g) {
        float ps = 0.f;
        if (RUNMAX) {
        float mx = sacc[g][0];
#pragma unroll
        for (int i = 1; i < 16; ++i) mx = fmaxf(mx, sacc[g][i]);
        mx = swapmax32(mx);
        const float mnew = fmaxf(mrun[g], mx);
        if (__ballot(mnew > mrun[g]) != 0ull) {
          const float alpha = __builtin_amdgcn_exp2f(mrun[g] - mnew);
          lrun[g] *= alpha;
#pragma unroll
          for (int i = 0; i < 16; ++i) { o[g][0][i] *= alpha; o[g][1][i] *= alpha; }
          mrun[g] = mnew;
        }
#pragma unroll
        for (int i = 0; i < 16; ++i) { const float e = __builtin_amdgcn_exp2f(sacc[g][i] - mrun[g]); sacc[g][i] = e; ps += e; }
        } else {
#pragma unroll
          for (int i = 0; i < 16; ++i) sacc[g][i] = __builtin_amdgcn_exp2f(sacc[g][i]);
        }
#pragma unroll
        for (int s = 0; s < 2; ++s) {
          const int s8 = s * 8;
          u32x4 pk = {cvtpk(sacc[g][s8], sacc[g][s8 + 1]), cvtpk(sacc[g][s8 + 2], sacc[g][s8 + 3]),
                      cvtpk(sacc[g][s8 + 4], sacc[g][s8 + 5]), cvtpk(sacc[g][s8 + 6], sacc[g][s8 + 7])};
          pf[g][s] = __builtin_bit_cast(bf16x8, pk);
          if (!RUNMAX) {
#pragma unroll
            for (int w = 0; w < 4; ++w) ps = fdot2(pk[w], 0x3F803F80u, ps);
          }
        }
        lrun[g] += ps;
      }
      __builtin_amdgcn_sched_barrier(0);
#pragma unroll
      for (int dt = 0; dt < 2; ++dt) {
        bf16x8 vf[2];
#pragma unroll
        for (int s = 0; s < 2; ++s) vf[s] = *(const bf16x8*)(Vs + (dt * 32 + r) * VSTR2 + (t2 * 2 + s) * 32 + h * 16);
#pragma unroll
        for (int s = 0; s < 2; ++s) {
          o[0][dt] = MFMA(vf[s], pf[0][s], o[0][dt]);
          o[1][dt] = MFMA(vf[s], pf[1][s], o[1][dt]);
        }
      }
    }
    __builtin_amdgcn_sched_barrier(0);
    if (nxt) put(smem + (cur ^ 1) * ABUF2);
    __syncthreads();
    cur ^= 1;
  }
#pragma unroll
  for (int g = 0; g < 2; ++g) {
    const float lsum = swapsum32(lrun[g]);
    const float inv = 1.f / lsum;
    const int qrow = qrow0 + 32 * g;
    float ss = 0.f;
    u16* dst = p.MIX + (size_t)(tb + qrow) * 1024 + hh * 64;
#pragma unroll
    for (int dt = 0; dt < 2; ++dt)
#pragma unroll
      for (int g4 = 0; g4 < 4; ++g4) {
        float v[4];
#pragma unroll
        for (int jj = 0; jj < 4; ++jj) { v[jj] = o[g][dt][4 * g4 + jj] * inv; ss += v[jj] * v[jj]; }
        u32x2 ov = {cvtpk(v[0], v[1]), cvtpk(v[2], v[3])};
        *(u32x2*)(dst + dt * 32 + 8 * g4 + 4 * h) = ov;
      }
    ss = swapsum32(ss);
    if (h == 0) p.SSA[(size_t)(tb + qrow) * 8 + hh] = ss;
  }
}

DI void phase4(const Params& p, char* smem) {
    const int G = gridDim.x;
  if (p.misc[0] > 64.f) { for (int a = vblock(); a < 1536; a += G) attn_tile2<true>(p, smem, a); }
  else { for (int a = vblock(); a < 1536; a += G) attn_tile2<false>(p, smem, a); }
  for (int tile = vblock(); tile < 1536; tile += G) {
    WAVE_COORDS_L
    int q, g, k1, S1, tb;
    if (tile < 512) { q = tile >> 8; g = (tile >> 6) & 3; k1 = tile & 63; S1 = 64; tb = q << 13; }
    else { const int b = tile - 512; q = 2 + (b >> 7); g = (b >> 5) & 3; k1 = b & 31; S1 = 32; tb = TP + ((q - 2) << 12); }
    f32x16 acc[2][2]; zero_acc(acc);
    const u16* A = p.G1 + (size_t)tb * 1024 + ((size_t)(g * 128) * S1 + k1) * 256;
    const u16* B = p.WB;
    const int rstride = S1 * 256;
    gemm_mainloop(acc, smem, [&](int rr) { return A + (size_t)rr * rstride; }, [&](int rr) { return B + (size_t)rr * 256; }, 0, 256);
#pragma unroll
    for (int ni = 0; ni < 2; ++ni) {
      const int k2 = wn * 64 + ni * 32 + r;
      const size_t tok = (size_t)(tb + k1 + S1 * k2);
      float ss = 0.f;
#pragma unroll
      for (int mi = 0; mi < 2; ++mi)
#pragma unroll
        for (int g4 = 0; g4 < 4; ++g4) {
          const int m = wm * 64 + mi * 32 + 8 * g4 + 4 * h;
          float v[4];
#pragma unroll
          for (int j = 0; j < 4; ++j) { v[j] = acc[mi][ni][4 * g4 + j]; ss += v[j] * v[j]; }
          u32x2 ov = {cvtpk(v[0], v[1]), cvtpk(v[2], v[3])};
          *(u32x2*)(p.MIX + tok * 1024 + 512 + g * 128 + m) = ov;
        }
      ss += __shfl_xor(ss, 32);
      if (h == 0) p.SSF[tok * 8 + g * 2 + wm] = ss;
    }
  }
}

DI void phase5(const Params& p, char* smem) {
    float* rs = (float*)(smem + 65536);
  const int G = gridDim.x;
  for (int tile = vblock(); tile < 384 * 8; tile += G) {
    WAVE_COORDS_L
    const int mt = tile >> 3, nt = tile & 7, m0 = mt * 128, n0 = nt * 128;
    __syncthreads();
    if (tid < 128) {
      const float* sa = p.SSA + (size_t)(m0 + tid) * 8; const float* sf = p.SSF + (size_t)(m0 + tid) * 8;
      const float ra = rsqrtf((sa[0] + sa[1] + sa[2] + sa[3] + sa[4] + sa[5] + sa[6] + sa[7]) * (1.f / 512.f) + EPS);
      const float rf = rsqrtf((sf[0] + sf[1] + sf[2] + sf[3] + sf[4] + sf[5] + sf[6] + sf[7]) * (1.f / 512.f) + EPS);
      rs[tid] = ra / rf; rs[128 + tid] = rf;
    }
    f32x16 acc[2][2]; zero_acc(acc);
    const u16* A = p.MIX + (size_t)m0 * 1024; const u16* B = p.WoutT + (size_t)n0 * 1024;
    auto af = [&](int rr) { return A + (size_t)rr * 1024; };
    auto bfn = [&](int rr) { return B + (size_t)rr * 1024; };
    gemm_mainloop<true>(acc, smem, af, bfn, 0, 512);
    {
      const float* rb = rs + wm * 64 + 4 * h;
#pragma unroll
      for (int mi = 0; mi < 2; ++mi)
#pragma unroll
        for (int i = 0; i < 16; ++i) {
          const float sc = rb[mi * 32 + (i & 3) + 8 * (i >> 2)];
          acc[mi][0][i] *= sc; acc[mi][1][i] *= sc;
        }
    }
    gemm_mainloop<true>(acc, smem, af, bfn, 512, 1024);
    {
      const float* rb = rs + 128 + wm * 64 + 4 * h;
      char* sb = smem + (wm * 64 + 4 * h) * 512 + (wn * 64 + r) * 4;
#pragma unroll
      for (int mi = 0; mi < 2; ++mi)
#pragma unroll
        for (int i = 0; i < 16; ++i) {
          const int ro = mi * 32 + (i & 3) + 8 * (i >> 2);
          const float sc = rb[ro];
#pragma unroll
          for (int ni = 0; ni < 2; ++ni) *(float*)(sb + ro * 512 + ni * 128) = acc[mi][ni][i] * sc;
        }
    }
    __syncthreads();
#pragma unroll 4
    for (int j = 0; j < 16; ++j) {
      const int id = tid + 256 * j, row = id >> 5, cc = id & 31;
      const int t = m0 + row, col = n0 + cc * 4;
      f32x4 v = *(const f32x4*)(smem + row * 512 + cc * 16);
      const f32x4 xv = *(const f32x4*)(xrow(p, t) + col);
      v[0] += xv[0]; v[1] += xv[1]; v[2] += xv[2]; v[3] += xv[3];
      *(f32x4*)(p.out + (size_t)t * 1024 + col) = v;
      u32x2 ob = {cvtpk(v[0], v[1]), cvtpk(v[2], v[3])};
      *(u32x2*)(p.X2b + (size_t)t * 1024 + col) = ob;
      float ss = v[0] * v[0] + v[1] * v[1] + v[2] * v[2] + v[3] * v[3];
      ss = red32(ss);
      if (cc == 0) p.SS2[(size_t)t * 16 + nt] = ss;
    }
  }
  const int gt = blockIdx.x * NTHR + threadIdx.x, gs = gridDim.x * NTHR;
  for (int id = gt; id < 16384 * 1024 / 16; id += gs) {
    const int d = (id & 63) * 16;
    u32x4 ou, ov;
#pragma unroll
    for (int k = 0; k < 4; ++k) {
      const f32x4 a = *(const f32x4*)(p.peer_u + (size_t)id * 16 + k * 4);
      const f32x4 g = *(const f32x4*)(p.ffn_norm_g + d + k * 4);
      const f32x4 b = *(const f32x4*)(p.peer_v + (size_t)id * 16 + k * 4);
      float u0 = fminf(fmaxf(a[0] * g[0] * USCALE, -448.f), 448.f), u1 = fminf(fmaxf(a[1] * g[1] * USCALE, -448.f), 448.f);
      float u2 = fminf(fmaxf(a[2] * g[2] * USCALE, -448.f), 448.f), u3 = fminf(fmaxf(a[3] * g[3] * USCALE, -448.f), 448.f);
      float v0 = fminf(fmaxf(b[0] * VSCALE, -448.f), 448.f), v1 = fminf(fmaxf(b[1] * VSCALE, -448.f), 448.f);
      float v2 = fminf(fmaxf(b[2] * VSCALE, -448.f), 448.f), v3 = fminf(fmaxf(b[3] * VSCALE, -448.f), 448.f);
      int pu = __builtin_amdgcn_cvt_pk_fp8_f32(u0, u1, 0, false); pu = __builtin_amdgcn_cvt_pk_fp8_f32(u2, u3, pu, true);
      int pv = __builtin_amdgcn_cvt_pk_fp8_f32(v0, v1, 0, false); pv = __builtin_amdgcn_cvt_pk_fp8_f32(v2, v3, pv, true);
      ou[k] = (unsigned)pu; ov[k] = (unsigned)pv;
    }
    {
      const int e = id >> 6, ch = id & 63;
      const size_t o = ((size_t)(ch >> 3) * 16384 + e) * 128 + (ch & 7) * 16;
      *(u32x4*)(p.U8 + o) = ou;
      *(u32x4*)(p.V8 + o) = ov;
    }
  }
}

DI void phase6(const Params& p, char* smem) {
    const int G = gridDim.x;
  for (int tile = vblock(); tile < 384 * 16; tile += G) {
    WAVE_COORDS_L
    const int mt = tile >> 4, nt = tile & 15, m0 = mt * 128, n0 = nt * 128;
    f32x16 acc[2][2]; zero_acc(acc);
    __syncthreads();
    const u16* A = p.X2b + (size_t)m0 * 1024; const u16* B = p.WpqT + (size_t)n0 * 1024;
    gemm_mainloop<true>(acc, smem, [&](int rr) { return A + (size_t)rr * 1024; }, [&](int rr) { return B + (size_t)rr * 1024; }, 0, 1024);
    stage_bf16_t<false>(smem, acc, nullptr, wm, wn, r, h);
    __syncthreads();
#pragma unroll
    for (int j = 0; j < 8; ++j) {
      const int id = tid + 256 * j, row = id >> 4, cc = id & 15;
      *(u32x4*)(p.Qp + (size_t)(m0 + row) * 2048 + n0 + cc * 8) = *(const u32x4*)(smem + row * SROW + cc * 16);
    }
  }
}

DI void ins16(float (&top)[16], float x) {
#pragma unroll
  for (int j = 0; j < 16; ++j) { const float hi = fmaxf(top[j], x); x = fminf(top[j], x); top[j] = hi; }
}
DI float mask7(float x) { return __uint_as_float(__float_as_uint(x) & ~0x7Fu); }

#define CE16(a, b) { const float hi_ = fmaxf(a, b); b = fminf(a, b); a = hi_; }
DI void sort16_desc(float (&x)[16]) {
  CE16(x[0], x[1])
  CE16(x[3], x[2])
  CE16(x[4], x[5])
  CE16(x[7], x[6])
  CE16(x[8], x[9])
  CE16(x[11], x[10])
  CE16(x[12], x[13])
  CE16(x[15], x[14])
  CE16(x[0], x[2])
  CE16(x[1], x[3])
  CE16(x[6], x[4])
  CE16(x[7], x[5])
  CE16(x[8], x[10])
  CE16(x[9], x[11])
  CE16(x[14], x[12])
  CE16(x[15], x[13])
  CE16(x[0], x[1])
  CE16(x[2], x[3])
  CE16(x[5], x[4])
  CE16(x[7], x[6])
  CE16(x[8], x[9])
  CE16(x[10], x[11])
  CE16(x[13], x[12])
  CE16(x[15], x[14])
  CE16(x[0], x[4])
  CE16(x[1], x[5])
  CE16(x[2], x[6])
  CE16(x[3], x[7])
  CE16(x[12], x[8])
  CE16(x[13], x[9])
  CE16(x[14], x[10])
  CE16(x[15], x[11])
  CE16(x[0], x[2])
  CE16(x[1], x[3])
  CE16(x[4], x[6])
  CE16(x[5], x[7])
  CE16(x[10], x[8])
  CE16(x[11], x[9])
  CE16(x[14], x[12])
  CE16(x[15], x[13])
  CE16(x[0], x[1])
  CE16(x[2], x[3])
  CE16(x[4], x[5])
  CE16(x[6], x[7])
  CE16(x[9], x[8])
  CE16(x[11], x[10])
  CE16(x[13], x[12])
  CE16(x[15], x[14])
  CE16(x[0], x[8])
  CE16(x[1], x[9])
  CE16(x[2], x[10])
  CE16(x[3], x[11])
  CE16(x[4], x[12])
  CE16(x[5], x[13])
  CE16(x[6], x[14])
  CE16(x[7], x[15])
  CE16(x[0], x[4])
  CE16(x[1], x[5])
  CE16(x[2], x[6])
  CE16(x[3], x[7])
  CE16(x[8], x[12])
  CE16(x[9], x[13])
  CE16(x[10], x[14])
  CE16(x[11], x[15])
  CE16(x[0], x[2])
  CE16(x[1], x[3])
  CE16(x[4], x[6])
  CE16(x[5], x[7])
  CE16(x[8], x[10])
  CE16(x[9], x[11])
  CE16(x[12], x[14])
  CE16(x[13], x[15])
  CE16(x[0], x[1])
  CE16(x[2], x[3])
  CE16(x[4], x[5])
  CE16(x[6], x[7])
  CE16(x[8], x[9])
  CE16(x[10], x[11])
  CE16(x[12], x[13])
  CE16(x[14], x[15])
}
DI void bmerge16_desc(float (&x)[16]) {
  CE16(x[0], x[8])
  CE16(x[1], x[9])
  CE16(x[2], x[10])
  CE16(x[3], x[11])
  CE16(x[4], x[12])
  CE16(x[5], x[13])
  CE16(x[6], x[14])
  CE16(x[7], x[15])
  CE16(x[0], x[4])
  CE16(x[1], x[5])
  CE16(x[2], x[6])
  CE16(x[3], x[7])
  CE16(x[8], x[12])
  CE16(x[9], x[13])
  CE16(x[10], x[14])
  CE16(x[11], x[15])
  CE16(x[0], x[2])
  CE16(x[1], x[3])
  CE16(x[4], x[6])
  CE16(x[5], x[7])
  CE16(x[8], x[10])
  CE16(x[9], x[11])
  CE16(x[12], x[14])
  CE16(x[13], x[15])
  CE16(x[0], x[1])
  CE16(x[2], x[3])
  CE16(x[4], x[5])
  CE16(x[6], x[7])
  CE16(x[8], x[9])
  CE16(x[10], x[11])
  CE16(x[12], x[13])
  CE16(x[14], x[15])
}
DI void top16_merge(float (&A)[16], const float (&B)[16]) {
#pragma unroll
  for (int i = 0; i < 16; ++i) A[i] = fmaxf(A[i], B[15 - i]);
  bmerge16_desc(A);
}

DI void score_top16(const Params& p, const char* sklds, int t, int hh, int c, int r, int h, float (&top)[16]) {
  f32x16 acc[4];
#pragma unroll
  for (int n = 0; n < 4; ++n)
#pragma unroll
    for (int i = 0; i < 16; ++i) acc[n][i] = 0.f;
  const u16* qp = p.Qp + (size_t)t * 2048 + (hh * 2 + c) * 128 + h * 8;
  const char* skb = sklds + c * 32768 + r * 256;
  const int hx = h ^ (r & 15);
  bf16x8 bq[8];
#pragma unroll
  for (int ks = 0; ks < 8; ++ks) bq[ks] = *(const bf16x8*)(qp + ks * 16);
#pragma unroll
  for (int n = 0; n < 4; ++n) {
    bf16x8 fa[8];
#pragma unroll
    for (int ks = 0; ks < 8; ++ks) fa[ks] = *(const bf16x8*)(skb + n * 8192 + (((ks * 2) ^ hx) << 4));
    __builtin_amdgcn_sched_barrier(0);
#pragma unroll
    for (int ks = 0; ks < 8; ++ks) acc[n] = MFMA(fa[ks], bq[ks], acc[n]);
    __builtin_amdgcn_sched_barrier(0);
  }
  float k1[16], k2[16], k3[16];
#pragma unroll
  for (int i = 0; i < 16; ++i) {
    const unsigned ci = (unsigned)crow(i, h);
    top[i] = __uint_as_float((__float_as_uint(acc[0][i]) & ~0x7Fu) | ci);
    k1[i] = __uint_as_float((__float_as_uint(acc[1][i]) & ~0x7Fu) | (32u + ci));
    k2[i] = __uint_as_float((__float_as_uint(acc[2][i]) & ~0x7Fu) | (64u + ci));
    k3[i] = __uint_as_float((__float_as_uint(acc[3][i]) & ~0x7Fu) | (96u + ci));
  }
  sort16_desc(top); sort16_desc(k1); sort16_desc(k2); sort16_desc(k3);
  top16_merge(top, k1); top16_merge(k2, k3); top16_merge(top, k2);
  float oth[16];
#pragma unroll
  for (int j = 0; j < 16; ++j) oth[j] = __shfl_xor(top[j], 32);
  top16_merge(top, oth);
}

DI void phase7(const Params& p, char* smem) {
  WAVE_COORDS
  const int G = gridDim.x;
  volatile unsigned* lw = (volatile unsigned*)(smem + 65536 + 2048 + wave * 1024);
  volatile unsigned char* lb = (volatile unsigned char*)(smem + 65536 + 2048 + wave * 1024);
  const float NEG_INF = __uint_as_float(0xFF800000u);
  const int hh = blockIdx.x & 7, slot = blockIdx.x >> 3, nslot = G >> 3;
  __syncthreads();
  {
    const u16* src = p.SK + (size_t)hh * 2 * 16384;
#pragma unroll 2
    for (int i = 0; i < 16; ++i) {
      const int id = tid + 256 * i;
      const int row = id >> 4, ch = id & 15;
      const u32x4 v = *(const u32x4*)(src + (size_t)row * 128 + ch * 8);
      *(u32x4*)(smem + row * 256 + ((ch ^ (row & 15)) << 4)) = v;
    }
  }
  __syncthreads();
  for (int grp = slot * 4 + wave; grp < 1536; grp += nslot * 4) {
    const int tok0 = grp * 32;
    const int t = tok0 + r;
    float L0[16], L1[16];
    score_top16(p, smem, t, hh, 0, r, h, L0);
    score_top16(p, smem, t, hh, 1, r, h, L1);
    float ct[16], cb[16];
    {
      float ck[50];
    ck[0] = __uint_as_float((__float_as_uint(mask7(L0[0]) + mask7(L1[0])) & ~0xFFu) | 0u);
    ck[1] = __uint_as_float((__float_as_uint(mask7(L0[0]) + mask7(L1[1])) & ~0xFFu) | 1u);
    ck[2] = __uint_as_float((__float_as_uint(mask7(L0[0]) + mask7(L1[2])) & ~0xFFu) | 2u);
    ck[3] = __uint_as_float((__float_as_uint(mask7(L0[0]) + mask7(L1[3])) & ~0xFFu) | 3u);
    ck[4] = __uint_as_float((__float_as_uint(mask7(L0[0]) + mask7(L1[4])) & ~0xFFu) | 4u);
    ck[5] = __uint_as_float((__float_as_uint(mask7(L0[0]) + mask7(L1[5])) & ~0xFFu) | 5u);
    ck[6] = __uint_as_float((__float_as_uint(mask7(L0[0]) + mask7(L1[6])) & ~0xFFu) | 6u);
    ck[7] = __uint_as_float((__float_as_uint(mask7(L0[0]) + mask7(L1[7])) & ~0xFFu) | 7u);
    ck[8] = __uint_as_float((__float_as_uint(mask7(L0[0]) + mask7(L1[8])) & ~0xFFu) | 8u);
    ck[9] = __uint_as_float((__float_as_uint(mask7(L0[0]) + mask7(L1[9])) & ~0xFFu) | 9u);
    ck[10] = __uint_as_float((__float_as_uint(mask7(L0[0]) + mask7(L1[10])) & ~0xFFu) | 10u);
    ck[11] = __uint_as_float((__float_as_uint(mask7(L0[0]) + mask7(L1[11])) & ~0xFFu) | 11u);
    ck[12] = __uint_as_float((__float_as_uint(mask7(L0[0]) + mask7(L1[12])) & ~0xFFu) | 12u);
    ck[13] = __uint_as_float((__float_as_uint(mask7(L0[0]) + mask7(L1[13])) & ~0xFFu) | 13u);
    ck[14] = __uint_as_float((__float_as_uint(mask7(L0[0]) + mask7(L1[14])) & ~0xFFu) | 14u);
    ck[15] = __uint_as_float((__float_as_uint(mask7(L0[0]) + mask7(L1[15])) & ~0xFFu) | 15u);
    ck[16] = __uint_as_float((__float_as_uint(mask7(L0[1]) + mask7(L1[0])) & ~0xFFu) | 16u);
    ck[17] = __uint_as_float((__float_as_uint(mask7(L0[1]) + mask7(L1[1])) & ~0xFFu) | 17u);
    ck[18] = __uint_as_float((__float_as_uint(mask7(L0[1]) + mask7(L1[2])) & ~0xFFu) | 18u);
    ck[19] = __uint_as_float((__float_as_uint(mask7(L0[1]) + mask7(L1[3])) & ~0xFFu) | 19u);
    ck[20] = __uint_as_float((__float_as_uint(mask7(L0[1]) + mask7(L1[4])) & ~0xFFu) | 20u);
    ck[21] = __uint_as_float((__float_as_uint(mask7(L0[1]) + mask7(L1[5])) & ~0xFFu) | 21u);
    ck[22] = __uint_as_float((__float_as_uint(mask7(L0[1]) + mask7(L1[6])) & ~0xFFu) | 22u);
    ck[23] = __uint_as_float((__float_as_uint(mask7(L0[1]) + mask7(L1[7])) & ~0xFFu) | 23u);
    ck[24] = __uint_as_float((__float_as_uint(mask7(L0[2]) + mask7(L1[0])) & ~0xFFu) | 32u);
    ck[25] = __uint_as_float((__float_as_uint(mask7(L0[2]) + mask7(L1[1])) & ~0xFFu) | 33u);
    ck[26] = __uint_as_float((__float_as_uint(mask7(L0[2]) + mask7(L1[2])) & ~0xFFu) | 34u);
    ck[27] = __uint_as_float((__float_as_uint(mask7(L0[2]) + mask7(L1[3])) & ~0xFFu) | 35u);
    ck[28] = __uint_as_float((__float_as_uint(mask7(L0[2]) + mask7(L1[4])) & ~0xFFu) | 36u);
    ck[29] = __uint_as_float((__float_as_uint(mask7(L0[3]) + mask7(L1[0])) & ~0xFFu) | 48u);
    ck[30] = __uint_as_float((__float_as_uint(mask7(L0[3]) + mask7(L1[1])) & ~0xFFu) | 49u);
    ck[31] = __uint_as_float((__float_as_uint(mask7(L0[3]) + mask7(L1[2])) & ~0xFFu) | 50u);
    ck[32] = __uint_as_float((__float_as_uint(mask7(L0[3]) + mask7(L1[3])) & ~0xFFu) | 51u);
    ck[33] = __uint_as_float((__float_as_uint(mask7(L0[4]) + mask7(L1[0])) & ~0xFFu) | 64u);
    ck[34] = __uint_as_float((__float_as_uint(mask7(L0[4]) + mask7(L1[1])) & ~0xFFu) | 65u);
    ck[35] = __uint_as_float((__float_as_uint(mask7(L0[4]) + mask7(L1[2])) & ~0xFFu) | 66u);
    ck[36] = __uint_as_float((__float_as_uint(mask7(L0[5]) + mask7(L1[0])) & ~0xFFu) | 80u);
    ck[37] = __uint_as_float((__float_as_uint(mask7(L0[5]) + mask7(L1[1])) & ~0xFFu) | 81u);
    ck[38] = __uint_as_float((__float_as_uint(mask7(L0[6]) + mask7(L1[0])) & ~0xFFu) | 96u);
    ck[39] = __uint_as_float((__float_as_uint(mask7(L0[6]) + mask7(L1[1])) & ~0xFFu) | 97u);
    ck[40] = __uint_as_float((__float_as_uint(mask7(L0[7]) + mask7(L1[0])) & ~0xFFu) | 112u);
    ck[41] = __uint_as_float((__float_as_uint(mask7(L0[7]) + mask7(L1[1])) & ~0xFFu) | 113u);
    ck[42] = __uint_as_float((__float_as_uint(mask7(L0[8]) + mask7(L1[0])) & ~0xFFu) | 128u);
    ck[43] = __uint_as_float((__float_as_uint(mask7(L0[9]) + mask7(L1[0])) & ~0xFFu) | 144u);
    ck[44] = __uint_as_float((__float_as_uint(mask7(L0[10]) + mask7(L1[0])) & ~0xFFu) | 160u);
    ck[45] = __uint_as_float((__float_as_uint(mask7(L0[11]) + mask7(L1[0])) & ~0xFFu) | 176u);
    ck[46] = __uint_as_float((__float_as_uint(mask7(L0[12]) + mask7(L1[0])) & ~0xFFu) | 192u);
    ck[47] = __uint_as_float((__float_as_uint(mask7(L0[13]) + mask7(L1[0])) & ~0xFFu) | 208u);
    ck[48] = __uint_as_float((__float_as_uint(mask7(L0[14]) + mask7(L1[0])) & ~0xFFu) | 224u);
    ck[49] = __uint_as_float((__float_as_uint(mask7(L0[15]) + mask7(L1[0])) & ~0xFFu) | 240u);
      const float NINF = __uint_as_float(0xFF800000u);
#pragma unroll
      for (int q = 0; q < 25; ++q) {
        float a_ = ck[q], b_ = ck[25 + q];
        asm volatile("" : "+v"(a_), "+v"(b_));
        const float m = h ? b_ : a_;
        if (q < 16) ct[q] = m; else cb[q - 16] = m;
      }
#pragma unroll
      for (int q = 9; q < 16; ++q) cb[q] = NINF;
      sort16_desc(ct); sort16_desc(cb);
      top16_merge(ct, cb);
#pragma unroll
      for (int q = 0; q < 16; ++q) cb[q] = __shfl_xor(ct[q], 32);
      top16_merge(ct, cb);
    }
    if (h == 0) {
#pragma unroll
      for (int w = 0; w < 4; ++w) {
        unsigned v = 0, v2 = 0;
#pragma unroll
        for (int b = 0; b < 4; ++b) {
          v |= (__float_as_uint(L0[w * 4 + b]) & 0x7Fu) << (8 * b);
          v2 |= (__float_as_uint(L1[w * 4 + b]) & 0x7Fu) << (8 * b);
        }
        lw[r * 8 + w] = v;
        lw[r * 8 + 4 + w] = v2;
      }
    }
    __builtin_amdgcn_wave_barrier();
    const float* s2 = p.SS2 + (size_t)t * 16;
    float ssum = 0.f;
#pragma unroll
    for (int j = 0; j < 8; ++j) ssum += s2[j];
    const float r2 = rsqrtf(ssum * (1.f / 1024.f) + EPS);
    float gv[16];
    const float v0 = __uint_as_float(__float_as_uint(ct[0]) & ~0xFFu) * r2;
    float esum = 0.f;
#pragma unroll
    for (int j = 0; j < 16; ++j) {
      const float vj = __uint_as_float(__float_as_uint(ct[j]) & ~0xFFu) * r2;
      gv[j] = __builtin_amdgcn_exp2f((vj - v0) * 1.4426950408889634f);
      esum += gv[j];
    }
    const float einv = 1.f / esum;
    u32x4 oi[2]; f32x4 og[2];
#pragma unroll
    for (int jj = 0; jj < 8; ++jj) {
      float ka = ct[jj], kb = ct[8 + jj], ga = gv[jj], gb = gv[8 + jj];
      asm volatile("" : "+v"(ka), "+v"(kb), "+v"(ga), "+v"(gb));
      const float key = h ? kb : ka;
      const float g = (h ? gb : ga) * einv;
      const unsigned code = __float_as_uint(key) & 0xFFu;
      const unsigned i1 = lb[r * 32 + (code >> 4)], i2 = lb[r * 32 + 16 + (code & 15)];
      oi[jj >> 2][jj & 3] = i1 * 128 + i2;
      og[jj >> 2][jj & 3] = g;
    }
    int* ip = p.IDX + (size_t)t * 128 + hh * 16 + h * 8;
    float* gp = p.G + (size_t)t * 128 + hh * 16 + h * 8;
    *(u32x4*)ip = oi[0]; *(u32x4*)(ip + 4) = oi[1];
    *(f32x4*)gp = og[0]; *(f32x4*)(gp + 4) = og[1];
    __builtin_amdgcn_wave_barrier();
  }
}

DI float gelu_tanh(float x) {
  const float u = 0.7978845608028654f * (x + 0.044715f * x * x * x);
  const float e = __builtin_amdgcn_exp2f(u * 2.8853900817779268f);
  const float th = 1.f - 2.f * __builtin_amdgcn_rcpf(e + 1.f);
  return 0.5f * x * (1.f + th);
}
DI float dot16_fp8(const u32x4& w, const u32x4& xa, const u32x4& xb) {
  float acc = 0.f;
#pragma unroll
  for (int k = 0; k < 4; ++k) {
    const bf2_t b0 = __builtin_amdgcn_cvt_scalef32_pk_bf16_fp8(w[k], 1.0f, false);
    const bf2_t b1 = __builtin_amdgcn_cvt_scalef32_pk_bf16_fp8(w[k], 1.0f, true);
    const unsigned x0 = (k < 2) ? xa[2 * k] : xb[2 * k - 4], x1 = (k < 2) ? xa[2 * k + 1] : xb[2 * k - 3];
    acc = __builtin_amdgcn_fdot2_f32_bf16(b0, __builtin_bit_cast(bf2_t, x0), acc, false);
    acc = __builtin_amdgcn_fdot2_f32_bf16(b1, __builtin_bit_cast(bf2_t, x1), acc, false);
  }
  return acc;
}

template <int CTRL>
DI float dppf(float x) { return __uint_as_float(__builtin_amdgcn_update_dpp(0u, __float_as_uint(x), CTRL, 0xF, 0xF, false)); }
DI float swap32sum(float a, float b) {
  auto rr = __builtin_amdgcn_permlane32_swap(__float_as_uint(a), __float_as_uint(b), false, false);
  return __uint_as_float(rr[0]) + __uint_as_float(rr[1]);
}
DI float swap16sum(float a, float b) {
  auto rr = __builtin_amdgcn_permlane16_swap(__float_as_uint(a), __float_as_uint(b), false, false);
  return __uint_as_float(rr[0]) + __uint_as_float(rr[1]);
}
struct P8Buf { u32x4 w[16]; u32x4 xa, xb; };

DI void p8_load_idx(const Params& p, int t, int j, u32x4 (&ix)[4]) {
  const int* ip = p.IDX + (size_t)t * 128 + j * 16;
#pragma unroll
  for (int q = 0; q < 4; ++q) ix[q] = *(const u32x4*)(ip + q * 4);
}
DI void p8_load_rows(const unsigned char* tab, int s, int cc, const u32x4 (&ix)[4], u32x4 (&w)[16]) {
  const unsigned char* base = tab + (size_t)s * (16384 * 128) + cc * 16;
#pragma unroll
  for (int i = 0; i < 16; ++i) w[i] = *(const u32x4*)(base + (size_t)ix[i >> 2][i & 3] * 128);
}

DI void phase8(const Params& p, char* smem, const int tbase) {
  WAVE_COORDS
  const int G = gridDim.x;
  const int gw = vblock() * 4 + wave, NW = G * 4;
  const int j = lane >> 3, cc = lane & 7;
  const bool b0 = lane & 1, b1 = lane & 2, b2 = lane & 4, b3 = lane & 8, b4 = lane & 16, b5 = lane & 32;
  f32x2* part = (f32x2*)(smem + wave * 12288) + lane;
  const float* coefl = (const float*)(smem + wave * 12288);
  const int ntok_all = (T_TOK - gw + NW - 1) / NW;
  const int ntok = min(24, ntok_all - tbase);
  const int gw0 = gw + tbase * NW;
  if (ntok <= 0) return;
  for (int s = 0; s < 8; ++s) {
    u32x4 ixA[4], ixB[4];
    u32x4 wA[16], wB[16];
    u32x4 xaA, xbA, xaB, xbB;
    auto issue = [&](int i, u32x4 (&ix)[4], u32x4 (&w)[16], u32x4& xa, u32x4& xb) {
      const int t = gw0 + i * NW;
      const u16* xr = p.X2b + (size_t)t * 1024 + s * 128 + cc * 16;
      xa = *(const u32x4*)xr; xb = *(const u32x4*)(xr + 8);
      p8_load_rows(p.U8, s, cc, ix, w);
    };
    auto compute = [&](int i, u32x4 (&w)[16], u32x4& xa, u32x4& xb) {
      float d[16];
#pragma unroll
      for (int q = 0; q < 16; ++q) d[q] = dot16_fp8(w[q], xa, xb);
      float v8[8], v4[4], v2[2];
#pragma unroll
      for (int m = 0; m < 8; ++m) { const float mine = b2 ? d[m + 8] : d[m], send = b2 ? d[m] : d[m + 8]; v8[m] = mine + dppf<0x141>(send); }
#pragma unroll
      for (int m = 0; m < 4; ++m) { const float mine = b1 ? v8[m + 4] : v8[m], send = b1 ? v8[m] : v8[m + 4]; v4[m] = mine + dppf<0x4E>(send); }
#pragma unroll
      for (int m = 0; m < 2; ++m) { const float mine = b0 ? v4[m + 2] : v4[m], send = b0 ? v4[m] : v4[m + 2]; v2[m] = mine + dppf<0xB1>(send); }
      f32x2 acc = {v2[0], v2[1]};
      if (s > 0) { const f32x2 o = part[i * 64]; acc[0] += o[0]; acc[1] += o[1]; }
      part[i * 64] = acc;
    };
    p8_load_idx(p, gw0, j, ixA);
    issue(0, ixA, wA, xaA, xbA);
    if (ntok > 1) p8_load_idx(p, gw0 + NW, j, ixB);
#pragma unroll 1
    for (int i = 0; i < ntok; i += 2) {
      if (i + 1 < ntok) issue(i + 1, ixB, wB, xaB, xbB);
      if (i + 2 < ntok) p8_load_idx(p, gw0 + (i + 2) * NW, j, ixA);
      __builtin_amdgcn_sched_barrier(0);
      compute(i, wA, xaA, xbA);
      __builtin_amdgcn_sched_barrier(0);
      if (i + 1 < ntok) {
        if (i + 2 < ntok) issue(i + 2, ixA, wA, xaA, xbA);
        if (i + 3 < ntok) p8_load_idx(p, gw0 + (i + 3) * NW, j, ixB);
        __builtin_amdgcn_sched_barrier(0);
        compute(i + 1, wB, xaB, xbB);
        __builtin_amdgcn_sched_barrier(0);
      }
    }
  }
  for (int i = 0; i < ntok; ++i) {
    const int t = gw0 + i * NW;
    const float* s2 = p.SS2 + (size_t)t * 16;
    float ssum = 0.f;
#pragma unroll
    for (int q = 0; q < 8; ++q) ssum += s2[q];
    const float r2 = rsqrtf(ssum * (1.f / 1024.f) + EPS) * (1.f / USCALE);
    const f32x2 g = *(const f32x2*)(p.G + (size_t)t * 128 + lane * 2);
    f32x2 a = part[i * 64];
    a[0] = gelu_tanh(a[0] * r2) * g[0] * (1.f / VSCALE);
    a[1] = gelu_tanh(a[1] * r2) * g[1] * (1.f / VSCALE);
    part[i * 64] = a;
  }
  asm volatile("" ::: "memory");
  __builtin_amdgcn_wave_barrier();
  for (int s = 0; s < 8; ++s) {
    u32x4 ixA[4], ixB[4];
    u32x4 wA[16], wB[16];
    auto compute = [&](int i, u32x4 (&w)[16]) {
      const int t = gw0 + i * NW;
      const float* cp = coefl + i * 128 + j * 16;
      f32x4 cf[4];
#pragma unroll
      for (int q = 0; q < 4; ++q) cf[q] = *(const f32x4*)(cp + q * 4);
      f32x2 acc2[8];
#pragma unroll
      for (int e = 0; e < 8; ++e) acc2[e] = f32x2{0.f, 0.f};
#pragma unroll
      for (int q = 0; q < 16; ++q) {
        const float cq = cf[q >> 2][q & 3];
        const f32x2 c2 = {cq, cq};
#pragma unroll
        for (int k = 0; k < 4; ++k) {
          const f32x2 lo = __builtin_amdgcn_cvt_pk_f32_fp8((int)w[q][k], false);
          const f32x2 hi = __builtin_amdgcn_cvt_pk_f32_fp8((int)w[q][k], true);
          acc2[2 * k] = __builtin_elementwise_fma(lo, c2, acc2[2 * k]);
          acc2[2 * k + 1] = __builtin_elementwise_fma(hi, c2, acc2[2 * k + 1]);
        }
      }
      float acc[16];
#pragma unroll
      for (int e = 0; e < 8; ++e) { acc[2 * e] = acc2[e][0]; acc[2 * e + 1] = acc2[e][1]; }
      float v8[8], v4[4], v2[2];
#pragma unroll
      for (int m = 0; m < 8; ++m) v8[m] = swap32sum(acc[m], acc[m + 8]);
#pragma unroll
      for (int m = 0; m < 4; ++m) v4[m] = swap16sum(v8[m], v8[m + 4]);
#pragma unroll
      for (int m = 0; m < 2; ++m) { const float mine = b3 ? v4[m + 2] : v4[m], send = b3 ? v4[m] : v4[m + 2]; v2[m] = mine + dppf<0x128>(send); }
      float* op = p.out + (size_t)t * 1024 + s * 128 + cc * 16 + 2 * j;
      f32x2 o = *(f32x2*)op;
      o[0] += v2[0]; o[1] += v2[1];
      *(f32x2*)op = o;
    };
    p8_load_idx(p, gw0, j, ixA);
    p8_load_rows(p.V8, s, cc, ixA, wA);
    if (ntok > 1) p8_load_idx(p, gw0 + NW, j, ixB);
#pragma unroll 1
    for (int i = 0; i < ntok; i += 2) {
      if (i + 1 < ntok) p8_load_rows(p.V8, s, cc, ixB, wB);
      if (i + 2 < ntok) p8_load_idx(p, gw0 + (i + 2) * NW, j, ixA);
      __builtin_amdgcn_sched_barrier(0);
      compute(i, wA);
      __builtin_amdgcn_sched_barrier(0);
      if (i + 1 < ntok) {
        if (i + 2 < ntok) p8_load_rows(p.V8, s, cc, ixA, wA);
        if (i + 3 < ntok) p8_load_idx(p, gw0 + (i + 3) * NW, j, ixB);
        __builtin_amdgcn_sched_barrier(0);
        compute(i + 1, wB);
        __builtin_amdgcn_sched_barrier(0);
      }
    }
  }
  asm volatile("" ::: "memory");
  __builtin_amdgcn_wave_barrier();
}

extern __shared__ __attribute__((aligned(16))) char dyn_smem[];

DI void run_phase(const Params& p, int ph, char* smem) {
  switch (ph) {
    case 0: phase0(p); break;
    case 1: phase1(p, smem); break;
    case 2: phase2(p, smem); break;
    case 3: phase3(p, smem); break;
    case 4: phase4(p, smem); break;
    case 5: phase5(p, smem); break;
    case 6: phase6(p, smem); break;
    case 7: phase7(p, smem); break;
    default: phase8(p, smem, 0); break;
  }
}


#define XB_TMO      128
#define XB_XCNT(j)  (256  + 64 * (j))
#define XB_XSUB(j)  (1280 + 64 * (j))
#define XB_XGEN(j)  (2304 + 64 * (j))
#define XB_TOP      3328
#define XB_TOPGEN   3392
#define XCD_BAR_WORDS 3456
#define XB_SPIN_CAP (1u << 22)
#define LAS __attribute__((address_space(3)))
DI unsigned xb_ld(unsigned* p) { return __hip_atomic_load(p, __ATOMIC_RELAXED, __HIP_MEMORY_SCOPE_AGENT); }
DI unsigned xb_add(unsigned* p, unsigned v) { return __hip_atomic_fetch_add(p, v, __ATOMIC_RELAXED, __HIP_MEMORY_SCOPE_AGENT); }
DI unsigned xb_xcc_id() { return (unsigned)__builtin_amdgcn_s_getreg((3 << 11) | 20) & 0xFu; }
#define XB_SPIN(cond, bar) do { unsigned _sp = 0; while (cond) { __builtin_amdgcn_s_sleep(1); \
    if ((++_sp & 255u) == 0u) { if (xb_ld(&(bar)[XB_TMO])) break; if (_sp > XB_SPIN_CAP) { atomicAdd(&(bar)[XB_TMO], 1u); break; } } } } while (0)
struct XcdBarrier { unsigned* bar; unsigned x; volatile LAS unsigned* st; };
DI XcdBarrier xcd_barrier_post(unsigned* bar, volatile LAS unsigned* st) {
  XcdBarrier b; b.bar = bar; b.x = xb_xcc_id(); b.st = st;
  if (threadIdx.x == 0) (void)xb_add(&bar[XB_XCNT(b.x)], 1u);
  return b;
}
DI void xcd_barrier_complete(unsigned* bar, unsigned x, unsigned& nloc, unsigned& nx) {
  const unsigned G = gridDim.x * gridDim.y * gridDim.z;
  unsigned sum, cnt, mine, sp = 0u;
  for (;;) {
    sum = 0u; cnt = 0u; mine = 0u;
#pragma unroll
    for (unsigned j = 0; j < 16; ++j) { const unsigned c = xb_ld(&bar[XB_XCNT(j)]); sum += c; cnt += (c > 0u) ? 1u : 0u; mine = (j == x) ? c : mine; }
    if (sum == G) break;
    __builtin_amdgcn_s_sleep(1);
    if ((++sp & 255u) == 0u) { if (xb_ld(&bar[XB_TMO])) break; if (sp > XB_SPIN_CAP) { atomicAdd(&bar[XB_TMO], 1u); break; } }
  }
  nloc = mine > 0u ? mine : 1u; nx = cnt > 0u ? cnt : 1u;
}
DI void xcd_barrier(const XcdBarrier& b) {
  asm volatile("s_waitcnt vmcnt(0)" ::: "memory");
  __syncthreads();
  if (threadIdx.x == 0) {
    unsigned* bar = b.bar;
    __builtin_amdgcn_s_waitcnt(0);
    unsigned nloc = b.st[0], nx = b.st[1];
    if (nloc == 0u) { xcd_barrier_complete(bar, b.x, nloc, nx); b.st[0] = nloc; b.st[1] = nx; }
    const unsigned old = xb_add(&bar[XB_XSUB(b.x)], 1u);
    const unsigned gen = old / nloc;
    if (old + 1u == (gen + 1u) * nloc) {
      __builtin_amdgcn_fence(__ATOMIC_RELEASE, "agent");
      asm volatile("s_waitcnt vmcnt(0)" ::: "memory");
      const unsigned og = xb_add(&bar[XB_TOP], 1u);
      const unsigned tg = og / nx;
      if (og + 1u == (tg + 1u) * nx) xb_add(&bar[XB_TOPGEN], 1u);
      else XB_SPIN(xb_ld(&bar[XB_TOPGEN]) == tg, bar);
      __builtin_amdgcn_fence(__ATOMIC_ACQUIRE, "agent");
      xb_add(&bar[XB_XGEN(b.x)], 1u);
      asm volatile("s_waitcnt vmcnt(0)" ::: "memory");
    } else {
      XB_SPIN(xb_ld(&bar[XB_XGEN(b.x)]) == gen, bar);
      __builtin_amdgcn_fence(__ATOMIC_ACQUIRE, "agent");
      asm volatile("s_waitcnt vmcnt(0)" ::: "memory");
    }
  }
  __syncthreads();
}

#if MK_COOP
__global__ void __launch_bounds__(NTHR, 2) mega_kernel(Params p) {
  cg::grid_group grid = cg::this_grid();
#ifndef PROBE_PH
#define PROBE_PH -1
#endif
  volatile LAS unsigned* st = (volatile LAS unsigned*)(dyn_smem + 65536 + 1024);
  if (threadIdx.x < 4) st[threadIdx.x] = 0u;
  for (int i = blockIdx.x * NTHR + threadIdx.x; i < XCD_BAR_WORDS; i += gridDim.x * NTHR) p.bar[i] = 0u;
  phase0(p);
  grid.sync();
  XcdBarrier xb = xcd_barrier_post(p.bar, st);
#define RUNP(k, call) call; xcd_barrier(xb); if (PROBE_PH == k) { call; xcd_barrier(xb); }
  RUNP(1, phase1(p, dyn_smem))
  RUNP(2, phase2(p, dyn_smem))
  RUNP(3, phase3(p, dyn_smem))
  RUNP(4, phase4(p, dyn_smem))
  RUNP(5, phase5(p, dyn_smem))
  RUNP(6, phase6(p, dyn_smem))
  RUNP(7, phase7(p, dyn_smem))
  for (int tb8 = 0; tb8 * (int)gridDim.x * 4 < T_TOK; tb8 += 24) phase8(p, dyn_smem, tb8);
}
#else
template <int PH>
__global__ void __launch_bounds__(NTHR, 2) phase_kernel(Params p) { run_phase(p, PH, dyn_smem); }
#endif

extern "C" void kernel_launch(void* const* d_in, const int* in_sizes, int n_in, void* d_out, int out_size, void* d_ws,
                              size_t ws_size, hipStream_t stream) {
  Params p{};
  const float* const* in = (const float* const*)d_in;
  p.x0 = in[0]; p.x1 = in[1]; p.attn_norm_g = in[2]; p.w_in = in[3]; p.q_lat_g = in[4]; p.w_uq = in[5];
  p.kv_lat_g = in[6]; p.w_ukv = in[7]; p.q_head_g = in[8]; p.k_head_g = in[9]; p.attn_out_g = in[10];
  p.fnet_out_g = in[11]; p.w_out = in[12]; p.ffn_norm_g = in[13]; p.peer_w_q = in[14]; p.peer_sub_keys = in[15];
  p.peer_u = in[16]; p.peer_v = in[17];
  p.out = (float*)d_out;
  char* ws = (char*)d_ws;
  size_t off = 0;
  auto take = [&](size_t bytes) { char* q = ws + off; off += (bytes + 255) & ~(size_t)255; return q; };
  p.WinT = (u16*)take(1280 * 1024 * 2); p.WuqT = (u16*)take(768 * 384 * 2); p.WukvT = (u16*)take(1024 * 256 * 2);
  p.WoutT = (u16*)take(1024 * 1024 * 2); p.WpqT = (u16*)take(2048 * 1024 * 2); p.SK = (u16*)take(262144 * 2);
  p.Wc = (u16*)take(256 * 128 * 2); p.WA64 = (u16*)take(128 * 128 * 2); p.WA32 = (u16*)take(128 * 64 * 2);
  p.WB = (u16*)take(128 * 256 * 2);
  p.ropec = (float*)take(8192 * 16 * 4); p.ropes = (float*)take(8192 * 16 * 4);
  p.rstd1 = (float*)take((size_t)T_TOK * 4); p.SSP = (float*)take((size_t)T_TOK * 10 * 4);
  p.SSA = (float*)take((size_t)T_TOK * 8 * 4); p.SSF = (float*)take((size_t)T_TOK * 8 * 4);
  p.SS2 = (float*)take((size_t)T_TOK * 16 * 4); p.KR = (float*)take((size_t)T_TOK * 32 * 4);
  p.bar = (unsigned*)take(XCD_BAR_WORDS * 4);
  p.misc = (float*)take(256);
  const size_t SMALL = 28u << 20;
  char* big = ws + SMALL;
  const size_t MB = 1u << 20;
  char* dsp = (char*)d_out;
  p.Xb = (u16*)(big + 0 * MB);
  p.CQ = (u16*)(big + 96 * MB); p.CKV = (u16*)(big + 132 * MB); p.F = (u16*)(big + 156 * MB);
  p.Z1 = (u16*)(big + 204 * MB);
  p.Vt = (u16*)(big + 300 * MB);
  p.Q1 = (u16*)(dsp + 0 * MB); p.K1 = (u16*)(dsp + 72 * MB);
  p.Qn = (u16*)(big + 0 * MB); p.Kn = (u16*)(dsp + 120 * MB);
  p.G1 = (u16*)(big + 96 * MB);
  p.MIX = (u16*)(big + 204 * MB);
  p.X2b = (u16*)(big + 0 * MB);
  p.Qp = (u16*)(big + 96 * MB);
  p.IDX = (int*)(big + 300 * MB); p.G = (float*)(big + 324 * MB);
  p.U8 = (unsigned char*)(big + 348 * MB); p.V8 = (unsigned char*)(big + 364 * MB);

#if MK_COOP
  static int grid_blocks = 0;
  if (!grid_blocks) {
    int dev = 0, cus = 0, per_cu = 0;
    hipGetDevice(&dev);
    hipDeviceGetAttribute(&cus, hipDeviceAttributeMultiprocessorCount, dev);
    hipFuncSetAttribute((const void*)mega_kernel, hipFuncAttributeMaxDynamicSharedMemorySize, LDS_BYTES);
    hipOccupancyMaxActiveBlocksPerMultiprocessor(&per_cu, mega_kernel, NTHR, LDS_BYTES);
    if (per_cu > 2) per_cu = 2;
    grid_blocks = cus * per_cu;
    grid_blocks &= ~7;
  }
  void* args[] = {&p};
  hipError_t e = hipLaunchCooperativeKernel((void*)mega_kernel, dim3(grid_blocks), dim3(NTHR), args, LDS_BYTES, stream);
  if (e != hipSuccess) fprintf(stderr, "cooperative launch failed: %s (grid %d)\n", hipGetErrorString(e), grid_blocks);
#else
  const int GB = 512;
#define LAUNCH(PH)                                                                                                \
  hipFuncSetAttribute((const void*)phase_kernel<PH>, hipFuncAttributeMaxDynamicSharedMemorySize, LDS_BYTES);      \
  phase_kernel<PH><<<GB, NTHR, LDS_BYTES, stream>>>(p);
  LAUNCH(0) LAUNCH(1) LAUNCH(2) LAUNCH(3) LAUNCH(4) LAUNCH(5) LAUNCH(6) LAUNCH(7) LAUNCH(8)
#endif
}
```

```cpp
#include <hip/hip_runtime.h>
#include <hip/hip_cooperative_groups.h>
#include <stdint.h>
#include <cstdio>
namespace cg = cooperative_groups;

#ifndef MK_COOP
#define MK_COOP 1
#endif

typedef unsigned short u16;
using bf16x8 = __attribute__((ext_vector_type(8))) short;
using f32x16 = __attribute__((ext_vector_type(16))) float;
using f32x4 = __attribute__((ext_vector_type(4))) float;
using f32x2 = __attribute__((ext_vector_type(2))) float;
using u32x4 = __attribute__((ext_vector_type(4))) unsigned;
using u32x2 = __attribute__((ext_vector_type(2))) unsigned;
typedef __bf16 bf2_t __attribute__((ext_vector_type(2)));

#define DI __device__ __forceinline__
#define MFMA(a, b, c) __builtin_amdgcn_mfma_f32_32x32x16_bf16((a), (b), (c), 0, 0, 0)

constexpr int T_TOK = 49152;
constexpr int TP = 16384;
constexpr float EPS = 1e-6f;
constexpr int NTHR = 256;
constexpr int LDS_BYTES = 65536 + 6144;
constexpr int GBUF = 32768;
constexpr float USCALE = 512.f, VSCALE = 256.f;

struct Params {
  const float *x0, *x1, *attn_norm_g, *w_in, *q_lat_g, *w_uq, *kv_lat_g, *w_ukv, *q_head_g, *k_head_g,
      *attn_out_g, *fnet_out_g, *w_out, *ffn_norm_g, *peer_w_q, *peer_sub_keys, *peer_u, *peer_v;
  float* out;
  u16 *WinT, *WuqT, *WukvT, *WoutT, *WpqT, *SK, *Wc, *WA64, *WA32, *WB;
  float *ropec, *ropes, *rstd1, *SSP, *SSA, *SSF, *SS2, *KR;
  u16 *Xb, *CQ, *CKV, *F, *Z1, *Vt, *Q1, *K1, *Qn, *Kn, *G1, *MIX, *X2b, *Qp;
  unsigned char *U8, *V8;
  int* IDX;
  float* G;
  unsigned* bar;
  float* misc;
};

DI unsigned cvtpk(float lo, float hi) {
  f32x2 v = {lo, hi};
  bf2_t b = __builtin_convertvector(v, bf2_t);
  return __builtin_bit_cast(unsigned, b);
}
DI u16 f2bf(float x) { return (u16)(cvtpk(x, 0.f) & 0xffffu); }
DI float bflo(unsigned w) { return __uint_as_float(w << 16); }
DI float bfhi(unsigned w) { return __uint_as_float(w & 0xffff0000u); }
DI int crow(int i, int h) { return (i & 3) + 8 * (i >> 2) + 4 * h; }
DI float red32(float v) {
  v += __shfl_xor(v, 1); v += __shfl_xor(v, 2); v += __shfl_xor(v, 4); v += __shfl_xor(v, 8); v += __shfl_xor(v, 16);
  return v;
}
DI float wave_sum(float v) { v = red32(v); v += __shfl_xor(v, 32); return v; }
DI const float* xrow(const Params& p, int t) {
  return t < TP ? p.x0 + (size_t)t * 1024 : p.x1 + (size_t)(t - TP) * 1024;
}
DI void tok2seq(int t, int& q, int& S, int& tb) {
  if (t < TP) { q = t >> 13; S = 8192; tb = q << 13; }
  else { int u = (t - TP) >> 12; q = 2 + u; S = 4096; tb = TP + (u << 12); }
}
DI int vblock() { return (blockIdx.x & 7) * (gridDim.x >> 3) + (blockIdx.x >> 3); }
DI float fdot2(unsigned a, unsigned b, float c) {
  return __builtin_amdgcn_fdot2_f32_bf16(__builtin_bit_cast(bf2_t, a), __builtin_bit_cast(bf2_t, b), c, false);
}

DI int swz(int row, int c) { return row * 128 + ((c ^ ((row >> 1) & 7)) << 4); }

template <bool BATCH = false, class AF, class BF>
DI void gemm_mainloop(f32x16 (&acc)[2][2], char* smem, AF arow, BF brow, int k0, int k1) {
  const int tid = threadIdx.x, lane = tid & 63, wave = tid >> 6;
  const int wm = wave >> 1, wn = wave & 1, r = lane & 31, h = lane >> 5;
  const int lrow = tid >> 3, lc = tid & 7;
  const u16* ap[4]; const u16* bp[4];
#pragma unroll
  for (int i = 0; i < 4; ++i) { ap[i] = arow(lrow + 32 * i) + lc * 8; bp[i] = brow(lrow + 32 * i) + lc * 8; }
  u32x4 ra0[4], rb0[4], ra1[4], rb1[4];
#pragma unroll
  for (int i = 0; i < 4; ++i) { ra0[i] = *(const u32x4*)(ap[i] + k0); rb0[i] = *(const u32x4*)(bp[i] + k0); }
#pragma unroll
  for (int i = 0; i < 4; ++i) {
    *(u32x4*)(smem + swz(lrow + 32 * i, lc)) = ra0[i];
    *(u32x4*)(smem + 16384 + swz(lrow + 32 * i, lc)) = rb0[i];
  }
  if (k0 + 64 < k1) {
#pragma unroll
    for (int i = 0; i < 4; ++i) { ra0[i] = *(const u32x4*)(ap[i] + k0 + 64); rb0[i] = *(const u32x4*)(bp[i] + k0 + 64); }
  }
  __syncthreads();
  int cur = 0;
  auto step = [&](int k, u32x4 (&xa)[4], u32x4 (&xb)[4], u32x4 (&ya)[4], u32x4 (&yb)[4]) {
    if (k + 128 < k1) {
#pragma unroll
      for (int i = 0; i < 4; ++i) { ya[i] = *(const u32x4*)(ap[i] + k + 128); yb[i] = *(const u32x4*)(bp[i] + k + 128); }
    }
    __builtin_amdgcn_sched_barrier(0);
    const char* As = smem + cur * GBUF;
    const char* Bs = As + 16384;
    if (BATCH) {
      bf16x8 af[4][2], bfr[4][2];
#pragma unroll
      for (int ks = 0; ks < 4; ++ks) {
#pragma unroll
        for (int mi = 0; mi < 2; ++mi) af[ks][mi] = *(const bf16x8*)(As + swz(wm * 64 + mi * 32 + r, ks * 2 + h));
#pragma unroll
        for (int ni = 0; ni < 2; ++ni) bfr[ks][ni] = *(const bf16x8*)(Bs + swz(wn * 64 + ni * 32 + r, ks * 2 + h));
      }
      __builtin_amdgcn_sched_barrier(0);
#pragma unroll
      for (int ks = 0; ks < 4; ++ks)
#pragma unroll
        for (int mi = 0; mi < 2; ++mi)
#pragma unroll
          for (int ni = 0; ni < 2; ++ni) acc[mi][ni] = MFMA(af[ks][mi], bfr[ks][ni], acc[mi][ni]);
    } else {
#pragma unroll
      for (int ks = 0; ks < 4; ++ks) {
        bf16x8 af[2], bfr[2];
#pragma unroll
        for (int mi = 0; mi < 2; ++mi) af[mi] = *(const bf16x8*)(As + swz(wm * 64 + mi * 32 + r, ks * 2 + h));
#pragma unroll
        for (int ni = 0; ni < 2; ++ni) bfr[ni] = *(const bf16x8*)(Bs + swz(wn * 64 + ni * 32 + r, ks * 2 + h));
#pragma unroll
        for (int mi = 0; mi < 2; ++mi)
#pragma unroll
          for (int ni = 0; ni < 2; ++ni) acc[mi][ni] = MFMA(af[mi], bfr[ni], acc[mi][ni]);
      }
    }
    __builtin_amdgcn_sched_barrier(0);
    if (k + 64 < k1) {
      char* An = smem + (cur ^ 1) * GBUF;
#pragma unroll
      for (int i = 0; i < 4; ++i) {
        *(u32x4*)(An + swz(lrow + 32 * i, lc)) = xa[i];
        *(u32x4*)(An + 16384 + swz(lrow + 32 * i, lc)) = xb[i];
      }
    }
    __syncthreads();
    cur ^= 1;
  };
#pragma unroll 1
  for (int k = k0; k < k1; k += 128) {
    step(k, ra0, rb0, ra1, rb1);
    if (k + 64 < k1) step(k + 64, ra1, rb1, ra0, rb0);
  }
}
DI void zero_acc(f32x16 (&acc)[2][2]) {
#pragma unroll
  for (int a = 0; a < 2; ++a)
#pragma unroll
    for (int b = 0; b < 2; ++b)
#pragma unroll
      for (int i = 0; i < 16; ++i) acc[a][b][i] = 0.f;
}
#define WAVE_COORDS                                                        \
  const int tid = threadIdx.x, lane = tid & 63, wave = tid >> 6;           \
  const int wm = wave >> 1, wn = wave & 1, r = lane & 31, h = lane >> 5;   \
  (void)wm; (void)wn; (void)r; (void)h; (void)lane;

constexpr int SROW = 272;
template <bool SCALE>
DI void stage_bf16_t(char* smem, f32x16 (&acc)[2][2], const float* rs, int wm, int wn, int r, int h) {
  char* base = smem + (wm * 64 + 4 * h) * SROW + (wn * 64 + r) * 2;
  const float* rb = rs + wm * 64 + 4 * h;
#pragma unroll
  for (int mi = 0; mi < 2; ++mi)
#pragma unroll
    for (int i = 0; i < 16; ++i) {
      const int ro = mi * 32 + (i & 3) + 8 * (i >> 2);
      const float sc = SCALE ? rb[ro] : 1.f;
#pragma unroll
      for (int ni = 0; ni < 2; ++ni)
        *(u16*)(base + ro * SROW + ni * 64) = f2bf(acc[mi][ni][i] * sc);
    }
}
DI void stage_bf16(char* smem, f32x16 (&acc)[2][2], const float* rs, int wm, int wn, int r, int h, int) {
  if (rs) stage_bf16_t<true>(smem, acc, rs, wm, wn, r, h); else stage_bf16_t<false>(smem, acc, rs, wm, wn, r, h);
}
DI float sumsq8(const u32x4& v) {
  float ss = 0.f;
#pragma unroll
  for (int j = 0; j < 4; ++j) { const float a = bflo(v[j]), b = bfhi(v[j]); ss += a * a + b * b; }
  return ss;
}

#define WAVE_COORDS_L                                                      \
  int tid = threadIdx.x; asm volatile("" : "+v"(tid));                     \
  const int lane = tid & 63, wave = tid >> 6;                              \
  const int wm = wave >> 1, wn = wave & 1, r = lane & 31, h = lane >> 5;   \
  (void)wm; (void)wn; (void)r; (void)h; (void)lane;

template <int MODE>
DI void transpose_w(u16* dst, const float* src, const float* g0, const float* g1, int N, int K, int Nsrc, int gt, int gs) {
  const int items = N * (K >> 3);
  for (int id = gt; id < items; id += gs) {
    const int kc = id / N, n = id - kc * N;
    int col = n; bool valid = true;
    if (MODE == 1) {
      if (n < 640) col = n; else if (n < 1152) col = n + 32; else if (n < 1184) col = 640 + n - 1152; else valid = false;
    }
    float v[8];
#pragma unroll
    for (int j = 0; j < 8; ++j) {
      const int k = kc * 8 + j;
      const float g = (MODE == 2 && k >= 512) ? g1[k - 512] : g0[k];
      v[j] = valid ? src[(size_t)k * Nsrc + col] * g : 0.f;
    }
    u32x4 o = {cvtpk(v[0], v[1]), cvtpk(v[2], v[3]), cvtpk(v[4], v[5]), cvtpk(v[6], v[7])};
    *(u32x4*)(dst + (size_t)n * K + kc * 8) = o;
  }
}

DI void phase0(const Params& p) {
  const int gt = blockIdx.x * NTHR + threadIdx.x, gs = gridDim.x * NTHR;
  if (gt == 0) {
    float mq = 0.f, mk = 0.f;
    for (int d = 0; d < 96; ++d) { mq = fmaxf(mq, fabsf(p.q_head_g[d])); mk = fmaxf(mk, fabsf(p.k_head_g[d])); }
    p.misc[0] = 96.f * mq * mk * (0.10206207261596575f * 1.4426950408889634f) * 1.02f;
  }
  const int lane = threadIdx.x & 63, gw = gt >> 6, nw = gs >> 6;
  for (int t = gw; t < T_TOK; t += nw) {
    const float* xr = xrow(p, t);
    f32x4 v[4]; float ss = 0.f;
#pragma unroll
    for (int i = 0; i < 4; ++i) {
      v[i] = *(const f32x4*)(xr + i * 256 + lane * 4);
      ss += v[i][0] * v[i][0] + v[i][1] * v[i][1] + v[i][2] * v[i][2] + v[i][3] * v[i][3];
    }
    ss = wave_sum(ss);
#pragma unroll
    for (int i = 0; i < 4; ++i) {
      u32x2 o = {cvtpk(v[i][0], v[i][1]), cvtpk(v[i][2], v[i][3])};
      *(u32x2*)(p.Xb + (size_t)t * 1024 + i * 256 + lane * 4) = o;
    }
    if (lane == 0) p.rstd1[t] = rsqrtf(ss * (1.f / 1024.f) + EPS);
  }
  transpose_w<1>(p.WinT, p.w_in, p.attn_norm_g, nullptr, 1280, 1024, 1184, gt, gs);
  transpose_w<0>(p.WuqT, p.w_uq, p.q_lat_g, nullptr, 768, 384, 768, gt, gs);
  transpose_w<0>(p.WukvT, p.w_ukv, p.kv_lat_g, nullptr, 1024, 256, 1024, gt, gs);
  transpose_w<2>(p.WoutT, p.w_out, p.attn_out_g, p.fnet_out_g, 1024, 1024, 1024, gt, gs);
  transpose_w<0>(p.WpqT, p.peer_w_q, p.ffn_norm_g, nullptr, 2048, 1024, 2048, gt, gs);
  for (int id = gt; id < 262144 / 4; id += gs) {
    f32x4 v = *(const f32x4*)(p.peer_sub_keys + (size_t)id * 4);
    u32x2 o = {cvtpk(v[0], v[1]), cvtpk(v[2], v[3])};
    *(u32x2*)(p.SK + (size_t)id * 4) = o;
  }
  for (int id = gt; id < 256 * 128; id += gs) {
    const int n = id >> 7, c = id & 127, pp = n >> 7, m = n & 127;
    const float fr = (float)((m * c) & 127) * (1.f / 128.f);
    const float val = (pp == 0 ? __builtin_amdgcn_cosf(fr) : -__builtin_amdgcn_sinf(fr)) * 0.08838834764831845f;
    p.Wc[id] = f2bf(val);
  }
  for (int id = gt; id < 128 * 128; id += gs) {
    const int n = id >> 7, k = id & 127;
    const int k1 = (n >> 6) * 32 + (n & 31), pq = (n >> 5) & 1, pp = k >> 6, s1 = k & 63;
    const float fr = (float)((s1 * k1) & 63) * (1.f / 64.f);
    const float c = __builtin_amdgcn_cosf(fr), s = __builtin_amdgcn_sinf(fr);
    const float val = (pq == 0 ? (pp == 0 ? c : s) : (pp == 0 ? -s : c)) * 0.125f;
    p.WA64[id] = f2bf(val);
  }
  for (int id = gt; id < 128 * 64; id += gs) {
    const int n = id >> 6, k = id & 63;
    const int k1 = n & 31, pq = (n >> 5) & 1, pp = k >> 5, s1 = k & 31;
    const float fr = (float)((s1 * k1) & 31) * (1.f / 32.f);
    const float c = __builtin_amdgcn_cosf(fr), s = __builtin_amdgcn_sinf(fr);
    float val = (pq == 0 ? (pp == 0 ? c : s) : (pp == 0 ? -s : c)) * 0.17677669529663687f;
    if (n >= 64) val = 0.f;
    p.WA32[id] = f2bf(val);
  }
  for (int id = gt; id < 128 * 256; id += gs) {
    const int k2 = id >> 8, k = id & 255, pq = k >> 7, s2 = k & 127;
    const float fr = (float)((s2 * k2) & 127) * (1.f / 128.f);
    const float val = (pq == 0 ? __builtin_amdgcn_cosf(fr) : __builtin_amdgcn_sinf(fr)) * 0.08838834764831845f;
    p.WB[id] = f2bf(val);
  }
  for (int id = gt; id < 8192 * 16; id += gs) {
    const int pos = id >> 4, j = id & 15;
    const float freq = exp2f(-(float)j * (13.287712379549449f / 16.f));
    const double rev = (double)pos * (double)freq * 0.15915494309189535;
    const float fr = (float)(rev - floor(rev));
    p.ropec[id] = __builtin_amdgcn_cosf(fr);
    p.ropes[id] = __builtin_amdgcn_sinf(fr);
  }
}

DI void phase1(const Params& p, char* smem) {
    float* rs = (float*)(smem + 65536);
  const int G = gridDim.x;
  for (int tile = vblock(); tile < 384 * 10; tile += G) {
    WAVE_COORDS_L
    const int mt = tile / 10, nt = tile - mt * 10, m0 = mt * 128, n0 = nt * 128;
    __syncthreads();
    if (tid < 128) rs[tid] = p.rstd1[m0 + tid];
    f32x16 acc[2][2]; zero_acc(acc);
    const u16* A = p.Xb + (size_t)m0 * 1024; const u16* B = p.WinT + (size_t)n0 * 1024;
    gemm_mainloop<true>(acc, smem, [&](int rr) { return A + (size_t)rr * 1024; }, [&](int rr) { return B + (size_t)rr * 1024; }, 0, 1024);
    if (nt == 9) {
      if (wn == 0) {
#pragma unroll
        for (int mi = 0; mi < 2; ++mi)
#pragma unroll
          for (int i = 0; i < 16; ++i) {
            const int ro = mi * 32 + (i & 3) + 8 * (i >> 2);
            p.KR[(size_t)(m0 + wm * 64 + 4 * h + ro) * 32 + r] = acc[mi][0][i] * rs[wm * 64 + 4 * h + ro];
          }
      }
    } else {
      stage_bf16_t<true>(smem, acc, rs, wm, wn, r, h);
      __syncthreads();
      u16* dbase; int dstride, cbase;
      if (nt < 3) { dbase = p.CQ; dstride = 384; cbase = n0; }
      else if (nt < 5) { dbase = p.CKV; dstride = 256; cbase = n0 - 384; }
      else { dbase = p.F; dstride = 512; cbase = n0 - 640; }
#pragma unroll
      for (int j = 0; j < 8; ++j) {
        const int id = tid + 256 * j, row = id >> 4, cc = id & 15;
        const u32x4 v = *(const u32x4*)(smem + row * SROW + cc * 16);
        *(u32x4*)(dbase + (size_t)(m0 + row) * dstride + cbase + cc * 8) = v;
        if (nt < 5) {
          float ss = sumsq8(v);
          ss += __shfl_xor(ss, 1); ss += __shfl_xor(ss, 2); ss += __shfl_xor(ss, 4); ss += __shfl_xor(ss, 8);
          if (cc == 0) p.SSP[(size_t)(m0 + row) * 10 + nt * 2] = ss;
        }
      }
    }
  }
}

DI void phase2(const Params& p, char* smem) {
    float* rs = (float*)(smem + 65536);
  const int G = gridDim.x;
  const int NUQ = 384 * 6, NUKV = 384 * 8, NCH = 384 * 8;
  for (int tile = vblock(); tile < NUQ + NUKV + NCH; tile += G) {
    WAVE_COORDS_L
    f32x16 acc[2][2]; zero_acc(acc);
    __syncthreads();
    if (tile < NUQ) {
      const int mt = tile / 6, nt = tile - mt * 6, m0 = mt * 128, n0 = nt * 128;
      if (tid < 128) {
        const float* s = p.SSP + (size_t)(m0 + tid) * 10;
        rs[tid] = rsqrtf((s[0] + s[2] + s[4]) * (1.f / 384.f) + EPS);
      }
      const u16* A = p.CQ + (size_t)m0 * 384; const u16* B = p.WuqT + (size_t)n0 * 384;
      gemm_mainloop(acc, smem, [&](int rr) { return A + (size_t)rr * 384; }, [&](int rr) { return B + (size_t)rr * 384; }, 0, 384);
      stage_bf16_t<true>(smem, acc, rs, wm, wn, r, h);
      __syncthreads();
#pragma unroll
      for (int j = 0; j < 8; ++j) {
        const int id = tid + 256 * j, row = id >> 4, cc = id & 15;
        *(u32x4*)(p.Q1 + (size_t)(m0 + row) * 768 + n0 + cc * 8) = *(const u32x4*)(smem + row * SROW + cc * 16);
      }
    } else if (tile < NUQ + NUKV) {
      const int tl = tile - NUQ;
      const int mt = tl >> 3, hh = tl & 7, m0 = mt * 128;
      int q, S, tb; tok2seq(m0, q, S, tb);
      if (tid < 128) {
        const float* s = p.SSP + (size_t)(m0 + tid) * 10;
        rs[tid] = rsqrtf((s[6] + s[8]) * (1.f / 256.f) + EPS);
      }
      const u16* A = p.CKV + (size_t)m0 * 256; const u16* B = p.WukvT + (size_t)hh * 128 * 256;
      gemm_mainloop(acc, smem, [&](int rr) { return A + (size_t)rr * 256; }, [&](int rr) { return B + (size_t)rr * 256; }, 0, 256);
      if (wn == 0) {
#pragma unroll
        for (int mi = 0; mi < 2; ++mi)
#pragma unroll
          for (int i = 0; i < 16; ++i) {
            const int ro = mi * 32 + (i & 3) + 8 * (i >> 2);
            const float sc = (rs + wm * 64 + 4 * h)[ro];
#pragma unroll
            for (int ni = 0; ni < 2; ++ni) *(u16*)(smem + (wm * 64 + 4 * h) * SROW + r * 2 + ro * SROW + ni * 64) = f2bf(acc[mi][ni][i] * sc);
          }
      } else {
        const int s0 = m0 - tb;
#pragma unroll
        for (int mi = 0; mi < 2; ++mi)
#pragma unroll
          for (int g4 = 0; g4 < 4; ++g4) {
            const int row = wm * 64 + mi * 32 + 8 * g4 + 4 * h;
            const f32x4 sc = *(const f32x4*)(rs + row);
#pragma unroll
            for (int ni = 0; ni < 2; ++ni) {
              const int dv = ni * 32 + r;
              u32x2 o = {cvtpk(acc[mi][ni][4 * g4] * sc[0], acc[mi][ni][4 * g4 + 1] * sc[1]),
                         cvtpk(acc[mi][ni][4 * g4 + 2] * sc[2], acc[mi][ni][4 * g4 + 3] * sc[3])};
              *(u32x2*)(p.Vt + (size_t)tb * 512 + (size_t)(hh * 64 + dv) * S + s0 + row) = o;
            }
            __builtin_amdgcn_sched_barrier(0);
          }
      }
      __syncthreads();
#pragma unroll
      for (int j = 0; j < 4; ++j) {
        const int id = tid + 256 * j, row = id >> 3, cc = id & 7;
        *(u32x4*)(p.K1 + (size_t)(m0 + row) * 512 + hh * 64 + cc * 8) = *(const u32x4*)(smem + row * SROW + cc * 16);
      }
    } else {
      const int tl = tile - NUQ - NUKV;
      const int pp = tl & 1, g = (tl >> 1) & 3, mt = tl >> 3, m0 = mt * 128;
      int q, S, tb; tok2seq(m0, q, S, tb);
      const int S1 = (q < 2) ? 64 : 32, l1 = (q < 2) ? 6 : 5;
      const int j0 = ((m0 - tb) >> 7) * (128 >> l1);
      const u16* Fb = p.F + (size_t)g * 128;
      const u16* B = p.Wc + (size_t)pp * 128 * 128;
      gemm_mainloop(acc, smem,
                    [&](int rr) { const int s1 = rr & (S1 - 1), s2 = j0 + (rr >> l1); return Fb + (size_t)(tb + s1 * 128 + s2) * 512; },
                    [&](int rr) { return B + (size_t)rr * 128; }, 0, 128);
      u16* Zb = p.Z1 + (size_t)tb * 1024;
#pragma unroll
      for (int mi = 0; mi < 2; ++mi)
#pragma unroll
        for (int g4 = 0; g4 < 4; ++g4) {
          const int rho = wm * 64 + mi * 32 + 8 * g4 + 4 * h;
          const int s1 = rho & (S1 - 1), s2 = j0 + (rho >> l1);
#pragma unroll
          for (int ni = 0; ni < 2; ++ni) {
            const int m = wn * 64 + ni * 32 + r;
            u32x2 o = {cvtpk(acc[mi][ni][4 * g4], acc[mi][ni][4 * g4 + 1]), cvtpk(acc[mi][ni][4 * g4 + 2], acc[mi][ni][4 * g4 + 3])};
            *(u32x2*)(Zb + ((size_t)((g * 128 + m) * 128 + s2) * (2 * S1)) + pp * S1 + s1) = o;
          }
          __builtin_amdgcn_sched_barrier(0);
        }
    }
  }
}

DI void phase3(const Params& p, char* smem) {
    const int G = gridDim.x;
  for (int tile = vblock(); tile < 5120; tile += G) {
    WAVE_COORDS_L
    const int q = tile >> 9, gm = tile & 511;
    const int tb = (q < 2) ? (q << 13) : (TP + ((q - 2) << 12));
    const int S = (q < 2) ? 8192 : 4096, S1 = (q < 2) ? 64 : 32, K = 2 * S1;
    f32x16 acc[2][2]; zero_acc(acc);
    const u16* A = p.Z1 + (size_t)tb * 1024 + (size_t)gm * 128 * K;
    const u16* B = (q < 2) ? p.WA64 : p.WA32;
    gemm_mainloop(acc, smem, [&](int rr) { return A + (size_t)rr * K; }, [&](int rr) { return B + (size_t)rr * K; }, 0, K);
    if (wn * 32 < S1) {
      const int k1 = wn * 32 + r;
      const float invS = 1.f / (float)S;
      u16* Gb = p.G1 + (size_t)tb * 1024 + (size_t)(gm * S1 + k1) * 256;
#pragma unroll
      for (int mi = 0; mi < 2; ++mi)
#pragma unroll
        for (int g4 = 0; g4 < 4; ++g4) {
          const int s2b = wm * 64 + mi * 32 + 8 * g4 + 4 * h;
          float ore[4], oim[4];
#pragma unroll
          for (int j = 0; j < 4; ++j) {
            const int s2 = s2b + j;
            const float fr = (float)((s2 * k1) & (S - 1)) * invS;
            const float c = __builtin_amdgcn_cosf(fr), s = __builtin_amdgcn_sinf(fr);
            const float re = acc[mi][0][4 * g4 + j], im = acc[mi][1][4 * g4 + j];
            ore[j] = re * c + im * s; oim[j] = im * c - re * s;
          }
          u32x2 o0 = {cvtpk(ore[0], ore[1]), cvtpk(ore[2], ore[3])};
          u32x2 o1 = {cvtpk(oim[0], oim[1]), cvtpk(oim[2], oim[3])};
          *(u32x2*)(Gb + s2b) = o0;
          *(u32x2*)(Gb + 128 + s2b) = o1;
        }
    }
  }
  const float QSCALE = 0.10206207261596575f * 1.4426950408889634f;
  for (int chunk = vblock(); chunk < T_TOK * 8 / NTHR; chunk += G) {
    WAVE_COORDS_L
    const int id = chunk * NTHR + tid;
    const int t = id >> 3, hh = id & 7;
    int q, S, tb; tok2seq(t, q, S, tb);
    const int s = t - tb;
    const size_t obase = ((size_t)tb * 8 + (size_t)hh * S + s) * 96;
    const float* rcp = p.ropec + s * 16; const float* rsp = p.ropes + s * 16;
    {
      u32x4 w[12];
      const u16* src = p.Q1 + (size_t)t * 768 + hh * 96;
#pragma unroll
      for (int i = 0; i < 12; ++i) w[i] = *(const u32x4*)(src + i * 8);
      float ss = 0.f;
#pragma unroll
      for (int i = 0; i < 12; ++i)
#pragma unroll
        for (int j = 0; j < 4; ++j) { const float a = bflo(w[i][j]), b = bfhi(w[i][j]); ss += a * a + b * b; }
      const float rinv = rsqrtf(ss * (1.f / 96.f) + EPS);
      u16* dst = p.Qn + obase;
#pragma unroll
      for (int i = 0; i < 8; ++i) {
        u32x4 o;
#pragma unroll
        for (int j = 0; j < 4; ++j) {
          const int d = i * 8 + j * 2;
          o[j] = cvtpk(bflo(w[i][j]) * rinv * p.q_head_g[d] * QSCALE, bfhi(w[i][j]) * rinv * p.q_head_g[d + 1] * QSCALE);
        }
        *(u32x4*)(dst + i * 8) = o;
      }
      float x1[16], x2[16];
#pragma unroll
      for (int i = 0; i < 2; ++i)
#pragma unroll
        for (int j = 0; j < 4; ++j) {
          const int e = i * 8 + j * 2;
          x1[e] = bflo(w[8 + i][j]) * rinv * p.q_head_g[64 + e]; x1[e + 1] = bfhi(w[8 + i][j]) * rinv * p.q_head_g[64 + e + 1];
          x2[e] = bflo(w[10 + i][j]) * rinv * p.q_head_g[80 + e]; x2[e + 1] = bfhi(w[10 + i][j]) * rinv * p.q_head_g[80 + e + 1];
        }
      float o1[16], o2[16];
#pragma unroll
      for (int e = 0; e < 16; ++e) {
        const float c = rcp[e], sn = rsp[e];
        o1[e] = (x1[e] * c - x2[e] * sn) * QSCALE; o2[e] = (x2[e] * c + x1[e] * sn) * QSCALE;
      }
#pragma unroll
      for (int i = 0; i < 2; ++i) {
        u32x4 a, b;
#pragma unroll
        for (int j = 0; j < 4; ++j) { a[j] = cvtpk(o1[i * 8 + j * 2], o1[i * 8 + j * 2 + 1]); b[j] = cvtpk(o2[i * 8 + j * 2], o2[i * 8 + j * 2 + 1]); }
        *(u32x4*)(dst + 64 + i * 8) = a;
        *(u32x4*)(dst + 80 + i * 8) = b;
      }
    }
    __builtin_amdgcn_sched_barrier(0);
    {
      u32x4 w[8];
      const u16* src = p.K1 + (size_t)t * 512 + hh * 64;
#pragma unroll
      for (int i = 0; i < 8; ++i) w[i] = *(const u32x4*)(src + i * 8);
      f32x4 kr[8];
#pragma unroll
      for (int i = 0; i < 8; ++i) kr[i] = *(const f32x4*)(p.KR + (size_t)t * 32 + i * 4);
      float ss = 0.f;
#pragma unroll
      for (int i = 0; i < 8; ++i)
#pragma unroll
        for (int j = 0; j < 4; ++j) { const float a = bflo(w[i][j]), b = bfhi(w[i][j]); ss += a * a + b * b + kr[i][j] * kr[i][j]; }
      const float rinv = rsqrtf(ss * (1.f / 96.f) + EPS);
      u16* dst = p.Kn + obase;
#pragma unroll
      for (int i = 0; i < 8; ++i) {
        u32x4 o;
#pragma unroll
        for (int j = 0; j < 4; ++j) {
          const int d = i * 8 + j * 2;
          o[j] = cvtpk(bflo(w[i][j]) * rinv * p.k_head_g[d], bfhi(w[i][j]) * rinv * p.k_head_g[d + 1]);
        }
        *(u32x4*)(dst + i * 8) = o;
      }
      float o1[16], o2[16];
#pragma unroll
      for (int e = 0; e < 16; ++e) {
        const float a = kr[e >> 2][e & 3] * rinv * p.k_head_g[64 + e];
        const float b = kr[4 + (e >> 2)][e & 3] * rinv * p.k_head_g[80 + e];
        const float c = rcp[e], sn = rsp[e];
        o1[e] = a * c - b * sn; o2[e] = b * c + a * sn;
      }
#pragma unroll
      for (int i = 0; i < 2; ++i) {
        u32x4 a, b;
#pragma unroll
        for (int j = 0; j < 4; ++j) { a[j] = cvtpk(o1[i * 8 + j * 2], o1[i * 8 + j * 2 + 1]); b[j] = cvtpk(o2[i * 8 + j * 2], o2[i * 8 + j * 2 + 1]); }
        *(u32x4*)(dst + 64 + i * 8) = a;
        *(u32x4*)(dst + 80 + i * 8) = b;
      }
    }
  }
}

constexpr int KSTR = 208, VSTR = 136, ABUF = 64 * KSTR + 64 * VSTR;

DI void attn_tile(const Params& p, char* smem, int a) {
  WAVE_COORDS
  int q, hh, qt, S, tb;
  if (a < 1024) { q = a >> 9; hh = (a >> 6) & 7; qt = a & 63; S = 8192; tb = q << 13; }
  else { const int b = a - 1024; q = 2 + (b >> 8); hh = (b >> 5) & 7; qt = b & 31; S = 4096; tb = TP + ((q - 2) << 12); }
  const size_t qkb = ((size_t)tb * 8 + (size_t)hh * S) * 96;
  const u16* Qb = p.Qn + qkb; const u16* Kb = p.Kn + qkb;
  const u16* Vb = p.Vt + (size_t)tb * 512 + (size_t)hh * 64 * S;
  const int qrow = qt * 128 + wave * 32 + r;
  bf16x8 qf[6];
#pragma unroll
  for (int ks = 0; ks < 6; ++ks) qf[ks] = *(const bf16x8*)(Qb + (size_t)qrow * 96 + ks * 16 + h * 8);
  f32x16 o[2];
#pragma unroll
  for (int i = 0; i < 16; ++i) { o[0][i] = 0.f; o[1][i] = 0.f; }
  float mrun = -1e30f, lrun = 0.f;
  int krow_[3], kc_[3], vrow_[2], vc_[2];
#pragma unroll
  for (int i = 0; i < 3; ++i) { const int id = tid + 256 * i; krow_[i] = id / 12; kc_[i] = id - krow_[i] * 12; }
#pragma unroll
  for (int i = 0; i < 2; ++i) { const int id = tid + 256 * i; vrow_[i] = id >> 3; vc_[i] = id & 7; }
  u32x4 rk[3], rv[2];
  const int nkt = S >> 6;
#pragma unroll
  for (int i = 0; i < 3; ++i) rk[i] = *(const u32x4*)(Kb + (size_t)krow_[i] * 96 + kc_[i] * 8);
#pragma unroll
  for (int i = 0; i < 2; ++i) rv[i] = *(const u32x4*)(Vb + (size_t)vrow_[i] * S + vc_[i] * 8);
  __syncthreads();
#pragma unroll
  for (int i = 0; i < 3; ++i) *(u32x4*)(smem + krow_[i] * KSTR + kc_[i] * 16) = rk[i];
#pragma unroll
  for (int i = 0; i < 2; ++i) {
    char* d = smem + 64 * KSTR + vrow_[i] * VSTR + vc_[i] * 16;
    *(u32x2*)d = u32x2{rv[i][0], rv[i][1]}; *(u32x2*)(d + 8) = u32x2{rv[i][2], rv[i][3]};
  }
  __syncthreads();
  int cur = 0;
  for (int kt = 0; kt < nkt; ++kt) {
    const bool nxt = (kt + 1 < nkt);
    if (nxt) {
#pragma unroll
      for (int i = 0; i < 3; ++i) rk[i] = *(const u32x4*)(Kb + (size_t)((kt + 1) * 64 + krow_[i]) * 96 + kc_[i] * 8);
#pragma unroll
      for (int i = 0; i < 2; ++i) rv[i] = *(const u32x4*)(Vb + (size_t)vrow_[i] * S + (kt + 1) * 64 + vc_[i] * 8);
    }
    __builtin_amdgcn_sched_barrier(0);
    const char* Ks = smem + cur * ABUF;
    const char* Vs = Ks + 64 * KSTR;
    f32x16 sacc[2];
#pragma unroll
    for (int i = 0; i < 16; ++i) { sacc[0][i] = 0.f; sacc[1][i] = 0.f; }
#pragma unroll
    for (int t2 = 0; t2 < 2; ++t2)
#pragma unroll
      for (int ks = 0; ks < 6; ++ks) {
        const bf16x8 kf = *(const bf16x8*)(Ks + (t2 * 32 + r) * KSTR + ks * 32 + h * 16);
        sacc[t2] = MFMA(kf, qf[ks], sacc[t2]);
      }
    float mx = sacc[0][0];
#pragma unroll
    for (int i = 0; i < 16; ++i) { mx = fmaxf(mx, sacc[0][i]); mx = fmaxf(mx, sacc[1][i]); }
    mx = fmaxf(mx, __shfl_xor(mx, 32));
    const float mnew = fmaxf(mrun, mx);
    const float alpha = __builtin_amdgcn_exp2f(mrun - mnew);
    mrun = mnew;
    lrun *= alpha;
#pragma unroll
    for (int i = 0; i < 16; ++i) { o[0][i] *= alpha; o[1][i] *= alpha; }
    float ps = 0.f;
#pragma unroll
    for (int t2 = 0; t2 < 2; ++t2)
#pragma unroll
      for (int i = 0; i < 16; ++i) { const float e = __builtin_amdgcn_exp2f(sacc[t2][i] - mnew); sacc[t2][i] = e; ps += e; }
    lrun += ps;
    bf16x8 pf[4];
#pragma unroll
    for (int kk = 0; kk < 4; ++kk) {
      const int t2 = kk >> 1, s8 = (kk & 1) * 8;
      u32x4 pk = {cvtpk(sacc[t2][s8], sacc[t2][s8 + 1]), cvtpk(sacc[t2][s8 + 2], sacc[t2][s8 + 3]),
                  cvtpk(sacc[t2][s8 + 4], sacc[t2][s8 + 5]), cvtpk(sacc[t2][s8 + 6], sacc[t2][s8 + 7])};
      pf[kk] = __builtin_bit_cast(bf16x8, pk);
    }
#pragma unroll
    for (int dt = 0; dt < 2; ++dt)
#pragma unroll
      for (int kk = 0; kk < 4; ++kk) {
        const char* vp = Vs + (dt * 32 + r) * VSTR + kk * 32 + h * 8;
        const u32x2 lo = *(const u32x2*)vp, hi = *(const u32x2*)(vp + 16);
        u32x4 vv = {lo[0], lo[1], hi[0], hi[1]};
        o[dt] = MFMA(__builtin_bit_cast(bf16x8, vv), pf[kk], o[dt]);
      }
    __builtin_amdgcn_sched_barrier(0);
    if (nxt) {
      char* Kn_ = smem + (cur ^ 1) * ABUF;
#pragma unroll
      for (int i = 0; i < 3; ++i) *(u32x4*)(Kn_ + krow_[i] * KSTR + kc_[i] * 16) = rk[i];
#pragma unroll
      for (int i = 0; i < 2; ++i) {
        char* d = Kn_ + 64 * KSTR + vrow_[i] * VSTR + vc_[i] * 16;
        *(u32x2*)d = u32x2{rv[i][0], rv[i][1]}; *(u32x2*)(d + 8) = u32x2{rv[i][2], rv[i][3]};
      }
    }
    __syncthreads();
    cur ^= 1;
  }
  lrun += __shfl_xor(lrun, 32);
  const float inv = 1.f / lrun;
  float ss = 0.f;
  u16* dst = p.MIX + (size_t)(tb + qrow) * 1024 + hh * 64;
#pragma unroll
  for (int dt = 0; dt < 2; ++dt)
#pragma unroll
    for (int g4 = 0; g4 < 4; ++g4) {
      float v[4];
#pragma unroll
      for (int j = 0; j < 4; ++j) { v[j] = o[dt][4 * g4 + j] * inv; ss += v[j] * v[j]; }
      u32x2 ov = {cvtpk(v[0], v[1]), cvtpk(v[2], v[3])};
      *(u32x2*)(dst + dt * 32 + 8 * g4 + 4 * h) = ov;
    }
  ss += __shfl_xor(ss, 32);
  if (h == 0) p.SSA[(size_t)(tb + qrow) * 8 + hh] = ss;
}

constexpr int VSTR2 = 144, ABUF2 = 64 * KSTR + 64 * VSTR2;
DI float swapmax32(float v) {
  auto rr = __builtin_amdgcn_permlane32_swap(__float_as_uint(v), __float_as_uint(v), false, false);
  return fmaxf(__uint_as_float(rr[0]), __uint_as_float(rr[1]));
}
DI float swapsum32(float v) {
  auto rr = __builtin_amdgcn_permlane32_swap(__float_as_uint(v), __float_as_uint(v), false, false);
  return __uint_as_float(rr[0]) + __uint_as_float(rr[1]);
}
template <bool RUNMAX>
DI void attn_tile2(const Params& p, char* smem, int a) {
  WAVE_COORDS_L
  int q, hh, qt, S, tb;
  if (a < 512) { q = a >> 8; hh = (a >> 5) & 7; qt = a & 31; S = 8192; tb = q << 13; }
  else { const int b = a - 512; q = 2 + (b >> 7); hh = (b >> 4) & 7; qt = b & 15; S = 4096; tb = TP + ((q - 2) << 12); }
  const size_t qkb = ((size_t)tb * 8 + (size_t)hh * S) * 96;
  const u16* Qb = p.Qn + qkb; const u16* Kb = p.Kn + qkb;
  const u16* Vb = p.Vt + (size_t)tb * 512 + (size_t)hh * 64 * S;
  const int qrow0 = qt * 256 + wave * 64 + r;
  bf16x8 qf[2][6];
#pragma unroll
  for (int g = 0; g < 2; ++g)
#pragma unroll
    for (int ks = 0; ks < 6; ++ks) qf[g][ks] = *(const bf16x8*)(Qb + (size_t)(qrow0 + 32 * g) * 96 + ks * 16 + h * 8);
  f32x16 o[2][2];
#pragma unroll
  for (int i = 0; i < 16; ++i) { o[0][0][i] = 0.f; o[0][1][i] = 0.f; o[1][0][i] = 0.f; o[1][1][i] = 0.f; }
  float mrun[2] = {-1e30f, -1e30f}, lrun[2] = {0.f, 0.f};
  int klds_[3], vlds_[2];
#pragma unroll
  for (int i = 0; i < 3; ++i) { const int id = tid + 256 * i; const int kr = id / 12; klds_[i] = kr * KSTR + (id - kr * 12) * 16; }
#pragma unroll
  for (int i = 0; i < 2; ++i) { const int vc = tid & 7; vlds_[i] = 64 * KSTR + ((tid >> 3) + 32 * i) * VSTR2 + (vc >> 1) * 32 + (vc & 1) * 8; }
  const u16* Kg = Kb + tid * 8;
  const u16* Vg = Vb + (size_t)(tid >> 3) * S + (tid & 7) * 8;
  u32x4 rk[3], rv[2];
  const int nkt = S >> 6;
#pragma unroll
  for (int i = 0; i < 3; ++i) rk[i] = *(const u32x4*)(Kg + i * 2048);
#pragma unroll
  for (int i = 0; i < 2; ++i) rv[i] = *(const u32x4*)(Vg + (size_t)(32 * i) * S);
  __syncthreads();
  auto put = [&](char* base) {
#pragma unroll
    for (int i = 0; i < 3; ++i) *(u32x4*)(base + klds_[i]) = rk[i];
#pragma unroll
    for (int i = 0; i < 2; ++i) {
      char* d = base + vlds_[i];
      *(u32x2*)d = u32x2{rv[i][0], rv[i][1]}; *(u32x2*)(d + 16) = u32x2{rv[i][2], rv[i][3]};
    }
  };
  put(smem);
  __syncthreads();
  int cur = 0;
#pragma unroll 1
  for (int kt = 0; kt < nkt; ++kt) {
    const bool nxt = (kt + 1 < nkt);
    if (nxt) {
#pragma unroll
      for (int i = 0; i < 3; ++i) rk[i] = *(const u32x4*)(Kg + (size_t)(kt + 1) * 6144 + i * 2048);
#pragma unroll
      for (int i = 0; i < 2; ++i) rv[i] = *(const u32x4*)(Vg + (size_t)(32 * i) * S + (kt + 1) * 64);
    }
    __builtin_amdgcn_sched_barrier(0);
    const char* Ks = smem + cur * ABUF2;
    const char* Vs = Ks + 64 * KSTR;
#pragma unroll
    for (int t2 = 0; t2 < 2; ++t2) {
      f32x16 sacc[2];
#pragma unroll
      for (int i = 0; i < 16; ++i) { sacc[0][i] = 0.f; sacc[1][i] = 0.f; }
#pragma unroll
      for (int kb = 0; kb < 2; ++kb) {
        bf16x8 kf[3];
#pragma unroll
        for (int ks = 0; ks < 3; ++ks) kf[ks] = *(const bf16x8*)(Ks + (t2 * 32 + r) * KSTR + (kb * 3 + ks) * 32 + h * 16);
#pragma unroll
        for (int ks = 0; ks < 3; ++ks) {
          sacc[0] = MFMA(kf[ks], qf[0][kb * 3 + ks], sacc[0]);
          sacc[1] = MFMA(kf[ks], qf[1][kb * 3 + ks], sacc[1]);
        }
      }
      __builtin_amdgcn_sched_barrier(0);
      bf16x8 pf[2][2];
#pragma unroll
      for (int g = 0; g < 2; ++g) {
        float ps = 0.f;
        if (RUNMAX) {
        float mx = sacc[g][0];
#pragma unroll
        for (int i = 1; i < 16; ++i) mx = fmaxf(mx, sacc[g][i]);
        mx = swapmax32(mx);
        const float mnew = fmaxf(mrun[g], mx);
        if (__ballot(mnew > mrun[g]) != 0ull) {
          const float alpha = __builtin_amdgcn_exp2f(mrun[g] - mnew);
          lrun[g] *= alpha;
#pragma unroll
          for (int i = 0; i < 16; ++i) { o[g][0][i] *= alpha; o[g][1][i] *= alpha; }
          mrun[g] = mnew;
        }
#pragma unroll
        for (int i = 0; i < 16; ++i) { const float e = __builtin_amdgcn_exp2f(sacc[g][i] - mrun[g]); sacc[g][i] = e; ps += e; }
        } else {
#pragma unroll
          for (int i = 0; i < 16; ++i) sacc[g][i] = __builtin_amdgcn_exp2f(sacc[g][i]);
        }
#pragma unroll
        for (int s = 0; s < 2; ++s) {
          const int s8 = s * 8;
          u32x4 pk = {cvtpk(sacc[g][s8], sacc[g][s8 + 1]), cvtpk(sacc[g][s8 + 2], sacc[g][s8 + 3]),
                      cvtpk(sacc[g][s8 + 4], sacc[g][s8 + 5]), cvtpk(sacc[g][s8 + 6], sacc[g][s8 + 7])};
          pf[g][s] = __builtin_bit_cast(bf16x8, pk);
          if (!RUNMAX) {
#pragma unroll
            for (int w = 0; w < 4; ++w) ps = fdot2(pk[w], 0x3F803F80u, ps);
          }
        }
        lrun[g] += ps;
      }
      __builtin_amdgcn_sched_barrier(0);
      {
        bf16x8 vf[2][2];
#pragma unroll
        for (int dt = 0; dt < 2; ++dt)
#pragma unroll
          for (int s = 0; s < 2; ++s) vf[dt][s] = *(const bf16x8*)(Vs + (dt * 32 + r) * VSTR2 + (t2 * 2 + s) * 32 + h * 16);
#pragma unroll
        for (int s = 0; s < 2; ++s)
#pragma unroll
          for (int dt = 0; dt < 2; ++dt) {
            o[0][dt] = MFMA(vf[dt][s], pf[0][s], o[0][dt]);
            o[1][dt] = MFMA(vf[dt][s], pf[1][s], o[1][dt]);
          }
      }
    }
    __builtin_amdgcn_sched_barrier(0);
    if (nxt) put(smem + (cur ^ 1) * ABUF2);
    __syncthreads();
    cur ^= 1;
  }
#pragma unroll
  for (int g = 0; g < 2; ++g) {
    const float lsum = swapsum32(lrun[g]);
    const float inv = 1.f / lsum;
    const int qrow = qrow0 + 32 * g;
    float ss = 0.f;
    u16* dst = p.MIX + (size_t)(tb + qrow) * 1024 + hh * 64;
#pragma unroll
    for (int dt = 0; dt < 2; ++dt)
#pragma unroll
      for (int g4 = 0; g4 < 4; ++g4) {
        float v[4];
#pragma unroll
        for (int jj = 0; jj < 4; ++jj) { v[jj] = o[g][dt][4 * g4 + jj] * inv; ss += v[jj] * v[jj]; }
        u32x2 ov = {cvtpk(v[0], v[1]), cvtpk(v[2], v[3])};
        *(u32x2*)(dst + dt * 32 + 8 * g4 + 4 * h) = ov;
      }
    ss = swapsum32(ss);
    if (h == 0) p.SSA[(size_t)(tb + qrow) * 8 + hh] = ss;
  }
}

DI void phase4(const Params& p, char* smem) {
    const int G = gridDim.x;
  if (p.misc[0] > 64.f) { for (int a = vblock(); a < 1536; a += G) attn_tile2<true>(p, smem, a); }
  else { for (int a = vblock(); a < 1536; a += G) attn_tile2<false>(p, smem, a); }
  for (int tile = vblock(); tile < 1536; tile += G) {
    WAVE_COORDS_L
    int q, g, k1, S1, tb;
    if (tile < 512) { q = tile >> 8; g = (tile >> 6) & 3; k1 = tile & 63; S1 = 64; tb = q << 13; }
    else { const int b = tile - 512; q = 2 + (b >> 7); g = (b >> 5) & 3; k1 = b & 31; S1 = 32; tb = TP + ((q - 2) << 12); }
    f32x16 acc[2][2]; zero_acc(acc);
    const u16* A = p.G1 + (size_t)tb * 1024 + ((size_t)(g * 128) * S1 + k1) * 256;
    const u16* B = p.WB;
    const int rstride = S1 * 256;
    gemm_mainloop(acc, smem, [&](int rr) { return A + (size_t)rr * rstride; }, [&](int rr) { return B + (size_t)rr * 256; }, 0, 256);
#pragma unroll
    for (int ni = 0; ni < 2; ++ni) {
      const int k2 = wn * 64 + ni * 32 + r;
      const size_t tok = (size_t)(tb + k1 + S1 * k2);
      float ss = 0.f;
#pragma unroll
      for (int mi = 0; mi < 2; ++mi)
#pragma unroll
        for (int g4 = 0; g4 < 4; ++g4) {
          const int m = wm * 64 + mi * 32 + 8 * g4 + 4 * h;
          float v[4];
#pragma unroll
          for (int j = 0; j < 4; ++j) { v[j] = acc[mi][ni][4 * g4 + j]; ss += v[j] * v[j]; }
          u32x2 ov = {cvtpk(v[0], v[1]), cvtpk(v[2], v[3])};
          *(u32x2*)(p.MIX + tok * 1024 + 512 + g * 128 + m) = ov;
        }
      ss += __shfl_xor(ss, 32);
      if (h == 0) p.SSF[tok * 8 + g * 2 + wm] = ss;
    }
  }
}

DI void phase5(const Params& p, char* smem) {
    float* rs = (float*)(smem + 65536);
  const int G = gridDim.x;
  for (int tile = vblock(); tile < 384 * 8; tile += G) {
    WAVE_COORDS_L
    const int mt = tile >> 3, nt = tile & 7, m0 = mt * 128, n0 = nt * 128;
    __syncthreads();
    if (tid < 128) {
      const float* sa = p.SSA + (size_t)(m0 + tid) * 8; const float* sf = p.SSF + (size_t)(m0 + tid) * 8;
      const float ra = rsqrtf((sa[0] + sa[1] + sa[2] + sa[3] + sa[4] + sa[5] + sa[6] + sa[7]) * (1.f / 512.f) + EPS);
      const float rf = rsqrtf((sf[0] + sf[1] + sf[2] + sf[3] + sf[4] + sf[5] + sf[6] + sf[7]) * (1.f / 512.f) + EPS);
      rs[tid] = ra / rf; rs[128 + tid] = rf;
    }
    f32x16 acc[2][2]; zero_acc(acc);
    const u16* A = p.MIX + (size_t)m0 * 1024; const u16* B = p.WoutT + (size_t)n0 * 1024;
    auto af = [&](int rr) { return A + (size_t)rr * 1024; };
    auto bfn = [&](int rr) { return B + (size_t)rr * 1024; };
    gemm_mainloop<true>(acc, smem, af, bfn, 0, 512);
    {
      const float* rb = rs + wm * 64 + 4 * h;
#pragma unroll
      for (int mi = 0; mi < 2; ++mi)
#pragma unroll
        for (int i = 0; i < 16; ++i) {
          const float sc = rb[mi * 32 + (i & 3) + 8 * (i >> 2)];
          acc[mi][0][i] *= sc; acc[mi][1][i] *= sc;
        }
    }
    gemm_mainloop<true>(acc, smem, af, bfn, 512, 1024);
    {
      const float* rb = rs + 128 + wm * 64 + 4 * h;
      char* sb = smem + (wm * 64 + 4 * h) * 512 + (wn * 64 + r) * 4;
#pragma unroll
      for (int mi = 0; mi < 2; ++mi)
#pragma unroll
        for (int i = 0; i < 16; ++i) {
          const int ro = mi * 32 + (i & 3) + 8 * (i >> 2);
          const float sc = rb[ro];
#pragma unroll
          for (int ni = 0; ni < 2; ++ni) *(float*)(sb + ro * 512 + ni * 128) = acc[mi][ni][i] * sc;
        }
    }
    __syncthreads();
#pragma unroll 4
    for (int j = 0; j < 16; ++j) {
      const int id = tid + 256 * j, row = id >> 5, cc = id & 31;
      const int t = m0 + row, col = n0 + cc * 4;
      f32x4 v = *(const f32x4*)(smem + row * 512 + cc * 16);
      const f32x4 xv = *(const f32x4*)(xrow(p, t) + col);
      v[0] += xv[0]; v[1] += xv[1]; v[2] += xv[2]; v[3] += xv[3];
      *(f32x4*)(p.out + (size_t)t * 1024 + col) = v;
      u32x2 ob = {cvtpk(v[0], v[1]), cvtpk(v[2], v[3])};
      *(u32x2*)(p.X2b + (size_t)t * 1024 + col) = ob;
      float ss = v[0] * v[0] + v[1] * v[1] + v[2] * v[2] + v[3] * v[3];
      ss = red32(ss);
      if (cc == 0) p.SS2[(size_t)t * 16 + nt] = ss;
    }
  }
  const int gt = blockIdx.x * NTHR + threadIdx.x, gs = gridDim.x * NTHR;
  for (int id = gt; id < 16384 * 1024 / 16; id += gs) {
    const int d = (id & 63) * 16;
    u32x4 ou, ov;
#pragma unroll
    for (int k = 0; k < 4; ++k) {
      const f32x4 a = *(const f32x4*)(p.peer_u + (size_t)id * 16 + k * 4);
      const f32x4 g = *(const f32x4*)(p.ffn_norm_g + d + k * 4);
      const f32x4 b = *(const f32x4*)(p.peer_v + (size_t)id * 16 + k * 4);
      float u0 = fminf(fmaxf(a[0] * g[0] * USCALE, -448.f), 448.f), u1 = fminf(fmaxf(a[1] * g[1] * USCALE, -448.f), 448.f);
      float u2 = fminf(fmaxf(a[2] * g[2] * USCALE, -448.f), 448.f), u3 = fminf(fmaxf(a[3] * g[3] * USCALE, -448.f), 448.f);
      float v0 = fminf(fmaxf(b[0] * VSCALE, -448.f), 448.f), v1 = fminf(fmaxf(b[1] * VSCALE, -448.f), 448.f);
      float v2 = fminf(fmaxf(b[2] * VSCALE, -448.f), 448.f), v3 = fminf(fmaxf(b[3] * VSCALE, -448.f), 448.f);
      int pu = __builtin_amdgcn_cvt_pk_fp8_f32(u0, u1, 0, false); pu = __builtin_amdgcn_cvt_pk_fp8_f32(u2, u3, pu, true);
      int pv = __builtin_amdgcn_cvt_pk_fp8_f32(v0, v1, 0, false); pv = __builtin_amdgcn_cvt_pk_fp8_f32(v2, v3, pv, true);
      ou[k] = (unsigned)pu; ov[k] = (unsigned)pv;
    }
    {
      const int e = id >> 6, ch = id & 63;
      const size_t o = ((size_t)(ch >> 3) * 16384 + e) * 128 + (ch & 7) * 16;
      *(u32x4*)(p.U8 + o) = ou;
      *(u32x4*)(p.V8 + o) = ov;
    }
  }
}

DI void phase6(const Params& p, char* smem) {
    const int G = gridDim.x;
  for (int tile = vblock(); tile < 384 * 16; tile += G) {
    WAVE_COORDS_L
    const int mt = tile >> 4, nt = tile & 15, m0 = mt * 128, n0 = nt * 128;
    f32x16 acc[2][2]; zero_acc(acc);
    __syncthreads();
    const u16* A = p.X2b + (size_t)m0 * 1024; const u16* B = p.WpqT + (size_t)n0 * 1024;
    gemm_mainloop<true>(acc, smem, [&](int rr) { return A + (size_t)rr * 1024; }, [&](int rr) { return B + (size_t)rr * 1024; }, 0, 1024);
    stage_bf16_t<false>(smem, acc, nullptr, wm, wn, r, h);
    __syncthreads();
#pragma unroll
    for (int j = 0; j < 8; ++j) {
      const int id = tid + 256 * j, row = id >> 4, cc = id & 15;
      *(u32x4*)(p.Qp + (size_t)(m0 + row) * 2048 + n0 + cc * 8) = *(const u32x4*)(smem + row * SROW + cc * 16);
    }
  }
}

DI void ins16(float (&top)[16], float x) {
#pragma unroll
  for (int j = 0; j < 16; ++j) { const float hi = fmaxf(top[j], x); x = fminf(top[j], x); top[j] = hi; }
}
DI float mask7(float x) { return __uint_as_float(__float_as_uint(x) & ~0x7Fu); }

#define CE16(a, b) { const float hi_ = fmaxf(a, b); b = fminf(a, b); a = hi_; }
DI void sort16_desc(float (&x)[16]) {
  CE16(x[0], x[1])
  CE16(x[3], x[2])
  CE16(x[4], x[5])
  CE16(x[7], x[6])
  CE16(x[8], x[9])
  CE16(x[11], x[10])
  CE16(x[12], x[13])
  CE16(x[15], x[14])
  CE16(x[0], x[2])
  CE16(x[1], x[3])
  CE16(x[6], x[4])
  CE16(x[7], x[5])
  CE16(x[8], x[10])
  CE16(x[9], x[11])
  CE16(x[14], x[12])
  CE16(x[15], x[13])
  CE16(x[0], x[1])
  CE16(x[2], x[3])
  CE16(x[5], x[4])
  CE16(x[7], x[6])
  CE16(x[8], x[9])
  CE16(x[10], x[11])
  CE16(x[13], x[12])
  CE16(x[15], x[14])
  CE16(x[0], x[4])
  CE16(x[1], x[5])
  CE16(x[2], x[6])
  CE16(x[3], x[7])
  CE16(x[12], x[8])
  CE16(x[13], x[9])
  CE16(x[14], x[10])
  CE16(x[15], x[11])
  CE16(x[0], x[2])
  CE16(x[1], x[3])
  CE16(x[4], x[6])
  CE16(x[5], x[7])
  CE16(x[10], x[8])
  CE16(x[11], x[9])
  CE16(x[14], x[12])
  CE16(x[15], x[13])
  CE16(x[0], x[1])
  CE16(x[2], x[3])
  CE16(x[4], x[5])
  CE16(x[6], x[7])
  CE16(x[9], x[8])
  CE16(x[11], x[10])
  CE16(x[13], x[12])
  CE16(x[15], x[14])
  CE16(x[0], x[8])
  CE16(x[1], x[9])
  CE16(x[2], x[10])
  CE16(x[3], x[11])
  CE16(x[4], x[12])
  CE16(x[5], x[13])
  CE16(x[6], x[14])
  CE16(x[7], x[15])
  CE16(x[0], x[4])
  CE16(x[1], x[5])
  CE16(x[2], x[6])
  CE16(x[3], x[7])
  CE16(x[8], x[12])
  CE16(x[9], x[13])
  CE16(x[10], x[14])
  CE16(x[11], x[15])
  CE16(x[0], x[2])
  CE16(x[1], x[3])
  CE16(x[4], x[6])
  CE16(x[5], x[7])
  CE16(x[8], x[10])
  CE16(x[9], x[11])
  CE16(x[12], x[14])
  CE16(x[13], x[15])
  CE16(x[0], x[1])
  CE16(x[2], x[3])
  CE16(x[4], x[5])
  CE16(x[6], x[7])
  CE16(x[8], x[9])
  CE16(x[10], x[11])
  CE16(x[12], x[13])
  CE16(x[14], x[15])
}
DI void bmerge16_desc(float (&x)[16]) {
  CE16(x[0], x[8])
  CE16(x[1], x[9])
  CE16(x[2], x[10])
  CE16(x[3], x[11])
  CE16(x[4], x[12])
  CE16(x[5], x[13])
  CE16(x[6], x[14])
  CE16(x[7], x[15])
  CE16(x[0], x[4])
  CE16(x[1], x[5])
  CE16(x[2], x[6])
  CE16(x[3], x[7])
  CE16(x[8], x[12])
  CE16(x[9], x[13])
  CE16(x[10], x[14])
  CE16(x[11], x[15])
  CE16(x[0], x[2])
  CE16(x[1], x[3])
  CE16(x[4], x[6])
  CE16(x[5], x[7])
  CE16(x[8], x[10])
  CE16(x[9], x[11])
  CE16(x[12], x[14])
  CE16(x[13], x[15])
  CE16(x[0], x[1])
  CE16(x[2], x[3])
  CE16(x[4], x[5])
  CE16(x[6], x[7])
  CE16(x[8], x[9])
  CE16(x[10], x[11])
  CE16(x[12], x[13])
  CE16(x[14], x[15])
}
DI void top16_merge(float (&A)[16], const float (&B)[16]) {
#pragma unroll
  for (int i = 0; i < 16; ++i) A[i] = fmaxf(A[i], B[15 - i]);
  bmerge16_desc(A);
}

DI void score_top16(const Params& p, const char* sklds, int t, int hh, int c, int r, int h, float (&top)[16]) {
  f32x16 acc[4];
#pragma unroll
  for (int n = 0; n < 4; ++n)
#pragma unroll
    for (int i = 0; i < 16; ++i) acc[n][i] = 0.f;
  const u16* qp = p.Qp + (size_t)t * 2048 + (hh * 2 + c) * 128 + h * 8;
  const char* skb = sklds + c * 32768 + r * 256;
  const int hx = h ^ (r & 15);
  bf16x8 bq[8];
#pragma unroll
  for (int ks = 0; ks < 8; ++ks) bq[ks] = *(const bf16x8*)(qp + ks * 16);
#pragma unroll
  for (int n = 0; n < 4; ++n) {
    bf16x8 fa[8];
#pragma unroll
    for (int ks = 0; ks < 8; ++ks) fa[ks] = *(const bf16x8*)(skb + n * 8192 + (((ks * 2) ^ hx) << 4));
    __builtin_amdgcn_sched_barrier(0);
#pragma unroll
    for (int ks = 0; ks < 8; ++ks) acc[n] = MFMA(fa[ks], bq[ks], acc[n]);
    __builtin_amdgcn_sched_barrier(0);
  }
  float k1[16], k2[16], k3[16];
#pragma unroll
  for (int i = 0; i < 16; ++i) {
    const unsigned ci = (unsigned)crow(i, h);
    top[i] = __uint_as_float((__float_as_uint(acc[0][i]) & ~0x7Fu) | ci);
    k1[i] = __uint_as_float((__float_as_uint(acc[1][i]) & ~0x7Fu) | (32u + ci));
    k2[i] = __uint_as_float((__float_as_uint(acc[2][i]) & ~0x7Fu) | (64u + ci));
    k3[i] = __uint_as_float((__float_as_uint(acc[3][i]) & ~0x7Fu) | (96u + ci));
  }
  sort16_desc(top); sort16_desc(k1); sort16_desc(k2); sort16_desc(k3);
  top16_merge(top, k1); top16_merge(k2, k3); top16_merge(top, k2);
  float oth[16];
#pragma unroll
  for (int j = 0; j < 16; ++j) oth[j] = __shfl_xor(top[j], 32);
  top16_merge(top, oth);
}

DI void phase7(const Params& p, char* smem) {
  WAVE_COORDS
  const int G = gridDim.x;
  volatile unsigned* lw = (volatile unsigned*)(smem + 65536 + 2048 + wave * 1024);
  volatile unsigned char* lb = (volatile unsigned char*)(smem + 65536 + 2048 + wave * 1024);
  const float NEG_INF = __uint_as_float(0xFF800000u);
  const int hh = blockIdx.x & 7, slot = blockIdx.x >> 3, nslot = G >> 3;
  __syncthreads();
  {
    const u16* src = p.SK + (size_t)hh * 2 * 16384;
#pragma unroll 2
    for (int i = 0; i < 16; ++i) {
      const int id = tid + 256 * i;
      const int row = id >> 4, ch = id & 15;
      const u32x4 v = *(const u32x4*)(src + (size_t)row * 128 + ch * 8);
      *(u32x4*)(smem + row * 256 + ((ch ^ (row & 15)) << 4)) = v;
    }
  }
  __syncthreads();
  for (int grp = slot * 4 + wave; grp < 1536; grp += nslot * 4) {
    const int tok0 = grp * 32;
    const int t = tok0 + r;
    float L0[16], L1[16];
    score_top16(p, smem, t, hh, 0, r, h, L0);
    score_top16(p, smem, t, hh, 1, r, h, L1);
    float ct[16], cb[16];
    {
      float ck[50];
    ck[0] = __uint_as_float((__float_as_uint(mask7(L0[0]) + mask7(L1[0])) & ~0xFFu) | 0u);
    ck[1] = __uint_as_float((__float_as_uint(mask7(L0[0]) + mask7(L1[1])) & ~0xFFu) | 1u);
    ck[2] = __uint_as_float((__float_as_uint(mask7(L0[0]) + mask7(L1[2])) & ~0xFFu) | 2u);
    ck[3] = __uint_as_float((__float_as_uint(mask7(L0[0]) + mask7(L1[3])) & ~0xFFu) | 3u);
    ck[4] = __uint_as_float((__float_as_uint(mask7(L0[0]) + mask7(L1[4])) & ~0xFFu) | 4u);
    ck[5] = __uint_as_float((__float_as_uint(mask7(L0[0]) + mask7(L1[5])) & ~0xFFu) | 5u);
    ck[6] = __uint_as_float((__float_as_uint(mask7(L0[0]) + mask7(L1[6])) & ~0xFFu) | 6u);
    ck[7] = __uint_as_float((__float_as_uint(mask7(L0[0]) + mask7(L1[7])) & ~0xFFu) | 7u);
    ck[8] = __uint_as_float((__float_as_uint(mask7(L0[0]) + mask7(L1[8])) & ~0xFFu) | 8u);
    ck[9] = __uint_as_float((__float_as_uint(mask7(L0[0]) + mask7(L1[9])) & ~0xFFu) | 9u);
    ck[10] = __uint_as_float((__float_as_uint(mask7(L0[0]) + mask7(L1[10])) & ~0xFFu) | 10u);
    ck[11] = __uint_as_float((__float_as_uint(mask7(L0[0]) + mask7(L1[11])) & ~0xFFu) | 11u);
    ck[12] = __uint_as_float((__float_as_uint(mask7(L0[0]) + mask7(L1[12])) & ~0xFFu) | 12u);
    ck[13] = __uint_as_float((__float_as_uint(mask7(L0[0]) + mask7(L1[13])) & ~0xFFu) | 13u);
    ck[14] = __uint_as_float((__float_as_uint(mask7(L0[0]) + mask7(L1[14])) & ~0xFFu) | 14u);
    ck[15] = __uint_as_float((__float_as_uint(mask7(L0[0]) + mask7(L1[15])) & ~0xFFu) | 15u);
    ck[16] = __uint_as_float((__float_as_uint(mask7(L0[1]) + mask7(L1[0])) & ~0xFFu) | 16u);
    ck[17] = __uint_as_float((__float_as_uint(mask7(L0[1]) + mask7(L1[1])) & ~0xFFu) | 17u);
    ck[18] = __uint_as_float((__float_as_uint(mask7(L0[1]) + mask7(L1[2])) & ~0xFFu) | 18u);
    ck[19] = __uint_as_float((__float_as_uint(mask7(L0[1]) + mask7(L1[3])) & ~0xFFu) | 19u);
    ck[20] = __uint_as_float((__float_as_uint(mask7(L0[1]) + mask7(L1[4])) & ~0xFFu) | 20u);
    ck[21] = __uint_as_float((__float_as_uint(mask7(L0[1]) + mask7(L1[5])) & ~0xFFu) | 21u);
    ck[22] = __uint_as_float((__float_as_uint(mask7(L0[1]) + mask7(L1[6])) & ~0xFFu) | 22u);
    ck[23] = __uint_as_float((__float_as_uint(mask7(L0[1]) + mask7(L1[7])) & ~0xFFu) | 23u);
    ck[24] = __uint_as_float((__float_as_uint(mask7(L0[2]) + mask7(L1[0])) & ~0xFFu) | 32u);
    ck[25] = __uint_as_float((__float_as_uint(mask7(L0[2]) + mask7(L1[1])) & ~0xFFu) | 33u);
    ck[26] = __uint_as_float((__float_as_uint(mask7(L0[2]) + mask7(L1[2])) & ~0xFFu) | 34u);
    ck[27] = __uint_as_float((__float_as_uint(mask7(L0[2]) + mask7(L1[3])) & ~0xFFu) | 35u);
    ck[28] = __uint_as_float((__float_as_uint(mask7(L0[2]) + mask7(L1[4])) & ~0xFFu) | 36u);
    ck[29] = __uint_as_float((__float_as_uint(mask7(L0[3]) + mask7(L1[0])) & ~0xFFu) | 48u);
    ck[30] = __uint_as_float((__float_as_uint(mask7(L0[3]) + mask7(L1[1])) & ~0xFFu) | 49u);
    ck[31] = __uint_as_float((__float_as_uint(mask7(L0[3]) + mask7(L1[2])) & ~0xFFu) | 50u);
    ck[32] = __uint_as_float((__float_as_uint(mask7(L0[3]) + mask7(L1[3])) & ~0xFFu) | 51u);
    ck[33] = __uint_as_float((__float_as_uint(mask7(L0[4]) + mask7(L1[0])) & ~0xFFu) | 64u);
    ck[34] = __uint_as_float((__float_as_uint(mask7(L0[4]) + mask7(L1[1])) & ~0xFFu) | 65u);
    ck[35] = __uint_as_float((__float_as_uint(mask7(L0[4]) + mask7(L1[2])) & ~0xFFu) | 66u);
    ck[36] = __uint_as_float((__float_as_uint(mask7(L0[5]) + mask7(L1[0])) & ~0xFFu) | 80u);
    ck[37] = __uint_as_float((__float_as_uint(mask7(L0[5]) + mask7(L1[1])) & ~0xFFu) | 81u);
    ck[38] = __uint_as_float((__float_as_uint(mask7(L0[6]) + mask7(L1[0])) & ~0xFFu) | 96u);
    ck[39] = __uint_as_float((__float_as_uint(mask7(L0[6]) + mask7(L1[1])) & ~0xFFu) | 97u);
    ck[40] = __uint_as_float((__float_as_uint(mask7(L0[7]) + mask7(L1[0])) & ~0xFFu) | 112u);
    ck[41] = __uint_as_float((__float_as_uint(mask7(L0[7]) + mask7(L1[1])) & ~0xFFu) | 113u);
    ck[42] = __uint_as_float((__float_as_uint(mask7(L0[8]) + mask7(L1[0])) & ~0xFFu) | 128u);
    ck[43] = __uint_as_float((__float_as_uint(mask7(L0[9]) + mask7(L1[0])) & ~0xFFu) | 144u);
    ck[44] = __uint_as_float((__float_as_uint(mask7(L0[10]) + mask7(L1[0])) & ~0xFFu) | 160u);
    ck[45] = __uint_as_float((__float_as_uint(mask7(L0[11]) + mask7(L1[0])) & ~0xFFu) | 176u);
    ck[46] = __uint_as_float((__float_as_uint(mask7(L0[12]) + mask7(L1[0])) & ~0xFFu) | 192u);
    ck[47] = __uint_as_float((__float_as_uint(mask7(L0[13]) + mask7(L1[0])) & ~0xFFu) | 208u);
    ck[48] = __uint_as_float((__float_as_uint(mask7(L0[14]) + mask7(L1[0])) & ~0xFFu) | 224u);
    ck[49] = __uint_as_float((__float_as_uint(mask7(L0[15]) + mask7(L1[0])) & ~0xFFu) | 240u);
      const float NINF = __uint_as_float(0xFF800000u);
#pragma unroll
      for (int q = 0; q < 25; ++q) {
        float a_ = ck[q], b_ = ck[25 + q];
        asm volatile("" : "+v"(a_), "+v"(b_));
        const float m = h ? b_ : a_;
        if (q < 16) ct[q] = m; else cb[q - 16] = m;
      }
#pragma unroll
      for (int q = 9; q < 16; ++q) cb[q] = NINF;
      sort16_desc(ct); sort16_desc(cb);
      top16_merge(ct, cb);
#pragma unroll
      for (int q = 0; q < 16; ++q) cb[q] = __shfl_xor(ct[q], 32);
      top16_merge(ct, cb);
    }
    if (h == 0) {
#pragma unroll
      for (int w = 0; w < 4; ++w) {
        unsigned v = 0, v2 = 0;
#pragma unroll
        for (int b = 0; b < 4; ++b) {
          v |= (__float_as_uint(L0[w * 4 + b]) & 0x7Fu) << (8 * b);
          v2 |= (__float_as_uint(L1[w * 4 + b]) & 0x7Fu) << (8 * b);
        }
        lw[r * 8 + w] = v;
        lw[r * 8 + 4 + w] = v2;
      }
    }
    __builtin_amdgcn_wave_barrier();
    const float* s2 = p.SS2 + (size_t)t * 16;
    float ssum = 0.f;
#pragma unroll
    for (int j = 0; j < 8; ++j) ssum += s2[j];
    const float r2 = rsqrtf(ssum * (1.f / 1024.f) + EPS);
    float gv[16];
    const float v0 = __uint_as_float(__float_as_uint(ct[0]) & ~0xFFu) * r2;
    float esum = 0.f;
#pragma unroll
    for (int j = 0; j < 16; ++j) {
      const float vj = __uint_as_float(__float_as_uint(ct[j]) & ~0xFFu) * r2;
      gv[j] = __builtin_amdgcn_exp2f((vj - v0) * 1.4426950408889634f);
      esum += gv[j];
    }
    const float einv = 1.f / esum;
    u32x4 oi[2]; f32x4 og[2];
#pragma unroll
    for (int jj = 0; jj < 8; ++jj) {
      float ka = ct[jj], kb = ct[8 + jj], ga = gv[jj], gb = gv[8 + jj];
      asm volatile("" : "+v"(ka), "+v"(kb), "+v"(ga), "+v"(gb));
      const float key = h ? kb : ka;
      const float g = (h ? gb : ga) * einv;
      const unsigned code = __float_as_uint(key) & 0xFFu;
      const unsigned i1 = lb[r * 32 + (code >> 4)], i2 = lb[r * 32 + 16 + (code & 15)];
      oi[jj >> 2][jj & 3] = i1 * 128 + i2;
      og[jj >> 2][jj & 3] = g;
    }
    int* ip = p.IDX + (size_t)t * 128 + hh * 16 + h * 8;
    float* gp = p.G + (size_t)t * 128 + hh * 16 + h * 8;
    *(u32x4*)ip = oi[0]; *(u32x4*)(ip + 4) = oi[1];
    *(f32x4*)gp = og[0]; *(f32x4*)(gp + 4) = og[1];
    __builtin_amdgcn_wave_barrier();
  }
}

DI float gelu_tanh(float x) {
  const float u = 0.7978845608028654f * (x + 0.044715f * x * x * x);
  const float e = __builtin_amdgcn_exp2f(u * 2.8853900817779268f);
  const float th = 1.f - 2.f * __builtin_amdgcn_rcpf(e + 1.f);
  return 0.5f * x * (1.f + th);
}
DI float dot16_fp8(const u32x4& w, const u32x4& xa, const u32x4& xb) {
  float acc = 0.f;
#pragma unroll
  for (int k = 0; k < 4; ++k) {
    const bf2_t b0 = __builtin_amdgcn_cvt_scalef32_pk_bf16_fp8(w[k], 1.0f, false);
    const bf2_t b1 = __builtin_amdgcn_cvt_scalef32_pk_bf16_fp8(w[k], 1.0f, true);
    const unsigned x0 = (k < 2) ? xa[2 * k] : xb[2 * k - 4], x1 = (k < 2) ? xa[2 * k + 1] : xb[2 * k - 3];
    acc = __builtin_amdgcn_fdot2_f32_bf16(b0, __builtin_bit_cast(bf2_t, x0), acc, false);
    acc = __builtin_amdgcn_fdot2_f32_bf16(b1, __builtin_bit_cast(bf2_t, x1), acc, false);
  }
  return acc;
}

template <int CTRL>
DI float dppf(float x) { return __uint_as_float(__builtin_amdgcn_update_dpp(0u, __float_as_uint(x), CTRL, 0xF, 0xF, false)); }
DI float swap32sum(float a, float b) {
  auto rr = __builtin_amdgcn_permlane32_swap(__float_as_uint(a), __float_as_uint(b), false, false);
  return __uint_as_float(rr[0]) + __uint_as_float(rr[1]);
}
DI float swap16sum(float a, float b) {
  auto rr = __builtin_amdgcn_permlane16_swap(__float_as_uint(a), __float_as_uint(b), false, false);
  return __uint_as_float(rr[0]) + __uint_as_float(rr[1]);
}
struct P8Buf { u32x4 w[16]; u32x4 xa, xb; };

DI void p8_load_idx(const Params& p, int t, int j, u32x4 (&ix)[4]) {
  const int* ip = p.IDX + (size_t)t * 128 + j * 16;
#pragma unroll
  for (int q = 0; q < 4; ++q) ix[q] = *(const u32x4*)(ip + q * 4);
}
DI void p8_load_rows(const unsigned char* tab, int s, int cc, const u32x4 (&ix)[4], u32x4 (&w)[16]) {
  const unsigned char* base = tab + (size_t)s * (16384 * 128) + cc * 16;
#pragma unroll
  for (int i = 0; i < 16; ++i) w[i] = *(const u32x4*)(base + (size_t)ix[i >> 2][i & 3] * 128);
}

DI void phase8(const Params& p, char* smem, const int tbase) {
  WAVE_COORDS
  const int G = gridDim.x;
  const int gw = vblock() * 4 + wave, NW = G * 4;
  const int j = lane >> 3, cc = lane & 7;
  const bool b0 = lane & 1, b1 = lane & 2, b2 = lane & 4, b3 = lane & 8, b4 = lane & 16, b5 = lane & 32;
  f32x2* part = (f32x2*)(smem + wave * 12288) + lane;
  const float* coefl = (const float*)(smem + wave * 12288);
  const int ntok_all = (T_TOK - gw + NW - 1) / NW;
  const int ntok = min(24, ntok_all - tbase);
  const int gw0 = gw + tbase * NW;
  if (ntok <= 0) return;
  for (int s = 0; s < 8; ++s) {
    u32x4 ixA[4], ixB[4];
    u32x4 wA[16], wB[16];
    u32x4 xaA, xbA, xaB, xbB;
    auto issue = [&](int i, u32x4 (&ix)[4], u32x4 (&w)[16], u32x4& xa, u32x4& xb) {
      const int t = gw0 + i * NW;
      const u16* xr = p.X2b + (size_t)t * 1024 + s * 128 + cc * 16;
      xa = *(const u32x4*)xr; xb = *(const u32x4*)(xr + 8);
      p8_load_rows(p.U8, s, cc, ix, w);
    };
    auto compute = [&](int i, u32x4 (&w)[16], u32x4& xa, u32x4& xb) {
      float d[16];
#pragma unroll
      for (int q = 0; q < 16; ++q) d[q] = dot16_fp8(w[q], xa, xb);
      float v8[8], v4[4], v2[2];
#pragma unroll
      for (int m = 0; m < 8; ++m) { const float mine = b2 ? d[m + 8] : d[m], send = b2 ? d[m] : d[m + 8]; v8[m] = mine + dppf<0x141>(send); }
#pragma unroll
      for (int m = 0; m < 4; ++m) { const float mine = b1 ? v8[m + 4] : v8[m], send = b1 ? v8[m] : v8[m + 4]; v4[m] = mine + dppf<0x4E>(send); }
#pragma unroll
      for (int m = 0; m < 2; ++m) { const float mine = b0 ? v4[m + 2] : v4[m], send = b0 ? v4[m] : v4[m + 2]; v2[m] = mine + dppf<0xB1>(send); }
      f32x2 acc = {v2[0], v2[1]};
      if (s > 0) { const f32x2 o = part[i * 64]; acc[0] += o[0]; acc[1] += o[1]; }
      part[i * 64] = acc;
    };
    p8_load_idx(p, gw0, j, ixA);
    issue(0, ixA, wA, xaA, xbA);
    if (ntok > 1) p8_load_idx(p, gw0 + NW, j, ixB);
#pragma unroll 1
    for (int i = 0; i < ntok; i += 2) {
      if (i + 1 < ntok) issue(i + 1, ixB, wB, xaB, xbB);
      if (i + 2 < ntok) p8_load_idx(p, gw0 + (i + 2) * NW, j, ixA);
      __builtin_amdgcn_sched_barrier(0);
      compute(i, wA, xaA, xbA);
      __builtin_amdgcn_sched_barrier(0);
      if (i + 1 < ntok) {
        if (i + 2 < ntok) issue(i + 2, ixA, wA, xaA, xbA);
        if (i + 3 < ntok) p8_load_idx(p, gw0 + (i + 3) * NW, j, ixB);
        __builtin_amdgcn_sched_barrier(0);
        compute(i + 1, wB, xaB, xbB);
        __builtin_amdgcn_sched_barrier(0);
      }
    }
  }
  for (int i = 0; i < ntok; ++i) {
    const int t = gw0 + i * NW;
    const float* s2 = p.SS2 + (size_t)t * 16;
    float ssum = 0.f;
#pragma unroll
    for (int q = 0; q < 8; ++q) ssum += s2[q];
    const float r2 = rsqrtf(ssum * (1.f / 1024.f) + EPS) * (1.f / USCALE);
    const f32x2 g = *(const f32x2*)(p.G + (size_t)t * 128 + lane * 2);
    f32x2 a = part[i * 64];
    a[0] = gelu_tanh(a[0] * r2) * g[0] * (1.f / VSCALE);
    a[1] = gelu_tanh(a[1] * r2) * g[1] * (1.f / VSCALE);
    part[i * 64] = a;
  }
  asm volatile("" ::: "memory");
  __builtin_amdgcn_wave_barrier();
  for (int s = 0; s < 8; ++s) {
    u32x4 ixA[4], ixB[4];
    u32x4 wA[16], wB[16];
    auto compute = [&](int i, u32x4 (&w)[16]) {
      const int t = gw0 + i * NW;
      const float* cp = coefl + i * 128 + j * 16;
      f32x4 cf[4];
#pragma unroll
      for (int q = 0; q < 4; ++q) cf[q] = *(const f32x4*)(cp + q * 4);
      f32x2 acc2[8];
#pragma unroll
      for (int e = 0; e < 8; ++e) acc2[e] = f32x2{0.f, 0.f};
#pragma unroll
      for (int q = 0; q < 16; ++q) {
        const float cq = cf[q >> 2][q & 3];
        const f32x2 c2 = {cq, cq};
#pragma unroll
        for (int k = 0; k < 4; ++k) {
          const f32x2 lo = __builtin_amdgcn_cvt_pk_f32_fp8((int)w[q][k], false);
          const f32x2 hi = __builtin_amdgcn_cvt_pk_f32_fp8((int)w[q][k], true);
          acc2[2 * k] = __builtin_elementwise_fma(lo, c2, acc2[2 * k]);
          acc2[2 * k + 1] = __builtin_elementwise_fma(hi, c2, acc2[2 * k + 1]);
        }
      }
      float acc[16];
#pragma unroll
      for (int e = 0; e < 8; ++e) { acc[2 * e] = acc2[e][0]; acc[2 * e + 1] = acc2[e][1]; }
      float v8[8], v4[4], v2[2];
#pragma unroll
      for (int m = 0; m < 8; ++m) v8[m] = swap32sum(acc[m], acc[m + 8]);
#pragma unroll
      for (int m = 0; m < 4; ++m) v4[m] = swap16sum(v8[m], v8[m + 4]);
#pragma unroll
      for (int m = 0; m < 2; ++m) { const float mine = b3 ? v4[m + 2] : v4[m], send = b3 ? v4[m] : v4[m + 2]; v2[m] = mine + dppf<0x128>(send); }
      float* op = p.out + (size_t)t * 1024 + s * 128 + cc * 16 + 2 * j;
      f32x2 o = *(f32x2*)op;
      o[0] += v2[0]; o[1] += v2[1];
      *(f32x2*)op = o;
    };
    p8_load_idx(p, gw0, j, ixA);
    p8_load_rows(p.V8, s, cc, ixA, wA);
    if (ntok > 1) p8_load_idx(p, gw0 + NW, j, ixB);
#pragma unroll 1
    for (int i = 0; i < ntok; i += 2) {
      if (i + 1 < ntok) p8_load_rows(p.V8, s, cc, ixB, wB);
      if (i + 2 < ntok) p8_load_idx(p, gw0 + (i + 2) * NW, j, ixA);
      __builtin_amdgcn_sched_barrier(0);
      compute(i, wA);
      __builtin_amdgcn_sched_barrier(0);
      if (i + 1 < ntok) {
        if (i + 2 < ntok) p8_load_rows(p.V8, s, cc, ixA, wA);
        if (i + 3 < ntok) p8_load_idx(p, gw0 + (i + 3) * NW, j, ixB);
        __builtin_amdgcn_sched_barrier(0);
        compute(i + 1, wB);
        __builtin_amdgcn_sched_barrier(0);
      }
    }
  }
  asm volatile("" ::: "memory");
  __builtin_amdgcn_wave_barrier();
}

extern __shared__ __attribute__((aligned(16))) char dyn_smem[];

DI void run_phase(const Params& p, int ph, char* smem) {
  switch (ph) {
    case 0: phase0(p); break;
    case 1: phase1(p, smem); break;
    case 2: phase2(p, smem); break;
    case 3: phase3(p, smem); break;
    case 4: phase4(p, smem); break;
    case 5: phase5(p, smem); break;
    case 6: phase6(p, smem); break;
    case 7: phase7(p, smem); break;
    default: phase8(p, smem, 0); break;
  }
}


#define XB_TMO      128
#define XB_XCNT(j)  (256  + 64 * (j))
#define XB_XSUB(j)  (1280 + 64 * (j))
#define XB_XGEN(j)  (2304 + 64 * (j))
#define XB_TOP      3328
#define XB_TOPGEN   3392
#define XCD_BAR_WORDS 3456
#define XB_SPIN_CAP (1u << 22)
#define LAS __attribute__((address_space(3)))
DI unsigned xb_ld(unsigned* p) { return __hip_atomic_load(p, __ATOMIC_RELAXED, __HIP_MEMORY_SCOPE_AGENT); }
DI unsigned xb_add(unsigned* p, unsigned v) { return __hip_atomic_fetch_add(p, v, __ATOMIC_RELAXED, __HIP_MEMORY_SCOPE_AGENT); }
DI unsigned xb_xcc_id() { return (unsigned)__builtin_amdgcn_s_getreg((3 << 11) | 20) & 0xFu; }
#define XB_SPIN(cond, bar) do { unsigned _sp = 0; while (cond) { __builtin_amdgcn_s_sleep(1); \
    if ((++_sp & 255u) == 0u) { if (xb_ld(&(bar)[XB_TMO])) break; if (_sp > XB_SPIN_CAP) { atomicAdd(&(bar)[XB_TMO], 1u); break; } } } } while (0)
struct XcdBarrier { unsigned* bar; unsigned x; volatile LAS unsigned* st; };
DI XcdBarrier xcd_barrier_post(unsigned* bar, volatile LAS unsigned* st) {
  XcdBarrier b; b.bar = bar; b.x = xb_xcc_id(); b.st = st;
  if (threadIdx.x == 0) (void)xb_add(&bar[XB_XCNT(b.x)], 1u);
  return b;
}
DI void xcd_barrier_complete(unsigned* bar, unsigned x, unsigned& nloc, unsigned& nx) {
  const unsigned G = gridDim.x * gridDim.y * gridDim.z;
  unsigned sum, cnt, mine, sp = 0u;
  for (;;) {
    sum = 0u; cnt = 0u; mine = 0u;
#pragma unroll
    for (unsigned j = 0; j < 16; ++j) { const unsigned c = xb_ld(&bar[XB_XCNT(j)]); sum += c; cnt += (c > 0u) ? 1u : 0u; mine = (j == x) ? c : mine; }
    if (sum == G) break;
    __builtin_amdgcn_s_sleep(1);
    if ((++sp & 255u) == 0u) { if (xb_ld(&bar[XB_TMO])) break; if (sp > XB_SPIN_CAP) { atomicAdd(&bar[XB_TMO], 1u); break; } }
  }
  nloc = mine > 0u ? mine : 1u; nx = cnt > 0u ? cnt : 1u;
}
DI void xcd_barrier(const XcdBarrier& b) {
  asm volatile("s_waitcnt vmcnt(0)" ::: "memory");
  __syncthreads();
  if (threadIdx.x == 0) {
    unsigned* bar = b.bar;
    __builtin_amdgcn_s_waitcnt(0);
    unsigned nloc = b.st[0], nx = b.st[1];
    if (nloc == 0u) { xcd_barrier_complete(bar, b.x, nloc, nx); b.st[0] = nloc; b.st[1] = nx; }
    const unsigned old = xb_add(&bar[XB_XSUB(b.x)], 1u);
    const unsigned gen = old / nloc;
    if (old + 1u == (gen + 1u) * nloc) {
      __builtin_amdgcn_fence(__ATOMIC_RELEASE, "agent");
      asm volatile("s_waitcnt vmcnt(0)" ::: "memory");
      const unsigned og = xb_add(&bar[XB_TOP], 1u);
      const unsigned tg = og / nx;
      if (og + 1u == (tg + 1u) * nx) xb_add(&bar[XB_TOPGEN], 1u);
      else XB_SPIN(xb_ld(&bar[XB_TOPGEN]) == tg, bar);
      __builtin_amdgcn_fence(__ATOMIC_ACQUIRE, "agent");
      xb_add(&bar[XB_XGEN(b.x)], 1u);
      asm volatile("s_waitcnt vmcnt(0)" ::: "memory");
    } else {
      XB_SPIN(xb_ld(&bar[XB_XGEN(b.x)]) == gen, bar);
      __builtin_amdgcn_fence(__ATOMIC_ACQUIRE, "agent");
      asm volatile("s_waitcnt vmcnt(0)" ::: "memory");
    }
  }
  __syncthreads();
}

#if MK_COOP
__global__ void __launch_bounds__(NTHR, 2) mega_kernel(Params p) {
  cg::grid_group grid = cg::this_grid();
#ifndef PROBE_PH
#define PROBE_PH -1
#endif
  volatile LAS unsigned* st = (volatile LAS unsigned*)(dyn_smem + 65536 + 1024);
  if (threadIdx.x < 4) st[threadIdx.x] = 0u;
  for (int i = blockIdx.x * NTHR + threadIdx.x; i < XCD_BAR_WORDS; i += gridDim.x * NTHR) p.bar[i] = 0u;
  phase0(p);
  grid.sync();
  XcdBarrier xb = xcd_barrier_post(p.bar, st);
#define RUNP(k, call) call; xcd_barrier(xb); if (PROBE_PH == k) { call; xcd_barrier(xb); }
  RUNP(1, phase1(p, dyn_smem))
  RUNP(2, phase2(p, dyn_smem))
  RUNP(3, phase3(p, dyn_smem))
  RUNP(4, phase4(p, dyn_smem))
  RUNP(5, phase5(p, dyn_smem))
  RUNP(6, phase6(p, dyn_smem))
  RUNP(7, phase7(p, dyn_smem))
  for (int tb8 = 0; tb8 * (int)gridDim.x * 4 < T_TOK; tb8 += 24) phase8(p, dyn_smem, tb8);
}
#else
template <int PH>
__global__ void __launch_bounds__(NTHR, 2) phase_kernel(Params p) { run_phase(p, PH, dyn_smem); }
#endif

extern "C" void kernel_launch(void* const* d_in, const int* in_sizes, int n_in, void* d_out, int out_size, void* d_ws,
                              size_t ws_size, hipStream_t stream) {
  Params p{};
  const float* const* in = (const float* const*)d_in;
  p.x0 = in[0]; p.x1 = in[1]; p.attn_norm_g = in[2]; p.w_in = in[3]; p.q_lat_g = in[4]; p.w_uq = in[5];
  p.kv_lat_g = in[6]; p.w_ukv = in[7]; p.q_head_g = in[8]; p.k_head_g = in[9]; p.attn_out_g = in[10];
  p.fnet_out_g = in[11]; p.w_out = in[12]; p.ffn_norm_g = in[13]; p.peer_w_q = in[14]; p.peer_sub_keys = in[15];
  p.peer_u = in[16]; p.peer_v = in[17];
  p.out = (float*)d_out;
  char* ws = (char*)d_ws;
  size_t off = 0;
  auto take = [&](size_t bytes) { char* q = ws + off; off += (bytes + 255) & ~(size_t)255; return q; };
  p.WinT = (u16*)take(1280 * 1024 * 2); p.WuqT = (u16*)take(768 * 384 * 2); p.WukvT = (u16*)take(1024 * 256 * 2);
  p.WoutT = (u16*)take(1024 * 1024 * 2); p.WpqT = (u16*)take(2048 * 1024 * 2); p.SK = (u16*)take(262144 * 2);
  p.Wc = (u16*)take(256 * 128 * 2); p.WA64 = (u16*)take(128 * 128 * 2); p.WA32 = (u16*)take(128 * 64 * 2);
  p.WB = (u16*)take(128 * 256 * 2);
  p.ropec = (float*)take(8192 * 16 * 4); p.ropes = (float*)take(8192 * 16 * 4);
  p.rstd1 = (float*)take((size_t)T_TOK * 4); p.SSP = (float*)take((size_t)T_TOK * 10 * 4);
  p.SSA = (float*)take((size_t)T_TOK * 8 * 4); p.SSF = (float*)take((size_t)T_TOK * 8 * 4);
  p.SS2 = (float*)take((size_t)T_TOK * 16 * 4); p.KR = (float*)take((size_t)T_TOK * 32 * 4);
  p.bar = (unsigned*)take(XCD_BAR_WORDS * 4);
  p.misc = (float*)take(256);
  const size_t SMALL = 28u << 20;
  char* big = ws + SMALL;
  const size_t MB = 1u << 20;
  char* dsp = (char*)d_out;
  p.Xb = (u16*)(big + 0 * MB);
  p.CQ = (u16*)(big + 96 * MB); p.CKV = (u16*)(big + 132 * MB); p.F = (u16*)(big + 156 * MB);
  p.Z1 = (u16*)(big + 204 * MB);
  p.Vt = (u16*)(big + 300 * MB);
  p.Q1 = (u16*)(dsp + 0 * MB); p.K1 = (u16*)(dsp + 72 * MB);
  p.Qn = (u16*)(big + 0 * MB); p.Kn = (u16*)(dsp + 120 * MB);
  p.G1 = (u16*)(big + 96 * MB);
  p.MIX = (u16*)(big + 204 * MB);
  p.X2b = (u16*)(big + 0 * MB);
  p.Qp = (u16*)(big + 96 * MB);
  p.IDX = (int*)(big + 300 * MB); p.G = (float*)(big + 324 * MB);
  p.U8 = (unsigned char*)(big + 348 * MB); p.V8 = (unsigned char*)(big + 364 * MB);

#if MK_COOP
  static int grid_blocks = 0;
  if (!grid_blocks) {
    int dev = 0, cus = 0, per_cu = 0;
    hipGetDevice(&dev);
    hipDeviceGetAttribute(&cus, hipDeviceAttributeMultiprocessorCount, dev);
    hipFuncSetAttribute((const void*)mega_kernel, hipFuncAttributeMaxDynamicSharedMemorySize, LDS_BYTES);
    hipOccupancyMaxActiveBlocksPerMultiprocessor(&per_cu, mega_kernel, NTHR, LDS_BYTES);
    if (per_cu > 2) per_cu = 2;
    grid_blocks = cus * per_cu;
    grid_blocks &= ~7;
  }
  void* args[] = {&p};
  hipError_t e = hipLaunchCooperativeKernel((void*)mega_kernel, dim3(grid_blocks), dim3(NTHR), args, LDS_BYTES, stream);
  if (e != hipSuccess) fprintf(stderr, "cooperative launch failed: %s (grid %d)\n", hipGetErrorString(e), grid_blocks);
#else
  const int GB = 512;
#define LAUNCH(PH)                                                                                                \
  hipFuncSetAttribute((const void*)phase_kernel<PH>, hipFuncAttributeMaxDynamicSharedMemorySize, LDS_BYTES);      \
  phase_kernel<PH><<<GB, NTHR, LDS_BYTES, stream>>>(p);
  LAUNCH(0) LAUNCH(1) LAUNCH(2) LAUNCH(3) LAUNCH(4) LAUNCH(5) LAUNCH(6) LAUNCH(7) LAUNCH(8)
#endif
}
```

```cpp
#include <hip/hip_runtime.h>
#include <hip/hip_cooperative_groups.h>
#include <stdint.h>
#include <cstdio>
namespace cg = cooperative_groups;

#ifndef MK_COOP
#define MK_COOP 1
#endif

typedef unsigned short u16;
using bf16x8 = __attribute__((ext_vector_type(8))) short;
using f32x16 = __attribute__((ext_vector_type(16))) float;
using f32x4 = __attribute__((ext_vector_type(4))) float;
using f32x2 = __attribute__((ext_vector_type(2))) float;
using u32x4 = __attribute__((ext_vector_type(4))) unsigned;
using u32x2 = __attribute__((ext_vector_type(2))) unsigned;
typedef __bf16 bf2_t __attribute__((ext_vector_type(2)));

#define DI __device__ __forceinline__
#define MFMA(a, b, c) __builtin_amdgcn_mfma_f32_32x32x16_bf16((a), (b), (c), 0, 0, 0)

constexpr int T_TOK = 49152;
constexpr int TP = 16384;
constexpr float EPS = 1e-6f;
constexpr int NTHR = 256;
constexpr int LDS_BYTES = 65536 + 6144;
constexpr int GBUF = 32768;
constexpr float USCALE = 512.f, VSCALE = 256.f;

struct Params {
  const float *x0, *x1, *attn_norm_g, *w_in, *q_lat_g, *w_uq, *kv_lat_g, *w_ukv, *q_head_g, *k_head_g,
      *attn_out_g, *fnet_out_g, *w_out, *ffn_norm_g, *peer_w_q, *peer_sub_keys, *peer_u, *peer_v;
  float* out;
  u16 *WinT, *WuqT, *WukvT, *WoutT, *WpqT, *SK, *Wc, *WA64, *WA32, *WB;
  float *ropec, *ropes, *rstd1, *SSP, *SSA, *SSF, *SS2, *KR;
  u16 *Xb, *CQ, *CKV, *F, *Z1, *Vt, *Q1, *K1, *Qn, *Kn, *G1, *MIX, *X2b, *Qp;
  unsigned char *U8, *V8;
  int* IDX;
  float* G;
  unsigned* bar;
  float* misc;
};

DI unsigned cvtpk(float lo, float hi) {
  f32x2 v = {lo, hi};
  bf2_t b = __builtin_convertvector(v, bf2_t);
  return __builtin_bit_cast(unsigned, b);
}
DI u16 f2bf(float x) { return (u16)(cvtpk(x, 0.f) & 0xffffu); }
DI float bflo(unsigned w) { return __uint_as_float(w << 16); }
DI float bfhi(unsigned w) { return __uint_as_float(w & 0xffff0000u); }
DI int crow(int i, int h) { return (i & 3) + 8 * (i >> 2) + 4 * h; }
DI float red32(float v) {
  v += __shfl_xor(v, 1); v += __shfl_xor(v, 2); v += __shfl_xor(v, 4); v += __shfl_xor(v, 8); v += __shfl_xor(v, 16);
  return v;
}
DI float wave_sum(float v) { v = red32(v); v += __shfl_xor(v, 32); return v; }
DI const float* xrow(const Params& p, int t) {
  return t < TP ? p.x0 + (size_t)t * 1024 : p.x1 + (size_t)(t - TP) * 1024;
}
DI void tok2seq(int t, int& q, int& S, int& tb) {
  if (t < TP) { q = t >> 13; S = 8192; tb = q << 13; }
  else { int u = (t - TP) >> 12; q = 2 + u; S = 4096; tb = TP + (u << 12); }
}
DI int vblock() { return (blockIdx.x & 7) * (gridDim.x >> 3) + (blockIdx.x >> 3); }
DI float fdot2(unsigned a, unsigned b, float c) {
  return __builtin_amdgcn_fdot2_f32_bf16(__builtin_bit_cast(bf2_t, a), __builtin_bit_cast(bf2_t, b), c, false);
}

DI int swz(int row, int c) { return row * 128 + ((c ^ ((row >> 1) & 7)) << 4); }

template <bool BATCH = false, class AF, class BF>
DI void gemm_mainloop(f32x16 (&acc)[2][2], char* smem, AF arow, BF brow, int k0, int k1) {
  const int tid = threadIdx.x, lane = tid & 63, wave = tid >> 6;
  const int wm = wave >> 1, wn = wave & 1, r = lane & 31, h = lane >> 5;
  const int lrow = tid >> 3, lc = tid & 7;
  const u16* ap[4]; const u16* bp[4];
#pragma unroll
  for (int i = 0; i < 4; ++i) { ap[i] = arow(lrow + 32 * i) + lc * 8; bp[i] = brow(lrow + 32 * i) + lc * 8; }
  u32x4 ra0[4], rb0[4], ra1[4], rb1[4];
#pragma unroll
  for (int i = 0; i < 4; ++i) { ra0[i] = *(const u32x4*)(ap[i] + k0); rb0[i] = *(const u32x4*)(bp[i] + k0); }
#pragma unroll
  for (int i = 0; i < 4; ++i) {
    *(u32x4*)(smem + swz(lrow + 32 * i, lc)) = ra0[i];
    *(u32x4*)(smem + 16384 + swz(lrow + 32 * i, lc)) = rb0[i];
  }
  if (k0 + 64 < k1) {
#pragma unroll
    for (int i = 0; i < 4; ++i) { ra0[i] = *(const u32x4*)(ap[i] + k0 + 64); rb0[i] = *(const u32x4*)(bp[i] + k0 + 64); }
  }
  __syncthreads();
  int cur = 0;
  auto step = [&](int k, u32x4 (&xa)[4], u32x4 (&xb)[4], u32x4 (&ya)[4], u32x4 (&yb)[4]) {
    if (k + 128 < k1) {
#pragma unroll
      for (int i = 0; i < 4; ++i) { ya[i] = *(const u32x4*)(ap[i] + k + 128); yb[i] = *(const u32x4*)(bp[i] + k + 128); }
    }
    __builtin_amdgcn_sched_barrier(0);
    const char* As = smem + cur * GBUF;
    const char* Bs = As + 16384;
    if (BATCH) {
      bf16x8 af[4][2], bfr[4][2];
#pragma unroll
      for (int ks = 0; ks < 4; ++ks) {
#pragma unroll
        for (int mi = 0; mi < 2; ++mi) af[ks][mi] = *(const bf16x8*)(As + swz(wm * 64 + mi * 32 + r, ks * 2 + h));
#pragma unroll
        for (int ni = 0; ni < 2; ++ni) bfr[ks][ni] = *(const bf16x8*)(Bs + swz(wn * 64 + ni * 32 + r, ks * 2 + h));
      }
      __builtin_amdgcn_sched_barrier(0);
#pragma unroll
      for (int ks = 0; ks < 4; ++ks)
#pragma unroll
        for (int mi = 0; mi < 2; ++mi)
#pragma unroll
          for (int ni = 0; ni < 2; ++ni) acc[mi][ni] = MFMA(af[ks][mi], bfr[ks][ni], acc[mi][ni]);
    } else {
#pragma unroll
      for (int ks = 0; ks < 4; ++ks) {
        bf16x8 af[2], bfr[2];
#pragma unroll
        for (int mi = 0; mi < 2; ++mi) af[mi] = *(const bf16x8*)(As + swz(wm * 64 + mi * 32 + r, ks * 2 + h));
#pragma unroll
        for (int ni = 0; ni < 2; ++ni) bfr[ni] = *(const bf16x8*)(Bs + swz(wn * 64 + ni * 32 + r, ks * 2 + h));
#pragma unroll
        for (int mi = 0; mi < 2; ++mi)
#pragma unroll
          for (int ni = 0; ni < 2; ++ni) acc[mi][ni] = MFMA(af[mi], bfr[ni], acc[mi][ni]);
      }
    }
    __builtin_amdgcn_sched_barrier(0);
    if (k + 64 < k1) {
      char* An = smem + (cur ^ 1) * GBUF;
#pragma unroll
      for (int i = 0; i < 4; ++i) {
        *(u32x4*)(An + swz(lrow + 32 * i, lc)) = xa[i];
        *(u32x4*)(An + 16384 + swz(lrow + 32 * i, lc)) = xb[i];
      }
    }
    __syncthreads();
    cur ^= 1;
  };
#pragma unroll 1
  for (int k = k0; k < k1; k += 128) {
    step(k, ra0, rb0, ra1, rb1);
    if (k + 64 < k1) step(k + 64, ra1, rb1, ra0, rb0);
  }
}
DI void zero_acc(f32x16 (&acc)[2][2]) {
#pragma unroll
  for (int a = 0; a < 2; ++a)
#pragma unroll
    for (int b = 0; b < 2; ++b)
#pragma unroll
      for (int i = 0; i < 16; ++i) acc[a][b][i] = 0.f;
}
#define WAVE_COORDS                                                        \
  const int tid = threadIdx.x, lane = tid & 63, wave = tid >> 6;           \
  const int wm = wave >> 1, wn = wave & 1, r = lane & 31, h = lane >> 5;   \
  (void)wm; (void)wn; (void)r; (void)h; (void)lane;

constexpr int SROW = 272;
template <bool SCALE>
DI void stage_bf16_t(char* smem, f32x16 (&acc)[2][2], const float* rs, int wm, int wn, int r, int h) {
  char* base = smem + (wm * 64 + 4 * h) * SROW + (wn * 64 + r) * 2;
  const float* rb = rs + wm * 64 + 4 * h;
#pragma unroll
  for (int mi = 0; mi < 2; ++mi)
#pragma unroll
    for (int i = 0; i < 16; ++i) {
      const int ro = mi * 32 + (i & 3) + 8 * (i >> 2);
      const float sc = SCALE ? rb[ro] : 1.f;
#pragma unroll
      for (int ni = 0; ni < 2; ++ni)
        *(u16*)(base + ro * SROW + ni * 64) = f2bf(acc[mi][ni][i] * sc);
    }
}
DI void stage_bf16(char* smem, f32x16 (&acc)[2][2], const float* rs, int wm, int wn, int r, int h, int) {
  if (rs) stage_bf16_t<true>(smem, acc, rs, wm, wn, r, h); else stage_bf16_t<false>(smem, acc, rs, wm, wn, r, h);
}
DI float sumsq8(const u32x4& v) {
  float ss = 0.f;
#pragma unroll
  for (int j = 0; j < 4; ++j) { const float a = bflo(v[j]), b = bfhi(v[j]); ss += a * a + b * b; }
  return ss;
}

#define WAVE_COORDS_L                                                      \
  int tid = threadIdx.x; asm volatile("" : "+v"(tid));                     \
  const int lane = tid & 63, wave = tid >> 6;                              \
  const int wm = wave >> 1, wn = wave & 1, r = lane & 31, h = lane >> 5;   \
  (void)wm; (void)wn; (void)r; (void)h; (void)lane;

template <int MODE>
DI void transpose_w(u16* dst, const float* src, const float* g0, const float* g1, int N, int K, int Nsrc, int gt, int gs) {
  const int items = N * (K >> 3);
  for (int id = gt; id < items; id += gs) {
    const int kc = id / N, n = id - kc * N;
    int col = n; bool valid = true;
    if (MODE == 1) {
      if (n < 640) col = n; else if (n < 1152) col = n + 32; else if (n < 1184) col = 640 + n - 1152; else valid = false;
    }
    float v[8];
#pragma unroll
    for (int j = 0; j < 8; ++j) {
      const int k = kc * 8 + j;
      const float g = (MODE == 2 && k >= 512) ? g1[k - 512] : g0[k];
      v[j] = valid ? src[(size_t)k * Nsrc + col] * g : 0.f;
    }
    u32x4 o = {cvtpk(v[0], v[1]), cvtpk(v[2], v[3]), cvtpk(v[4], v[5]), cvtpk(v[6], v[7])};
    *(u32x4*)(dst + (size_t)n * K + kc * 8) = o;
  }
}

DI void phase0(const Params& p) {
  const int gt = blockIdx.x * NTHR + threadIdx.x, gs = gridDim.x * NTHR;
  if (gt == 0) {
    float mq = 0.f, mk = 0.f;
    for (int d = 0; d < 96; ++d) { mq = fmaxf(mq, fabsf(p.q_head_g[d])); mk = fmaxf(mk, fabsf(p.k_head_g[d])); }
    p.misc[0] = 96.f * mq * mk * (0.10206207261596575f * 1.4426950408889634f) * 1.02f;
  }
  const int lane = threadIdx.x & 63, gw = gt >> 6, nw = gs >> 6;
  for (int t = gw; t < T_TOK; t += nw) {
    const float* xr = xrow(p, t);
    f32x4 v[4]; float ss = 0.f;
#pragma unroll
    for (int i = 0; i < 4; ++i) {
      v[i] = *(const f32x4*)(xr + i * 256 + lane * 4);
      ss += v[i][0] * v[i][0] + v[i][1] * v[i][1] + v[i][2] * v[i][2] + v[i][3] * v[i][3];
    }
    ss = wave_sum(ss);
#pragma unroll
    for (int i = 0; i < 4; ++i) {
      u32x2 o = {cvtpk(v[i][0], v[i][1]), cvtpk(v[i][2], v[i][3])};
      *(u32x2*)(p.Xb + (size_t)t * 1024 + i * 256 + lane * 4) = o;
    }
    if (lane == 0) p.rstd1[t] = rsqrtf(ss * (1.f / 1024.f) + EPS);
  }
  transpose_w<1>(p.WinT, p.w_in, p.attn_norm_g, nullptr, 1280, 1024, 1184, gt, gs);
  transpose_w<0>(p.WuqT, p.w_uq, p.q_lat_g, nullptr, 768, 384, 768, gt, gs);
  transpose_w<0>(p.WukvT, p.w_ukv, p.kv_lat_g, nullptr, 1024, 256, 1024, gt, gs);
  transpose_w<2>(p.WoutT, p.w_out, p.attn_out_g, p.fnet_out_g, 1024, 1024, 1024, gt, gs);
  transpose_w<0>(p.WpqT, p.peer_w_q, p.ffn_norm_g, nullptr, 2048, 1024, 2048, gt, gs);
  for (int id = gt; id < 262144 / 4; id += gs) {
    f32x4 v = *(const f32x4*)(p.peer_sub_keys + (size_t)id * 4);
    u32x2 o = {cvtpk(v[0], v[1]), cvtpk(v[2], v[3])};
    *(u32x2*)(p.SK + (size_t)id * 4) = o;
  }
  for (int id = gt; id < 256 * 128; id += gs) {
    const int n = id >> 7, c = id & 127, pp = n >> 7, m = n & 127;
    const float fr = (float)((m * c) & 127) * (1.f / 128.f);
    const float val = (pp == 0 ? __builtin_amdgcn_cosf(fr) : -__builtin_amdgcn_sinf(fr)) * 0.08838834764831845f;
    p.Wc[id] = f2bf(val);
  }
  for (int id = gt; id < 128 * 128; id += gs) {
    const int n = id >> 7, k = id & 127;
    const int k1 = (n >> 6) * 32 + (n & 31), pq = (n >> 5) & 1, pp = k >> 6, s1 = k & 63;
    const float fr = (float)((s1 * k1) & 63) * (1.f / 64.f);
    const float c = __builtin_amdgcn_cosf(fr), s = __builtin_amdgcn_sinf(fr);
    const float val = (pq == 0 ? (pp == 0 ? c : s) : (pp == 0 ? -s : c)) * 0.125f;
    p.WA64[id] = f2bf(val);
  }
  for (int id = gt; id < 128 * 64; id += gs) {
    const int n = id >> 6, k = id & 63;
    const int k1 = n & 31, pq = (n >> 5) & 1, pp = k >> 5, s1 = k & 31;
    const float fr = (float)((s1 * k1) & 31) * (1.f / 32.f);
    const float c = __builtin_amdgcn_cosf(fr), s = __builtin_amdgcn_sinf(fr);
    float val = (pq == 0 ? (pp == 0 ? c : s) : (pp == 0 ? -s : c)) * 0.17677669529663687f;
    if (n >= 64) val = 0.f;
    p.WA32[id] = f2bf(val);
  }
  for (int id = gt; id < 128 * 256; id += gs) {
    const int k2 = id >> 8, k = id & 255, pq = k >> 7, s2 = k & 127;
    const float fr = (float)((s2 * k2) & 127) * (1.f / 128.f);
    const float val = (pq == 0 ? __builtin_amdgcn_cosf(fr) : __builtin_amdgcn_sinf(fr)) * 0.08838834764831845f;
    p.WB[id] = f2bf(val);
  }
  for (int id = gt; id < 8192 * 16; id += gs) {
    const int pos = id >> 4, j = id & 15;
    const float freq = exp2f(-(float)j * (13.287712379549449f / 16.f));
    const double rev = (double)pos * (double)freq * 0.15915494309189535;
    const float fr = (float)(rev - floor(rev));
    p.ropec[id] = __builtin_amdgcn_cosf(fr);
    p.ropes[id] = __builtin_amdgcn_sinf(fr);
  }
}

DI void phase1(const Params& p, char* smem) {
    float* rs = (float*)(smem + 65536);
  const int G = gridDim.x;
  for (int tile = vblock(); tile < 384 * 10; tile += G) {
    WAVE_COORDS_L
    const int mt = tile / 10, nt = tile - mt * 10, m0 = mt * 128, n0 = nt * 128;
    __syncthreads();
    if (tid < 128) rs[tid] = p.rstd1[m0 + tid];
    f32x16 acc[2][2]; zero_acc(acc);
    const u16* A = p.Xb + (size_t)m0 * 1024; const u16* B = p.WinT + (size_t)n0 * 1024;
    gemm_mainloop<true>(acc, smem, [&](int rr) { return A + (size_t)rr * 1024; }, [&](int rr) { return B + (size_t)rr * 1024; }, 0, 1024);
    if (nt == 9) {
      if (wn == 0) {
#pragma unroll
        for (int mi = 0; mi < 2; ++mi)
#pragma unroll
          for (int i = 0; i < 16; ++i) {
            const int ro = mi * 32 + (i & 3) + 8 * (i >> 2);
            p.KR[(size_t)(m0 + wm * 64 + 4 * h + ro) * 32 + r] = acc[mi][0][i] * rs[wm * 64 + 4 * h + ro];
          }
      }
    } else {
      stage_bf16_t<true>(smem, acc, rs, wm, wn, r, h);
      __syncthreads();
      u16* dbase; int dstride, cbase;
      if (nt < 3) { dbase = p.CQ; dstride = 384; cbase = n0; }
      else if (nt < 5) { dbase = p.CKV; dstride = 256; cbase = n0 - 384; }
      else { dbase = p.F; dstride = 512; cbase = n0 - 640; }
#pragma unroll
      for (int j = 0; j < 8; ++j) {
        const int id = tid + 256 * j, row = id >> 4, cc = id & 15;
        const u32x4 v = *(const u32x4*)(smem + row * SROW + cc * 16);
        *(u32x4*)(dbase + (size_t)(m0 + row) * dstride + cbase + cc * 8) = v;
        if (nt < 5) {
          float ss = sumsq8(v);
          ss += __shfl_xor(ss, 1); ss += __shfl_xor(ss, 2); ss += __shfl_xor(ss, 4); ss += __shfl_xor(ss, 8);
          if (cc == 0) p.SSP[(size_t)(m0 + row) * 10 + nt * 2] = ss;
        }
      }
    }
  }
}

DI void phase2(const Params& p, char* smem) {
    float* rs = (float*)(smem + 65536);
  const int G = gridDim.x;
  const int NUQ = 384 * 6, NUKV = 384 * 8, NCH = 384 * 8;
  for (int tile = vblock(); tile < NUQ + NUKV + NCH; tile += G) {
    WAVE_COORDS_L
    f32x16 acc[2][2]; zero_acc(acc);
    __syncthreads();
    if (tile < NUQ) {
      const int mt = tile / 6, nt = tile - mt * 6, m0 = mt * 128, n0 = nt * 128;
      if (tid < 128) {
        const float* s = p.SSP + (size_t)(m0 + tid) * 10;
        rs[tid] = rsqrtf((s[0] + s[2] + s[4]) * (1.f / 384.f) + EPS);
      }
      const u16* A = p.CQ + (size_t)m0 * 384; const u16* B = p.WuqT + (size_t)n0 * 384;
      gemm_mainloop(acc, smem, [&](int rr) { return A + (size_t)rr * 384; }, [&](int rr) { return B + (size_t)rr * 384; }, 0, 384);
      stage_bf16_t<true>(smem, acc, rs, wm, wn, r, h);
      __syncthreads();
#pragma unroll
      for (int j = 0; j < 8; ++j) {
        const int id = tid + 256 * j, row = id >> 4, cc = id & 15;
        *(u32x4*)(p.Q1 + (size_t)(m0 + row) * 768 + n0 + cc * 8) = *(const u32x4*)(smem + row * SROW + cc * 16);
      }
    } else if (tile < NUQ + NUKV) {
      const int tl = tile - NUQ;
      const int mt = tl >> 3, hh = tl & 7, m0 = mt * 128;
      int q, S, tb; tok2seq(m0, q, S, tb);
      if (tid < 128) {
        const float* s = p.SSP + (size_t)(m0 + tid) * 10;
        rs[tid] = rsqrtf((s[6] + s[8]) * (1.f / 256.f) + EPS);
      }
      const u16* A = p.CKV + (size_t)m0 * 256; const u16* B = p.WukvT + (size_t)hh * 128 * 256;
      gemm_mainloop(acc, smem, [&](int rr) { return A + (size_t)rr * 256; }, [&](int rr) { return B + (size_t)rr * 256; }, 0, 256);
      if (wn == 0) {
#pragma unroll
        for (int mi = 0; mi < 2; ++mi)
#pragma unroll
          for (int i = 0; i < 16; ++i) {
            const int ro = mi * 32 + (i & 3) + 8 * (i >> 2);
            const float sc = (rs + wm * 64 + 4 * h)[ro];
#pragma unroll
            for (int ni = 0; ni < 2; ++ni) *(u16*)(smem + (wm * 64 + 4 * h) * SROW + r * 2 + ro * SROW + ni * 64) = f2bf(acc[mi][ni][i] * sc);
          }
      } else {
        const int s0 = m0 - tb;
#pragma unroll
        for (int mi = 0; mi < 2; ++mi)
#pragma unroll
          for (int g4 = 0; g4 < 4; ++g4) {
            const int row = wm * 64 + mi * 32 + 8 * g4 + 4 * h;
            const f32x4 sc = *(const f32x4*)(rs + row);
#pragma unroll
            for (int ni = 0; ni < 2; ++ni) {
              const int dv = ni * 32 + r;
              u32x2 o = {cvtpk(acc[mi][ni][4 * g4] * sc[0], acc[mi][ni][4 * g4 + 1] * sc[1]),
                         cvtpk(acc[mi][ni][4 * g4 + 2] * sc[2], acc[mi][ni][4 * g4 + 3] * sc[3])};
              *(u32x2*)(p.Vt + (size_t)tb * 512 + (size_t)(hh * 64 + dv) * S + s0 + row) = o;
            }
            __builtin_amdgcn_sched_barrier(0);
          }
      }
      __syncthreads();
#pragma unroll
      for (int j = 0; j < 4; ++j) {
        const int id = tid + 256 * j, row = id >> 3, cc = id & 7;
        *(u32x4*)(p.K1 + (size_t)(m0 + row) * 512 + hh * 64 + cc * 8) = *(const u32x4*)(smem + row * SROW + cc * 16);
      }
    } else {
      const int tl = tile - NUQ - NUKV;
      const int pp = tl & 1, g = (tl >> 1) & 3, mt = tl >> 3, m0 = mt * 128;
      int q, S, tb; tok2seq(m0, q, S, tb);
      const int S1 = (q < 2) ? 64 : 32, l1 = (q < 2) ? 6 : 5;
      const int j0 = ((m0 - tb) >> 7) * (128 >> l1);
      const u16* Fb = p.F + (size_t)g * 128;
      const u16* B = p.Wc + (size_t)pp * 128 * 128;
      gemm_mainloop(acc, smem,
                    [&](int rr) { const int s1 = rr & (S1 - 1), s2 = j0 + (rr >> l1); return Fb + (size_t)(tb + s1 * 128 + s2) * 512; },
                    [&](int rr) { return B + (size_t)rr * 128; }, 0, 128);
      u16* Zb = p.Z1 + (size_t)tb * 1024;
#pragma unroll
      for (int mi = 0; mi < 2; ++mi)
#pragma unroll
        for (int g4 = 0; g4 < 4; ++g4) {
          const int rho = wm * 64 + mi * 32 + 8 * g4 + 4 * h;
          const int s1 = rho & (S1 - 1), s2 = j0 + (rho >> l1);
#pragma unroll
          for (int ni = 0; ni < 2; ++ni) {
            const int m = wn * 64 + ni * 32 + r;
            u32x2 o = {cvtpk(acc[mi][ni][4 * g4], acc[mi][ni][4 * g4 + 1]), cvtpk(acc[mi][ni][4 * g4 + 2], acc[mi][ni][4 * g4 + 3])};
            *(u32x2*)(Zb + ((size_t)((g * 128 + m) * 128 + s2) * (2 * S1)) + pp * S1 + s1) = o;
          }
          __builtin_amdgcn_sched_barrier(0);
        }
    }
  }
}

DI void phase3(const Params& p, char* smem) {
    const int G = gridDim.x;
  for (int tile = vblock(); tile < 5120; tile += G) {
    WAVE_COORDS_L
    const int q = tile >> 9, gm = tile & 511;
    const int tb = (q < 2) ? (q << 13) : (TP + ((q - 2) << 12));
    const int S = (q < 2) ? 8192 : 4096, S1 = (q < 2) ? 64 : 32, K = 2 * S1;
    f32x16 acc[2][2]; zero_acc(acc);
    const u16* A = p.Z1 + (size_t)tb * 1024 + (size_t)gm * 128 * K;
    const u16* B = (q < 2) ? p.WA64 : p.WA32;
    gemm_mainloop(acc, smem, [&](int rr) { return A + (size_t)rr * K; }, [&](int rr) { return B + (size_t)rr * K; }, 0, K);
    if (wn * 32 < S1) {
      const int k1 = wn * 32 + r;
      const float invS = 1.f / (float)S;
      u16* Gb = p.G1 + (size_t)tb * 1024 + (size_t)(gm * S1 + k1) * 256;
#pragma unroll
      for (int mi = 0; mi < 2; ++mi)
#pragma unroll
        for (int g4 = 0; g4 < 4; ++g4) {
          const int s2b = wm * 64 + mi * 32 + 8 * g4 + 4 * h;
          float ore[4], oim[4];
#pragma unroll
          for (int j = 0; j < 4; ++j) {
            const int s2 = s2b + j;
            const float fr = (float)((s2 * k1) & (S - 1)) * invS;
            const float c = __builtin_amdgcn_cosf(fr), s = __builtin_amdgcn_sinf(fr);
            const float re = acc[mi][0][4 * g4 + j], im = acc[mi][1][4 * g4 + j];
            ore[j] = re * c + im * s; oim[j] = im * c - re * s;
          }
          u32x2 o0 = {cvtpk(ore[0], ore[1]), cvtpk(ore[2], ore[3])};
          u32x2 o1 = {cvtpk(oim[0], oim[1]), cvtpk(oim[2], oim[3])};
          *(u32x2*)(Gb + s2b) = o0;
          *(u32x2*)(Gb + 128 + s2b) = o1;
        }
    }
  }
  const float QSCALE = 0.10206207261596575f * 1.4426950408889634f;
  for (int chunk = vblock(); chunk < T_TOK * 8 / NTHR; chunk += G) {
    WAVE_COORDS_L
    const int id = chunk * NTHR + tid;
    const int t = id >> 3, hh = id & 7;
    int q, S, tb; tok2seq(t, q, S, tb);
    const int s = t - tb;
    const size_t obase = ((size_t)tb * 8 + (size_t)hh * S + s) * 96;
    const float* rcp = p.ropec + s * 16; const float* rsp = p.ropes + s * 16;
    {
      u32x4 w[12];
      const u16* src = p.Q1 + (size_t)t * 768 + hh * 96;
#pragma unroll
      for (int i = 0; i < 12; ++i) w[i] = *(const u32x4*)(src + i * 8);
      float ss = 0.f;
#pragma unroll
      for (int i = 0; i < 12; ++i)
#pragma unroll
        for (int j = 0; j < 4; ++j) { const float a = bflo(w[i][j]), b = bfhi(w[i][j]); ss += a * a + b * b; }
      const float rinv = rsqrtf(ss * (1.f / 96.f) + EPS);
      u16* dst = p.Qn + obase;
#pragma unroll
      for (int i = 0; i < 8; ++i) {
        u32x4 o;
#pragma unroll
        for (int j = 0; j < 4; ++j) {
          const int d = i * 8 + j * 2;
          o[j] = cvtpk(bflo(w[i][j]) * rinv * p.q_head_g[d] * QSCALE, bfhi(w[i][j]) * rinv * p.q_head_g[d + 1] * QSCALE);
        }
        *(u32x4*)(dst + i * 8) = o;
      }
      float x1[16], x2[16];
#pragma unroll
      for (int i = 0; i < 2; ++i)
#pragma unroll
        for (int j = 0; j < 4; ++j) {
          const int e = i * 8 + j * 2;
          x1[e] = bflo(w[8 + i][j]) * rinv * p.q_head_g[64 + e]; x1[e + 1] = bfhi(w[8 + i][j]) * rinv * p.q_head_g[64 + e + 1];
          x2[e] = bflo(w[10 + i][j]) * rinv * p.q_head_g[80 + e]; x2[e + 1] = bfhi(w[10 + i][j]) * rinv * p.q_head_g[80 + e + 1];
        }
      float o1[16], o2[16];
#pragma unroll
      for (int e = 0; e < 16; ++e) {
        const float c = rcp[e], sn = rsp[e];
        o1[e] = (x1[e] * c - x2[e] * sn) * QSCALE; o2[e] = (x2[e] * c + x1[e] * sn) * QSCALE;
      }
#pragma unroll
      for (int i = 0; i < 2; ++i) {
        u32x4 a, b;
#pragma unroll
        for (int j = 0; j < 4; ++j) { a[j] = cvtpk(o1[i * 8 + j * 2], o1[i * 8 + j * 2 + 1]); b[j] = cvtpk(o2[i * 8 + j * 2], o2[i * 8 + j * 2 + 1]); }
        *(u32x4*)(dst + 64 + i * 8) = a;
        *(u32x4*)(dst + 80 + i * 8) = b;
      }
    }
    __builtin_amdgcn_sched_barrier(0);
    {
      u32x4 w[8];
      const u16* src = p.K1 + (size_t)t * 512 + hh * 64;
#pragma unroll
      for (int i = 0; i < 8; ++i) w[i] = *(const u32x4*)(src + i * 8);
      f32x4 kr[8];
#pragma unroll
      for (int i = 0; i < 8; ++i) kr[i] = *(const f32x4*)(p.KR + (size_t)t * 32 + i * 4);
      float ss = 0.f;
#pragma unroll
      for (int i = 0; i < 8; ++i)
#pragma unroll
        for (int j = 0; j < 4; ++j) { const float a = bflo(w[i][j]), b = bfhi(w[i][j]); ss += a * a + b * b + kr[i][j] * kr[i][j]; }
      const float rinv = rsqrtf(ss * (1.f / 96.f) + EPS);
      u16* dst = p.Kn + obase;
#pragma unroll
      for (int i = 0; i < 8; ++i) {
        u32x4 o;
#pragma unroll
        for (int j = 0; j < 4; ++j) {
          const int d = i * 8 + j * 2;
          o[j] = cvtpk(bflo(w[i][j]) * rinv * p.k_head_g[d], bfhi(w[i][j]) * rinv * p.k_head_g[d + 1]);
        }
        *(u32x4*)(dst + i * 8) = o;
      }
      float o1[16], o2[16];
#pragma unroll
      for (int e = 0; e < 16; ++e) {
        const float a = kr[e >> 2][e & 3] * rinv * p.k_head_g[64 + e];
        const float b = kr[4 + (e >> 2)][e & 3] * rinv * p.k_head_g[80 + e];
        const float c = rcp[e], sn = rsp[e];
        o1[e] = a * c - b * sn; o2[e] = b * c + a * sn;
      }
#pragma unroll
      for (int i = 0; i < 2; ++i) {
        u32x4 a, b;
#pragma unroll
        for (int j = 0; j < 4; ++j) { a[j] = cvtpk(o1[i * 8 + j * 2], o1[i * 8 + j * 2 + 1]); b[j] = cvtpk(o2[i * 8 + j * 2], o2[i * 8 + j * 2 + 1]); }
        *(u32x4*)(dst + 64 + i * 8) = a;
        *(u32x4*)(dst + 80 + i * 8) = b;
      }
    }
  }
}

constexpr int KSTR = 208, VSTR = 136, ABUF = 64 * KSTR + 64 * VSTR;

DI void attn_tile(const Params& p, char* smem, int a) {
  WAVE_COORDS
  int q, hh, qt, S, tb;
  if (a < 1024) { q = a >> 9; hh = (a >> 6) & 7; qt = a & 63; S = 8192; tb = q << 13; }
  else { const int b = a - 1024; q = 2 + (b >> 8); hh = (b >> 5) & 7; qt = b & 31; S = 4096; tb = TP + ((q - 2) << 12); }
  const size_t qkb = ((size_t)tb * 8 + (size_t)hh * S) * 96;
  const u16* Qb = p.Qn + qkb; const u16* Kb = p.Kn + qkb;
  const u16* Vb = p.Vt + (size_t)tb * 512 + (size_t)hh * 64 * S;
  const int qrow = qt * 128 + wave * 32 + r;
  bf16x8 qf[6];
#pragma unroll
  for (int ks = 0; ks < 6; ++ks) qf[ks] = *(const bf16x8*)(Qb + (size_t)qrow * 96 + ks * 16 + h * 8);
  f32x16 o[2];
#pragma unroll
  for (int i = 0; i < 16; ++i) { o[0][i] = 0.f; o[1][i] = 0.f; }
  float mrun = -1e30f, lrun = 0.f;
  int krow_[3], kc_[3], vrow_[2], vc_[2];
#pragma unroll
  for (int i = 0; i < 3; ++i) { const int id = tid + 256 * i; krow_[i] = id / 12; kc_[i] = id - krow_[i] * 12; }
#pragma unroll
  for (int i = 0; i < 2; ++i) { const int id = tid + 256 * i; vrow_[i] = id >> 3; vc_[i] = id & 7; }
  u32x4 rk[3], rv[2];
  const int nkt = S >> 6;
#pragma unroll
  for (int i = 0; i < 3; ++i) rk[i] = *(const u32x4*)(Kb + (size_t)krow_[i] * 96 + kc_[i] * 8);
#pragma unroll
  for (int i = 0; i < 2; ++i) rv[i] = *(const u32x4*)(Vb + (size_t)vrow_[i] * S + vc_[i] * 8);
  __syncthreads();
#pragma unroll
  for (int i = 0; i < 3; ++i) *(u32x4*)(smem + krow_[i] * KSTR + kc_[i] * 16) = rk[i];
#pragma unroll
  for (int i = 0; i < 2; ++i) {
    char* d = smem + 64 * KSTR + vrow_[i] * VSTR + vc_[i] * 16;
    *(u32x2*)d = u32x2{rv[i][0], rv[i][1]}; *(u32x2*)(d + 8) = u32x2{rv[i][2], rv[i][3]};
  }
  __syncthreads();
  int cur = 0;
  for (int kt = 0; kt < nkt; ++kt) {
    const bool nxt = (kt + 1 < nkt);
    if (nxt) {
#pragma unroll
      for (int i = 0; i < 3; ++i) rk[i] = *(const u32x4*)(Kb + (size_t)((kt + 1) * 64 + krow_[i]) * 96 + kc_[i] * 8);
#pragma unroll
      for (int i = 0; i < 2; ++i) rv[i] = *(const u32x4*)(Vb + (size_t)vrow_[i] * S + (kt + 1) * 64 + vc_[i] * 8);
    }
    __builtin_amdgcn_sched_barrier(0);
    const char* Ks = smem + cur * ABUF;
    const char* Vs = Ks + 64 * KSTR;
    f32x16 sacc[2];
#pragma unroll
    for (int i = 0; i < 16; ++i) { sacc[0][i] = 0.f; sacc[1][i] = 0.f; }
#pragma unroll
    for (int t2 = 0; t2 < 2; ++t2)
#pragma unroll
      for (int ks = 0; ks < 6; ++ks) {
        const bf16x8 kf = *(const bf16x8*)(Ks + (t2 * 32 + r) * KSTR + ks * 32 + h * 16);
        sacc[t2] = MFMA(kf, qf[ks], sacc[t2]);
      }
    float mx = sacc[0][0];
#pragma unroll
    for (int i = 0; i < 16; ++i) { mx = fmaxf(mx, sacc[0][i]); mx = fmaxf(mx, sacc[1][i]); }
    mx = fmaxf(mx, __shfl_xor(mx, 32));
    const float mnew = fmaxf(mrun, mx);
    const float alpha = __builtin_amdgcn_exp2f(mrun - mnew);
    mrun = mnew;
    lrun *= alpha;
#pragma unroll
    for (int i = 0; i < 16; ++i) { o[0][i] *= alpha; o[1][i] *= alpha; }
    float ps = 0.f;
#pragma unroll
    for (int t2 = 0; t2 < 2; ++t2)
#pragma unroll
      for (int i = 0; i < 16; ++i) { const float e = __builtin_amdgcn_exp2f(sacc[t2][i] - mnew); sacc[t2][i] = e; ps += e; }
    lrun += ps;
    bf16x8 pf[4];
#pragma unroll
    for (int kk = 0; kk < 4; ++kk) {
      const int t2 = kk >> 1, s8 = (kk & 1) * 8;
      u32x4 pk = {cvtpk(sacc[t2][s8], sacc[t2][s8 + 1]), cvtpk(sacc[t2][s8 + 2], sacc[t2][s8 + 3]),
                  cvtpk(sacc[t2][s8 + 4], sacc[t2][s8 + 5]), cvtpk(sacc[t2][s8 + 6], sacc[t2][s8 + 7])};
      pf[kk] = __builtin_bit_cast(bf16x8, pk);
    }
#pragma unroll
    for (int dt = 0; dt < 2; ++dt)
#pragma unroll
      for (int kk = 0; kk < 4; ++kk) {
        const char* vp = Vs + (dt * 32 + r) * VSTR + kk * 32 + h * 8;
        const u32x2 lo = *(const u32x2*)vp, hi = *(const u32x2*)(vp + 16);
        u32x4 vv = {lo[0], lo[1], hi[0], hi[1]};
        o[dt] = MFMA(__builtin_bit_cast(bf16x8, vv), pf[kk], o[dt]);
      }
    __builtin_amdgcn_sched_barrier(0);
    if (nxt) {
      char* Kn_ = smem + (cur ^ 1) * ABUF;
#pragma unroll
      for (int i = 0; i < 3; ++i) *(u32x4*)(Kn_ + krow_[i] * KSTR + kc_[i] * 16) = rk[i];
#pragma unroll
      for (int i = 0; i < 2; ++i) {
        char* d = Kn_ + 64 * KSTR + vrow_[i] * VSTR + vc_[i] * 16;
        *(u32x2*)d = u32x2{rv[i][0], rv[i][1]}; *(u32x2*)(d + 8) = u32x2{rv[i][2], rv[i][3]};
      }
    }
    __syncthreads();
    cur ^= 1;
  }
  lrun += __shfl_xor(lrun, 32);
  const float inv = 1.f / lrun;
  float ss = 0.f;
  u16* dst = p.MIX + (size_t)(tb + qrow) * 1024 + hh * 64;
#pragma unroll
  for (int dt = 0; dt < 2; ++dt)
#pragma unroll
    for (int g4 = 0; g4 < 4; ++g4) {
      float v[4];
#pragma unroll
      for (int j = 0; j < 4; ++j) { v[j] = o[dt][4 * g4 + j] * inv; ss += v[j] * v[j]; }
      u32x2 ov = {cvtpk(v[0], v[1]), cvtpk(v[2], v[3])};
      *(u32x2*)(dst + dt * 32 + 8 * g4 + 4 * h) = ov;
    }
  ss += __shfl_xor(ss, 32);
  if (h == 0) p.SSA[(size_t)(tb + qrow) * 8 + hh] = ss;
}

constexpr int VSTR2 = 144, ABUF2 = 64 * KSTR + 64 * VSTR2;
DI float swapmax32(float v) {
  auto rr = __builtin_amdgcn_permlane32_swap(__float_as_uint(v), __float_as_uint(v), false, false);
  return fmaxf(__uint_as_float(rr[0]), __uint_as_float(rr[1]));
}
DI float swapsum32(float v) {
  auto rr = __builtin_amdgcn_permlane32_swap(__float_as_uint(v), __float_as_uint(v), false, false);
  return __uint_as_float(rr[0]) + __uint_as_float(rr[1]);
}
template <bool RUNMAX>
DI void attn_tile2(const Params& p, char* smem, int a) {
  WAVE_COORDS_L
  int q, hh, qt, S, tb;
  if (a < 512) { q = a >> 8; hh = (a >> 5) & 7; qt = a & 31; S = 8192; tb = q << 13; }
  else { const int b = a - 512; q = 2 + (b >> 7); hh = (b >> 4) & 7; qt = b & 15; S = 4096; tb = TP + ((q - 2) << 12); }
  const size_t qkb = ((size_t)tb * 8 + (size_t)hh * S) * 96;
  const u16* Qb = p.Qn + qkb; const u16* Kb = p.Kn + qkb;
  const u16* Vb = p.Vt + (size_t)tb * 512 + (size_t)hh * 64 * S;
  const int qrow0 = qt * 256 + wave * 64 + r;
  bf16x8 qf[2][6];
#pragma unroll
  for (int g = 0; g < 2; ++g)
#pragma unroll
    for (int ks = 0; ks < 6; ++ks) qf[g][ks] = *(const bf16x8*)(Qb + (size_t)(qrow0 + 32 * g) * 96 + ks * 16 + h * 8);
  f32x16 o[2][2];
#pragma unroll
  for (int i = 0; i < 16; ++i) { o[0][0][i] = 0.f; o[0][1][i] = 0.f; o[1][0][i] = 0.f; o[1][1][i] = 0.f; }
  float mrun[2] = {-1e30f, -1e30f}, lrun[2] = {0.f, 0.f};
  int klds_[3], vlds_[2];
#pragma unroll
  for (int i = 0; i < 3; ++i) { const int id = tid + 256 * i; const int kr = id / 12; klds_[i] = kr * KSTR + (id - kr * 12) * 16; }
#pragma unroll
  for (int i = 0; i < 2; ++i) { const int vc = tid & 7; vlds_[i] = 64 * KSTR + ((tid >> 3) + 32 * i) * VSTR2 + (vc >> 1) * 32 + (vc & 1) * 8; }
  const u16* Kg = Kb + tid * 8;
  const u16* Vg = Vb + (size_t)(tid >> 3) * S + (tid & 7) * 8;
  u32x4 rk[3], rv[2];
  const int nkt = S >> 6;
#pragma unroll
  for (int i = 0; i < 3; ++i) rk[i] = *(const u32x4*)(Kg + i * 2048);
#pragma unroll
  for (int i = 0; i < 2; ++i) rv[i] = *(const u32x4*)(Vg + (size_t)(32 * i) * S);
  __syncthreads();
  auto put = [&](char* base) {
#pragma unroll
    for (int i = 0; i < 3; ++i) *(u32x4*)(base + klds_[i]) = rk[i];
#pragma unroll
    for (int i = 0; i < 2; ++i) {
      char* d = base + vlds_[i];
      *(u32x2*)d = u32x2{rv[i][0], rv[i][1]}; *(u32x2*)(d + 16) = u32x2{rv[i][2], rv[i][3]};
    }
  };
  put(smem);
  __syncthreads();
  int cur = 0;
#pragma unroll 1
  for (int kt = 0; kt < nkt; ++kt) {
    const bool nxt = (kt + 1 < nkt);
    if (nxt) {
#pragma unroll
      for (int i = 0; i < 3; ++i) rk[i] = *(const u32x4*)(Kg + (size_t)(kt + 1) * 6144 + i * 2048);
#pragma unroll
      for (int i = 0; i < 2; ++i) rv[i] = *(const u32x4*)(Vg + (size_t)(32 * i) * S + (kt + 1) * 64);
    }
    __builtin_amdgcn_sched_barrier(0);
    const char* Ks = smem + cur * ABUF2;
    const char* Vs = Ks + 64 * KSTR;
#pragma unroll
    for (int t2 = 0; t2 < 2; ++t2) {
      f32x16 sacc[2];
#pragma unroll
      for (int i = 0; i < 16; ++i) { sacc[0][i] = 0.f; sacc[1][i] = 0.f; }
#pragma unroll
      for (int kb = 0; kb < 2; ++kb) {
        bf16x8 kf[3];
#pragma unroll
        for (int ks = 0; ks < 3; ++ks) kf[ks] = *(const bf16x8*)(Ks + (t2 * 32 + r) * KSTR + (kb * 3 + ks) * 32 + h * 16);
#pragma unroll
        for (int ks = 0; ks < 3; ++ks) {
          sacc[0] = MFMA(kf[ks], qf[0][kb * 3 + ks], sacc[0]);
          sacc[1] = MFMA(kf[ks], qf[1][kb * 3 + ks], sacc[1]);
        }
      }
      __builtin_amdgcn_sched_barrier(0);
      bf16x8 pf[2][2];
#pragma unroll
      for (int g = 0; g < 2; ++g) {
        float ps = 0.f;
        if (RUNMAX) {
        float mx = sacc[g][0];
#pragma unroll
        for (int i = 1; i < 16; ++i) mx = fmaxf(mx, sacc[g][i]);
        mx = swapmax32(mx);
        const float mnew = fmaxf(mrun[g], mx);
        if (__ballot(mnew > mrun[g]) != 0ull) {
          const float alpha = __builtin_amdgcn_exp2f(mrun[g] - mnew);
          lrun[g] *= alpha;
#pragma unroll
          for (int i = 0; i < 16; ++i) { o[g][0][i] *= alpha; o[g][1][i] *= alpha; }
          mrun[g] = mnew;
        }
#pragma unroll
        for (int i = 0; i < 16; ++i) { const float e = __builtin_amdgcn_exp2f(sacc[g][i] - mrun[g]); sacc[g][i] = e; ps += e; }
        } else {
#pragma unroll
          for (int i = 0; i < 16; ++i) sacc[g][i] = __builtin_amdgcn_exp2f(sacc[g][i]);
        }
#pragma unroll
        for (int s = 0; s < 2; ++s) {
          const int s8 = s * 8;
          u32x4 pk = {cvtpk(sacc[g][s8], sacc[g][s8 + 1]), cvtpk(sacc[g][s8 + 2], sacc[g][s8 + 3]),
                      cvtpk(sacc[g][s8 + 4], sacc[g][s8 + 5]), cvtpk(sacc[g][s8 + 6], sacc[g][s8 + 7])};
          pf[g][s] = __builtin_bit_cast(bf16x8, pk);
          if (!RUNMAX) {
#pragma unroll
            for (int w = 0; w < 4; ++w) ps = fdot2(pk[w], 0x3F803F80u, ps);
          }
        }
        lrun[g] += ps;
      }
      __builtin_amdgcn_sched_barrier(0);
      {
        bf16x8 vf[2][2];
#pragma unroll
        for (int dt = 0; dt < 2; ++dt)
#pragma unroll
          for (int s = 0; s < 2; ++s) vf[dt][s] = *(const bf16x8*)(Vs + (dt * 32 + r) * VSTR2 + (t2 * 2 + s) * 32 + h * 16);
#pragma unroll
        for (int s = 0; s < 2; ++s)
#pragma unroll
          for (int dt = 0; dt < 2; ++dt) {
            o[0][dt] = MFMA(vf[dt][s], pf[0][s], o[0][dt]);
            o[1][dt] = MFMA(vf[dt][s], pf[1][s], o[1][dt]);
          }
      }
    }
    __builtin_amdgcn_sched_barrier(0);
    if (nxt) put(smem + (cur ^ 1) * ABUF2);
    __syncthreads();
    cur ^= 1;
  }
#pragma unroll
  for (int g = 0; g < 2; ++g) {
    const float lsum = swapsum32(lrun[g]);
    const float inv = 1.f / lsum;
    const int qrow = qrow0 + 32 * g;
    float ss = 0.f;
    u16* dst = p.MIX + (size_t)(tb + qrow) * 1024 + hh * 64;
#pragma unroll
    for (int dt = 0; dt < 2; ++dt)
#pragma unroll
      for (int g4 = 0; g4 < 4; ++g4) {
        float v[4];
#pragma unroll
        for (int jj = 0; jj < 4; ++jj) { v[jj] = o[g][dt][4 * g4 + jj] * inv; ss += v[jj] * v[jj]; }
        u32x2 ov = {cvtpk(v[0], v[1]), cvtpk(v[2], v[3])};
        *(u32x2*)(dst + dt * 32 + 8 * g4 + 4 * h) = ov;
      }
    ss = swapsum32(ss);
    if (h == 0) p.SSA[(size_t)(tb + qrow) * 8 + hh] = ss;
  }
}

DI void attn_tile3(const Params& p, char* smem, int a) {
  WAVE_COORDS_L
  int q, hh, qt, S, tb;
  if (a < 512) { q = a >> 8; hh = (a >> 5) & 7; qt = a & 31; S = 8192; tb = q << 13; }
  else { const int b = a - 512; q = 2 + (b >> 7); hh = (b >> 4) & 7; qt = b & 15; S = 4096; tb = TP + ((q - 2) << 12); }
  const size_t qkb = ((size_t)tb * 8 + (size_t)hh * S) * 96;
  const u16* Qb = p.Qn + qkb; const u16* Kb = p.Kn + qkb;
  const u16* Vb = p.Vt + (size_t)tb * 512 + (size_t)hh * 64 * S;
  const int qrow0 = qt * 256 + wave * 64 + r;
  bf16x8 qf[2][6];
#pragma unroll
  for (int g = 0; g < 2; ++g)
#pragma unroll
    for (int ks = 0; ks < 6; ++ks) qf[g][ks] = *(const bf16x8*)(Qb + (size_t)(qrow0 + 32 * g) * 96 + ks * 16 + h * 8);
  f32x16 o[2][2];
#pragma unroll
  for (int i = 0; i < 16; ++i) { o[0][0][i] = 0.f; o[0][1][i] = 0.f; o[1][0][i] = 0.f; o[1][1][i] = 0.f; }
  float lrun[2] = {0.f, 0.f};
  int klds_[3], vlds_[2];
#pragma unroll
  for (int i = 0; i < 3; ++i) { const int id = tid + 256 * i; const int kr = id / 12; klds_[i] = kr * KSTR + (id - kr * 12) * 16; }
#pragma unroll
  for (int i = 0; i < 2; ++i) { const int vc = tid & 7; vlds_[i] = 64 * KSTR + ((tid >> 3) + 32 * i) * VSTR2 + (vc >> 1) * 32 + (vc & 1) * 8; }
  const u16* Kg = Kb + tid * 8;
  const u16* Vg = Vb + (size_t)(tid >> 3) * S + (tid & 7) * 8;
  u32x4 rk[3], rv[2];
  const int nkt = S >> 6;
#pragma unroll
  for (int i = 0; i < 3; ++i) rk[i] = *(const u32x4*)(Kg + i * 2048);
#pragma unroll
  for (int i = 0; i < 2; ++i) rv[i] = *(const u32x4*)(Vg + (size_t)(32 * i) * S);
  __syncthreads();
  auto put = [&](char* base) {
#pragma unroll
    for (int i = 0; i < 3; ++i) *(u32x4*)(base + klds_[i]) = rk[i];
#pragma unroll
    for (int i = 0; i < 2; ++i) {
      char* d = base + vlds_[i];
      *(u32x2*)d = u32x2{rv[i][0], rv[i][1]}; *(u32x2*)(d + 16) = u32x2{rv[i][2], rv[i][3]};
    }
  };
  put(smem);
  __syncthreads();
  int cur = 0;
#pragma unroll 1
  for (int kt = 0; kt < nkt; ++kt) {
    const bool nxt = (kt + 1 < nkt);
    if (nxt) {
#pragma unroll
      for (int i = 0; i < 3; ++i) rk[i] = *(const u32x4*)(Kg + (size_t)(kt + 1) * 6144 + i * 2048);
#pragma unroll
      for (int i = 0; i < 2; ++i) rv[i] = *(const u32x4*)(Vg + (size_t)(32 * i) * S + (kt + 1) * 64);
    }
    __builtin_amdgcn_sched_barrier(0);
    const char* Ks = smem + cur * ABUF2;
    const char* Vs = Ks + 64 * KSTR;
    f32x16 sacc[2][2];
#pragma unroll
    for (int i = 0; i < 16; ++i) { sacc[0][0][i] = 0.f; sacc[0][1][i] = 0.f; sacc[1][0][i] = 0.f; sacc[1][1][i] = 0.f; }
#pragma unroll
    for (int kb = 0; kb < 2; ++kb) {
      bf16x8 kf[2][3];
#pragma unroll
      for (int t2 = 0; t2 < 2; ++t2)
#pragma unroll
        for (int ks = 0; ks < 3; ++ks) kf[t2][ks] = *(const bf16x8*)(Ks + (t2 * 32 + r) * KSTR + (kb * 3 + ks) * 32 + h * 16);
#pragma unroll
      for (int ks = 0; ks < 3; ++ks)
#pragma unroll
        for (int t2 = 0; t2 < 2; ++t2) {
          sacc[t2][0] = MFMA(kf[t2][ks], qf[0][kb * 3 + ks], sacc[t2][0]);
          sacc[t2][1] = MFMA(kf[t2][ks], qf[1][kb * 3 + ks], sacc[t2][1]);
        }
    }
    __builtin_amdgcn_sched_barrier(0);
    bf16x8 pf[2][4];
#pragma unroll
    for (int g = 0; g < 2; ++g) {
      float ps = 0.f;
#pragma unroll
      for (int t2 = 0; t2 < 2; ++t2) {
#pragma unroll
        for (int i = 0; i < 16; ++i) sacc[t2][g][i] = __builtin_amdgcn_exp2f(sacc[t2][g][i]);
#pragma unroll
        for (int s = 0; s < 2; ++s) {
          const int s8 = s * 8;
          u32x4 pk = {cvtpk(sacc[t2][g][s8], sacc[t2][g][s8 + 1]), cvtpk(sacc[t2][g][s8 + 2], sacc[t2][g][s8 + 3]),
                      cvtpk(sacc[t2][g][s8 + 4], sacc[t2][g][s8 + 5]), cvtpk(sacc[t2][g][s8 + 6], sacc[t2][g][s8 + 7])};
          pf[g][t2 * 2 + s] = __builtin_bit_cast(bf16x8, pk);
#pragma unroll
          for (int w = 0; w < 4; ++w) ps = fdot2(pk[w], 0x3F803F80u, ps);
        }
      }
      lrun[g] += ps;
    }
    __builtin_amdgcn_sched_barrier(0);
#pragma unroll
    for (int kp = 0; kp < 2; ++kp) {
      bf16x8 vf[2][2];
#pragma unroll
      for (int dt = 0; dt < 2; ++dt)
#pragma unroll
        for (int s = 0; s < 2; ++s) vf[dt][s] = *(const bf16x8*)(Vs + (dt * 32 + r) * VSTR2 + (kp * 2 + s) * 32 + h * 16);
#pragma unroll
      for (int s = 0; s < 2; ++s)
#pragma unroll
        for (int dt = 0; dt < 2; ++dt) {
          o[0][dt] = MFMA(vf[dt][s], pf[0][kp * 2 + s], o[0][dt]);
          o[1][dt] = MFMA(vf[dt][s], pf[1][kp * 2 + s], o[1][dt]);
        }
    }
    __builtin_amdgcn_sched_barrier(0);
    if (nxt) put(smem + (cur ^ 1) * ABUF2);
    __syncthreads();
    cur ^= 1;
  }
#pragma unroll
  for (int g = 0; g < 2; ++g) {
    const float lsum = swapsum32(lrun[g]);
    const float inv = 1.f / lsum;
    const int qrow = qrow0 + 32 * g;
    float ss = 0.f;
    u16* dst = p.MIX + (size_t)(tb + qrow) * 1024 + hh * 64;
#pragma unroll
    for (int dt = 0; dt < 2; ++dt)
#pragma unroll
      for (int g4 = 0; g4 < 4; ++g4) {
        float v[4];
#pragma unroll
        for (int jj = 0; jj < 4; ++jj) { v[jj] = o[g][dt][4 * g4 + jj] * inv; ss += v[jj] * v[jj]; }
        u32x2 ov = {cvtpk(v[0], v[1]), cvtpk(v[2], v[3])};
        *(u32x2*)(dst + dt * 32 + 8 * g4 + 4 * h) = ov;
      }
    ss = swapsum32(ss);
    if (h == 0) p.SSA[(size_t)(tb + qrow) * 8 + hh] = ss;
  }
}

DI void phase4(const Params& p, char* smem) {
    const int G = gridDim.x;
  if (p.misc[0] > 64.f) { for (int a = vblock(); a < 1536; a += G) attn_tile2<true>(p, smem, a); }
  else { for (int a = vblock(); a < 1536; a += G) attn_tile3(p, smem, a); }
  for (int tile = vblock(); tile < 1536; tile += G) {
    WAVE_COORDS_L
    int q, g, k1, S1, tb;
    if (tile < 512) { q = tile >> 8; g = (tile >> 6) & 3; k1 = tile & 63; S1 = 64; tb = q << 13; }
    else { const int b = tile - 512; q = 2 + (b >> 7); g = (b >> 5) & 3; k1 = b & 31; S1 = 32; tb = TP + ((q - 2) << 12); }
    f32x16 acc[2][2]; zero_acc(acc);
    const u16* A = p.G1 + (size_t)tb * 1024 + ((size_t)(g * 128) * S1 + k1) * 256;
    const u16* B = p.WB;
    const int rstride = S1 * 256;
    gemm_mainloop(acc, smem, [&](int rr) { return A + (size_t)rr * rstride; }, [&](int rr) { return B + (size_t)rr * 256; }, 0, 256);
#pragma unroll
    for (int ni = 0; ni < 2; ++ni) {
      const int k2 = wn * 64 + ni * 32 + r;
      const size_t tok = (size_t)(tb + k1 + S1 * k2);
      float ss = 0.f;
#pragma unroll
      for (int mi = 0; mi < 2; ++mi)
#pragma unroll
        for (int g4 = 0; g4 < 4; ++g4) {
          const int m = wm * 64 + mi * 32 + 8 * g4 + 4 * h;
          float v[4];
#pragma unroll
          for (int j = 0; j < 4; ++j) { v[j] = acc[mi][ni][4 * g4 + j]; ss += v[j] * v[j]; }
          u32x2 ov = {cvtpk(v[0], v[1]), cvtpk(v[2], v[3])};
          *(u32x2*)(p.MIX + tok * 1024 + 512 + g * 128 + m) = ov;
        }
      ss += __shfl_xor(ss, 32);
      if (h == 0) p.SSF[tok * 8 + g * 2 + wm] = ss;
    }
  }
}

DI void phase5(const Params& p, char* smem) {
    float* rs = (float*)(smem + 65536);
  const int G = gridDim.x;
  for (int tile = vblock(); tile < 384 * 8; tile += G) {
    WAVE_COORDS_L
    const int mt = tile >> 3, nt = tile & 7, m0 = mt * 128, n0 = nt * 128;
    __syncthreads();
    if (tid < 128) {
      const float* sa = p.SSA + (size_t)(m0 + tid) * 8; const float* sf = p.SSF + (size_t)(m0 + tid) * 8;
      const float ra = rsqrtf((sa[0] + sa[1] + sa[2] + sa[3] + sa[4] + sa[5] + sa[6] + sa[7]) * (1.f / 512.f) + EPS);
      const float rf = rsqrtf((sf[0] + sf[1] + sf[2] + sf[3] + sf[4] + sf[5] + sf[6] + sf[7]) * (1.f / 512.f) + EPS);
      rs[tid] = ra / rf; rs[128 + tid] = rf;
    }
    f32x16 acc[2][2]; zero_acc(acc);
    const u16* A = p.MIX + (size_t)m0 * 1024; const u16* B = p.WoutT + (size_t)n0 * 1024;
    auto af = [&](int rr) { return A + (size_t)rr * 1024; };
    auto bfn = [&](int rr) { return B + (size_t)rr * 1024; };
    gemm_mainloop<true>(acc, smem, af, bfn, 0, 512);
    {
      const float* rb = rs + wm * 64 + 4 * h;
#pragma unroll
      for (int mi = 0; mi < 2; ++mi)
#pragma unroll
        for (int i = 0; i < 16; ++i) {
          const float sc = rb[mi * 32 + (i & 3) + 8 * (i >> 2)];
          acc[mi][0][i] *= sc; acc[mi][1][i] *= sc;
        }
    }
    gemm_mainloop<true>(acc, smem, af, bfn, 512, 1024);
    {
      const float* rb = rs + 128 + wm * 64 + 4 * h;
      char* sb = smem + (wm * 64 + 4 * h) * 512 + (wn * 64 + r) * 4;
#pragma unroll
      for (int mi = 0; mi < 2; ++mi)
#pragma unroll
        for (int i = 0; i < 16; ++i) {
          const int ro = mi * 32 + (i & 3) + 8 * (i >> 2);
          const float sc = rb[ro];
#pragma unroll
          for (int ni = 0; ni < 2; ++ni) *(float*)(sb + ro * 512 + ni * 128) = acc[mi][ni][i] * sc;
        }
    }
    __syncthreads();
#pragma unroll 4
    for (int j = 0; j < 16; ++j) {
      const int id = tid + 256 * j, row = id >> 5, cc = id & 31;
      const int t = m0 + row, col = n0 + cc * 4;
      f32x4 v = *(const f32x4*)(smem + row * 512 + cc * 16);
      const f32x4 xv = *(const f32x4*)(xrow(p, t) + col);
      v[0] += xv[0]; v[1] += xv[1]; v[2] += xv[2]; v[3] += xv[3];
      *(f32x4*)(p.out + (size_t)t * 1024 + col) = v;
      u32x2 ob = {cvtpk(v[0], v[1]), cvtpk(v[2], v[3])};
      *(u32x2*)(p.X2b + (size_t)t * 1024 + col) = ob;
      float ss = v[0] * v[0] + v[1] * v[1] + v[2] * v[2] + v[3] * v[3];
      ss = red32(ss);
      if (cc == 0) p.SS2[(size_t)t * 16 + nt] = ss;
    }
  }
  const int gt = blockIdx.x * NTHR + threadIdx.x, gs = gridDim.x * NTHR;
  for (int id = gt; id < 16384 * 1024 / 16; id += gs) {
    const int d = (id & 63) * 16;
    u32x4 ou, ov;
#pragma unroll
    for (int k = 0; k < 4; ++k) {
      const f32x4 a = *(const f32x4*)(p.peer_u + (size_t)id * 16 + k * 4);
      const f32x4 g = *(const f32x4*)(p.ffn_norm_g + d + k * 4);
      const f32x4 b = *(const f32x4*)(p.peer_v + (size_t)id * 16 + k * 4);
      float u0 = fminf(fmaxf(a[0] * g[0] * USCALE, -448.f), 448.f), u1 = fminf(fmaxf(a[1] * g[1] * USCALE, -448.f), 448.f);
      float u2 = fminf(fmaxf(a[2] * g[2] * USCALE, -448.f), 448.f), u3 = fminf(fmaxf(a[3] * g[3] * USCALE, -448.f), 448.f);
      float v0 = fminf(fmaxf(b[0] * VSCALE, -448.f), 448.f), v1 = fminf(fmaxf(b[1] * VSCALE, -448.f), 448.f);
      float v2 = fminf(fmaxf(b[2] * VSCALE, -448.f), 448.f), v3 = fminf(fmaxf(b[3] * VSCALE, -448.f), 448.f);
      int pu = __builtin_amdgcn_cvt_pk_fp8_f32(u0, u1, 0, false); pu = __builtin_amdgcn_cvt_pk_fp8_f32(u2, u3, pu, true);
      int pv = __builtin_amdgcn_cvt_pk_fp8_f32(v0, v1, 0, false); pv = __builtin_amdgcn_cvt_pk_fp8_f32(v2, v3, pv, true);
      ou[k] = (unsigned)pu; ov[k] = (unsigned)pv;
    }
    {
      const int e = id >> 6, ch = id & 63;
      const size_t o = ((size_t)(ch >> 3) * 16384 + e) * 128 + (ch & 7) * 16;
      *(u32x4*)(p.U8 + o) = ou;
      *(u32x4*)(p.V8 + o) = ov;
    }
  }
}

DI void phase6(const Params& p, char* smem) {
    const int G = gridDim.x;
  for (int tile = vblock(); tile < 384 * 16; tile += G) {
    WAVE_COORDS_L
    const int mt = tile >> 4, nt = tile & 15, m0 = mt * 128, n0 = nt * 128;
    f32x16 acc[2][2]; zero_acc(acc);
    __syncthreads();
    const u16* A = p.X2b + (size_t)m0 * 1024; const u16* B = p.WpqT + (size_t)n0 * 1024;
    gemm_mainloop<true>(acc, smem, [&](int rr) { return A + (size_t)rr * 1024; }, [&](int rr) { return B + (size_t)rr * 1024; }, 0, 1024);
    stage_bf16_t<false>(smem, acc, nullptr, wm, wn, r, h);
    __syncthreads();
#pragma unroll
    for (int j = 0; j < 8; ++j) {
      const int id = tid + 256 * j, row = id >> 4, cc = id & 15;
      *(u32x4*)(p.Qp + (size_t)(m0 + row) * 2048 + n0 + cc * 8) = *(const u32x4*)(smem + row * SROW + cc * 16);
    }
  }
}

DI void ins16(float (&top)[16], float x) {
#pragma unroll
  for (int j = 0; j < 16; ++j) { const float hi = fmaxf(top[j], x); x = fminf(top[j], x); top[j] = hi; }
}
DI float mask7(float x) { return __uint_as_float(__float_as_uint(x) & ~0x7Fu); }

#define CE16(a, b) { const float hi_ = fmaxf(a, b); b = fminf(a, b); a = hi_; }
DI void sort16_desc(float (&x)[16]) {
  CE16(x[0], x[1])
  CE16(x[3], x[2])
  CE16(x[4], x[5])
  CE16(x[7], x[6])
  CE16(x[8], x[9])
  CE16(x[11], x[10])
  CE16(x[12], x[13])
  CE16(x[15], x[14])
  CE16(x[0], x[2])
  CE16(x[1], x[3])
  CE16(x[6], x[4])
  CE16(x[7], x[5])
  CE16(x[8], x[10])
  CE16(x[9], x[11])
  CE16(x[14], x[12])
  CE16(x[15], x[13])
  CE16(x[0], x[1])
  CE16(x[2], x[3])
  CE16(x[5], x[4])
  CE16(x[7], x[6])
  CE16(x[8], x[9])
  CE16(x[10], x[11])
  CE16(x[13], x[12])
  CE16(x[15], x[14])
  CE16(x[0], x[4])
  CE16(x[1], x[5])
  CE16(x[2], x[6])
  CE16(x[3], x[7])
  CE16(x[12], x[8])
  CE16(x[13], x[9])
  CE16(x[14], x[10])
  CE16(x[15], x[11])
  CE16(x[0], x[2])
  CE16(x[1], x[3])
  CE16(x[4], x[6])
  CE16(x[5], x[7])
  CE16(x[10], x[8])
  CE16(x[11], x[9])
  CE16(x[14], x[12])
  CE16(x[15], x[13])
  CE16(x[0], x[1])
  CE16(x[2], x[3])
  CE16(x[4], x[5])
  CE16(x[6], x[7])
  CE16(x[9], x[8])
  CE16(x[11], x[10])
  CE16(x[13], x[12])
  CE16(x[15], x[14])
  CE16(x[0], x[8])
  CE16(x[1], x[9])
  CE16(x[2], x[10])
  CE16(x[3], x[11])
  CE16(x[4], x[12])
  CE16(x[5], x[13])
  CE16(x[6], x[14])
  CE16(x[7], x[15])
  CE16(x[0], x[4])
  CE16(x[1], x[5])
  CE16(x[2], x[6])
  CE16(x[3], x[7])
  CE16(x[8], x[12])
  CE16(x[9], x[13])
  CE16(x[10], x[14])
  CE16(x[11], x[15])
  CE16(x[0], x[2])
  CE16(x[1], x[3])
  CE16(x[4], x[6])
  CE16(x[5], x[7])
  CE16(x[8], x[10])
  CE16(x[9], x[11])
  CE16(x[12], x[14])
  CE16(x[13], x[15])
  CE16(x[0], x[1])
  CE16(x[2], x[3])
  CE16(x[4], x[5])
  CE16(x[6], x[7])
  CE16(x[8], x[9])
  CE16(x[10], x[11])
  CE16(x[12], x[13])
  CE16(x[14], x[15])
}
DI void bmerge16_desc(float (&x)[16]) {
  CE16(x[0], x[8])
  CE16(x[1], x[9])
  CE16(x[2], x[10])
  CE16(x[3], x[11])
  CE16(x[4], x[12])
  CE16(x[5], x[13])
  CE16(x[6], x[14])
  CE16(x[7], x[15])
  CE16(x[0], x[4])
  CE16(x[1], x[5])
  CE16(x[2], x[6])
  CE16(x[3], x[7])
  CE16(x[8], x[12])
  CE16(x[9], x[13])
  CE16(x[10], x[14])
  CE16(x[11], x[15])
  CE16(x[0], x[2])
  CE16(x[1], x[3])
  CE16(x[4], x[6])
  CE16(x[5], x[7])
  CE16(x[8], x[10])
  CE16(x[9], x[11])
  CE16(x[12], x[14])
  CE16(x[13], x[15])
  CE16(x[0], x[1])
  CE16(x[2], x[3])
  CE16(x[4], x[5])
  CE16(x[6], x[7])
  CE16(x[8], x[9])
  CE16(x[10], x[11])
  CE16(x[12], x[13])
  CE16(x[14], x[15])
}
DI void top16_merge(float (&A)[16], const float (&B)[16]) {
#pragma unroll
  for (int i = 0; i < 16; ++i) A[i] = fmaxf(A[i], B[15 - i]);
  bmerge16_desc(A);
}

DI void score_top16(const Params& p, const char* sklds, int t, int hh, int c, int r, int h, float (&top)[16]) {
  f32x16 acc[4];
#pragma unroll
  for (int n = 0; n < 4; ++n)
#pragma unroll
    for (int i = 0; i < 16; ++i) acc[n][i] = 0.f;
  const u16* qp = p.Qp + (size_t)t * 2048 + (hh * 2 + c) * 128 + h * 8;
  const char* skb = sklds + c * 32768 + r * 256;
  const int hx = h ^ (r & 15);
  bf16x8 bq[8];
#pragma unroll
  for (int ks = 0; ks < 8; ++ks) bq[ks] = *(const bf16x8*)(qp + ks * 16);
#pragma unroll
  for (int n = 0; n < 4; ++n) {
    bf16x8 fa[8];
#pragma unroll
    for (int ks = 0; ks < 8; ++ks) fa[ks] = *(const bf16x8*)(skb + n * 8192 + (((ks * 2) ^ hx) << 4));
    __builtin_amdgcn_sched_barrier(0);
#pragma unroll
    for (int ks = 0; ks < 8; ++ks) acc[n] = MFMA(fa[ks], bq[ks], acc[n]);
    __builtin_amdgcn_sched_barrier(0);
  }
  float k1[16], k2[16], k3[16];
#pragma unroll
  for (int i = 0; i < 16; ++i) {
    const unsigned ci = (unsigned)crow(i, h);
    top[i] = __uint_as_float((__float_as_uint(acc[0][i]) & ~0x7Fu) | ci);
    k1[i] = __uint_as_float((__float_as_uint(acc[1][i]) & ~0x7Fu) | (32u + ci));
    k2[i] = __uint_as_float((__float_as_uint(acc[2][i]) & ~0x7Fu) | (64u + ci));
    k3[i] = __uint_as_float((__float_as_uint(acc[3][i]) & ~0x7Fu) | (96u + ci));
  }
  sort16_desc(top); sort16_desc(k1); sort16_desc(k2); sort16_desc(k3);
  top16_merge(top, k1); top16_merge(k2, k3); top16_merge(top, k2);
  float oth[16];
#pragma unroll
  for (int j = 0; j < 16; ++j) oth[j] = __shfl_xor(top[j], 32);
  top16_merge(top, oth);
}

DI void phase7(const Params& p, char* smem) {
  WAVE_COORDS
  const int G = gridDim.x;
  volatile unsigned* lw = (volatile unsigned*)(smem + 65536 + 2048 + wave * 1024);
  volatile unsigned char* lb = (volatile unsigned char*)(smem + 65536 + 2048 + wave * 1024);
  const float NEG_INF = __uint_as_float(0xFF800000u);
  const int hh = blockIdx.x & 7, slot = blockIdx.x >> 3, nslot = G >> 3;
  __syncthreads();
  {
    const u16* src = p.SK + (size_t)hh * 2 * 16384;
#pragma unroll 2
    for (int i = 0; i < 16; ++i) {
      const int id = tid + 256 * i;
      const int row = id >> 4, ch = id & 15;
      const u32x4 v = *(const u32x4*)(src + (size_t)row * 128 + ch * 8);
      *(u32x4*)(smem + row * 256 + ((ch ^ (row & 15)) << 4)) = v;
    }
  }
  __syncthreads();
  for (int grp = slot * 4 + wave; grp < 1536; grp += nslot * 4) {
    const int tok0 = grp * 32;
    const int t = tok0 + r;
    float L0[16], L1[16];
    score_top16(p, smem, t, hh, 0, r, h, L0);
    score_top16(p, smem, t, hh, 1, r, h, L1);
    float ct[16], cb[16];
    {
      float ck[50];
    ck[0] = __uint_as_float((__float_as_uint(mask7(L0[0]) + mask7(L1[0])) & ~0xFFu) | 0u);
    ck[1] = __uint_as_float((__float_as_uint(mask7(L0[0]) + mask7(L1[1])) & ~0xFFu) | 1u);
    ck[2] = __uint_as_float((__float_as_uint(mask7(L0[0]) + mask7(L1[2])) & ~0xFFu) | 2u);
    ck[3] = __uint_as_float((__float_as_uint(mask7(L0[0]) + mask7(L1[3])) & ~0xFFu) | 3u);
    ck[4] = __uint_as_float((__float_as_uint(mask7(L0[0]) + mask7(L1[4])) & ~0xFFu) | 4u);
    ck[5] = __uint_as_float((__float_as_uint(mask7(L0[0]) + mask7(L1[5])) & ~0xFFu) | 5u);
    ck[6] = __uint_as_float((__float_as_uint(mask7(L0[0]) + mask7(L1[6])) & ~0xFFu) | 6u);
    ck[7] = __uint_as_float((__float_as_uint(mask7(L0[0]) + mask7(L1[7])) & ~0xFFu) | 7u);
    ck[8] = __uint_as_float((__float_as_uint(mask7(L0[0]) + mask7(L1[8])) & ~0xFFu) | 8u);
    ck[9] = __uint_as_float((__float_as_uint(mask7(L0[0]) + mask7(L1[9])) & ~0xFFu) | 9u);
    ck[10] = __uint_as_float((__float_as_uint(mask7(L0[0]) + mask7(L1[10])) & ~0xFFu) | 10u);
    ck[11] = __uint_as_float((__float_as_uint(mask7(L0[0]) + mask7(L1[11])) & ~0xFFu) | 11u);
    ck[12] = __uint_as_float((__float_as_uint(mask7(L0[0]) + mask7(L1[12])) & ~0xFFu) | 12u);
    ck[13] = __uint_as_float((__float_as_uint(mask7(L0[0]) + mask7(L1[13])) & ~0xFFu) | 13u);
    ck[14] = __uint_as_float((__float_as_uint(mask7(L0[0]) + mask7(L1[14])) & ~0xFFu) | 14u);
    ck[15] = __uint_as_float((__float_as_uint(mask7(L0[0]) + mask7(L1[15])) & ~0xFFu) | 15u);
    ck[16] = __uint_as_float((__float_as_uint(mask7(L0[1]) + mask7(L1[0])) & ~0xFFu) | 16u);
    ck[17] = __uint_as_float((__float_as_uint(mask7(L0[1]) + mask7(L1[1])) & ~0xFFu) | 17u);
    ck[18] = __uint_as_float((__float_as_uint(mask7(L0[1]) + mask7(L1[2])) & ~0xFFu) | 18u);
    ck[19] = __uint_as_float((__float_as_uint(mask7(L0[1]) + mask7(L1[3])) & ~0xFFu) | 19u);
    ck[20] = __uint_as_float((__float_as_uint(mask7(L0[1]) + mask7(L1[4])) & ~0xFFu) | 20u);
    ck[21] = __uint_as_float((__float_as_uint(mask7(L0[1]) + mask7(L1[5])) & ~0xFFu) | 21u);
    ck[22] = __uint_as_float((__float_as_uint(mask7(L0[1]) + mask7(L1[6])) & ~0xFFu) | 22u);
    ck[23] = __uint_as_float((__float_as_uint(mask7(L0[1]) + mask7(L1[7])) & ~0xFFu) | 23u);
    ck[24] = __uint_as_float((__float_as_uint(mask7(L0[2]) + mask7(L1[0])) & ~0xFFu) | 32u);
    ck[25] = __uint_as_float((__float_as_uint(mask7(L0[2]) + mask7(L1[1])) & ~0xFFu) | 33u);
    ck[26] = __uint_as_float((__float_as_uint(mask7(L0[2]) + mask7(L1[2])) & ~0xFFu) | 34u);
    ck[27] = __uint_as_float((__float_as_uint(mask7(L0[2]) + mask7(L1[3])) & ~0xFFu) | 35u);
    ck[28] = __uint_as_float((__float_as_uint(mask7(L0[2]) + mask7(L1[4])) & ~0xFFu) | 36u);
    ck[29] = __uint_as_float((__float_as_uint(mask7(L0[3]) + mask7(L1[0])) & ~0xFFu) | 48u);
    ck[30] = __uint_as_float((__float_as_uint(mask7(L0[3]) + mask7(L1[1])) & ~0xFFu) | 49u);
    ck[31] = __uint_as_float((__float_as_uint(mask7(L0[3]) + mask7(L1[2])) & ~0xFFu) | 50u);
    ck[32] = __uint_as_float((__float_as_uint(mask7(L0[3]) + mask7(L1[3])) & ~0xFFu) | 51u);
    ck[33] = __uint_as_float((__float_as_uint(mask7(L0[4]) + mask7(L1[0])) & ~0xFFu) | 64u);
    ck[34] = __uint_as_float((__float_as_uint(mask7(L0[4]) + mask7(L1[1])) & ~0xFFu) | 65u);
    ck[35] = __uint_as_float((__float_as_uint(mask7(L0[4]) + mask7(L1[2])) & ~0xFFu) | 66u);
    ck[36] = __uint_as_float((__float_as_uint(mask7(L0[5]) + mask7(L1[0])) & ~0xFFu) | 80u);
    ck[37] = __uint_as_float((__float_as_uint(mask7(L0[5]) + mask7(L1[1])) & ~0xFFu) | 81u);
    ck[38] = __uint_as_float((__float_as_uint(mask7(L0[6]) + mask7(L1[0])) & ~0xFFu) | 96u);
    ck[39] = __uint_as_float((__float_as_uint(mask7(L0[6]) + mask7(L1[1])) & ~0xFFu) | 97u);
    ck[40] = __uint_as_float((__float_as_uint(mask7(L0[7]) + mask7(L1[0])) & ~0xFFu) | 112u);
    ck[41] = __uint_as_float((__float_as_uint(mask7(L0[7]) + mask7(L1[1])) & ~0xFFu) | 113u);
    ck[42] = __uint_as_float((__float_as_uint(mask7(L0[8]) + mask7(L1[0])) & ~0xFFu) | 128u);
    ck[43] = __uint_as_float((__float_as_uint(mask7(L0[9]) + mask7(L1[0])) & ~0xFFu) | 144u);
    ck[44] = __uint_as_float((__float_as_uint(mask7(L0[10]) + mask7(L1[0])) & ~0xFFu) | 160u);
    ck[45] = __uint_as_float((__float_as_uint(mask7(L0[11]) + mask7(L1[0])) & ~0xFFu) | 176u);
    ck[46] = __uint_as_float((__float_as_uint(mask7(L0[12]) + mask7(L1[0])) & ~0xFFu) | 192u);
    ck[47] = __uint_as_float((__float_as_uint(mask7(L0[13]) + mask7(L1[0])) & ~0xFFu) | 208u);
    ck[48] = __uint_as_float((__float_as_uint(mask7(L0[14]) + mask7(L1[0])) & ~0xFFu) | 224u);
    ck[49] = __uint_as_float((__float_as_uint(mask7(L0[15]) + mask7(L1[0])) & ~0xFFu) | 240u);
      const float NINF = __uint_as_float(0xFF800000u);
#pragma unroll
      for (int q = 0; q < 25; ++q) {
        float a_ = ck[q], b_ = ck[25 + q];
        asm volatile("" : "+v"(a_), "+v"(b_));
        const float m = h ? b_ : a_;
        if (q < 16) ct[q] = m; else cb[q - 16] = m;
      }
#pragma unroll
      for (int q = 9; q < 16; ++q) cb[q] = NINF;
      sort16_desc(ct); sort16_desc(cb);
      top16_merge(ct, cb);
#pragma unroll
      for (int q = 0; q < 16; ++q) cb[q] = __shfl_xor(ct[q], 32);
      top16_merge(ct, cb);
    }
    if (h == 0) {
#pragma unroll
      for (int w = 0; w < 4; ++w) {
        unsigned v = 0, v2 = 0;
#pragma unroll
        for (int b = 0; b < 4; ++b) {
          v |= (__float_as_uint(L0[w * 4 + b]) & 0x7Fu) << (8 * b);
          v2 |= (__float_as_uint(L1[w * 4 + b]) & 0x7Fu) << (8 * b);
        }
        lw[r * 8 + w] = v;
        lw[r * 8 + 4 + w] = v2;
      }
    }
    __builtin_amdgcn_wave_barrier();
    const float* s2 = p.SS2 + (size_t)t * 16;
    float ssum = 0.f;
#pragma unroll
    for (int j = 0; j < 8; ++j) ssum += s2[j];
    const float r2 = rsqrtf(ssum * (1.f / 1024.f) + EPS);
    float gv[16];
    const float v0 = __uint_as_float(__float_as_uint(ct[0]) & ~0xFFu) * r2;
    float esum = 0.f;
#pragma unroll
    for (int j = 0; j < 16; ++j) {
      const float vj = __uint_as_float(__float_as_uint(ct[j]) & ~0xFFu) * r2;
      gv[j] = __builtin_amdgcn_exp2f((vj - v0) * 1.4426950408889634f);
      esum += gv[j];
    }
    const float einv = 1.f / esum;
    u32x4 oi[2]; f32x4 og[2];
#pragma unroll
    for (int jj = 0; jj < 8; ++jj) {
      float ka = ct[jj], kb = ct[8 + jj], ga = gv[jj], gb = gv[8 + jj];
      asm volatile("" : "+v"(ka), "+v"(kb), "+v"(ga), "+v"(gb));
      const float key = h ? kb : ka;
      const float g = (h ? gb : ga) * einv;
      const unsigned code = __float_as_uint(key) & 0xFFu;
      const unsigned i1 = lb[r * 32 + (code >> 4)], i2 = lb[r * 32 + 16 + (code & 15)];
      oi[jj >> 2][jj & 3] = i1 * 128 + i2;
      og[jj >> 2][jj & 3] = g;
    }
    int* ip = p.IDX + (size_t)t * 128 + hh * 16 + h * 8;
    float* gp = p.G + (size_t)t * 128 + hh * 16 + h * 8;
    *(u32x4*)ip = oi[0]; *(u32x4*)(ip + 4) = oi[1];
    *(f32x4*)gp = og[0]; *(f32x4*)(gp + 4) = og[1];
    __builtin_amdgcn_wave_barrier();
  }
}

DI float gelu_tanh(float x) {
  const float u = 0.7978845608028654f * (x + 0.044715f * x * x * x);
  const float e = __builtin_amdgcn_exp2f(u * 2.8853900817779268f);
  const float th = 1.f - 2.f * __builtin_amdgcn_rcpf(e + 1.f);
  return 0.5f * x * (1.f + th);
}
DI float dot16_fp8(const u32x4& w, const u32x4& xa, const u32x4& xb) {
  float acc = 0.f;
#pragma unroll
  for (int k = 0; k < 4; ++k) {
    const bf2_t b0 = __builtin_amdgcn_cvt_scalef32_pk_bf16_fp8(w[k], 1.0f, false);
    const bf2_t b1 = __builtin_amdgcn_cvt_scalef32_pk_bf16_fp8(w[k], 1.0f, true);
    const unsigned x0 = (k < 2) ? xa[2 * k] : xb[2 * k - 4], x1 = (k < 2) ? xa[2 * k + 1] : xb[2 * k - 3];
    acc = __builtin_amdgcn_fdot2_f32_bf16(b0, __builtin_bit_cast(bf2_t, x0), acc, false);
    acc = __builtin_amdgcn_fdot2_f32_bf16(b1, __builtin_bit_cast(bf2_t, x1), acc, false);
  }
  return acc;
}

template <int CTRL>
DI float dppf(float x) { return __uint_as_float(__builtin_amdgcn_update_dpp(0u, __float_as_uint(x), CTRL, 0xF, 0xF, false)); }
DI float swap32sum(float a, float b) {
  auto rr = __builtin_amdgcn_permlane32_swap(__float_as_uint(a), __float_as_uint(b), false, false);
  return __uint_as_float(rr[0]) + __uint_as_float(rr[1]);
}
DI float swap16sum(float a, float b) {
  auto rr = __builtin_amdgcn_permlane16_swap(__float_as_uint(a), __float_as_uint(b), false, false);
  return __uint_as_float(rr[0]) + __uint_as_float(rr[1]);
}
struct P8Buf { u32x4 w[16]; u32x4 xa, xb; };

DI void p8_load_idx(const Params& p, int t, int j, u32x4 (&ix)[4]) {
  const int* ip = p.IDX + (size_t)t * 128 + j * 16;
#pragma unroll
  for (int q = 0; q < 4; ++q) ix[q] = *(const u32x4*)(ip + q * 4);
}
DI void p8_load_rows(const unsigned char* tab, int s, int cc, const u32x4 (&ix)[4], u32x4 (&w)[16]) {
  const unsigned char* base = tab + (size_t)s * (16384 * 128) + cc * 16;
#pragma unroll
  for (int i = 0; i < 16; ++i) w[i] = *(const u32x4*)(base + (size_t)ix[i >> 2][i & 3] * 128);
}

DI void phase8(const Params& p, char* smem, const int tbase) {
  WAVE_COORDS
  const int G = gridDim.x;
  const int gw = vblock() * 4 + wave, NW = G * 4;
  const int j = lane >> 3, cc = lane & 7;
  const bool b0 = lane & 1, b1 = lane & 2, b2 = lane & 4, b3 = lane & 8, b4 = lane & 16, b5 = lane & 32;
  f32x2* part = (f32x2*)(smem + wave * 12288) + lane;
  const float* coefl = (const float*)(smem + wave * 12288);
  const int ntok_all = (T_TOK - gw + NW - 1) / NW;
  const int ntok = min(24, ntok_all - tbase);
  const int gw0 = gw + tbase * NW;
  if (ntok <= 0) return;
  for (int s = 0; s < 8; ++s) {
    u32x4 ixA[4], ixB[4];
    u32x4 wA[16], wB[16];
    u32x4 xaA, xbA, xaB, xbB;
    auto issue = [&](int i, u32x4 (&ix)[4], u32x4 (&w)[16], u32x4& xa, u32x4& xb) {
      const int t = gw0 + i * NW;
      const u16* xr = p.X2b + (size_t)t * 1024 + s * 128 + cc * 16;
      xa = *(const u32x4*)xr; xb = *(const u32x4*)(xr + 8);
      p8_load_rows(p.U8, s, cc, ix, w);
    };
    auto compute = [&](int i, u32x4 (&w)[16], u32x4& xa, u32x4& xb) {
      float d[16];
#pragma unroll
      for (int q = 0; q < 16; ++q) d[q] = dot16_fp8(w[q], xa, xb);
      float v8[8], v4[4], v2[2];
#pragma unroll
      for (int m = 0; m < 8; ++m) { const float mine = b2 ? d[m + 8] : d[m], send = b2 ? d[m] : d[m + 8]; v8[m] = mine + dppf<0x141>(send); }
#pragma unroll
      for (int m = 0; m < 4; ++m) { const float mine = b1 ? v8[m + 4] : v8[m], send = b1 ? v8[m] : v8[m + 4]; v4[m] = mine + dppf<0x4E>(send); }
#pragma unroll
      for (int m = 0; m < 2; ++m) { const float mine = b0 ? v4[m + 2] : v4[m], send = b0 ? v4[m] : v4[m + 2]; v2[m] = mine + dppf<0xB1>(send); }
      f32x2 acc = {v2[0], v2[1]};
      if (s > 0) { const f32x2 o = part[i * 64]; acc[0] += o[0]; acc[1] += o[1]; }
      part[i * 64] = acc;
    };
    p8_load_idx(p, gw0, j, ixA);
    issue(0, ixA, wA, xaA, xbA);
    if (ntok > 1) p8_load_idx(p, gw0 + NW, j, ixB);
#pragma unroll 1
    for (int i = 0; i < ntok; i += 2) {
      if (i + 1 < ntok) issue(i + 1, ixB, wB, xaB, xbB);
      if (i + 2 < ntok) p8_load_idx(p, gw0 + (i + 2) * NW, j, ixA);
      __builtin_amdgcn_sched_barrier(0);
      compute(i, wA, xaA, xbA);
      __builtin_amdgcn_sched_barrier(0);
      if (i + 1 < ntok) {
        if (i + 2 < ntok) issue(i + 2, ixA, wA, xaA, xbA);
        if (i + 3 < ntok) p8_load_idx(p, gw0 + (i + 3) * NW, j, ixB);
        __builtin_amdgcn_sched_barrier(0);
        compute(i + 1, wB, xaB, xbB);
        __builtin_amdgcn_sched_barrier(0);
      }
    }
  }
  for (int i = 0; i < ntok; ++i) {
    const int t = gw0 + i * NW;
    const float* s2 = p.SS2 + (size_t)t * 16;
    float ssum = 0.f;
#pragma unroll
    for (int q = 0; q < 8; ++q) ssum += s2[q];
    const float r2 = rsqrtf(ssum * (1.f / 1024.f) + EPS) * (1.f / USCALE);
    const f32x2 g = *(const f32x2*)(p.G + (size_t)t * 128 + lane * 2);
    f32x2 a = part[i * 64];
    a[0] = gelu_tanh(a[0] * r2) * g[0] * (1.f / VSCALE);
    a[1] = gelu_tanh(a[1] * r2) * g[1] * (1.f / VSCALE);
    part[i * 64] = a;
  }
  asm volatile("" ::: "memory");
  __builtin_amdgcn_wave_barrier();
  for (int s = 0; s < 8; ++s) {
    u32x4 ixA[4], ixB[4];
    u32x4 wA[16], wB[16];
    auto compute = [&](int i, u32x4 (&w)[16]) {
      const int t = gw0 + i * NW;
      const float* cp = coefl + i * 128 + j * 16;
      f32x4 cf[4];
#pragma unroll
      for (int q = 0; q < 4; ++q) cf[q] = *(const f32x4*)(cp + q * 4);
      f32x2 acc2[8];
#pragma unroll
      for (int e = 0; e < 8; ++e) acc2[e] = f32x2{0.f, 0.f};
#pragma unroll
      for (int q = 0; q < 16; ++q) {
        const float cq = cf[q >> 2][q & 3];
        const f32x2 c2 = {cq, cq};
#pragma unroll
        for (int k = 0; k < 4; ++k) {
          const f32x2 lo = __builtin_amdgcn_cvt_pk_f32_fp8((int)w[q][k], false);
          const f32x2 hi = __builtin_amdgcn_cvt_pk_f32_fp8((int)w[q][k], true);
          acc2[2 * k] = __builtin_elementwise_fma(lo, c2, acc2[2 * k]);
          acc2[2 * k + 1] = __builtin_elementwise_fma(hi, c2, acc2[2 * k + 1]);
        }
      }
      float acc[16];
#pragma unroll
      for (int e = 0; e < 8; ++e) { acc[2 * e] = acc2[e][0]; acc[2 * e + 1] = acc2[e][1]; }
      float v8[8], v4[4], v2[2];
#pragma unroll
      for (int m = 0; m < 8; ++m) v8[m] = swap32sum(acc[m], acc[m + 8]);
#pragma unroll
      for (int m = 0; m < 4; ++m) v4[m] = swap16sum(v8[m], v8[m + 4]);
#pragma unroll
      for (int m = 0; m < 2; ++m) { const float mine = b3 ? v4[m + 2] : v4[m], send = b3 ? v4[m] : v4[m + 2]; v2[m] = mine + dppf<0x128>(send); }
      float* op = p.out + (size_t)t * 1024 + s * 128 + cc * 16 + 2 * j;
      f32x2 o = *(f32x2*)op;
      o[0] += v2[0]; o[1] += v2[1];
      *(f32x2*)op = o;
    };
    p8_load_idx(p, gw0, j, ixA);
    p8_load_rows(p.V8, s, cc, ixA, wA);
    if (ntok > 1) p8_load_idx(p, gw0 + NW, j, ixB);
#pragma unroll 1
    for (int i = 0; i < ntok; i += 2) {
      if (i + 1 < ntok) p8_load_rows(p.V8, s, cc, ixB, wB);
      if (i + 2 < ntok) p8_load_idx(p, gw0 + (i + 2) * NW, j, ixA);
      __builtin_amdgcn_sched_barrier(0);
      compute(i, wA);
      __builtin_amdgcn_sched_barrier(0);
      if (i + 1 < ntok) {
        if (i + 2 < ntok) p8_load_rows(p.V8, s, cc, ixA, wA);
        if (i + 3 < ntok) p8_load_idx(p, gw0 + (i + 3) * NW, j, ixB);
        __builtin_amdgcn_sched_barrier(0);
        compute(i + 1, wB);
        __builtin_amdgcn_sched_barrier(0);
      }
    }
  }
  asm volatile("" ::: "memory");
  __builtin_amdgcn_wave_barrier();
}

extern __shared__ __attribute__((aligned(16))) char dyn_smem[];

DI void run_phase(const Params& p, int ph, char* smem) {
  switch (ph) {
    case 0: phase0(p); break;
    case 1: phase1(p, smem); break;
    case 2: phase2(p, smem); break;
    case 3: phase3(p, smem); break;
    case 4: phase4(p, smem); break;
    case 5: phase5(p, smem); break;
    case 6: phase6(p, smem); break;
    case 7: phase7(p, smem); break;
    default: phase8(p, smem, 0); break;
  }
}


#define XB_TMO      128
#define XB_XCNT(j)  (256  + 64 * (j))
#define XB_XSUB(j)  (1280 + 64 * (j))
#define XB_XGEN(j)  (2304 + 64 * (j))
#define XB_TOP      3328
#define XB_TOPGEN   3392
#define XCD_BAR_WORDS 3456
#define XB_SPIN_CAP (1u << 22)
#define LAS __attribute__((address_space(3)))
DI unsigned xb_ld(unsigned* p) { return __hip_atomic_load(p, __ATOMIC_RELAXED, __HIP_MEMORY_SCOPE_AGENT); }
DI unsigned xb_add(unsigned* p, unsigned v) { return __hip_atomic_fetch_add(p, v, __ATOMIC_RELAXED, __HIP_MEMORY_SCOPE_AGENT); }
DI unsigned xb_xcc_id() { return (unsigned)__builtin_amdgcn_s_getreg((3 << 11) | 20) & 0xFu; }
#define XB_SPIN(cond, bar) do { unsigned _sp = 0; while (cond) { __builtin_amdgcn_s_sleep(1); \
    if ((++_sp & 255u) == 0u) { if (xb_ld(&(bar)[XB_TMO])) break; if (_sp > XB_SPIN_CAP) { atomicAdd(&(bar)[XB_TMO], 1u); break; } } } } while (0)
struct XcdBarrier { unsigned* bar; unsigned x; volatile LAS unsigned* st; };
DI XcdBarrier xcd_barrier_post(unsigned* bar, volatile LAS unsigned* st) {
  XcdBarrier b; b.bar = bar; b.x = xb_xcc_id(); b.st = st;
  if (threadIdx.x == 0) (void)xb_add(&bar[XB_XCNT(b.x)], 1u);
  return b;
}
DI void xcd_barrier_complete(unsigned* bar, unsigned x, unsigned& nloc, unsigned& nx) {
  const unsigned G = gridDim.x * gridDim.y * gridDim.z;
  unsigned sum, cnt, mine, sp = 0u;
  for (;;) {
    sum = 0u; cnt = 0u; mine = 0u;
#pragma unroll
    for (unsigned j = 0; j < 16; ++j) { const unsigned c = xb_ld(&bar[XB_XCNT(j)]); sum += c; cnt += (c > 0u) ? 1u : 0u; mine = (j == x) ? c : mine; }
    if (sum == G) break;
    __builtin_amdgcn_s_sleep(1);
    if ((++sp & 255u) == 0u) { if (xb_ld(&bar[XB_TMO])) break; if (sp > XB_SPIN_CAP) { atomicAdd(&bar[XB_TMO], 1u); break; } }
  }
  nloc = mine > 0u ? mine : 1u; nx = cnt > 0u ? cnt : 1u;
}
DI void xcd_barrier(const XcdBarrier& b) {
  asm volatile("s_waitcnt vmcnt(0)" ::: "memory");
  __syncthreads();
  if (threadIdx.x == 0) {
    unsigned* bar = b.bar;
    __builtin_amdgcn_s_waitcnt(0);
    unsigned nloc = b.st[0], nx = b.st[1];
    if (nloc == 0u) { xcd_barrier_complete(bar, b.x, nloc, nx); b.st[0] = nloc; b.st[1] = nx; }
    const unsigned old = xb_add(&bar[XB_XSUB(b.x)], 1u);
    const unsigned gen = old / nloc;
    if (old + 1u == (gen + 1u) * nloc) {
      __builtin_amdgcn_fence(__ATOMIC_RELEASE, "agent");
      asm volatile("s_waitcnt vmcnt(0)" ::: "memory");
      const unsigned og = xb_add(&bar[XB_TOP], 1u);
      const unsigned tg = og / nx;
      if (og + 1u == (tg + 1u) * nx) xb_add(&bar[XB_TOPGEN], 1u);
      else XB_SPIN(xb_ld(&bar[XB_TOPGEN]) == tg, bar);
      __builtin_amdgcn_fence(__ATOMIC_ACQUIRE, "agent");
      xb_add(&bar[XB_XGEN(b.x)], 1u);
      asm volatile("s_waitcnt vmcnt(0)" ::: "memory");
    } else {
      XB_SPIN(xb_ld(&bar[XB_XGEN(b.x)]) == gen, bar);
      __builtin_amdgcn_fence(__ATOMIC_ACQUIRE, "agent");
      asm volatile("s_waitcnt vmcnt(0)" ::: "memory");
    }
  }
  __syncthreads();
}

#if MK_COOP
__global__ void __launch_bounds__(NTHR, 2) mega_kernel(Params p) {
  cg::grid_group grid = cg::this_grid();
#ifndef PROBE_PH
#define PROBE_PH -1
#endif
  volatile LAS unsigned* st = (volatile LAS unsigned*)(dyn_smem + 65536 + 1024);
  if (threadIdx.x < 4) st[threadIdx.x] = 0u;
  for (int i = blockIdx.x * NTHR + threadIdx.x; i < XCD_BAR_WORDS; i += gridDim.x * NTHR) p.bar[i] = 0u;
  phase0(p);
  grid.sync();
  XcdBarrier xb = xcd_barrier_post(p.bar, st);
#define RUNP(k, call) call; xcd_barrier(xb); if (PROBE_PH == k) { call; xcd_barrier(xb); }
  RUNP(1, phase1(p, dyn_smem))
  RUNP(2, phase2(p, dyn_smem))
  RUNP(3, phase3(p, dyn_smem))
  RUNP(4, phase4(p, dyn_smem))
  RUNP(5, phase5(p, dyn_smem))
  RUNP(6, phase6(p, dyn_smem))
  RUNP(7, phase7(p, dyn_smem))
  for (int tb8 = 0; tb8 * (int)gridDim.x * 4 < T_TOK; tb8 += 24) phase8(p, dyn_smem, tb8);
}
#else
template <int PH>
__global__ void __launch_bounds__(NTHR, 2) phase_kernel(Params p) { run_phase(p, PH, dyn_smem); }
#endif

extern "C" void kernel_launch(void* const* d_in, const int* in_sizes, int n_in, void* d_out, int out_size, void* d_ws,
                              size_t ws_size, hipStream_t stream) {
  Params p{};
  const float* const* in = (const float* const*)d_in;
  p.x0 = in[0]; p.x1 = in[1]; p.attn_norm_g = in[2]; p.w_in = in[3]; p.q_lat_g = in[4]; p.w_uq = in[5];
  p.kv_lat_g = in[6]; p.w_ukv = in[7]; p.q_head_g = in[8]; p.k_head_g = in[9]; p.attn_out_g = in[10];
  p.fnet_out_g = in[11]; p.w_out = in[12]; p.ffn_norm_g = in[13]; p.peer_w_q = in[14]; p.peer_sub_keys = in[15];
  p.peer_u = in[16]; p.peer_v = in[17];
  p.out = (float*)d_out;
  char* ws = (char*)d_ws;
  size_t off = 0;
  auto take = [&](size_t bytes) { char* q = ws + off; off += (bytes + 255) & ~(size_t)255; return q; };
  p.WinT = (u16*)take(1280 * 1024 * 2); p.WuqT = (u16*)take(768 * 384 * 2); p.WukvT = (u16*)take(1024 * 256 * 2);
  p.WoutT = (u16*)take(1024 * 1024 * 2); p.WpqT = (u16*)take(2048 * 1024 * 2); p.SK = (u16*)take(262144 * 2);
  p.Wc = (u16*)take(256 * 128 * 2); p.WA64 = (u16*)take(128 * 128 * 2); p.WA32 = (u16*)take(128 * 64 * 2);
  p.WB = (u16*)take(128 * 256 * 2);
  p.ropec = (float*)take(8192 * 16 * 4); p.ropes = (float*)take(8192 * 16 * 4);
  p.rstd1 = (float*)take((size_t)T_TOK * 4); p.SSP = (float*)take((size_t)T_TOK * 10 * 4);
  p.SSA = (float*)take((size_t)T_TOK * 8 * 4); p.SSF = (float*)take((size_t)T_TOK * 8 * 4);
  p.SS2 = (float*)take((size_t)T_TOK * 16 * 4); p.KR = (float*)take((size_t)T_TOK * 32 * 4);
  p.bar = (unsigned*)take(XCD_BAR_WORDS * 4);
  p.misc = (float*)take(256);
  const size_t SMALL = 28u << 20;
  char* big = ws + SMALL;
  const size_t MB = 1u << 20;
  char* dsp = (char*)d_out;
  p.Xb = (u16*)(big + 0 * MB);
  p.CQ = (u16*)(big + 96 * MB); p.CKV = (u16*)(big + 132 * MB); p.F = (u16*)(big + 156 * MB);
  p.Z1 = (u16*)(big + 204 * MB);
  p.Vt = (u16*)(big + 300 * MB);
  p.Q1 = (u16*)(dsp + 0 * MB); p.K1 = (u16*)(dsp + 72 * MB);
  p.Qn = (u16*)(big + 0 * MB); p.Kn = (u16*)(dsp + 120 * MB);
  p.G1 = (u16*)(big + 96 * MB);
  p.MIX = (u16*)(big + 204 * MB);
  p.X2b = (u16*)(big + 0 * MB);
  p.Qp = (u16*)(big + 96 * MB);
  p.IDX = (int*)(big + 300 * MB); p.G = (float*)(big + 324 * MB);
  p.U8 = (unsigned char*)(big + 348 * MB); p.V8 = (unsigned char*)(big + 364 * MB);

#if MK_COOP
  static int grid_blocks = 0;
  if (!grid_blocks) {
    int dev = 0, cus = 0, per_cu = 0;
    hipGetDevice(&dev);
    hipDeviceGetAttribute(&cus, hipDeviceAttributeMultiprocessorCount, dev);
    hipFuncSetAttribute((const void*)mega_kernel, hipFuncAttributeMaxDynamicSharedMemorySize, LDS_BYTES);
    hipOccupancyMaxActiveBlocksPerMultiprocessor(&per_cu, mega_kernel, NTHR, LDS_BYTES);
    if (per_cu > 2) per_cu = 2;
    grid_blocks = cus * per_cu;
    grid_blocks &= ~7;
  }
  void* args[] = {&p};
  hipError_t e = hipLaunchCooperativeKernel((void*)mega_kernel, dim3(grid_blocks), dim3(NTHR), args, LDS_BYTES, stream);
  if (e != hipSuccess) fprintf(stderr, "cooperative launch failed: %s (grid %d)\n", hipGetErrorString(e), grid_blocks);
#else
  const int GB = 512;
#define LAUNCH(PH)                                                                                                \
  hipFuncSetAttribute((const void*)phase_kernel<PH>, hipFuncAttributeMaxDynamicSharedMemorySize, LDS_BYTES);      \
  phase_kernel<PH><<<GB, NTHR, LDS_BYTES, stream>>>(p);
  LAUNCH(0) LAUNCH(1) LAUNCH(2) LAUNCH(3) LAUNCH(4) LAUNCH(5) LAUNCH(6) LAUNCH(7) LAUNCH(8)
#endif
}
```

```cpp
#include <hip/hip_runtime.h>
#include <hip/hip_cooperative_groups.h>
#include <stdint.h>
#include <cstdio>
namespace cg = cooperative_groups;

#ifndef MK_COOP
#define MK_COOP 1
#endif

typedef unsigned short u16;
using bf16x8 = __attribute__((ext_vector_type(8))) short;
using f32x16 = __attribute__((ext_vector_type(16))) float;
using f32x4 = __attribute__((ext_vector_type(4))) float;
using f32x2 = __attribute__((ext_vector_type(2))) float;
using u32x4 = __attribute__((ext_vector_type(4))) unsigned;
using u32x2 = __attribute__((ext_vector_type(2))) unsigned;
typedef __bf16 bf2_t __attribute__((ext_vector_type(2)));

#define DI __device__ __forceinline__
#define MFMA(a, b, c) __builtin_amdgcn_mfma_f32_32x32x16_bf16((a), (b), (c), 0, 0, 0)

constexpr int T_TOK = 49152;
constexpr int TP = 16384;
constexpr float EPS = 1e-6f;
constexpr int NTHR = 256;
constexpr int LDS_BYTES = 65536 + 6144;
constexpr int GBUF = 32768;
constexpr float USCALE = 512.f, VSCALE = 256.f;

struct Params {
  const float *x0, *x1, *attn_norm_g, *w_in, *q_lat_g, *w_uq, *kv_lat_g, *w_ukv, *q_head_g, *k_head_g,
      *attn_out_g, *fnet_out_g, *w_out, *ffn_norm_g, *peer_w_q, *peer_sub_keys, *peer_u, *peer_v;
  float* out;
  u16 *WinT, *WuqT, *WukvT, *WoutT, *WpqT, *SK, *Wc, *WA64, *WA32, *WB;
  float *ropec, *ropes, *rstd1, *SSP, *SSA, *SSF, *SS2, *KR;
  u16 *Xb, *CQ, *CKV, *F, *Z1, *Vt, *Q1, *K1, *Qn, *Kn, *G1, *MIX, *X2b, *Qp;
  unsigned char *U8, *V8;
  int* IDX;
  float* G;
  unsigned* bar;
  float* misc;
};

DI unsigned cvtpk(float lo, float hi) {
  f32x2 v = {lo, hi};
  bf2_t b = __builtin_convertvector(v, bf2_t);
  return __builtin_bit_cast(unsigned, b);
}
DI u16 f2bf(float x) { return (u16)(cvtpk(x, 0.f) & 0xffffu); }
DI float bflo(unsigned w) { return __uint_as_float(w << 16); }
DI float bfhi(unsigned w) { return __uint_as_float(w & 0xffff0000u); }
DI int crow(int i, int h) { return (i & 3) + 8 * (i >> 2) + 4 * h; }
DI float red32(float v) {
  v += __shfl_xor(v, 1); v += __shfl_xor(v, 2); v += __shfl_xor(v, 4); v += __shfl_xor(v, 8); v += __shfl_xor(v, 16);
  return v;
}
DI float wave_sum(float v) { v = red32(v); v += __shfl_xor(v, 32); return v; }
DI const float* xrow(const Params& p, int t) {
  return t < TP ? p.x0 + (size_t)t * 1024 : p.x1 + (size_t)(t - TP) * 1024;
}
DI void tok2seq(int t, int& q, int& S, int& tb) {
  if (t < TP) { q = t >> 13; S = 8192; tb = q << 13; }
  else { int u = (t - TP) >> 12; q = 2 + u; S = 4096; tb = TP + (u << 12); }
}
DI int vblock() { return (blockIdx.x & 7) * (gridDim.x >> 3) + (blockIdx.x >> 3); }
DI float fdot2(unsigned a, unsigned b, float c) {
  return __builtin_amdgcn_fdot2_f32_bf16(__builtin_bit_cast(bf2_t, a), __builtin_bit_cast(bf2_t, b), c, false);
}

DI int swz(int row, int c) { return row * 128 + ((c ^ ((row >> 1) & 7)) << 4); }

template <class AF, class BF>
DI void gemm_issue(u32x4 (&ra)[4], u32x4 (&rb)[4], AF arow, BF brow, int k0) {
  const int tid = threadIdx.x, lrow = tid >> 3, lc = tid & 7;
#pragma unroll
  for (int i = 0; i < 4; ++i) {
    ra[i] = *(const u32x4*)(arow(lrow + 32 * i) + lc * 8 + k0);
    rb[i] = *(const u32x4*)(brow(lrow + 32 * i) + lc * 8 + k0);
  }
}
template <bool BATCH = false, bool PRE = false, class AF, class BF>
DI void gemm_stream(f32x16 (&acc)[2][2], char* smem, AF arow, BF brow, int k0, int k1, u32x4 (&ra0)[4], u32x4 (&rb0)[4],
                    bool hasn, long dA, long dB) {
  const int tid = threadIdx.x, lane = tid & 63, wave = tid >> 6;
  const int wm = wave >> 1, wn = wave & 1, r = lane & 31, h = lane >> 5;
  const int lrow = tid >> 3, lc = tid & 7;
  const u16* ap[4]; const u16* bp[4];
#pragma unroll
  for (int i = 0; i < 4; ++i) { ap[i] = arow(lrow + 32 * i) + lc * 8; bp[i] = brow(lrow + 32 * i) + lc * 8; }
  u32x4 ra1[4], rb1[4];
  if (!PRE) {
#pragma unroll
    for (int i = 0; i < 4; ++i) { ra0[i] = *(const u32x4*)(ap[i] + k0); rb0[i] = *(const u32x4*)(bp[i] + k0); }
  }
#pragma unroll
  for (int i = 0; i < 4; ++i) {
    *(u32x4*)(smem + swz(lrow + 32 * i, lc)) = ra0[i];
    *(u32x4*)(smem + 16384 + swz(lrow + 32 * i, lc)) = rb0[i];
  }
  if (k0 + 64 < k1) {
#pragma unroll
    for (int i = 0; i < 4; ++i) { ra0[i] = *(const u32x4*)(ap[i] + k0 + 64); rb0[i] = *(const u32x4*)(bp[i] + k0 + 64); }
  }
  __syncthreads();
  int cur = 0;
  auto step = [&](int k, u32x4 (&xa)[4], u32x4 (&xb)[4], u32x4 (&ya)[4], u32x4 (&yb)[4]) {
    if (k + 128 < k1) {
#pragma unroll
      for (int i = 0; i < 4; ++i) { ya[i] = *(const u32x4*)(ap[i] + k + 128); yb[i] = *(const u32x4*)(bp[i] + k + 128); }
    }
    if (hasn && k + 64 >= k1) {
#pragma unroll
      for (int i = 0; i < 4; ++i) { ra0[i] = *(const u32x4*)(ap[i] + dA); rb0[i] = *(const u32x4*)(bp[i] + dB); }
    }
    __builtin_amdgcn_sched_barrier(0);
    const char* As = smem + cur * GBUF;
    const char* Bs = As + 16384;
    if (BATCH) {
      bf16x8 af[4][2], bfr[4][2];
#pragma unroll
      for (int ks = 0; ks < 4; ++ks) {
#pragma unroll
        for (int mi = 0; mi < 2; ++mi) af[ks][mi] = *(const bf16x8*)(As + swz(wm * 64 + mi * 32 + r, ks * 2 + h));
#pragma unroll
        for (int ni = 0; ni < 2; ++ni) bfr[ks][ni] = *(const bf16x8*)(Bs + swz(wn * 64 + ni * 32 + r, ks * 2 + h));
      }
      __builtin_amdgcn_sched_barrier(0);
#pragma unroll
      for (int ks = 0; ks < 4; ++ks)
#pragma unroll
        for (int mi = 0; mi < 2; ++mi)
#pragma unroll
          for (int ni = 0; ni < 2; ++ni) acc[mi][ni] = MFMA(af[ks][mi], bfr[ks][ni], acc[mi][ni]);
    } else {
#pragma unroll
      for (int ks = 0; ks < 4; ++ks) {
        bf16x8 af[2], bfr[2];
#pragma unroll
        for (int mi = 0; mi < 2; ++mi) af[mi] = *(const bf16x8*)(As + swz(wm * 64 + mi * 32 + r, ks * 2 + h));
#pragma unroll
        for (int ni = 0; ni < 2; ++ni) bfr[ni] = *(const bf16x8*)(Bs + swz(wn * 64 + ni * 32 + r, ks * 2 + h));
#pragma unroll
        for (int mi = 0; mi < 2; ++mi)
#pragma unroll
          for (int ni = 0; ni < 2; ++ni) acc[mi][ni] = MFMA(af[mi], bfr[ni], acc[mi][ni]);
      }
    }
    __builtin_amdgcn_sched_barrier(0);
    if (k + 64 < k1) {
      char* An = smem + (cur ^ 1) * GBUF;
#pragma unroll
      for (int i = 0; i < 4; ++i) {
        *(u32x4*)(An + swz(lrow + 32 * i, lc)) = xa[i];
        *(u32x4*)(An + 16384 + swz(lrow + 32 * i, lc)) = xb[i];
      }
    }
    __syncthreads();
    cur ^= 1;
  };
#pragma unroll 1
  for (int k = k0; k < k1; k += 128) {
    step(k, ra0, rb0, ra1, rb1);
    if (k + 64 < k1) step(k + 64, ra1, rb1, ra0, rb0);
  }
}
template <bool BATCH = false, class AF, class BF>
DI void gemm_mainloop(f32x16 (&acc)[2][2], char* smem, AF arow, BF brow, int k0, int k1) {
  u32x4 ra0[4], rb0[4];
  gemm_stream<BATCH, false>(acc, smem, arow, brow, k0, k1, ra0, rb0, false, 0, 0);
}
DI void zero_acc(f32x16 (&acc)[2][2]) {
#pragma unroll
  for (int a = 0; a < 2; ++a)
#pragma unroll
    for (int b = 0; b < 2; ++b)
#pragma unroll
      for (int i = 0; i < 16; ++i) acc[a][b][i] = 0.f;
}
#define WAVE_COORDS                                                        \
  const int tid = threadIdx.x, lane = tid & 63, wave = tid >> 6;           \
  const int wm = wave >> 1, wn = wave & 1, r = lane & 31, h = lane >> 5;   \
  (void)wm; (void)wn; (void)r; (void)h; (void)lane;

constexpr int SROW = 272;
template <bool SCALE>
DI void stage_bf16_t(char* smem, f32x16 (&acc)[2][2], const float* rs, int wm, int wn, int r, int h) {
  char* base = smem + (wm * 64 + 4 * h) * SROW + (wn * 64 + r) * 2;
  const float* rb = rs + wm * 64 + 4 * h;
#pragma unroll
  for (int mi = 0; mi < 2; ++mi)
#pragma unroll
    for (int i = 0; i < 16; ++i) {
      const int ro = mi * 32 + (i & 3) + 8 * (i >> 2);
      const float sc = SCALE ? rb[ro] : 1.f;
#pragma unroll
      for (int ni = 0; ni < 2; ++ni)
        *(u16*)(base + ro * SROW + ni * 64) = f2bf(acc[mi][ni][i] * sc);
    }
}
DI void stage_bf16(char* smem, f32x16 (&acc)[2][2], const float* rs, int wm, int wn, int r, int h, int) {
  if (rs) stage_bf16_t<true>(smem, acc, rs, wm, wn, r, h); else stage_bf16_t<false>(smem, acc, rs, wm, wn, r, h);
}
DI float sumsq8(const u32x4& v) {
  float ss = 0.f;
#pragma unroll
  for (int j = 0; j < 4; ++j) { const float a = bflo(v[j]), b = bfhi(v[j]); ss += a * a + b * b; }
  return ss;
}

#define WAVE_COORDS_L                                                      \
  int tid = threadIdx.x; asm volatile("" : "+v"(tid));                     \
  const int lane = tid & 63, wave = tid >> 6;                              \
  const int wm = wave >> 1, wn = wave & 1, r = lane & 31, h = lane >> 5;   \
  (void)wm; (void)wn; (void)r; (void)h; (void)lane;

template <int MODE>
DI void transpose_w(u16* dst, const float* src, const float* g0, const float* g1, int N, int K, int Nsrc, int gt, int gs) {
  const int items = N * (K >> 3);
  for (int id = gt; id < items; id += gs) {
    const int kc = id / N, n = id - kc * N;
    int col = n; bool valid = true;
    if (MODE == 1) {
      if (n < 640) col = n; else if (n < 1152) col = n + 32; else if (n < 1184) col = 640 + n - 1152; else valid = false;
    }
    float v[8];
#pragma unroll
    for (int j = 0; j < 8; ++j) {
      const int k = kc * 8 + j;
      const float g = (MODE == 2 && k >= 512) ? g1[k - 512] : g0[k];
      v[j] = valid ? src[(size_t)k * Nsrc + col] * g : 0.f;
    }
    u32x4 o = {cvtpk(v[0], v[1]), cvtpk(v[2], v[3]), cvtpk(v[4], v[5]), cvtpk(v[6], v[7])};
    *(u32x4*)(dst + (size_t)n * K + kc * 8) = o;
  }
}

DI void phase0(const Params& p) {
  const int gt = blockIdx.x * NTHR + threadIdx.x, gs = gridDim.x * NTHR;
  if (gt == 0) {
    float mq = 0.f, mk = 0.f;
    for (int d = 0; d < 96; ++d) { mq = fmaxf(mq, fabsf(p.q_head_g[d])); mk = fmaxf(mk, fabsf(p.k_head_g[d])); }
    p.misc[0] = 96.f * mq * mk * (0.10206207261596575f * 1.4426950408889634f) * 1.02f;
  }
  const int lane = threadIdx.x & 63, gw = gt >> 6, nw = gs >> 6;
  for (int t = gw; t < T_TOK; t += nw) {
    const float* xr = xrow(p, t);
    f32x4 v[4]; float ss = 0.f;
#pragma unroll
    for (int i = 0; i < 4; ++i) {
      v[i] = *(const f32x4*)(xr + i * 256 + lane * 4);
      ss += v[i][0] * v[i][0] + v[i][1] * v[i][1] + v[i][2] * v[i][2] + v[i][3] * v[i][3];
    }
    ss = wave_sum(ss);
#pragma unroll
    for (int i = 0; i < 4; ++i) {
      u32x2 o = {cvtpk(v[i][0], v[i][1]), cvtpk(v[i][2], v[i][3])};
      *(u32x2*)(p.Xb + (size_t)t * 1024 + i * 256 + lane * 4) = o;
    }
    if (lane == 0) p.rstd1[t] = rsqrtf(ss * (1.f / 1024.f) + EPS);
  }
  transpose_w<1>(p.WinT, p.w_in, p.attn_norm_g, nullptr, 1280, 1024, 1184, gt, gs);
  transpose_w<0>(p.WuqT, p.w_uq, p.q_lat_g, nullptr, 768, 384, 768, gt, gs);
  transpose_w<0>(p.WukvT, p.w_ukv, p.kv_lat_g, nullptr, 1024, 256, 1024, gt, gs);
  transpose_w<2>(p.WoutT, p.w_out, p.attn_out_g, p.fnet_out_g, 1024, 1024, 1024, gt, gs);
  transpose_w<0>(p.WpqT, p.peer_w_q, p.ffn_norm_g, nullptr, 2048, 1024, 2048, gt, gs);
  for (int id = gt; id < 262144 / 4; id += gs) {
    f32x4 v = *(const f32x4*)(p.peer_sub_keys + (size_t)id * 4);
    u32x2 o = {cvtpk(v[0], v[1]), cvtpk(v[2], v[3])};
    *(u32x2*)(p.SK + (size_t)id * 4) = o;
  }
  for (int id = gt; id < 256 * 128; id += gs) {
    const int n = id >> 7, c = id & 127, pp = n >> 7, m = n & 127;
    const float fr = (float)((m * c) & 127) * (1.f / 128.f);
    const float val = (pp == 0 ? __builtin_amdgcn_cosf(fr) : -__builtin_amdgcn_sinf(fr)) * 0.08838834764831845f;
    p.Wc[id] = f2bf(val);
  }
  for (int id = gt; id < 128 * 128; id += gs) {
    const int n = id >> 7, k = id & 127;
    const int k1 = (n >> 6) * 32 + (n & 31), pq = (n >> 5) & 1, pp = k >> 6, s1 = k & 63;
    const float fr = (float)((s1 * k1) & 63) * (1.f / 64.f);
    const float c = __builtin_amdgcn_cosf(fr), s = __builtin_amdgcn_sinf(fr);
    const float val = (pq == 0 ? (pp == 0 ? c : s) : (pp == 0 ? -s : c)) * 0.125f;
    p.WA64[id] = f2bf(val);
  }
  for (int id = gt; id < 128 * 64; id += gs) {
    const int n = id >> 6, k = id & 63;
    const int k1 = n & 31, pq = (n >> 5) & 1, pp = k >> 5, s1 = k & 31;
    const float fr = (float)((s1 * k1) & 31) * (1.f / 32.f);
    const float c = __builtin_amdgcn_cosf(fr), s = __builtin_amdgcn_sinf(fr);
    float val = (pq == 0 ? (pp == 0 ? c : s) : (pp == 0 ? -s : c)) * 0.17677669529663687f;
    if (n >= 64) val = 0.f;
    p.WA32[id] = f2bf(val);
  }
  for (int id = gt; id < 128 * 256; id += gs) {
    const int k2 = id >> 8, k = id & 255, pq = k >> 7, s2 = k & 127;
    const float fr = (float)((s2 * k2) & 127) * (1.f / 128.f);
    const float val = (pq == 0 ? __builtin_amdgcn_cosf(fr) : __builtin_amdgcn_sinf(fr)) * 0.08838834764831845f;
    p.WB[id] = f2bf(val);
  }
  for (int id = gt; id < 8192 * 16; id += gs) {
    const int pos = id >> 4, j = id & 15;
    const float freq = exp2f(-(float)j * (13.287712379549449f / 16.f));
    const double rev = (double)pos * (double)freq * 0.15915494309189535;
    const float fr = (float)(rev - floor(rev));
    p.ropec[id] = __builtin_amdgcn_cosf(fr);
    p.ropes[id] = __builtin_amdgcn_sinf(fr);
  }
}

DI void phase1(const Params& p, char* smem) {
    float* rs = (float*)(smem + 65536);
  const int G = gridDim.x;
  u32x4 sa[4], sb[4];
  if (vblock() < 384 * 10) {
    const int t0 = vblock(), mt0 = t0 / 10;
    const u16* A0 = p.Xb + (size_t)mt0 * 128 * 1024; const u16* B0 = p.WinT + (size_t)(t0 - mt0 * 10) * 128 * 1024;
    gemm_issue(sa, sb, [&](int rr) { return A0 + (size_t)rr * 1024; }, [&](int rr) { return B0 + (size_t)rr * 1024; }, 0);
  }
  for (int tile = vblock(); tile < 384 * 10; tile += G) {
    WAVE_COORDS_L
    const int mt = tile / 10, nt = tile - mt * 10, m0 = mt * 128, n0 = nt * 128;
    const int nx = tile + G; const bool hasn = nx < 384 * 10;
    const int nmt = nx / 10;
    const u16* An = p.Xb + (size_t)nmt * 128 * 1024; const u16* Bn = p.WinT + (size_t)(nx - nmt * 10) * 128 * 1024;
    __syncthreads();
    if (tid < 128) rs[tid] = p.rstd1[m0 + tid];
    f32x16 acc[2][2]; zero_acc(acc);
    const u16* A = p.Xb + (size_t)m0 * 1024; const u16* B = p.WinT + (size_t)n0 * 1024;
    gemm_stream<true, true>(acc, smem, [&](int rr) { return A + (size_t)rr * 1024; }, [&](int rr) { return B + (size_t)rr * 1024; }, 0, 1024, sa, sb,
                      hasn, (long)(An - A), (long)(Bn - B));
    if (nt == 9) {
      if (wn == 0) {
#pragma unroll
        for (int mi = 0; mi < 2; ++mi)
#pragma unroll
          for (int i = 0; i < 16; ++i) {
            const int ro = mi * 32 + (i & 3) + 8 * (i >> 2);
            p.KR[(size_t)(m0 + wm * 64 + 4 * h + ro) * 32 + r] = acc[mi][0][i] * rs[wm * 64 + 4 * h + ro];
          }
      }
    } else {
      stage_bf16_t<true>(smem, acc, rs, wm, wn, r, h);
      __syncthreads();
      u16* dbase; int dstride, cbase;
      if (nt < 3) { dbase = p.CQ; dstride = 384; cbase = n0; }
      else if (nt < 5) { dbase = p.CKV; dstride = 256; cbase = n0 - 384; }
      else { dbase = p.F; dstride = 512; cbase = n0 - 640; }
#pragma unroll
      for (int j = 0; j < 8; ++j) {
        const int id = tid + 256 * j, row = id >> 4, cc = id & 15;
        const u32x4 v = *(const u32x4*)(smem + row * SROW + cc * 16);
        *(u32x4*)(dbase + (size_t)(m0 + row) * dstride + cbase + cc * 8) = v;
        if (nt < 5) {
          float ss = sumsq8(v);
          ss += __shfl_xor(ss, 1); ss += __shfl_xor(ss, 2); ss += __shfl_xor(ss, 4); ss += __shfl_xor(ss, 8);
          if (cc == 0) p.SSP[(size_t)(m0 + row) * 10 + nt * 2] = ss;
        }
      }
    }
  }
}

DI void phase2(const Params& p, char* smem) {
    float* rs = (float*)(smem + 65536);
  const int G = gridDim.x;
  const int NUQ = 384 * 6, NUKV = 384 * 8, NCH = 384 * 8;
  for (int tile = vblock(); tile < NUQ + NUKV + NCH; tile += G) {
    WAVE_COORDS_L
    f32x16 acc[2][2]; zero_acc(acc);
    __syncthreads();
    if (tile < NUQ) {
      const int mt = tile / 6, nt = tile - mt * 6, m0 = mt * 128, n0 = nt * 128;
      if (tid < 128) {
        const float* s = p.SSP + (size_t)(m0 + tid) * 10;
        rs[tid] = rsqrtf((s[0] + s[2] + s[4]) * (1.f / 384.f) + EPS);
      }
      const u16* A = p.CQ + (size_t)m0 * 384; const u16* B = p.WuqT + (size_t)n0 * 384;
      gemm_mainloop(acc, smem, [&](int rr) { return A + (size_t)rr * 384; }, [&](int rr) { return B + (size_t)rr * 384; }, 0, 384);
      stage_bf16_t<true>(smem, acc, rs, wm, wn, r, h);
      __syncthreads();
#pragma unroll
      for (int j = 0; j < 8; ++j) {
        const int id = tid + 256 * j, row = id >> 4, cc = id & 15;
        *(u32x4*)(p.Q1 + (size_t)(m0 + row) * 768 + n0 + cc * 8) = *(const u32x4*)(smem + row * SROW + cc * 16);
      }
    } else if (tile < NUQ + NUKV) {
      const int tl = tile - NUQ;
      const int mt = tl >> 3, hh = tl & 7, m0 = mt * 128;
      int q, S, tb; tok2seq(m0, q, S, tb);
      if (tid < 128) {
        const float* s = p.SSP + (size_t)(m0 + tid) * 10;
        rs[tid] = rsqrtf((s[6] + s[8]) * (1.f / 256.f) + EPS);
      }
      const u16* A = p.CKV + (size_t)m0 * 256; const u16* B = p.WukvT + (size_t)hh * 128 * 256;
      gemm_mainloop(acc, smem, [&](int rr) { return A + (size_t)rr * 256; }, [&](int rr) { return B + (size_t)rr * 256; }, 0, 256);
      if (wn == 0) {
#pragma unroll
        for (int mi = 0; mi < 2; ++mi)
#pragma unroll
          for (int i = 0; i < 16; ++i) {
            const int ro = mi * 32 + (i & 3) + 8 * (i >> 2);
            const float sc = (rs + wm * 64 + 4 * h)[ro];
#pragma unroll
            for (int ni = 0; ni < 2; ++ni) *(u16*)(smem + (wm * 64 + 4 * h) * SROW + r * 2 + ro * SROW + ni * 64) = f2bf(acc[mi][ni][i] * sc);
          }
      } else {
        const int s0 = m0 - tb;
#pragma unroll
        for (int mi = 0; mi < 2; ++mi)
#pragma unroll
          for (int g4 = 0; g4 < 4; ++g4) {
            const int row = wm * 64 + mi * 32 + 8 * g4 + 4 * h;
            const f32x4 sc = *(const f32x4*)(rs + row);
#pragma unroll
            for (int ni = 0; ni < 2; ++ni) {
              const int dv = ni * 32 + r;
              u32x2 o = {cvtpk(acc[mi][ni][4 * g4] * sc[0], acc[mi][ni][4 * g4 + 1] * sc[1]),
                         cvtpk(acc[mi][ni][4 * g4 + 2] * sc[2], acc[mi][ni][4 * g4 + 3] * sc[3])};
              *(u32x2*)(p.Vt + (size_t)tb * 512 + (size_t)(hh * 64 + dv) * S + s0 + row) = o;
            }
            __builtin_amdgcn_sched_barrier(0);
          }
      }
      __syncthreads();
#pragma unroll
      for (int j = 0; j < 4; ++j) {
        const int id = tid + 256 * j, row = id >> 3, cc = id & 7;
        *(u32x4*)(p.K1 + (size_t)(m0 + row) * 512 + hh * 64 + cc * 8) = *(const u32x4*)(smem + row * SROW + cc * 16);
      }
    } else {
      const int tl = tile - NUQ - NUKV;
      const int pp = tl & 1, g = (tl >> 1) & 3, mt = tl >> 3, m0 = mt * 128;
      int q, S, tb; tok2seq(m0, q, S, tb);
      const int S1 = (q < 2) ? 64 : 32, l1 = (q < 2) ? 6 : 5;
      const int j0 = ((m0 - tb) >> 7) * (128 >> l1);
      const u16* Fb = p.F + (size_t)g * 128;
      const u16* B = p.Wc + (size_t)pp * 128 * 128;
      gemm_mainloop(acc, smem,
                    [&](int rr) { const int s1 = rr & (S1 - 1), s2 = j0 + (rr >> l1); return Fb + (size_t)(tb + s1 * 128 + s2) * 512; },
                    [&](int rr) { return B + (size_t)rr * 128; }, 0, 128);
      u16* Zb = p.Z1 + (size_t)tb * 1024;
#pragma unroll
      for (int mi = 0; mi < 2; ++mi)
#pragma unroll
        for (int g4 = 0; g4 < 4; ++g4) {
          const int rho = wm * 64 + mi * 32 + 8 * g4 + 4 * h;
          const int s1 = rho & (S1 - 1), s2 = j0 + (rho >> l1);
#pragma unroll
          for (int ni = 0; ni < 2; ++ni) {
            const int m = wn * 64 + ni * 32 + r;
            u32x2 o = {cvtpk(acc[mi][ni][4 * g4], acc[mi][ni][4 * g4 + 1]), cvtpk(acc[mi][ni][4 * g4 + 2], acc[mi][ni][4 * g4 + 3])};
            *(u32x2*)(Zb + ((size_t)((g * 128 + m) * 128 + s2) * (2 * S1)) + pp * S1 + s1) = o;
          }
          __builtin_amdgcn_sched_barrier(0);
        }
    }
  }
}

DI void phase3(const Params& p, char* smem) {
    const int G = gridDim.x;
  for (int tile = vblock(); tile < 5120; tile += G) {
    WAVE_COORDS_L
    const int q = tile >> 9, gm = tile & 511;
    const int tb = (q < 2) ? (q << 13) : (TP + ((q - 2) << 12));
    const int S = (q < 2) ? 8192 : 4096, S1 = (q < 2) ? 64 : 32, K = 2 * S1;
    f32x16 acc[2][2]; zero_acc(acc);
    const u16* A = p.Z1 + (size_t)tb * 1024 + (size_t)gm * 128 * K;
    const u16* B = (q < 2) ? p.WA64 : p.WA32;
    gemm_mainloop(acc, smem, [&](int rr) { return A + (size_t)rr * K; }, [&](int rr) { return B + (size_t)rr * K; }, 0, K);
    if (wn * 32 < S1) {
      const int k1 = wn * 32 + r;
      const float invS = 1.f / (float)S;
      u16* Gb = p.G1 + (size_t)tb * 1024 + (size_t)(gm * S1 + k1) * 256;
#pragma unroll
      for (int mi = 0; mi < 2; ++mi)
#pragma unroll
        for (int g4 = 0; g4 < 4; ++g4) {
          const int s2b = wm * 64 + mi * 32 + 8 * g4 + 4 * h;
          float ore[4], oim[4];
#pragma unroll
          for (int j = 0; j < 4; ++j) {
            const int s2 = s2b + j;
            const float fr = (float)((s2 * k1) & (S - 1)) * invS;
            const float c = __builtin_amdgcn_cosf(fr), s = __builtin_amdgcn_sinf(fr);
            const float re = acc[mi][0][4 * g4 + j], im = acc[mi][1][4 * g4 + j];
            ore[j] = re * c + im * s; oim[j] = im * c - re * s;
          }
          u32x2 o0 = {cvtpk(ore[0], ore[1]), cvtpk(ore[2], ore[3])};
          u32x2 o1 = {cvtpk(oim[0], oim[1]), cvtpk(oim[2], oim[3])};
          *(u32x2*)(Gb + s2b) = o0;
          *(u32x2*)(Gb + 128 + s2b) = o1;
        }
    }
  }
  const float QSCALE = 0.10206207261596575f * 1.4426950408889634f;
  for (int chunk = vblock(); chunk < T_TOK * 8 / NTHR; chunk += G) {
    WAVE_COORDS_L
    const int id = chunk * NTHR + tid;
    const int t = id >> 3, hh = id & 7;
    int q, S, tb; tok2seq(t, q, S, tb);
    const int s = t - tb;
    const size_t obase = ((size_t)tb * 8 + (size_t)hh * S + s) * 96;
    const float* rcp = p.ropec + s * 16; const float* rsp = p.ropes + s * 16;
    {
      u32x4 w[12];
      const u16* src = p.Q1 + (size_t)t * 768 + hh * 96;
#pragma unroll
      for (int i = 0; i < 12; ++i) w[i] = *(const u32x4*)(src + i * 8);
      float ss = 0.f;
#pragma unroll
      for (int i = 0; i < 12; ++i)
#pragma unroll
        for (int j = 0; j < 4; ++j) { const float a = bflo(w[i][j]), b = bfhi(w[i][j]); ss += a * a + b * b; }
      const float rinv = rsqrtf(ss * (1.f / 96.f) + EPS);
      u16* dst = p.Qn + obase;
#pragma unroll
      for (int i = 0; i < 8; ++i) {
        u32x4 o;
#pragma unroll
        for (int j = 0; j < 4; ++j) {
          const int d = i * 8 + j * 2;
          o[j] = cvtpk(bflo(w[i][j]) * rinv * p.q_head_g[d] * QSCALE, bfhi(w[i][j]) * rinv * p.q_head_g[d + 1] * QSCALE);
        }
        *(u32x4*)(dst + i * 8) = o;
      }
      float x1[16], x2[16];
#pragma unroll
      for (int i = 0; i < 2; ++i)
#pragma unroll
        for (int j = 0; j < 4; ++j) {
          const int e = i * 8 + j * 2;
          x1[e] = bflo(w[8 + i][j]) * rinv * p.q_head_g[64 + e]; x1[e + 1] = bfhi(w[8 + i][j]) * rinv * p.q_head_g[64 + e + 1];
          x2[e] = bflo(w[10 + i][j]) * rinv * p.q_head_g[80 + e]; x2[e + 1] = bfhi(w[10 + i][j]) * rinv * p.q_head_g[80 + e + 1];
        }
      float o1[16], o2[16];
#pragma unroll
      for (int e = 0; e < 16; ++e) {
        const float c = rcp[e], sn = rsp[e];
        o1[e] = (x1[e] * c - x2[e] * sn) * QSCALE; o2[e] = (x2[e] * c + x1[e] * sn) * QSCALE;
      }
#pragma unroll
      for (int i = 0; i < 2; ++i) {
        u32x4 a, b;
#pragma unroll
        for (int j = 0; j < 4; ++j) { a[j] = cvtpk(o1[i * 8 + j * 2], o1[i * 8 + j * 2 + 1]); b[j] = cvtpk(o2[i * 8 + j * 2], o2[i * 8 + j * 2 + 1]); }
        *(u32x4*)(dst + 64 + i * 8) = a;
        *(u32x4*)(dst + 80 + i * 8) = b;
      }
    }
    __builtin_amdgcn_sched_barrier(0);
    {
      u32x4 w[8];
      const u16* src = p.K1 + (size_t)t * 512 + hh * 64;
#pragma unroll
      for (int i = 0; i < 8; ++i) w[i] = *(const u32x4*)(src + i * 8);
      f32x4 kr[8];
#pragma unroll
      for (int i = 0; i < 8; ++i) kr[i] = *(const f32x4*)(p.KR + (size_t)t * 32 + i * 4);
      float ss = 0.f;
#pragma unroll
      for (int i = 0; i < 8; ++i)
#pragma unroll
        for (int j = 0; j < 4; ++j) { const float a = bflo(w[i][j]), b = bfhi(w[i][j]); ss += a * a + b * b + kr[i][j] * kr[i][j]; }
      const float rinv = rsqrtf(ss * (1.f / 96.f) + EPS);
      u16* dst = p.Kn + obase;
#pragma unroll
      for (int i = 0; i < 8; ++i) {
        u32x4 o;
#pragma unroll
        for (int j = 0; j < 4; ++j) {
          const int d = i * 8 + j * 2;
          o[j] = cvtpk(bflo(w[i][j]) * rinv * p.k_head_g[d], bfhi(w[i][j]) * rinv * p.k_head_g[d + 1]);
        }
        *(u32x4*)(dst + i * 8) = o;
      }
      float o1[16], o2[16];
#pragma unroll
      for (int e = 0; e < 16; ++e) {
        const float a = kr[e >> 2][e & 3] * rinv * p.k_head_g[64 + e];
        const float b = kr[4 + (e >> 2)][e & 3] * rinv * p.k_head_g[80 + e];
        const float c = rcp[e], sn = rsp[e];
        o1[e] = a * c - b * sn; o2[e] = b * c + a * sn;
      }
#pragma unroll
      for (int i = 0; i < 2; ++i) {
        u32x4 a, b;
#pragma unroll
        for (int j = 0; j < 4; ++j) { a[j] = cvtpk(o1[i * 8 + j * 2], o1[i * 8 + j * 2 + 1]); b[j] = cvtpk(o2[i * 8 + j * 2], o2[i * 8 + j * 2 + 1]); }
        *(u32x4*)(dst + 64 + i * 8) = a;
        *(u32x4*)(dst + 80 + i * 8) = b;
      }
    }
  }
}

constexpr int KSTR = 208, VSTR = 136, ABUF = 64 * KSTR + 64 * VSTR;

DI void attn_tile(const Params& p, char* smem, int a) {
  WAVE_COORDS
  int q, hh, qt, S, tb;
  if (a < 1024) { q = a >> 9; hh = (a >> 6) & 7; qt = a & 63; S = 8192; tb = q << 13; }
  else { const int b = a - 1024; q = 2 + (b >> 8); hh = (b >> 5) & 7; qt = b & 31; S = 4096; tb = TP + ((q - 2) << 12); }
  const size_t qkb = ((size_t)tb * 8 + (size_t)hh * S) * 96;
  const u16* Qb = p.Qn + qkb; const u16* Kb = p.Kn + qkb;
  const u16* Vb = p.Vt + (size_t)tb * 512 + (size_t)hh * 64 * S;
  const int qrow = qt * 128 + wave * 32 + r;
  bf16x8 qf[6];
#pragma unroll
  for (int ks = 0; ks < 6; ++ks) qf[ks] = *(const bf16x8*)(Qb + (size_t)qrow * 96 + ks * 16 + h * 8);
  f32x16 o[2];
#pragma unroll
  for (int i = 0; i < 16; ++i) { o[0][i] = 0.f; o[1][i] = 0.f; }
  float mrun = -1e30f, lrun = 0.f;
  int krow_[3], kc_[3], vrow_[2], vc_[2];
#pragma unroll
  for (int i = 0; i < 3; ++i) { const int id = tid + 256 * i; krow_[i] = id / 12; kc_[i] = id - krow_[i] * 12; }
#pragma unroll
  for (int i = 0; i < 2; ++i) { const int id = tid + 256 * i; vrow_[i] = id >> 3; vc_[i] = id & 7; }
  u32x4 rk[3], rv[2];
  const int nkt = S >> 6;
#pragma unroll
  for (int i = 0; i < 3; ++i) rk[i] = *(const u32x4*)(Kb + (size_t)krow_[i] * 96 + kc_[i] * 8);
#pragma unroll
  for (int i = 0; i < 2; ++i) rv[i] = *(const u32x4*)(Vb + (size_t)vrow_[i] * S + vc_[i] * 8);
  __syncthreads();
#pragma unroll
  for (int i = 0; i < 3; ++i) *(u32x4*)(smem + krow_[i] * KSTR + kc_[i] * 16) = rk[i];
#pragma unroll
  for (int i = 0; i < 2; ++i) {
    char* d = smem + 64 * KSTR + vrow_[i] * VSTR + vc_[i] * 16;
    *(u32x2*)d = u32x2{rv[i][0], rv[i][1]}; *(u32x2*)(d + 8) = u32x2{rv[i][2], rv[i][3]};
  }
  __syncthreads();
  int cur = 0;
  for (int kt = 0; kt < nkt; ++kt) {
    const bool nxt = (kt + 1 < nkt);
    if (nxt) {
#pragma unroll
      for (int i = 0; i < 3; ++i) rk[i] = *(const u32x4*)(Kb + (size_t)((kt + 1) * 64 + krow_[i]) * 96 + kc_[i] * 8);
#pragma unroll
      for (int i = 0; i < 2; ++i) rv[i] = *(const u32x4*)(Vb + (size_t)vrow_[i] * S + (kt + 1) * 64 + vc_[i] * 8);
    }
    __builtin_amdgcn_sched_barrier(0);
    const char* Ks = smem + cur * ABUF;
    const char* Vs = Ks + 64 * KSTR;
    f32x16 sacc[2];
#pragma unroll
    for (int i = 0; i < 16; ++i) { sacc[0][i] = 0.f; sacc[1][i] = 0.f; }
#pragma unroll
    for (int t2 = 0; t2 < 2; ++t2)
#pragma unroll
      for (int ks = 0; ks < 6; ++ks) {
        const bf16x8 kf = *(const bf16x8*)(Ks + (t2 * 32 + r) * KSTR + ks * 32 + h * 16);
        sacc[t2] = MFMA(kf, qf[ks], sacc[t2]);
      }
    float mx = sacc[0][0];
#pragma unroll
    for (int i = 0; i < 16; ++i) { mx = fmaxf(mx, sacc[0][i]); mx = fmaxf(mx, sacc[1][i]); }
    mx = fmaxf(mx, __shfl_xor(mx, 32));
    const float mnew = fmaxf(mrun, mx);
    const float alpha = __builtin_amdgcn_exp2f(mrun - mnew);
    mrun = mnew;
    lrun *= alpha;
#pragma unroll
    for (int i = 0; i < 16; ++i) { o[0][i] *= alpha; o[1][i] *= alpha; }
    float ps = 0.f;
#pragma unroll
    for (int t2 = 0; t2 < 2; ++t2)
#pragma unroll
      for (int i = 0; i < 16; ++i) { const float e = __builtin_amdgcn_exp2f(sacc[t2][i] - mnew); sacc[t2][i] = e; ps += e; }
    lrun += ps;
    bf16x8 pf[4];
#pragma unroll
    for (int kk = 0; kk < 4; ++kk) {
      const int t2 = kk >> 1, s8 = (kk & 1) * 8;
      u32x4 pk = {cvtpk(sacc[t2][s8], sacc[t2][s8 + 1]), cvtpk(sacc[t2][s8 + 2], sacc[t2][s8 + 3]),
                  cvtpk(sacc[t2][s8 + 4], sacc[t2][s8 + 5]), cvtpk(sacc[t2][s8 + 6], sacc[t2][s8 + 7])};
      pf[kk] = __builtin_bit_cast(bf16x8, pk);
    }
#pragma unroll
    for (int dt = 0; dt < 2; ++dt)
#pragma unroll
      for (int kk = 0; kk < 4; ++kk) {
        const char* vp = Vs + (dt * 32 + r) * VSTR + kk * 32 + h * 8;
        const u32x2 lo = *(const u32x2*)vp, hi = *(const u32x2*)(vp + 16);
        u32x4 vv = {lo[0], lo[1], hi[0], hi[1]};
        o[dt] = MFMA(__builtin_bit_cast(bf16x8, vv), pf[kk], o[dt]);
      }
    __builtin_amdgcn_sched_barrier(0);
    if (nxt) {
      char* Kn_ = smem + (cur ^ 1) * ABUF;
#pragma unroll
      for (int i = 0; i < 3; ++i) *(u32x4*)(Kn_ + krow_[i] * KSTR + kc_[i] * 16) = rk[i];
#pragma unroll
      for (int i = 0; i < 2; ++i) {
        char* d = Kn_ + 64 * KSTR + vrow_[i] * VSTR + vc_[i] * 16;
        *(u32x2*)d = u32x2{rv[i][0], rv[i][1]}; *(u32x2*)(d + 8) = u32x2{rv[i][2], rv[i][3]};
      }
    }
    __syncthreads();
    cur ^= 1;
  }
  lrun += __shfl_xor(lrun, 32);
  const float inv = 1.f / lrun;
  float ss = 0.f;
  u16* dst = p.MIX + (size_t)(tb + qrow) * 1024 + hh * 64;
#pragma unroll
  for (int dt = 0; dt < 2; ++dt)
#pragma unroll
    for (int g4 = 0; g4 < 4; ++g4) {
      float v[4];
#pragma unroll
      for (int j = 0; j < 4; ++j) { v[j] = o[dt][4 * g4 + j] * inv; ss += v[j] * v[j]; }
      u32x2 ov = {cvtpk(v[0], v[1]), cvtpk(v[2], v[3])};
      *(u32x2*)(dst + dt * 32 + 8 * g4 + 4 * h) = ov;
    }
  ss += __shfl_xor(ss, 32);
  if (h == 0) p.SSA[(size_t)(tb + qrow) * 8 + hh] = ss;
}

constexpr int VSTR2 = 144, ABUF2 = 64 * KSTR + 64 * VSTR2;
DI float swapmax32(float v) {
  auto rr = __builtin_amdgcn_permlane32_swap(__float_as_uint(v), __float_as_uint(v), false, false);
  return fmaxf(__uint_as_float(rr[0]), __uint_as_float(rr[1]));
}
DI float swapsum32(float v) {
  auto rr = __builtin_amdgcn_permlane32_swap(__float_as_uint(v), __float_as_uint(v), false, false);
  return __uint_as_float(rr[0]) + __uint_as_float(rr[1]);
}
template <bool RUNMAX>
DI void attn_tile2(const Params& p, char* smem, int a) {
  WAVE_COORDS_L
  int q, hh, qt, S, tb;
  if (a < 512) { q = a >> 8; hh = (a >> 5) & 7; qt = a & 31; S = 8192; tb = q << 13; }
  else { const int b = a - 512; q = 2 + (b >> 7); hh = (b >> 4) & 7; qt = b & 15; S = 4096; tb = TP + ((q - 2) << 12); }
  const size_t qkb = ((size_t)tb * 8 + (size_t)hh * S) * 96;
  const u16* Qb = p.Qn + qkb; const u16* Kb = p.Kn + qkb;
  const u16* Vb = p.Vt + (size_t)tb * 512 + (size_t)hh * 64 * S;
  const int qrow0 = qt * 256 + wave * 64 + r;
  bf16x8 qf[2][6];
#pragma unroll
  for (int g = 0; g < 2; ++g)
#pragma unroll
    for (int ks = 0; ks < 6; ++ks) qf[g][ks] = *(const bf16x8*)(Qb + (size_t)(qrow0 + 32 * g) * 96 + ks * 16 + h * 8);
  f32x16 o[2][2];
#pragma unroll
  for (int i = 0; i < 16; ++i) { o[0][0][i] = 0.f; o[0][1][i] = 0.f; o[1][0][i] = 0.f; o[1][1][i] = 0.f; }
  float mrun[2] = {-1e30f, -1e30f}, lrun[2] = {0.f, 0.f};
  int klds_[3], vlds_[2];
#pragma unroll
  for (int i = 0; i < 3; ++i) { const int id = tid + 256 * i; const int kr = id / 12; klds_[i] = kr * KSTR + (id - kr * 12) * 16; }
#pragma unroll
  for (int i = 0; i < 2; ++i) { const int vc = tid & 7; vlds_[i] = 64 * KSTR + ((tid >> 3) + 32 * i) * VSTR2 + (vc >> 1) * 32 + (vc & 1) * 8; }
  const u16* Kg = Kb + tid * 8;
  const u16* Vg = Vb + (size_t)(tid >> 3) * S + (tid & 7) * 8;
  u32x4 rk[3], rv[2];
  const int nkt = S >> 6;
#pragma unroll
  for (int i = 0; i < 3; ++i) rk[i] = *(const u32x4*)(Kg + i * 2048);
#pragma unroll
  for (int i = 0; i < 2; ++i) rv[i] = *(const u32x4*)(Vg + (size_t)(32 * i) * S);
  __syncthreads();
  auto put = [&](char* base) {
#pragma unroll
    for (int i = 0; i < 3; ++i) *(u32x4*)(base + klds_[i]) = rk[i];
#pragma unroll
    for (int i = 0; i < 2; ++i) {
      char* d = base + vlds_[i];
      *(u32x2*)d = u32x2{rv[i][0], rv[i][1]}; *(u32x2*)(d + 16) = u32x2{rv[i][2], rv[i][3]};
    }
  };
  put(smem);
  __syncthreads();
  int cur = 0;
#pragma unroll 1
  for (int kt = 0; kt < nkt; ++kt) {
    const bool nxt = (kt + 1 < nkt);
    if (nxt) {
#pragma unroll
      for (int i = 0; i < 3; ++i) rk[i] = *(const u32x4*)(Kg + (size_t)(kt + 1) * 6144 + i * 2048);
#pragma unroll
      for (int i = 0; i < 2; ++i) rv[i] = *(const u32x4*)(Vg + (size_t)(32 * i) * S + (kt + 1) * 64);
    }
    __builtin_amdgcn_sched_barrier(0);
    const char* Ks = smem + cur * ABUF2;
    const char* Vs = Ks + 64 * KSTR;
#pragma unroll
    for (int t2 = 0; t2 < 2; ++t2) {
      f32x16 sacc[2];
#pragma unroll
      for (int i = 0; i < 16; ++i) { sacc[0][i] = 0.f; sacc[1][i] = 0.f; }
#pragma unroll
      for (int kb = 0; kb < 2; ++kb) {
        bf16x8 kf[3];
#pragma unroll
        for (int ks = 0; ks < 3; ++ks) kf[ks] = *(const bf16x8*)(Ks + (t2 * 32 + r) * KSTR + (kb * 3 + ks) * 32 + h * 16);
#pragma unroll
        for (int ks = 0; ks < 3; ++ks) {
          sacc[0] = MFMA(kf[ks], qf[0][kb * 3 + ks], sacc[0]);
          sacc[1] = MFMA(kf[ks], qf[1][kb * 3 + ks], sacc[1]);
        }
      }
      __builtin_amdgcn_sched_barrier(0);
      bf16x8 pf[2][2];
#pragma unroll
      for (int g = 0; g < 2; ++g) {
        float ps = 0.f;
        if (RUNMAX) {
        float mx = sacc[g][0];
#pragma unroll
        for (int i = 1; i < 16; ++i) mx = fmaxf(mx, sacc[g][i]);
        mx = swapmax32(mx);
        const float mnew = fmaxf(mrun[g], mx);
        if (__ballot(mnew > mrun[g]) != 0ull) {
          const float alpha = __builtin_amdgcn_exp2f(mrun[g] - mnew);
          lrun[g] *= alpha;
#pragma unroll
          for (int i = 0; i < 16; ++i) { o[g][0][i] *= alpha; o[g][1][i] *= alpha; }
          mrun[g] = mnew;
        }
#pragma unroll
        for (int i = 0; i < 16; ++i) { const float e = __builtin_amdgcn_exp2f(sacc[g][i] - mrun[g]); sacc[g][i] = e; ps += e; }
        } else {
#pragma unroll
          for (int i = 0; i < 16; ++i) sacc[g][i] = __builtin_amdgcn_exp2f(sacc[g][i]);
        }
#pragma unroll
        for (int s = 0; s < 2; ++s) {
          const int s8 = s * 8;
          u32x4 pk = {cvtpk(sacc[g][s8], sacc[g][s8 + 1]), cvtpk(sacc[g][s8 + 2], sacc[g][s8 + 3]),
                      cvtpk(sacc[g][s8 + 4], sacc[g][s8 + 5]), cvtpk(sacc[g][s8 + 6], sacc[g][s8 + 7])};
          pf[g][s] = __builtin_bit_cast(bf16x8, pk);
          if (!RUNMAX) {
#pragma unroll
            for (int w = 0; w < 4; ++w) ps = fdot2(pk[w], 0x3F803F80u, ps);
          }
        }
        lrun[g] += ps;
      }
      __builtin_amdgcn_sched_barrier(0);
      {
        bf16x8 vf[2][2];
#pragma unroll
        for (int dt = 0; dt < 2; ++dt)
#pragma unroll
          for (int s = 0; s < 2; ++s) vf[dt][s] = *(const bf16x8*)(Vs + (dt * 32 + r) * VSTR2 + (t2 * 2 + s) * 32 + h * 16);
#pragma unroll
        for (int s = 0; s < 2; ++s)
#pragma unroll
          for (int dt = 0; dt < 2; ++dt) {
            o[0][dt] = MFMA(vf[dt][s], pf[0][s], o[0][dt]);
            o[1][dt] = MFMA(vf[dt][s], pf[1][s], o[1][dt]);
          }
      }
    }
    __builtin_amdgcn_sched_barrier(0);
    if (nxt) put(smem + (cur ^ 1) * ABUF2);
    __syncthreads();
    cur ^= 1;
  }
#pragma unroll
  for (int g = 0; g < 2; ++g) {
    const float lsum = swapsum32(lrun[g]);
    const float inv = 1.f / lsum;
    const int qrow = qrow0 + 32 * g;
    float ss = 0.f;
    u16* dst = p.MIX + (size_t)(tb + qrow) * 1024 + hh * 64;
#pragma unroll
    for (int dt = 0; dt < 2; ++dt)
#pragma unroll
      for (int g4 = 0; g4 < 4; ++g4) {
        float v[4];
#pragma unroll
        for (int jj = 0; jj < 4; ++jj) { v[jj] = o[g][dt][4 * g4 + jj] * inv; ss += v[jj] * v[jj]; }
        u32x2 ov = {cvtpk(v[0], v[1]), cvtpk(v[2], v[3])};
        *(u32x2*)(dst + dt * 32 + 8 * g4 + 4 * h) = ov;
      }
    ss = swapsum32(ss);
    if (h == 0) p.SSA[(size_t)(tb + qrow) * 8 + hh] = ss;
  }
}

DI void attn_tile3(const Params& p, char* smem, int a) {
  WAVE_COORDS_L
  int q, hh, qt, S, tb;
  if (a < 512) { q = a >> 8; hh = (a >> 5) & 7; qt = a & 31; S = 8192; tb = q << 13; }
  else { const int b = a - 512; q = 2 + (b >> 7); hh = (b >> 4) & 7; qt = b & 15; S = 4096; tb = TP + ((q - 2) << 12); }
  const size_t qkb = ((size_t)tb * 8 + (size_t)hh * S) * 96;
  const u16* Qb = p.Qn + qkb; const u16* Kb = p.Kn + qkb;
  const u16* Vb = p.Vt + (size_t)tb * 512 + (size_t)hh * 64 * S;
  const int qrow0 = qt * 256 + wave * 64 + r;
  bf16x8 qf[2][6];
#pragma unroll
  for (int g = 0; g < 2; ++g)
#pragma unroll
    for (int ks = 0; ks < 6; ++ks) qf[g][ks] = *(const bf16x8*)(Qb + (size_t)(qrow0 + 32 * g) * 96 + ks * 16 + h * 8);
  f32x16 o[2][2];
#pragma unroll
  for (int i = 0; i < 16; ++i) { o[0][0][i] = 0.f; o[0][1][i] = 0.f; o[1][0][i] = 0.f; o[1][1][i] = 0.f; }
  float lrun[2] = {0.f, 0.f};
  int klds_[3], vlds_[2];
#pragma unroll
  for (int i = 0; i < 3; ++i) { const int id = tid + 256 * i; const int kr = id / 12; klds_[i] = kr * KSTR + (id - kr * 12) * 16; }
#pragma unroll
  for (int i = 0; i < 2; ++i) { const int vc = tid & 7; vlds_[i] = 64 * KSTR + ((tid >> 3) + 32 * i) * VSTR2 + (vc >> 1) * 32 + (vc & 1) * 8; }
  const u16* Kg = Kb + tid * 8;
  const u16* Vg = Vb + (size_t)(tid >> 3) * S + (tid & 7) * 8;
  u32x4 rk[3], rv[2];
  const int nkt = S >> 6;
#pragma unroll
  for (int i = 0; i < 3; ++i) rk[i] = *(const u32x4*)(Kg + i * 2048);
#pragma unroll
  for (int i = 0; i < 2; ++i) rv[i] = *(const u32x4*)(Vg + (size_t)(32 * i) * S);
  __syncthreads();
  auto put = [&](char* base) {
#pragma unroll
    for (int i = 0; i < 3; ++i) *(u32x4*)(base + klds_[i]) = rk[i];
#pragma unroll
    for (int i = 0; i < 2; ++i) {
      char* d = base + vlds_[i];
      *(u32x2*)d = u32x2{rv[i][0], rv[i][1]}; *(u32x2*)(d + 16) = u32x2{rv[i][2], rv[i][3]};
    }
  };
  put(smem);
  __syncthreads();
  int cur = 0;
#pragma unroll 1
  for (int kt = 0; kt < nkt; ++kt) {
    const bool nxt = (kt + 1 < nkt);
    if (nxt) {
#pragma unroll
      for (int i = 0; i < 3; ++i) rk[i] = *(const u32x4*)(Kg + (size_t)(kt + 1) * 6144 + i * 2048);
#pragma unroll
      for (int i = 0; i < 2; ++i) rv[i] = *(const u32x4*)(Vg + (size_t)(32 * i) * S + (kt + 1) * 64);
    }
    __builtin_amdgcn_sched_barrier(0);
    const char* Ks = smem + cur * ABUF2;
    const char* Vs = Ks + 64 * KSTR;
    f32x16 sacc[2][2];
#pragma unroll
    for (int i = 0; i < 16; ++i) { sacc[0][0][i] = 0.f; sacc[0][1][i] = 0.f; sacc[1][0][i] = 0.f; sacc[1][1][i] = 0.f; }
#pragma unroll
    for (int kb = 0; kb < 2; ++kb) {
      bf16x8 kf[2][3];
#pragma unroll
      for (int t2 = 0; t2 < 2; ++t2)
#pragma unroll
        for (int ks = 0; ks < 3; ++ks) kf[t2][ks] = *(const bf16x8*)(Ks + (t2 * 32 + r) * KSTR + (kb * 3 + ks) * 32 + h * 16);
#pragma unroll
      for (int ks = 0; ks < 3; ++ks)
#pragma unroll
        for (int t2 = 0; t2 < 2; ++t2) {
          sacc[t2][0] = MFMA(kf[t2][ks], qf[0][kb * 3 + ks], sacc[t2][0]);
          sacc[t2][1] = MFMA(kf[t2][ks], qf[1][kb * 3 + ks], sacc[t2][1]);
        }
    }
    __builtin_amdgcn_sched_barrier(0);
    bf16x8 pf[2][4];
#pragma unroll
    for (int g = 0; g < 2; ++g) {
      float ps = 0.f;
#pragma unroll
      for (int t2 = 0; t2 < 2; ++t2) {
#pragma unroll
        for (int i = 0; i < 16; ++i) sacc[t2][g][i] = __builtin_amdgcn_exp2f(sacc[t2][g][i]);
#pragma unroll
        for (int s = 0; s < 2; ++s) {
          const int s8 = s * 8;
          u32x4 pk = {cvtpk(sacc[t2][g][s8], sacc[t2][g][s8 + 1]), cvtpk(sacc[t2][g][s8 + 2], sacc[t2][g][s8 + 3]),
                      cvtpk(sacc[t2][g][s8 + 4], sacc[t2][g][s8 + 5]), cvtpk(sacc[t2][g][s8 + 6], sacc[t2][g][s8 + 7])};
          pf[g][t2 * 2 + s] = __builtin_bit_cast(bf16x8, pk);
#pragma unroll
          for (int w = 0; w < 4; ++w) ps = fdot2(pk[w], 0x3F803F80u, ps);
        }
      }
      lrun[g] += ps;
    }
    __builtin_amdgcn_sched_barrier(0);
#pragma unroll
    for (int kp = 0; kp < 2; ++kp) {
      bf16x8 vf[2][2];
#pragma unroll
      for (int dt = 0; dt < 2; ++dt)
#pragma unroll
        for (int s = 0; s < 2; ++s) vf[dt][s] = *(const bf16x8*)(Vs + (dt * 32 + r) * VSTR2 + (kp * 2 + s) * 32 + h * 16);
#pragma unroll
      for (int s = 0; s < 2; ++s)
#pragma unroll
        for (int dt = 0; dt < 2; ++dt) {
          o[0][dt] = MFMA(vf[dt][s], pf[0][kp * 2 + s], o[0][dt]);
          o[1][dt] = MFMA(vf[dt][s], pf[1][kp * 2 + s], o[1][dt]);
        }
    }
    __builtin_amdgcn_sched_barrier(0);
    if (nxt) put(smem + (cur ^ 1) * ABUF2);
    __syncthreads();
    cur ^= 1;
  }
#pragma unroll
  for (int g = 0; g < 2; ++g) {
    const float lsum = swapsum32(lrun[g]);
    const float inv = 1.f / lsum;
    const int qrow = qrow0 + 32 * g;
    float ss = 0.f;
    u16* dst = p.MIX + (size_t)(tb + qrow) * 1024 + hh * 64;
#pragma unroll
    for (int dt = 0; dt < 2; ++dt)
#pragma unroll
      for (int g4 = 0; g4 < 4; ++g4) {
        float v[4];
#pragma unroll
        for (int jj = 0; jj < 4; ++jj) { v[jj] = o[g][dt][4 * g4 + jj] * inv; ss += v[jj] * v[jj]; }
        u32x2 ov = {cvtpk(v[0], v[1]), cvtpk(v[2], v[3])};
        *(u32x2*)(dst + dt * 32 + 8 * g4 + 4 * h) = ov;
      }
    ss = swapsum32(ss);
    if (h == 0) p.SSA[(size_t)(tb + qrow) * 8 + hh] = ss;
  }
}

DI void phase4(const Params& p, char* smem) {
    const int G = gridDim.x;
  if (p.misc[0] > 64.f) { for (int a = vblock(); a < 1536; a += G) attn_tile2<true>(p, smem, a); }
  else { for (int a = vblock(); a < 1536; a += G) attn_tile3(p, smem, a); }
  for (int tile = vblock(); tile < 1536; tile += G) {
    WAVE_COORDS_L
    int q, g, k1, S1, tb;
    if (tile < 512) { q = tile >> 8; g = (tile >> 6) & 3; k1 = tile & 63; S1 = 64; tb = q << 13; }
    else { const int b = tile - 512; q = 2 + (b >> 7); g = (b >> 5) & 3; k1 = b & 31; S1 = 32; tb = TP + ((q - 2) << 12); }
    f32x16 acc[2][2]; zero_acc(acc);
    const u16* A = p.G1 + (size_t)tb * 1024 + ((size_t)(g * 128) * S1 + k1) * 256;
    const u16* B = p.WB;
    const int rstride = S1 * 256;
    gemm_mainloop(acc, smem, [&](int rr) { return A + (size_t)rr * rstride; }, [&](int rr) { return B + (size_t)rr * 256; }, 0, 256);
#pragma unroll
    for (int ni = 0; ni < 2; ++ni) {
      const int k2 = wn * 64 + ni * 32 + r;
      const size_t tok = (size_t)(tb + k1 + S1 * k2);
      float ss = 0.f;
#pragma unroll
      for (int mi = 0; mi < 2; ++mi)
#pragma unroll
        for (int g4 = 0; g4 < 4; ++g4) {
          const int m = wm * 64 + mi * 32 + 8 * g4 + 4 * h;
          float v[4];
#pragma unroll
          for (int j = 0; j < 4; ++j) { v[j] = acc[mi][ni][4 * g4 + j]; ss += v[j] * v[j]; }
          u32x2 ov = {cvtpk(v[0], v[1]), cvtpk(v[2], v[3])};
          *(u32x2*)(p.MIX + tok * 1024 + 512 + g * 128 + m) = ov;
        }
      ss += __shfl_xor(ss, 32);
      if (h == 0) p.SSF[tok * 8 + g * 2 + wm] = ss;
    }
  }
}

DI void phase5(const Params& p, char* smem) {
    float* rs = (float*)(smem + 65536);
  const int G = gridDim.x;
  for (int tile = vblock(); tile < 384 * 8; tile += G) {
    WAVE_COORDS_L
    const int mt = tile >> 3, nt = tile & 7, m0 = mt * 128, n0 = nt * 128;
    __syncthreads();
    if (tid < 128) {
      const float* sa = p.SSA + (size_t)(m0 + tid) * 8; const float* sf = p.SSF + (size_t)(m0 + tid) * 8;
      const float ra = rsqrtf((sa[0] + sa[1] + sa[2] + sa[3] + sa[4] + sa[5] + sa[6] + sa[7]) * (1.f / 512.f) + EPS);
      const float rf = rsqrtf((sf[0] + sf[1] + sf[2] + sf[3] + sf[4] + sf[5] + sf[6] + sf[7]) * (1.f / 512.f) + EPS);
      rs[tid] = ra / rf; rs[128 + tid] = rf;
    }
    f32x16 acc[2][2]; zero_acc(acc);
    const u16* A = p.MIX + (size_t)m0 * 1024; const u16* B = p.WoutT + (size_t)n0 * 1024;
    auto af = [&](int rr) { return A + (size_t)rr * 1024; };
    auto bfn = [&](int rr) { return B + (size_t)rr * 1024; };
    gemm_mainloop<true>(acc, smem, af, bfn, 0, 512);
    {
      const float* rb = rs + wm * 64 + 4 * h;
#pragma unroll
      for (int mi = 0; mi < 2; ++mi)
#pragma unroll
        for (int i = 0; i < 16; ++i) {
          const float sc = rb[mi * 32 + (i & 3) + 8 * (i >> 2)];
          acc[mi][0][i] *= sc; acc[mi][1][i] *= sc;
        }
    }
    gemm_mainloop<true>(acc, smem, af, bfn, 512, 1024);
    {
      const float* rb = rs + 128 + wm * 64 + 4 * h;
      char* sb = smem + (wm * 64 + 4 * h) * 512 + (wn * 64 + r) * 4;
#pragma unroll
      for (int mi = 0; mi < 2; ++mi)
#pragma unroll
        for (int i = 0; i < 16; ++i) {
          const int ro = mi * 32 + (i & 3) + 8 * (i >> 2);
          const float sc = rb[ro];
#pragma unroll
          for (int ni = 0; ni < 2; ++ni) *(float*)(sb + ro * 512 + ni * 128) = acc[mi][ni][i] * sc;
        }
    }
    __syncthreads();
#pragma unroll 4
    for (int j = 0; j < 16; ++j) {
      const int id = tid + 256 * j, row = id >> 5, cc = id & 31;
      const int t = m0 + row, col = n0 + cc * 4;
      f32x4 v = *(const f32x4*)(smem + row * 512 + cc * 16);
      const f32x4 xv = *(const f32x4*)(xrow(p, t) + col);
      v[0] += xv[0]; v[1] += xv[1]; v[2] += xv[2]; v[3] += xv[3];
      *(f32x4*)(p.out + (size_t)t * 1024 + col) = v;
      u32x2 ob = {cvtpk(v[0], v[1]), cvtpk(v[2], v[3])};
      *(u32x2*)(p.X2b + (size_t)t * 1024 + col) = ob;
      float ss = v[0] * v[0] + v[1] * v[1] + v[2] * v[2] + v[3] * v[3];
      ss = red32(ss);
      if (cc == 0) p.SS2[(size_t)t * 16 + nt] = ss;
    }
  }
  const int gt = blockIdx.x * NTHR + threadIdx.x, gs = gridDim.x * NTHR;
  for (int id = gt; id < 16384 * 1024 / 16; id += gs) {
    const int d = (id & 63) * 16;
    u32x4 ou, ov;
#pragma unroll
    for (int k = 0; k < 4; ++k) {
      const f32x4 a = *(const f32x4*)(p.peer_u + (size_t)id * 16 + k * 4);
      const f32x4 g = *(const f32x4*)(p.ffn_norm_g + d + k * 4);
      const f32x4 b = *(const f32x4*)(p.peer_v + (size_t)id * 16 + k * 4);
      float u0 = fminf(fmaxf(a[0] * g[0] * USCALE, -448.f), 448.f), u1 = fminf(fmaxf(a[1] * g[1] * USCALE, -448.f), 448.f);
      float u2 = fminf(fmaxf(a[2] * g[2] * USCALE, -448.f), 448.f), u3 = fminf(fmaxf(a[3] * g[3] * USCALE, -448.f), 448.f);
      float v0 = fminf(fmaxf(b[0] * VSCALE, -448.f), 448.f), v1 = fminf(fmaxf(b[1] * VSCALE, -448.f), 448.f);
      float v2 = fminf(fmaxf(b[2] * VSCALE, -448.f), 448.f), v3 = fminf(fmaxf(b[3] * VSCALE, -448.f), 448.f);
      int pu = __builtin_amdgcn_cvt_pk_fp8_f32(u0, u1, 0, false); pu = __builtin_amdgcn_cvt_pk_fp8_f32(u2, u3, pu, true);
      int pv = __builtin_amdgcn_cvt_pk_fp8_f32(v0, v1, 0, false); pv = __builtin_amdgcn_cvt_pk_fp8_f32(v2, v3, pv, true);
      ou[k] = (unsigned)pu; ov[k] = (unsigned)pv;
    }
    {
      const int e = id >> 6, ch = id & 63;
      const size_t o = ((size_t)(ch >> 3) * 16384 + e) * 128 + (ch & 7) * 16;
      *(u32x4*)(p.U8 + o) = ou;
      *(u32x4*)(p.V8 + o) = ov;
    }
  }
}

DI void phase6(const Params& p, char* smem) {
    const int G = gridDim.x;
  u32x4 sa[4], sb[4];
  if (vblock() < 384 * 16) {
    const int t0 = vblock();
    const u16* A0 = p.X2b + (size_t)(t0 >> 4) * 128 * 1024; const u16* B0 = p.WpqT + (size_t)(t0 & 15) * 128 * 1024;
    gemm_issue(sa, sb, [&](int rr) { return A0 + (size_t)rr * 1024; }, [&](int rr) { return B0 + (size_t)rr * 1024; }, 0);
  }
  for (int tile = vblock(); tile < 384 * 16; tile += G) {
    WAVE_COORDS_L
    const int mt = tile >> 4, nt = tile & 15, m0 = mt * 128, n0 = nt * 128;
    const int nx = tile + G; const bool hasn = nx < 384 * 16;
    const u16* An = p.X2b + (size_t)(nx >> 4) * 128 * 1024; const u16* Bn = p.WpqT + (size_t)(nx & 15) * 128 * 1024;
    f32x16 acc[2][2]; zero_acc(acc);
    __syncthreads();
    const u16* A = p.X2b + (size_t)m0 * 1024; const u16* B = p.WpqT + (size_t)n0 * 1024;
    gemm_stream<true, true>(acc, smem, [&](int rr) { return A + (size_t)rr * 1024; }, [&](int rr) { return B + (size_t)rr * 1024; }, 0, 1024, sa, sb,
                      hasn, (long)(An - A), (long)(Bn - B));
    stage_bf16_t<false>(smem, acc, nullptr, wm, wn, r, h);
    __syncthreads();
#pragma unroll
    for (int j = 0; j < 8; ++j) {
      const int id = tid + 256 * j, row = id >> 4, cc = id & 15;
      *(u32x4*)(p.Qp + (size_t)(m0 + row) * 2048 + n0 + cc * 8) = *(const u32x4*)(smem + row * SROW + cc * 16);
    }
  }
}

DI void ins16(float (&top)[16], float x) {
#pragma unroll
  for (int j = 0; j < 16; ++j) { const float hi = fmaxf(top[j], x); x = fminf(top[j], x); top[j] = hi; }
}
DI float mask7(float x) { return __uint_as_float(__float_as_uint(x) & ~0x7Fu); }

#define CE16(a, b) { const float hi_ = fmaxf(a, b); b = fminf(a, b); a = hi_; }
DI void sort16_desc(float (&x)[16]) {
  CE16(x[0], x[1])
  CE16(x[3], x[2])
  CE16(x[4], x[5])
  CE16(x[7], x[6])
  CE16(x[8], x[9])
  CE16(x[11], x[10])
  CE16(x[12], x[13])
  CE16(x[15], x[14])
  CE16(x[0], x[2])
  CE16(x[1], x[3])
  CE16(x[6], x[4])
  CE16(x[7], x[5])
  CE16(x[8], x[10])
  CE16(x[9], x[11])
  CE16(x[14], x[12])
  CE16(x[15], x[13])
  CE16(x[0], x[1])
  CE16(x[2], x[3])
  CE16(x[5], x[4])
  CE16(x[7], x[6])
  CE16(x[8], x[9])
  CE16(x[10], x[11])
  CE16(x[13], x[12])
  CE16(x[15], x[14])
  CE16(x[0], x[4])
  CE16(x[1], x[5])
  CE16(x[2], x[6])
  CE16(x[3], x[7])
  CE16(x[12], x[8])
  CE16(x[13], x[9])
  CE16(x[14], x[10])
  CE16(x[15], x[11])
  CE16(x[0], x[2])
  CE16(x[1], x[3])
  CE16(x[4], x[6])
  CE16(x[5], x[7])
  CE16(x[10], x[8])
  CE16(x[11], x[9])
  CE16(x[14], x[12])
  CE16(x[15], x[13])
  CE16(x[0], x[1])
  CE16(x[2], x[3])
  CE16(x[4], x[5])
  CE16(x[6], x[7])
  CE16(x[9], x[8])
  CE16(x[11], x[10])
  CE16(x[13], x[12])
  CE16(x[15], x[14])
  CE16(x[0], x[8])
  CE16(x[1], x[9])
  CE16(x[2], x[10])
  CE16(x[3], x[11])
  CE16(x[4], x[12])
  CE16(x[5], x[13])
  CE16(x[6], x[14])
  CE16(x[7], x[15])
  CE16(x[0], x[4])
  CE16(x[1], x[5])
  CE16(x[2], x[6])
  CE16(x[3], x[7])
  CE16(x[8], x[12])
  CE16(x[9], x[13])
  CE16(x[10], x[14])
  CE16(x[11], x[15])
  CE16(x[0], x[2])
  CE16(x[1], x[3])
  CE16(x[4], x[6])
  CE16(x[5], x[7])
  CE16(x[8], x[10])
  CE16(x[9], x[11])
  CE16(x[12], x[14])
  CE16(x[13], x[15])
  CE16(x[0], x[1])
  CE16(x[2], x[3])
  CE16(x[4], x[5])
  CE16(x[6], x[7])
  CE16(x[8], x[9])
  CE16(x[10], x[11])
  CE16(x[12], x[13])
  CE16(x[14], x[15])
}
DI void bmerge16_desc(float (&x)[16]) {
  CE16(x[0], x[8])
  CE16(x[1], x[9])
  CE16(x[2], x[10])
  CE16(x[3], x[11])
  CE16(x[4], x[12])
  CE16(x[5], x[13])
  CE16(x[6], x[14])
  CE16(x[7], x[15])
  CE16(x[0], x[4])
  CE16(x[1], x[5])
  CE16(x[2], x[6])
  CE16(x[3], x[7])
  CE16(x[8], x[12])
  CE16(x[9], x[13])
  CE16(x[10], x[14])
  CE16(x[11], x[15])
  CE16(x[0], x[2])
  CE16(x[1], x[3])
  CE16(x[4], x[6])
  CE16(x[5], x[7])
  CE16(x[8], x[10])
  CE16(x[9], x[11])
  CE16(x[12], x[14])
  CE16(x[13], x[15])
  CE16(x[0], x[1])
  CE16(x[2], x[3])
  CE16(x[4], x[5])
  CE16(x[6], x[7])
  CE16(x[8], x[9])
  CE16(x[10], x[11])
  CE16(x[12], x[13])
  CE16(x[14], x[15])
}
DI void top16_merge(float (&A)[16], const float (&B)[16]) {
#pragma unroll
  for (int i = 0; i < 16; ++i) A[i] = fmaxf(A[i], B[15 - i]);
  bmerge16_desc(A);
}

DI void score_top16(const Params& p, const char* sklds, int t, int hh, int c, int r, int h, float (&top)[16]) {
  f32x16 acc[4];
#pragma unroll
  for (int n = 0; n < 4; ++n)
#pragma unroll
    for (int i = 0; i < 16; ++i) acc[n][i] = 0.f;
  const u16* qp = p.Qp + (size_t)t * 2048 + (hh * 2 + c) * 128 + h * 8;
  const char* skb = sklds + c * 32768 + r * 256;
  const int hx = h ^ (r & 15);
  bf16x8 bq[8];
#pragma unroll
  for (int ks = 0; ks < 8; ++ks) bq[ks] = *(const bf16x8*)(qp + ks * 16);
#pragma unroll
  for (int n = 0; n < 4; ++n) {
    bf16x8 fa[8];
#pragma unroll
    for (int ks = 0; ks < 8; ++ks) fa[ks] = *(const bf16x8*)(skb + n * 8192 + (((ks * 2) ^ hx) << 4));
    __builtin_amdgcn_sched_barrier(0);
#pragma unroll
    for (int ks = 0; ks < 8; ++ks) acc[n] = MFMA(fa[ks], bq[ks], acc[n]);
    __builtin_amdgcn_sched_barrier(0);
  }
  float k1[16], k2[16], k3[16];
#pragma unroll
  for (int i = 0; i < 16; ++i) {
    const unsigned ci = (unsigned)crow(i, h);
    top[i] = __uint_as_float((__float_as_uint(acc[0][i]) & ~0x7Fu) | ci);
    k1[i] = __uint_as_float((__float_as_uint(acc[1][i]) & ~0x7Fu) | (32u + ci));
    k2[i] = __uint_as_float((__float_as_uint(acc[2][i]) & ~0x7Fu) | (64u + ci));
    k3[i] = __uint_as_float((__float_as_uint(acc[3][i]) & ~0x7Fu) | (96u + ci));
  }
  sort16_desc(top); sort16_desc(k1); sort16_desc(k2); sort16_desc(k3);
  top16_merge(top, k1); top16_merge(k2, k3); top16_merge(top, k2);
  float oth[16];
#pragma unroll
  for (int j = 0; j < 16; ++j) oth[j] = __shfl_xor(top[j], 32);
  top16_merge(top, oth);
}

DI void phase7(const Params& p, char* smem) {
  WAVE_COORDS
  const int G = gridDim.x;
  volatile unsigned* lw = (volatile unsigned*)(smem + 65536 + 2048 + wave * 1024);
  volatile unsigned char* lb = (volatile unsigned char*)(smem + 65536 + 2048 + wave * 1024);
  const float NEG_INF = __uint_as_float(0xFF800000u);
  const int hh = blockIdx.x & 7, slot = blockIdx.x >> 3, nslot = G >> 3;
  __syncthreads();
  {
    const u16* src = p.SK + (size_t)hh * 2 * 16384;
#pragma unroll 2
    for (int i = 0; i < 16; ++i) {
      const int id = tid + 256 * i;
      const int row = id >> 4, ch = id & 15;
      const u32x4 v = *(const u32x4*)(src + (size_t)row * 128 + ch * 8);
      *(u32x4*)(smem + row * 256 + ((ch ^ (row & 15)) << 4)) = v;
    }
  }
  __syncthreads();
  for (int grp = slot * 4 + wave; grp < 1536; grp += nslot * 4) {
    const int tok0 = grp * 32;
    const int t = tok0 + r;
    float L0[16], L1[16];
    score_top16(p, smem, t, hh, 0, r, h, L0);
    score_top16(p, smem, t, hh, 1, r, h, L1);
    float ct[16], cb[16];
    {
      float ck[50];
    ck[0] = __uint_as_float((__float_as_uint(mask7(L0[0]) + mask7(L1[0])) & ~0xFFu) | 0u);
    ck[1] = __uint_as_float((__float_as_uint(mask7(L0[0]) + mask7(L1[1])) & ~0xFFu) | 1u);
    ck[2] = __uint_as_float((__float_as_uint(mask7(L0[0]) + mask7(L1[2])) & ~0xFFu) | 2u);
    ck[3] = __uint_as_float((__float_as_uint(mask7(L0[0]) + mask7(L1[3])) & ~0xFFu) | 3u);
    ck[4] = __uint_as_float((__float_as_uint(mask7(L0[0]) + mask7(L1[4])) & ~0xFFu) | 4u);
    ck[5] = __uint_as_float((__float_as_uint(mask7(L0[0]) + mask7(L1[5])) & ~0xFFu) | 5u);
    ck[6] = __uint_as_float((__float_as_uint(mask7(L0[0]) + mask7(L1[6])) & ~0xFFu) | 6u);
    ck[7] = __uint_as_float((__float_as_uint(mask7(L0[0]) + mask7(L1[7])) & ~0xFFu) | 7u);
    ck[8] = __uint_as_float((__float_as_uint(mask7(L0[0]) + mask7(L1[8])) & ~0xFFu) | 8u);
    ck[9] = __uint_as_float((__float_as_uint(mask7(L0[0]) + mask7(L1[9])) & ~0xFFu) | 9u);
    ck[10] = __uint_as_float((__float_as_uint(mask7(L0[0]) + mask7(L1[10])) & ~0xFFu) | 10u);
    ck[11] = __uint_as_float((__float_as_uint(mask7(L0[0]) + mask7(L1[11])) & ~0xFFu) | 11u);
    ck[12] = __uint_as_float((__float_as_uint(mask7(L0[0]) + mask7(L1[12])) & ~0xFFu) | 12u);
    ck[13] = __uint_as_float((__float_as_uint(mask7(L0[0]) + mask7(L1[13])) & ~0xFFu) | 13u);
    ck[14] = __uint_as_float((__float_as_uint(mask7(L0[0]) + mask7(L1[14])) & ~0xFFu) | 14u);
    ck[15] = __uint_as_float((__float_as_uint(mask7(L0[0]) + mask7(L1[15])) & ~0xFFu) | 15u);
    ck[16] = __uint_as_float((__float_as_uint(mask7(L0[1]) + mask7(L1[0])) & ~0xFFu) | 16u);
    ck[17] = __uint_as_float((__float_as_uint(mask7(L0[1]) + mask7(L1[1])) & ~0xFFu) | 17u);
    ck[18] = __uint_as_float((__float_as_uint(mask7(L0[1]) + mask7(L1[2])) & ~0xFFu) | 18u);
    ck[19] = __uint_as_float((__float_as_uint(mask7(L0[1]) + mask7(L1[3])) & ~0xFFu) | 19u);
    ck[20] = __uint_as_float((__float_as_uint(mask7(L0[1]) + mask7(L1[4])) & ~0xFFu) | 20u);
    ck[21] = __uint_as_float((__float_as_uint(mask7(L0[1]) + mask7(L1[5])) & ~0xFFu) | 21u);
    ck[22] = __uint_as_float((__float_as_uint(mask7(L0[1]) + mask7(L1[6])) & ~0xFFu) | 22u);
    ck[23] = __uint_as_float((__float_as_uint(mask7(L0[1]) + mask7(L1[7])) & ~0xFFu) | 23u);
    ck[24] = __uint_as_float((__float_as_uint(mask7(L0[2]) + mask7(L1[0])) & ~0xFFu) | 32u);
    ck[25] = __uint_as_float((__float_as_uint(mask7(L0[2]) + mask7(L1[1])) & ~0xFFu) | 33u);
    ck[26] = __uint_as_float((__float_as_uint(mask7(L0[2]) + mask7(L1[2])) & ~0xFFu) | 34u);
    ck[27] = __uint_as_float((__float_as_uint(mask7(L0[2]) + mask7(L1[3])) & ~0xFFu) | 35u);
    ck[28] = __uint_as_float((__float_as_uint(mask7(L0[2]) + mask7(L1[4])) & ~0xFFu) | 36u);
    ck[29] = __uint_as_float((__float_as_uint(mask7(L0[3]) + mask7(L1[0])) & ~0xFFu) | 48u);
    ck[30] = __uint_as_float((__float_as_uint(mask7(L0[3]) + mask7(L1[1])) & ~0xFFu) | 49u);
    ck[31] = __uint_as_float((__float_as_uint(mask7(L0[3]) + mask7(L1[2])) & ~0xFFu) | 50u);
    ck[32] = __uint_as_float((__float_as_uint(mask7(L0[3]) + mask7(L1[3])) & ~0xFFu) | 51u);
    ck[33] = __uint_as_float((__float_as_uint(mask7(L0[4]) + mask7(L1[0])) & ~0xFFu) | 64u);
    ck[34] = __uint_as_float((__float_as_uint(mask7(L0[4]) + mask7(L1[1])) & ~0xFFu) | 65u);
    ck[35] = __uint_as_float((__float_as_uint(mask7(L0[4]) + mask7(L1[2])) & ~0xFFu) | 66u);
    ck[36] = __uint_as_float((__float_as_uint(mask7(L0[5]) + mask7(L1[0])) & ~0xFFu) | 80u);
    ck[37] = __uint_as_float((__float_as_uint(mask7(L0[5]) + mask7(L1[1])) & ~0xFFu) | 81u);
    ck[38] = __uint_as_float((__float_as_uint(mask7(L0[6]) + mask7(L1[0])) & ~0xFFu) | 96u);
    ck[39] = __uint_as_float((__float_as_uint(mask7(L0[6]) + mask7(L1[1])) & ~0xFFu) | 97u);
    ck[40] = __uint_as_float((__float_as_uint(mask7(L0[7]) + mask7(L1[0])) & ~0xFFu) | 112u);
    ck[41] = __uint_as_float((__float_as_uint(mask7(L0[7]) + mask7(L1[1])) & ~0xFFu) | 113u);
    ck[42] = __uint_as_float((__float_as_uint(mask7(L0[8]) + mask7(L1[0])) & ~0xFFu) | 128u);
    ck[43] = __uint_as_float((__float_as_uint(mask7(L0[9]) + mask7(L1[0])) & ~0xFFu) | 144u);
    ck[44] = __uint_as_float((__float_as_uint(mask7(L0[10]) + mask7(L1[0])) & ~0xFFu) | 160u);
    ck[45] = __uint_as_float((__float_as_uint(mask7(L0[11]) + mask7(L1[0])) & ~0xFFu) | 176u);
    ck[46] = __uint_as_float((__float_as_uint(mask7(L0[12]) + mask7(L1[0])) & ~0xFFu) | 192u);
    ck[47] = __uint_as_float((__float_as_uint(mask7(L0[13]) + mask7(L1[0])) & ~0xFFu) | 208u);
    ck[48] = __uint_as_float((__float_as_uint(mask7(L0[14]) + mask7(L1[0])) & ~0xFFu) | 224u);
    ck[49] = __uint_as_float((__float_as_uint(mask7(L0[15]) + mask7(L1[0])) & ~0xFFu) | 240u);
      const float NINF = __uint_as_float(0xFF800000u);
#pragma unroll
      for (int q = 0; q < 25; ++q) {
        float a_ = ck[q], b_ = ck[25 + q];
        asm volatile("" : "+v"(a_), "+v"(b_));
        const float m = h ? b_ : a_;
        if (q < 16) ct[q] = m; else cb[q - 16] = m;
      }
#pragma unroll
      for (int q = 9; q < 16; ++q) cb[q] = NINF;
      sort16_desc(ct); sort16_desc(cb);
      top16_merge(ct, cb);
#pragma unroll
      for (int q = 0; q < 16; ++q) cb[q] = __shfl_xor(ct[q], 32);
      top16_merge(ct, cb);
    }
    if (h == 0) {
#pragma unroll
      for (int w = 0; w < 4; ++w) {
        unsigned v = 0, v2 = 0;
#pragma unroll
        for (int b = 0; b < 4; ++b) {
          v |= (__float_as_uint(L0[w * 4 + b]) & 0x7Fu) << (8 * b);
          v2 |= (__float_as_uint(L1[w * 4 + b]) & 0x7Fu) << (8 * b);
        }
        lw[r * 8 + w] = v;
        lw[r * 8 + 4 + w] = v2;
      }
    }
    __builtin_amdgcn_wave_barrier();
    const float* s2 = p.SS2 + (size_t)t * 16;
    float ssum = 0.f;
#pragma unroll
    for (int j = 0; j < 8; ++j) ssum += s2[j];
    const float r2 = rsqrtf(ssum * (1.f / 1024.f) + EPS);
    float gv[16];
    const float v0 = __uint_as_float(__float_as_uint(ct[0]) & ~0xFFu) * r2;
    float esum = 0.f;
#pragma unroll
    for (int j = 0; j < 16; ++j) {
      const float vj = __uint_as_float(__float_as_uint(ct[j]) & ~0xFFu) * r2;
      gv[j] = __builtin_amdgcn_exp2f((vj - v0) * 1.4426950408889634f);
      esum += gv[j];
    }
    const float einv = 1.f / esum;
    u32x4 oi[2]; f32x4 og[2];
#pragma unroll
    for (int jj = 0; jj < 8; ++jj) {
      float ka = ct[jj], kb = ct[8 + jj], ga = gv[jj], gb = gv[8 + jj];
      asm volatile("" : "+v"(ka), "+v"(kb), "+v"(ga), "+v"(gb));
      const float key = h ? kb : ka;
      const float g = (h ? gb : ga) * einv;
      const unsigned code = __float_as_uint(key) & 0xFFu;
      const unsigned i1 = lb[r * 32 + (code >> 4)], i2 = lb[r * 32 + 16 + (code & 15)];
      oi[jj >> 2][jj & 3] = i1 * 128 + i2;
      og[jj >> 2][jj & 3] = g;
    }
    int* ip = p.IDX + (size_t)t * 128 + hh * 16 + h * 8;
    float* gp = p.G + (size_t)t * 128 + hh * 16 + h * 8;
    *(u32x4*)ip = oi[0]; *(u32x4*)(ip + 4) = oi[1];
    *(f32x4*)gp = og[0]; *(f32x4*)(gp + 4) = og[1];
    __builtin_amdgcn_wave_barrier();
  }
}

DI float gelu_tanh(float x) {
  const float u = 0.7978845608028654f * (x + 0.044715f * x * x * x);
  const float e = __builtin_amdgcn_exp2f(u * 2.8853900817779268f);
  const float th = 1.f - 2.f * __builtin_amdgcn_rcpf(e + 1.f);
  return 0.5f * x * (1.f + th);
}
DI float dot16_fp8(const u32x4& w, const u32x4& xa, const u32x4& xb) {
  float acc = 0.f;
#pragma unroll
  for (int k = 0; k < 4; ++k) {
    const bf2_t b0 = __builtin_amdgcn_cvt_scalef32_pk_bf16_fp8(w[k], 1.0f, false);
    const bf2_t b1 = __builtin_amdgcn_cvt_scalef32_pk_bf16_fp8(w[k], 1.0f, true);
    const unsigned x0 = (k < 2) ? xa[2 * k] : xb[2 * k - 4], x1 = (k < 2) ? xa[2 * k + 1] : xb[2 * k - 3];
    acc = __builtin_amdgcn_fdot2_f32_bf16(b0, __builtin_bit_cast(bf2_t, x0), acc, false);
    acc = __builtin_amdgcn_fdot2_f32_bf16(b1, __builtin_bit_cast(bf2_t, x1), acc, false);
  }
  return acc;
}

template <int CTRL>
DI float dppf(float x) { return __uint_as_float(__builtin_amdgcn_update_dpp(0u, __float_as_uint(x), CTRL, 0xF, 0xF, false)); }
DI float swap32sum(float a, float b) {
  auto rr = __builtin_amdgcn_permlane32_swap(__float_as_uint(a), __float_as_uint(b), false, false);
  return __uint_as_float(rr[0]) + __uint_as_float(rr[1]);
}
DI float swap16sum(float a, float b) {
  auto rr = __builtin_amdgcn_permlane16_swap(__float_as_uint(a), __float_as_uint(b), false, false);
  return __uint_as_float(rr[0]) + __uint_as_float(rr[1]);
}
struct P8Buf { u32x4 w[16]; u32x4 xa, xb; };

DI void p8_load_idx(const Params& p, int t, int j, u32x4 (&ix)[4]) {
  const int* ip = p.IDX + (size_t)t * 128 + j * 16;
#pragma unroll
  for (int q = 0; q < 4; ++q) ix[q] = *(const u32x4*)(ip + q * 4);
}
DI void p8_load_rows(const unsigned char* tab, int s, int cc, const u32x4 (&ix)[4], u32x4 (&w)[16]) {
  const unsigned char* base = tab + (size_t)s * (16384 * 128) + cc * 16;
#pragma unroll
  for (int i = 0; i < 16; ++i) w[i] = *(const u32x4*)(base + (size_t)ix[i >> 2][i & 3] * 128);
}

DI void phase8(const Params& p, char* smem, const int tbase) {
  WAVE_COORDS
  const int G = gridDim.x;
  const int gw = vblock() * 4 + wave, NW = G * 4;
  const int j = lane >> 3, cc = lane & 7;
  const bool b0 = lane & 1, b1 = lane & 2, b2 = lane & 4, b3 = lane & 8, b4 = lane & 16, b5 = lane & 32;
  f32x2* part = (f32x2*)(smem + wave * 12288) + lane;
  const float* coefl = (const float*)(smem + wave * 12288);
  const int ntok_all = (T_TOK - gw + NW - 1) / NW;
  const int ntok = min(24, ntok_all - tbase);
  const int gw0 = gw + tbase * NW;
  if (ntok <= 0) return;
  for (int s = 0; s < 8; ++s) {
    u32x4 ixA[4], ixB[4];
    u32x4 wA[16], wB[16];
    u32x4 xaA, xbA, xaB, xbB;
    auto issue = [&](int i, u32x4 (&ix)[4], u32x4 (&w)[16], u32x4& xa, u32x4& xb) {
      const int t = gw0 + i * NW;
      const u16* xr = p.X2b + (size_t)t * 1024 + s * 128 + cc * 16;
      xa = *(const u32x4*)xr; xb = *(const u32x4*)(xr + 8);
      p8_load_rows(p.U8, s, cc, ix, w);
    };
    auto compute = [&](int i, u32x4 (&w)[16], u32x4& xa, u32x4& xb) {
      float d[16];
#pragma unroll
      for (int q = 0; q < 16; ++q) d[q] = dot16_fp8(w[q], xa, xb);
      float v8[8], v4[4], v2[2];
#pragma unroll
      for (int m = 0; m < 8; ++m) { const float mine = b2 ? d[m + 8] : d[m], send = b2 ? d[m] : d[m + 8]; v8[m] = mine + dppf<0x141>(send); }
#pragma unroll
      for (int m = 0; m < 4; ++m) { const float mine = b1 ? v8[m + 4] : v8[m], send = b1 ? v8[m] : v8[m + 4]; v4[m] = mine + dppf<0x4E>(send); }
#pragma unroll
      for (int m = 0; m < 2; ++m) { const float mine = b0 ? v4[m + 2] : v4[m], send = b0 ? v4[m] : v4[m + 2]; v2[m] = mine + dppf<0xB1>(send); }
      f32x2 acc = {v2[0], v2[1]};
      if (s > 0) { const f32x2 o = part[i * 64]; acc[0] += o[0]; acc[1] += o[1]; }
      part[i * 64] = acc;
    };
    p8_load_idx(p, gw0, j, ixA);
    issue(0, ixA, wA, xaA, xbA);
    if (ntok > 1) p8_load_idx(p, gw0 + NW, j, ixB);
#pragma unroll 1
    for (int i = 0; i < ntok; i += 2) {
      if (i + 1 < ntok) issue(i + 1, ixB, wB, xaB, xbB);
      if (i + 2 < ntok) p8_load_idx(p, gw0 + (i + 2) * NW, j, ixA);
      __builtin_amdgcn_sched_barrier(0);
      compute(i, wA, xaA, xbA);
      __builtin_amdgcn_sched_barrier(0);
      if (i + 1 < ntok) {
        if (i + 2 < ntok) issue(i + 2, ixA, wA, xaA, xbA);
        if (i + 3 < ntok) p8_load_idx(p, gw0 + (i + 3) * NW, j, ixB);
        __builtin_amdgcn_sched_barrier(0);
        compute(i + 1, wB, xaB, xbB);
        __builtin_amdgcn_sched_barrier(0);
      }
    }
  }
  for (int i = 0; i < ntok; ++i) {
    const int t = gw0 + i * NW;
    const float* s2 = p.SS2 + (size_t)t * 16;
    float ssum = 0.f;
#pragma unroll
    for (int q = 0; q < 8; ++q) ssum += s2[q];
    const float r2 = rsqrtf(ssum * (1.f / 1024.f) + EPS) * (1.f / USCALE);
    const f32x2 g = *(const f32x2*)(p.G + (size_t)t * 128 + lane * 2);
    f32x2 a = part[i * 64];
    a[0] = gelu_tanh(a[0] * r2) * g[0] * (1.f / VSCALE);
    a[1] = gelu_tanh(a[1] * r2) * g[1] * (1.f / VSCALE);
    part[i * 64] = a;
  }
  asm volatile("" ::: "memory");
  __builtin_amdgcn_wave_barrier();
  for (int s = 0; s < 8; ++s) {
    u32x4 ixA[4], ixB[4];
    u32x4 wA[16], wB[16];
    auto compute = [&](int i, u32x4 (&w)[16]) {
      const int t = gw0 + i * NW;
      const float* cp = coefl + i * 128 + j * 16;
      f32x4 cf[4];
#pragma unroll
      for (int q = 0; q < 4; ++q) cf[q] = *(const f32x4*)(cp + q * 4);
      f32x2 acc2[8];
#pragma unroll
      for (int e = 0; e < 8; ++e) acc2[e] = f32x2{0.f, 0.f};
#pragma unroll
      for (int q = 0; q < 16; ++q) {
        const float cq = cf[q >> 2][q & 3];
        const f32x2 c2 = {cq, cq};
#pragma unroll
        for (int k = 0; k < 4; ++k) {
          const f32x2 lo = __builtin_amdgcn_cvt_pk_f32_fp8((int)w[q][k], false);
          const f32x2 hi = __builtin_amdgcn_cvt_pk_f32_fp8((int)w[q][k], true);
          acc2[2 * k] = __builtin_elementwise_fma(lo, c2, acc2[2 * k]);
          acc2[2 * k + 1] = __builtin_elementwise_fma(hi, c2, acc2[2 * k + 1]);
        }
      }
      float acc[16];
#pragma unroll
      for (int e = 0; e < 8; ++e) { acc[2 * e] = acc2[e][0]; acc[2 * e + 1] = acc2[e][1]; }
      float v8[8], v4[4], v2[2];
#pragma unroll
      for (int m = 0; m < 8; ++m) v8[m] = swap32sum(acc[m], acc[m + 8]);
#pragma unroll
      for (int m = 0; m < 4; ++m) v4[m] = swap16sum(v8[m], v8[m + 4]);
#pragma unroll
      for (int m = 0; m < 2; ++m) { const float mine = b3 ? v4[m + 2] : v4[m], send = b3 ? v4[m] : v4[m + 2]; v2[m] = mine + dppf<0x128>(send); }
      float* op = p.out + (size_t)t * 1024 + s * 128 + cc * 16 + 2 * j;
      f32x2 o = *(f32x2*)op;
      o[0] += v2[0]; o[1] += v2[1];
      *(f32x2*)op = o;
    };
    p8_load_idx(p, gw0, j, ixA);
    p8_load_rows(p.V8, s, cc, ixA, wA);
    if (ntok > 1) p8_load_idx(p, gw0 + NW, j, ixB);
#pragma unroll 1
    for (int i = 0; i < ntok; i += 2) {
      if (i + 1 < ntok) p8_load_rows(p.V8, s, cc, ixB, wB);
      if (i + 2 < ntok) p8_load_idx(p, gw0 + (i + 2) * NW, j, ixA);
      __builtin_amdgcn_sched_barrier(0);
      compute(i, wA);
      __builtin_amdgcn_sched_barrier(0);
      if (i + 1 < ntok) {
        if (i + 2 < ntok) p8_load_rows(p.V8, s, cc, ixA, wA);
        if (i + 3 < ntok) p8_load_idx(p, gw0 + (i + 3) * NW, j, ixB);
        __builtin_amdgcn_sched_barrier(0);
        compute(i + 1, wB);
        __builtin_amdgcn_sched_barrier(0);
      }
    }
  }
  asm volatile("" ::: "memory");
  __builtin_amdgcn_wave_barrier();
}

extern __shared__ __attribute__((aligned(16))) char dyn_smem[];

DI void run_phase(const Params& p, int ph, char* smem) {
  switch (ph) {
    case 0: phase0(p); break;
    case 1: phase1(p, smem); break;
    case 2: phase2(p, smem); break;
    case 3: phase3(p, smem); break;
    case 4: phase4(p, smem); break;
    case 5: phase5(p, smem); break;
    case 6: phase6(p, smem); break;
    case 7: phase7(p, smem); break;
    default: phase8(p, smem, 0); break;
  }
}


#define XB_TMO      128
#define XB_XCNT(j)  (256  + 64 * (j))
#define XB_XSUB(j)  (1280 + 64 * (j))
#define XB_XGEN(j)  (2304 + 64 * (j))
#define XB_TOP      3328
#define XB_TOPGEN   3392
#define XCD_BAR_WORDS 3456
#define XB_SPIN_CAP (1u << 22)
#define LAS __attribute__((address_space(3)))
DI unsigned xb_ld(unsigned* p) { return __hip_atomic_load(p, __ATOMIC_RELAXED, __HIP_MEMORY_SCOPE_AGENT); }
DI unsigned xb_add(unsigned* p, unsigned v) { return __hip_atomic_fetch_add(p, v, __ATOMIC_RELAXED, __HIP_MEMORY_SCOPE_AGENT); }
DI unsigned xb_xcc_id() { return (unsigned)__builtin_amdgcn_s_getreg((3 << 11) | 20) & 0xFu; }
#define XB_SPIN(cond, bar) do { unsigned _sp = 0; while (cond) { __builtin_amdgcn_s_sleep(1); \
    if ((++_sp & 255u) == 0u) { if (xb_ld(&(bar)[XB_TMO])) break; if (_sp > XB_SPIN_CAP) { atomicAdd(&(bar)[XB_TMO], 1u); break; } } } } while (0)
struct XcdBarrier { unsigned* bar; unsigned x; volatile LAS unsigned* st; };
DI XcdBarrier xcd_barrier_post(unsigned* bar, volatile LAS unsigned* st) {
  XcdBarrier b; b.bar = bar; b.x = xb_xcc_id(); b.st = st;
  if (threadIdx.x == 0) (void)xb_add(&bar[XB_XCNT(b.x)], 1u);
  return b;
}
DI void xcd_barrier_complete(unsigned* bar, unsigned x, unsigned& nloc, unsigned& nx) {
  const unsigned G = gridDim.x * gridDim.y * gridDim.z;
  unsigned sum, cnt, mine, sp = 0u;
  for (;;) {
    sum = 0u; cnt = 0u; mine = 0u;
#pragma unroll
    for (unsigned j = 0; j < 16; ++j) { const unsigned c = xb_ld(&bar[XB_XCNT(j)]); sum += c; cnt += (c > 0u) ? 1u : 0u; mine = (j == x) ? c : mine; }
    if (sum == G) break;
    __builtin_amdgcn_s_sleep(1);
    if ((++sp & 255u) == 0u) { if (xb_ld(&bar[XB_TMO])) break; if (sp > XB_SPIN_CAP) { atomicAdd(&bar[XB_TMO], 1u); break; } }
  }
  nloc = mine > 0u ? mine : 1u; nx = cnt > 0u ? cnt : 1u;
}
DI void xcd_barrier(const XcdBarrier& b) {
  asm volatile("s_waitcnt vmcnt(0)" ::: "memory");
  __syncthreads();
  if (threadIdx.x == 0) {
    unsigned* bar = b.bar;
    __builtin_amdgcn_s_waitcnt(0);
    unsigned nloc = b.st[0], nx = b.st[1];
    if (nloc == 0u) { xcd_barrier_complete(bar, b.x, nloc, nx); b.st[0] = nloc; b.st[1] = nx; }
    const unsigned old = xb_add(&bar[XB_XSUB(b.x)], 1u);
    const unsigned gen = old / nloc;
    if (old + 1u == (gen + 1u) * nloc) {
      __builtin_amdgcn_fence(__ATOMIC_RELEASE, "agent");
      asm volatile("s_waitcnt vmcnt(0)" ::: "memory");
      const unsigned og = xb_add(&bar[XB_TOP], 1u);
      const unsigned tg = og / nx;
      if (og + 1u == (tg + 1u) * nx) xb_add(&bar[XB_TOPGEN], 1u);
      else XB_SPIN(xb_ld(&bar[XB_TOPGEN]) == tg, bar);
      __builtin_amdgcn_fence(__ATOMIC_ACQUIRE, "agent");
      xb_add(&bar[XB_XGEN(b.x)], 1u);
      asm volatile("s_waitcnt vmcnt(0)" ::: "memory");
    } else {
      XB_SPIN(xb_ld(&bar[XB_XGEN(b.x)]) == gen, bar);
      __builtin_amdgcn_fence(__ATOMIC_ACQUIRE, "agent");
      asm volatile("s_waitcnt vmcnt(0)" ::: "memory");
    }
  }
  __syncthreads();
}

#if MK_COOP
__global__ void __launch_bounds__(NTHR, 2) mega_kernel(Params p) {
  cg::grid_group grid = cg::this_grid();
#ifndef PROBE_PH
#define PROBE_PH -1
#endif
  volatile LAS unsigned* st = (volatile LAS unsigned*)(dyn_smem + 65536 + 1024);
  if (threadIdx.x < 4) st[threadIdx.x] = 0u;
  for (int i = blockIdx.x * NTHR + threadIdx.x; i < XCD_BAR_WORDS; i += gridDim.x * NTHR) p.bar[i] = 0u;
  phase0(p);
  grid.sync();
  XcdBarrier xb = xcd_barrier_post(p.bar, st);
#define RUNP(k, call) call; xcd_barrier(xb); if (PROBE_PH == k) { call; xcd_barrier(xb); }
  RUNP(1, phase1(p, dyn_smem))
  RUNP(2, phase2(p, dyn_smem))
  RUNP(3, phase3(p, dyn_smem))
  RUNP(4, phase4(p, dyn_smem))
  RUNP(5, phase5(p, dyn_smem))
  RUNP(6, phase6(p, dyn_smem))
  RUNP(7, phase7(p, dyn_smem))
  for (int tb8 = 0; tb8 * (int)gridDim.x * 4 < T_TOK; tb8 += 24) phase8(p, dyn_smem, tb8);
}
#else
template <int PH>
__global__ void __launch_bounds__(NTHR, 2) phase_kernel(Params p) { run_phase(p, PH, dyn_smem); }
#endif

extern "C" void kernel_launch(void* const* d_in, const int* in_sizes, int n_in, void* d_out, int out_size, void* d_ws,
                              size_t ws_size, hipStream_t stream) {
  Params p{};
  const float* const* in = (const float* const*)d_in;
  p.x0 = in[0]; p.x1 = in[1]; p.attn_norm_g = in[2]; p.w_in = in[3]; p.q_lat_g = in[4]; p.w_uq = in[5];
  p.kv_lat_g = in[6]; p.w_ukv = in[7]; p.q_head_g = in[8]; p.k_head_g = in[9]; p.attn_out_g = in[10];
  p.fnet_out_g = in[11]; p.w_out = in[12]; p.ffn_norm_g = in[13]; p.peer_w_q = in[14]; p.peer_sub_keys = in[15];
  p.peer_u = in[16]; p.peer_v = in[17];
  p.out = (float*)d_out;
  char* ws = (char*)d_ws;
  size_t off = 0;
  auto take = [&](size_t bytes) { char* q = ws + off; off += (bytes + 255) & ~(size_t)255; return q; };
  p.WinT = (u16*)take(1280 * 1024 * 2); p.WuqT = (u16*)take(768 * 384 * 2); p.WukvT = (u16*)take(1024 * 256 * 2);
  p.WoutT = (u16*)take(1024 * 1024 * 2); p.WpqT = (u16*)take(2048 * 1024 * 2); p.SK = (u16*)take(262144 * 2);
  p.Wc = (u16*)take(256 * 128 * 2); p.WA64 = (u16*)take(128 * 128 * 2); p.WA32 = (u16*)take(128 * 64 * 2);
  p.WB = (u16*)take(128 * 256 * 2);
  p.ropec = (float*)take(8192 * 16 * 4); p.ropes = (float*)take(8192 * 16 * 4);
  p.rstd1 = (float*)take((size_t)T_TOK * 4); p.SSP = (float*)take((size_t)T_TOK * 10 * 4);
  p.SSA = (float*)take((size_t)T_TOK * 8 * 4); p.SSF = (float*)take((size_t)T_TOK * 8 * 4);
  p.SS2 = (float*)take((size_t)T_TOK * 16 * 4); p.KR = (float*)take((size_t)T_TOK * 32 * 4);
  p.bar = (unsigned*)take(XCD_BAR_WORDS * 4);
  p.misc = (float*)take(256);
  const size_t SMALL = 28u << 20;
  char* big = ws + SMALL;
  const size_t MB = 1u << 20;
  char* dsp = (char*)d_out;
  p.Xb = (u16*)(big + 0 * MB);
  p.CQ = (u16*)(big + 96 * MB); p.CKV = (u16*)(big + 132 * MB); p.F = (u16*)(big + 156 * MB);
  p.Z1 = (u16*)(big + 204 * MB);
  p.Vt = (u16*)(big + 300 * MB);
  p.Q1 = (u16*)(dsp + 0 * MB); p.K1 = (u16*)(dsp + 72 * MB);
  p.Qn = (u16*)(big + 0 * MB); p.Kn = (u16*)(dsp + 120 * MB);
  p.G1 = (u16*)(big + 96 * MB);
  p.MIX = (u16*)(big + 204 * MB);
  p.X2b = (u16*)(big + 0 * MB);
  p.Qp = (u16*)(big + 96 * MB);
  p.IDX = (int*)(big + 300 * MB); p.G = (float*)(big + 324 * MB);
  p.U8 = (unsigned char*)(big + 348 * MB); p.V8 = (unsigned char*)(big + 364 * MB);

#if MK_COOP
  static int grid_blocks = 0;
  if (!grid_blocks) {
    int dev = 0, cus = 0, per_cu = 0;
    hipGetDevice(&dev);
    hipDeviceGetAttribute(&cus, hipDeviceAttributeMultiprocessorCount, dev);
    hipFuncSetAttribute((const void*)mega_kernel, hipFuncAttributeMaxDynamicSharedMemorySize, LDS_BYTES);
    hipOccupancyMaxActiveBlocksPerMultiprocessor(&per_cu, mega_kernel, NTHR, LDS_BYTES);
    if (per_cu > 2) per_cu = 2;
    grid_blocks = cus * per_cu;
    grid_blocks &= ~7;
  }
  void* args[] = {&p};
  hipError_t e = hipLaunchCooperativeKernel((void*)mega_kernel, dim3(grid_blocks), dim3(NTHR), args, LDS_BYTES, stream);
  if (e != hipSuccess) fprintf(stderr, "cooperative launch failed: %s (grid %d)\n", hipGetErrorString(e), grid_blocks);
#else
  const int GB = 512;
#define LAUNCH(PH)                                                                                                \
  hipFuncSetAttribute((const void*)phase_kernel<PH>, hipFuncAttributeMaxDynamicSharedMemorySize, LDS_BYTES);      \
  phase_kernel<PH><<<GB, NTHR, LDS_BYTES, stream>>>(p);
  LAUNCH(0) LAUNCH(1) LAUNCH(2) LAUNCH(3) LAUNCH(4) LAUNCH(5) LAUNCH(6) LAUNCH(7) LAUNCH(8)
#endif
}
```

```cpp
#include <hip/hip_runtime.h>
#include <hip/hip_cooperative_groups.h>
#include <stdint.h>
#include <cstdio>
namespace cg = cooperative_groups;

#ifndef MK_COOP
#define MK_COOP 1
#endif

typedef unsigned short u16;
using bf16x8 = __attribute__((ext_vector_type(8))) short;
using f32x16 = __attribute__((ext_vector_type(16))) float;
using f32x4 = __attribute__((ext_vector_type(4))) float;
using f32x2 = __attribute__((ext_vector_type(2))) float;
using u32x4 = __attribute__((ext_vector_type(4))) unsigned;
using u32x2 = __attribute__((ext_vector_type(2))) unsigned;
typedef __bf16 bf2_t __attribute__((ext_vector_type(2)));

#define DI __device__ __forceinline__
#define MFMA(a, b, c) __builtin_amdgcn_mfma_f32_32x32x16_bf16((a), (b), (c), 0, 0, 0)

constexpr int T_TOK = 49152;
constexpr int TP = 16384;
constexpr float EPS = 1e-6f;
constexpr int NTHR = 256;
constexpr int LDS_BYTES = 65536 + 6144;
constexpr int GBUF = 32768;
constexpr float USCALE = 512.f, VSCALE = 256.f;

struct Params {
  const float *x0, *x1, *attn_norm_g, *w_in, *q_lat_g, *w_uq, *kv_lat_g, *w_ukv, *q_head_g, *k_head_g,
      *attn_out_g, *fnet_out_g, *w_out, *ffn_norm_g, *peer_w_q, *peer_sub_keys, *peer_u, *peer_v;
  float* out;
  u16 *WinT, *WuqT, *WukvT, *WoutT, *WpqT, *SK, *Wc, *WA64, *WA32, *WB;
  float *ropec, *ropes, *rstd1, *SSP, *SSA, *SSF, *SS2, *KR;
  u16 *Xb, *CQ, *CKV, *F, *Z1, *Vt, *Q1, *K1, *Qn, *Kn, *G1, *MIX, *X2b, *Qp;
  unsigned char *U8, *V8;
  int* IDX;
  float* G;
  unsigned* bar;
  float* misc;
};

DI unsigned cvtpk(float lo, float hi) {
  f32x2 v = {lo, hi};
  bf2_t b = __builtin_convertvector(v, bf2_t);
  return __builtin_bit_cast(unsigned, b);
}
DI u16 f2bf(float x) { return (u16)(cvtpk(x, 0.f) & 0xffffu); }
DI float bflo(unsigned w) { return __uint_as_float(w << 16); }
DI float bfhi(unsigned w) { return __uint_as_float(w & 0xffff0000u); }
DI int crow(int i, int h) { return (i & 3) + 8 * (i >> 2) + 4 * h; }
DI float red32(float v) {
  v += __shfl_xor(v, 1); v += __shfl_xor(v, 2); v += __shfl_xor(v, 4); v += __shfl_xor(v, 8); v += __shfl_xor(v, 16);
  return v;
}
DI float wave_sum(float v) { v = red32(v); v += __shfl_xor(v, 32); return v; }
DI const float* xrow(const Params& p, int t) {
  return t < TP ? p.x0 + (size_t)t * 1024 : p.x1 + (size_t)(t - TP) * 1024;
}
DI void tok2seq(int t, int& q, int& S, int& tb) {
  if (t < TP) { q = t >> 13; S = 8192; tb = q << 13; }
  else { int u = (t - TP) >> 12; q = 2 + u; S = 4096; tb = TP + (u << 12); }
}
DI int vblock() { return (blockIdx.x & 7) * (gridDim.x >> 3) + (blockIdx.x >> 3); }
DI float fdot2(unsigned a, unsigned b, float c) {
  return __builtin_amdgcn_fdot2_f32_bf16(__builtin_bit_cast(bf2_t, a), __builtin_bit_cast(bf2_t, b), c, false);
}

DI int swz(int row, int c) { return row * 128 + ((c ^ ((row >> 1) & 7)) << 4); }

template <class AF, class BF>
DI void gemm_issue(u32x4 (&ra)[4], u32x4 (&rb)[4], AF arow, BF brow, int k0) {
  const int tid = threadIdx.x, lrow = tid >> 3, lc = tid & 7;
#pragma unroll
  for (int i = 0; i < 4; ++i) {
    ra[i] = *(const u32x4*)(arow(lrow + 32 * i) + lc * 8 + k0);
    rb[i] = *(const u32x4*)(brow(lrow + 32 * i) + lc * 8 + k0);
  }
}
template <bool BATCH = false, bool PRE = false, class AF, class BF>
DI void gemm_stream(f32x16 (&acc)[2][2], char* smem, AF arow, BF brow, int k0, int k1, u32x4 (&ra0)[4], u32x4 (&rb0)[4],
                    bool hasn, long dA, long dB) {
  const int tid = threadIdx.x, lane = tid & 63, wave = tid >> 6;
  const int wm = wave >> 1, wn = wave & 1, r = lane & 31, h = lane >> 5;
  const int lrow = tid >> 3, lc = tid & 7;
  const u16* ap[4]; const u16* bp[4];
#pragma unroll
  for (int i = 0; i < 4; ++i) { ap[i] = arow(lrow + 32 * i) + lc * 8; bp[i] = brow(lrow + 32 * i) + lc * 8; }
  u32x4 ra1[4], rb1[4];
  if (!PRE) {
#pragma unroll
    for (int i = 0; i < 4; ++i) { ra0[i] = *(const u32x4*)(ap[i] + k0); rb0[i] = *(const u32x4*)(bp[i] + k0); }
  }
#pragma unroll
  for (int i = 0; i < 4; ++i) {
    *(u32x4*)(smem + swz(lrow + 32 * i, lc)) = ra0[i];
    *(u32x4*)(smem + 16384 + swz(lrow + 32 * i, lc)) = rb0[i];
  }
  if (k0 + 64 < k1) {
#pragma unroll
    for (int i = 0; i < 4; ++i) { ra0[i] = *(const u32x4*)(ap[i] + k0 + 64); rb0[i] = *(const u32x4*)(bp[i] + k0 + 64); }
  }
  __syncthreads();
  int cur = 0;
  auto step = [&](int k, u32x4 (&xa)[4], u32x4 (&xb)[4], u32x4 (&ya)[4], u32x4 (&yb)[4]) {
    if (k + 128 < k1) {
#pragma unroll
      for (int i = 0; i < 4; ++i) { ya[i] = *(const u32x4*)(ap[i] + k + 128); yb[i] = *(const u32x4*)(bp[i] + k + 128); }
    }
    if (hasn && k + 64 >= k1) {
#pragma unroll
      for (int i = 0; i < 4; ++i) { ra0[i] = *(const u32x4*)(ap[i] + dA); rb0[i] = *(const u32x4*)(bp[i] + dB); }
    }
    __builtin_amdgcn_sched_barrier(0);
    const char* As = smem + cur * GBUF;
    const char* Bs = As + 16384;
    if (BATCH) {
      bf16x8 af[4][2], bfr[4][2];
#pragma unroll
      for (int ks = 0; ks < 4; ++ks) {
#pragma unroll
        for (int mi = 0; mi < 2; ++mi) af[ks][mi] = *(const bf16x8*)(As + swz(wm * 64 + mi * 32 + r, ks * 2 + h));
#pragma unroll
        for (int ni = 0; ni < 2; ++ni) bfr[ks][ni] = *(const bf16x8*)(Bs + swz(wn * 64 + ni * 32 + r, ks * 2 + h));
      }
      __builtin_amdgcn_sched_barrier(0);
#pragma unroll
      for (int ks = 0; ks < 4; ++ks)
#pragma unroll
        for (int mi = 0; mi < 2; ++mi)
#pragma unroll
          for (int ni = 0; ni < 2; ++ni) acc[mi][ni] = MFMA(af[ks][mi], bfr[ks][ni], acc[mi][ni]);
    } else {
#pragma unroll
      for (int ks = 0; ks < 4; ++ks) {
        bf16x8 af[2], bfr[2];
#pragma unroll
        for (int mi = 0; mi < 2; ++mi) af[mi] = *(const bf16x8*)(As + swz(wm * 64 + mi * 32 + r, ks * 2 + h));
#pragma unroll
        for (int ni = 0; ni < 2; ++ni) bfr[ni] = *(const bf16x8*)(Bs + swz(wn * 64 + ni * 32 + r, ks * 2 + h));
#pragma unroll
        for (int mi = 0; mi < 2; ++mi)
#pragma unroll
          for (int ni = 0; ni < 2; ++ni) acc[mi][ni] = MFMA(af[mi], bfr[ni], acc[mi][ni]);
      }
    }
    __builtin_amdgcn_sched_barrier(0);
    if (k + 64 < k1) {
      char* An = smem + (cur ^ 1) * GBUF;
#pragma unroll
      for (int i = 0; i < 4; ++i) {
        *(u32x4*)(An + swz(lrow + 32 * i, lc)) = xa[i];
        *(u32x4*)(An + 16384 + swz(lrow + 32 * i, lc)) = xb[i];
      }
    }
    __syncthreads();
    cur ^= 1;
  };
#pragma unroll 1
  for (int k = k0; k < k1; k += 128) {
    step(k, ra0, rb0, ra1, rb1);
    if (k + 64 < k1) step(k + 64, ra1, rb1, ra0, rb0);
  }
}
template <bool BATCH = false, class AF, class BF>
DI void gemm_mainloop(f32x16 (&acc)[2][2], char* smem, AF arow, BF brow, int k0, int k1) {
  u32x4 ra0[4], rb0[4];
  gemm_stream<BATCH, false>(acc, smem, arow, brow, k0, k1, ra0, rb0, false, 0, 0);
}
DI void zero_acc(f32x16 (&acc)[2][2]) {
#pragma unroll
  for (int a = 0; a < 2; ++a)
#pragma unroll
    for (int b = 0; b < 2; ++b)
#pragma unroll
      for (int i = 0; i < 16; ++i) acc[a][b][i] = 0.f;
}
#define WAVE_COORDS                                                        \
  const int tid = threadIdx.x, lane = tid & 63, wave = tid >> 6;           \
  const int wm = wave >> 1, wn = wave & 1, r = lane & 31, h = lane >> 5;   \
  (void)wm; (void)wn; (void)r; (void)h; (void)lane;

constexpr int SROW = 272;
template <bool SCALE>
DI void stage_bf16_t(char* smem, f32x16 (&acc)[2][2], const float* rs, int wm, int wn, int r, int h) {
  char* base = smem + (wm * 64 + 4 * h) * SROW + (wn * 64 + r) * 2;
  const float* rb = rs + wm * 64 + 4 * h;
#pragma unroll
  for (int mi = 0; mi < 2; ++mi)
#pragma unroll
    for (int i = 0; i < 16; ++i) {
      const int ro = mi * 32 + (i & 3) + 8 * (i >> 2);
      const float sc = SCALE ? rb[ro] : 1.f;
#pragma unroll
      for (int ni = 0; ni < 2; ++ni)
        *(u16*)(base + ro * SROW + ni * 64) = f2bf(acc[mi][ni][i] * sc);
    }
}
DI void stage_bf16(char* smem, f32x16 (&acc)[2][2], const float* rs, int wm, int wn, int r, int h, int) {
  if (rs) stage_bf16_t<true>(smem, acc, rs, wm, wn, r, h); else stage_bf16_t<false>(smem, acc, rs, wm, wn, r, h);
}
DI float sumsq8(const u32x4& v) {
  float ss = 0.f;
#pragma unroll
  for (int j = 0; j < 4; ++j) { const float a = bflo(v[j]), b = bfhi(v[j]); ss += a * a + b * b; }
  return ss;
}

#define WAVE_COORDS_L                                                      \
  int tid = threadIdx.x; asm volatile("" : "+v"(tid));                     \
  const int lane = tid & 63, wave = tid >> 6;                              \
  const int wm = wave >> 1, wn = wave & 1, r = lane & 31, h = lane >> 5;   \
  (void)wm; (void)wn; (void)r; (void)h; (void)lane;

template <int MODE>
DI void transpose_w(u16* dst, const float* src, const float* g0, const float* g1, int N, int K, int Nsrc, int gt, int gs) {
  const int items = N * (K >> 3);
  for (int id = gt; id < items; id += gs) {
    const int kc = id / N, n = id - kc * N;
    int col = n; bool valid = true;
    if (MODE == 1) {
      if (n < 640) col = n; else if (n < 1152) col = n + 32; else if (n < 1184) col = 640 + n - 1152; else valid = false;
    }
    float v[8];
#pragma unroll
    for (int j = 0; j < 8; ++j) {
      const int k = kc * 8 + j;
      const float g = (MODE == 2 && k >= 512) ? g1[k - 512] : g0[k];
      v[j] = valid ? src[(size_t)k * Nsrc + col] * g : 0.f;
    }
    u32x4 o = {cvtpk(v[0], v[1]), cvtpk(v[2], v[3]), cvtpk(v[4], v[5]), cvtpk(v[6], v[7])};
    *(u32x4*)(dst + (size_t)n * K + kc * 8) = o;
  }
}

DI void phase0(const Params& p) {
  const int gt = blockIdx.x * NTHR + threadIdx.x, gs = gridDim.x * NTHR;
  if (gt == 0) {
    float mq = 0.f, mk = 0.f;
    for (int d = 0; d < 96; ++d) { mq = fmaxf(mq, fabsf(p.q_head_g[d])); mk = fmaxf(mk, fabsf(p.k_head_g[d])); }
    p.misc[0] = 96.f * mq * mk * (0.10206207261596575f * 1.4426950408889634f) * 1.02f;
  }
  const int lane = threadIdx.x & 63, gw = gt >> 6, nw = gs >> 6;
  for (int t = gw; t < T_TOK; t += nw) {
    const float* xr = xrow(p, t);
    f32x4 v[4]; float ss = 0.f;
#pragma unroll
    for (int i = 0; i < 4; ++i) {
      v[i] = *(const f32x4*)(xr + i * 256 + lane * 4);
      ss += v[i][0] * v[i][0] + v[i][1] * v[i][1] + v[i][2] * v[i][2] + v[i][3] * v[i][3];
    }
    ss = wave_sum(ss);
#pragma unroll
    for (int i = 0; i < 4; ++i) {
      u32x2 o = {cvtpk(v[i][0], v[i][1]), cvtpk(v[i][2], v[i][3])};
      *(u32x2*)(p.Xb + (size_t)t * 1024 + i * 256 + lane * 4) = o;
    }
    if (lane == 0) p.rstd1[t] = rsqrtf(ss * (1.f / 1024.f) + EPS);
  }
  transpose_w<1>(p.WinT, p.w_in, p.attn_norm_g, nullptr, 1280, 1024, 1184, gt, gs);
  transpose_w<0>(p.WuqT, p.w_uq, p.q_lat_g, nullptr, 768, 384, 768, gt, gs);
  transpose_w<0>(p.WukvT, p.w_ukv, p.kv_lat_g, nullptr, 1024, 256, 1024, gt, gs);
  transpose_w<2>(p.WoutT, p.w_out, p.attn_out_g, p.fnet_out_g, 1024, 1024, 1024, gt, gs);
  transpose_w<0>(p.WpqT, p.peer_w_q, p.ffn_norm_g, nullptr, 2048, 1024, 2048, gt, gs);
  for (int id = gt; id < 262144 / 4; id += gs) {
    f32x4 v = *(const f32x4*)(p.peer_sub_keys + (size_t)id * 4);
    u32x2 o = {cvtpk(v[0], v[1]), cvtpk(v[2], v[3])};
    *(u32x2*)(p.SK + (size_t)id * 4) = o;
  }
  for (int id = gt; id < 256 * 128; id += gs) {
    const int n = id >> 7, c = id & 127, pp = n >> 7, m = n & 127;
    const float fr = (float)((m * c) & 127) * (1.f / 128.f);
    const float val = (pp == 0 ? __builtin_amdgcn_cosf(fr) : -__builtin_amdgcn_sinf(fr)) * 0.08838834764831845f;
    p.Wc[id] = f2bf(val);
  }
  for (int id = gt; id < 128 * 128; id += gs) {
    const int n = id >> 7, k = id & 127;
    const int k1 = (n >> 6) * 32 + (n & 31), pq = (n >> 5) & 1, pp = k >> 6, s1 = k & 63;
    const float fr = (float)((s1 * k1) & 63) * (1.f / 64.f);
    const float c = __builtin_amdgcn_cosf(fr), s = __builtin_amdgcn_sinf(fr);
    const float val = (pq == 0 ? (pp == 0 ? c : s) : (pp == 0 ? -s : c)) * 0.125f;
    p.WA64[id] = f2bf(val);
  }
  for (int id = gt; id < 128 * 64; id += gs) {
    const int n = id >> 6, k = id & 63;
    const int k1 = n & 31, pq = (n >> 5) & 1, pp = k >> 5, s1 = k & 31;
    const float fr = (float)((s1 * k1) & 31) * (1.f / 32.f);
    const float c = __builtin_amdgcn_cosf(fr), s = __builtin_amdgcn_sinf(fr);
    float val = (pq == 0 ? (pp == 0 ? c : s) : (pp == 0 ? -s : c)) * 0.17677669529663687f;
    if (n >= 64) val = 0.f;
    p.WA32[id] = f2bf(val);
  }
  for (int id = gt; id < 128 * 256; id += gs) {
    const int k2 = id >> 8, k = id & 255, pq = k >> 7, s2 = k & 127;
    const float fr = (float)((s2 * k2) & 127) * (1.f / 128.f);
    const float val = (pq == 0 ? __builtin_amdgcn_cosf(fr) : __builtin_amdgcn_sinf(fr)) * 0.08838834764831845f;
    p.WB[id] = f2bf(val);
  }
  for (int id = gt; id < 8192 * 16; id += gs) {
    const int pos = id >> 4, j = id & 15;
    const float freq = exp2f(-(float)j * (13.287712379549449f / 16.f));
    const double rev = (double)pos * (double)freq * 0.15915494309189535;
    const float fr = (float)(rev - floor(rev));
    p.ropec[id] = __builtin_amdgcn_cosf(fr);
    p.ropes[id] = __builtin_amdgcn_sinf(fr);
  }
}

DI void phase1(const Params& p, char* smem) {
    float* rs = (float*)(smem + 65536);
  const int G = gridDim.x;
  u32x4 sa[4], sb[4];
  if (vblock() < 384 * 10) {
    const int t0 = vblock(), mt0 = t0 / 10;
    const u16* A0 = p.Xb + (size_t)mt0 * 128 * 1024; const u16* B0 = p.WinT + (size_t)(t0 - mt0 * 10) * 128 * 1024;
    gemm_issue(sa, sb, [&](int rr) { return A0 + (size_t)rr * 1024; }, [&](int rr) { return B0 + (size_t)rr * 1024; }, 0);
  }
  for (int tile = vblock(); tile < 384 * 10; tile += G) {
    WAVE_COORDS_L
    const int mt = tile / 10, nt = tile - mt * 10, m0 = mt * 128, n0 = nt * 128;
    const int nx = tile + G; const bool hasn = nx < 384 * 10;
    const int nmt = nx / 10;
    const u16* An = p.Xb + (size_t)nmt * 128 * 1024; const u16* Bn = p.WinT + (size_t)(nx - nmt * 10) * 128 * 1024;
    __syncthreads();
    if (tid < 128) rs[tid] = p.rstd1[m0 + tid];
    f32x16 acc[2][2]; zero_acc(acc);
    const u16* A = p.Xb + (size_t)m0 * 1024; const u16* B = p.WinT + (size_t)n0 * 1024;
    gemm_stream<true, true>(acc, smem, [&](int rr) { return A + (size_t)rr * 1024; }, [&](int rr) { return B + (size_t)rr * 1024; }, 0, 1024, sa, sb,
                      hasn, (long)(An - A), (long)(Bn - B));
    if (nt == 9) {
      if (wn == 0) {
#pragma unroll
        for (int mi = 0; mi < 2; ++mi)
#pragma unroll
          for (int i = 0; i < 16; ++i) {
            const int ro = mi * 32 + (i & 3) + 8 * (i >> 2);
            p.KR[(size_t)(m0 + wm * 64 + 4 * h + ro) * 32 + r] = acc[mi][0][i] * rs[wm * 64 + 4 * h + ro];
          }
      }
    } else {
      stage_bf16_t<true>(smem, acc, rs, wm, wn, r, h);
      __syncthreads();
      u16* dbase; int dstride, cbase;
      if (nt < 3) { dbase = p.CQ; dstride = 384; cbase = n0; }
      else if (nt < 5) { dbase = p.CKV; dstride = 256; cbase = n0 - 384; }
      else { dbase = p.F; dstride = 512; cbase = n0 - 640; }
#pragma unroll
      for (int j = 0; j < 8; ++j) {
        const int id = tid + 256 * j, row = id >> 4, cc = id & 15;
        const u32x4 v = *(const u32x4*)(smem + row * SROW + cc * 16);
        *(u32x4*)(dbase + (size_t)(m0 + row) * dstride + cbase + cc * 8) = v;
        if (nt < 5) {
          float ss = sumsq8(v);
          ss += __shfl_xor(ss, 1); ss += __shfl_xor(ss, 2); ss += __shfl_xor(ss, 4); ss += __shfl_xor(ss, 8);
          if (cc == 0) p.SSP[(size_t)(m0 + row) * 10 + nt * 2] = ss;
        }
      }
    }
  }
}

DI void phase2(const Params& p, char* smem) {
    float* rs = (float*)(smem + 65536);
  const int G = gridDim.x;
  const int NUQ = 384 * 6, NUKV = 384 * 8, NCH = 384 * 8;
  for (int tile = vblock(); tile < NUQ + NUKV + NCH; tile += G) {
    WAVE_COORDS_L
    f32x16 acc[2][2]; zero_acc(acc);
    __syncthreads();
    if (tile < NUQ) {
      const int mt = tile / 6, nt = tile - mt * 6, m0 = mt * 128, n0 = nt * 128;
      if (tid < 128) {
        const float* s = p.SSP + (size_t)(m0 + tid) * 10;
        rs[tid] = rsqrtf((s[0] + s[2] + s[4]) * (1.f / 384.f) + EPS);
      }
      const u16* A = p.CQ + (size_t)m0 * 384; const u16* B = p.WuqT + (size_t)n0 * 384;
      gemm_mainloop(acc, smem, [&](int rr) { return A + (size_t)rr * 384; }, [&](int rr) { return B + (size_t)rr * 384; }, 0, 384);
      stage_bf16_t<true>(smem, acc, rs, wm, wn, r, h);
      __syncthreads();
#pragma unroll
      for (int j = 0; j < 8; ++j) {
        const int id = tid + 256 * j, row = id >> 4, cc = id & 15;
        *(u32x4*)(p.Q1 + (size_t)(m0 + row) * 768 + n0 + cc * 8) = *(const u32x4*)(smem + row * SROW + cc * 16);
      }
    } else if (tile < NUQ + NUKV) {
      const int tl = tile - NUQ;
      const int mt = tl >> 3, hh = tl & 7, m0 = mt * 128;
      int q, S, tb; tok2seq(m0, q, S, tb);
      if (tid < 128) {
        const float* s = p.SSP + (size_t)(m0 + tid) * 10;
        rs[tid] = rsqrtf((s[6] + s[8]) * (1.f / 256.f) + EPS);
      }
      const u16* A = p.CKV + (size_t)m0 * 256; const u16* B = p.WukvT + (size_t)hh * 128 * 256;
      gemm_mainloop(acc, smem, [&](int rr) { return A + (size_t)rr * 256; }, [&](int rr) { return B + (size_t)rr * 256; }, 0, 256);
      if (wn == 0) {
#pragma unroll
        for (int mi = 0; mi < 2; ++mi)
#pragma unroll
          for (int i = 0; i < 16; ++i) {
            const int ro = mi * 32 + (i & 3) + 8 * (i >> 2);
            const float sc = (rs + wm * 64 + 4 * h)[ro];
#pragma unroll
            for (int ni = 0; ni < 2; ++ni) *(u16*)(smem + (wm * 64 + 4 * h) * SROW + r * 2 + ro * SROW + ni * 64) = f2bf(acc[mi][ni][i] * sc);
          }
      } else {
        const int s0 = m0 - tb;
#pragma unroll
        for (int mi = 0; mi < 2; ++mi)
#pragma unroll
          for (int g4 = 0; g4 < 4; ++g4) {
            const int row = wm * 64 + mi * 32 + 8 * g4 + 4 * h;
            const f32x4 sc = *(const f32x4*)(rs + row);
#pragma unroll
            for (int ni = 0; ni < 2; ++ni) {
              const int dv = ni * 32 + r;
              u32x2 o = {cvtpk(acc[mi][ni][4 * g4] * sc[0], acc[mi][ni][4 * g4 + 1] * sc[1]),
                         cvtpk(acc[mi][ni][4 * g4 + 2] * sc[2], acc[mi][ni][4 * g4 + 3] * sc[3])};
              *(u32x2*)(p.Vt + (size_t)tb * 512 + (size_t)(hh * 64 + dv) * S + s0 + row) = o;
            }
            __builtin_amdgcn_sched_barrier(0);
          }
      }
      __syncthreads();
#pragma unroll
      for (int j = 0; j < 4; ++j) {
        const int id = tid + 256 * j, row = id >> 3, cc = id & 7;
        *(u32x4*)(p.K1 + (size_t)(m0 + row) * 512 + hh * 64 + cc * 8) = *(const u32x4*)(smem + row * SROW + cc * 16);
      }
    } else {
      const int tl = tile - NUQ - NUKV;
      const int pp = tl & 1, g = (tl >> 1) & 3, mt = tl >> 3, m0 = mt * 128;
      int q, S, tb; tok2seq(m0, q, S, tb);
      const int S1 = (q < 2) ? 64 : 32, l1 = (q < 2) ? 6 : 5;
      const int j0 = ((m0 - tb) >> 7) * (128 >> l1);
      const u16* Fb = p.F + (size_t)g * 128;
      const u16* B = p.Wc + (size_t)pp * 128 * 128;
      gemm_mainloop(acc, smem,
                    [&](int rr) { const int s1 = rr & (S1 - 1), s2 = j0 + (rr >> l1); return Fb + (size_t)(tb + s1 * 128 + s2) * 512; },
                    [&](int rr) { return B + (size_t)rr * 128; }, 0, 128);
      u16* Zb = p.Z1 + (size_t)tb * 1024;
#pragma unroll
      for (int mi = 0; mi < 2; ++mi)
#pragma unroll
        for (int g4 = 0; g4 < 4; ++g4) {
          const int rho = wm * 64 + mi * 32 + 8 * g4 + 4 * h;
          const int s1 = rho & (S1 - 1), s2 = j0 + (rho >> l1);
#pragma unroll
          for (int ni = 0; ni < 2; ++ni) {
            const int m = wn * 64 + ni * 32 + r;
            u32x2 o = {cvtpk(acc[mi][ni][4 * g4], acc[mi][ni][4 * g4 + 1]), cvtpk(acc[mi][ni][4 * g4 + 2], acc[mi][ni][4 * g4 + 3])};
            *(u32x2*)(Zb + ((size_t)((g * 128 + m) * 128 + s2) * (2 * S1)) + pp * S1 + s1) = o;
          }
          __builtin_amdgcn_sched_barrier(0);
        }
    }
  }
}

DI void phase3(const Params& p, char* smem) {
    const int G = gridDim.x;
  for (int tile = vblock(); tile < 5120; tile += G) {
    WAVE_COORDS_L
    const int q = tile >> 9, gm = tile & 511;
    const int tb = (q < 2) ? (q << 13) : (TP + ((q - 2) << 12));
    const int S = (q < 2) ? 8192 : 4096, S1 = (q < 2) ? 64 : 32, K = 2 * S1;
    f32x16 acc[2][2]; zero_acc(acc);
    const u16* A = p.Z1 + (size_t)tb * 1024 + (size_t)gm * 128 * K;
    const u16* B = (q < 2) ? p.WA64 : p.WA32;
    gemm_mainloop(acc, smem, [&](int rr) { return A + (size_t)rr * K; }, [&](int rr) { return B + (size_t)rr * K; }, 0, K);
    if (wn * 32 < S1) {
      const int k1 = wn * 32 + r;
      const float invS = 1.f / (float)S;
      u16* Gb = p.G1 + (size_t)tb * 1024 + (size_t)(gm * S1 + k1) * 256;
#pragma unroll
      for (int mi = 0; mi < 2; ++mi)
#pragma unroll
        for (int g4 = 0; g4 < 4; ++g4) {
          const int s2b = wm * 64 + mi * 32 + 8 * g4 + 4 * h;
          float ore[4], oim[4];
#pragma unroll
          for (int j = 0; j < 4; ++j) {
            const int s2 = s2b + j;
            const float fr = (float)((s2 * k1) & (S - 1)) * invS;
            const float c = __builtin_amdgcn_cosf(fr), s = __builtin_amdgcn_sinf(fr);
            const float re = acc[mi][0][4 * g4 + j], im = acc[mi][1][4 * g4 + j];
            ore[j] = re * c + im * s; oim[j] = im * c - re * s;
          }
          u32x2 o0 = {cvtpk(ore[0], ore[1]), cvtpk(ore[2], ore[3])};
          u32x2 o1 = {cvtpk(oim[0], oim[1]), cvtpk(oim[2], oim[3])};
          *(u32x2*)(Gb + s2b) = o0;
          *(u32x2*)(Gb + 128 + s2b) = o1;
        }
    }
  }
  const float QSCALE = 0.10206207261596575f * 1.4426950408889634f;
  for (int chunk = vblock(); chunk < T_TOK * 8 / NTHR; chunk += G) {
    WAVE_COORDS_L
    const int id = chunk * NTHR + tid;
    const int t = id >> 3, hh = id & 7;
    int q, S, tb; tok2seq(t, q, S, tb);
    const int s = t - tb;
    const size_t obase = ((size_t)tb * 8 + (size_t)hh * S + s) * 96;
    const float* rcp = p.ropec + s * 16; const float* rsp = p.ropes + s * 16;
    {
      u32x4 w[12];
      const u16* src = p.Q1 + (size_t)t * 768 + hh * 96;
#pragma unroll
      for (int i = 0; i < 12; ++i) w[i] = *(const u32x4*)(src + i * 8);
      float ss = 0.f;
#pragma unroll
      for (int i = 0; i < 12; ++i)
#pragma unroll
        for (int j = 0; j < 4; ++j) { const float a = bflo(w[i][j]), b = bfhi(w[i][j]); ss += a * a + b * b; }
      const float rinv = rsqrtf(ss * (1.f / 96.f) + EPS);
      u16* dst = p.Qn + obase;
#pragma unroll
      for (int i = 0; i < 8; ++i) {
        u32x4 o;
#pragma unroll
        for (int j = 0; j < 4; ++j) {
          const int d = i * 8 + j * 2;
          o[j] = cvtpk(bflo(w[i][j]) * rinv * p.q_head_g[d] * QSCALE, bfhi(w[i][j]) * rinv * p.q_head_g[d + 1] * QSCALE);
        }
        *(u32x4*)(dst + i * 8) = o;
      }
      float x1[16], x2[16];
#pragma unroll
      for (int i = 0; i < 2; ++i)
#pragma unroll
        for (int j = 0; j < 4; ++j) {
          const int e = i * 8 + j * 2;
          x1[e] = bflo(w[8 + i][j]) * rinv * p.q_head_g[64 + e]; x1[e + 1] = bfhi(w[8 + i][j]) * rinv * p.q_head_g[64 + e + 1];
          x2[e] = bflo(w[10 + i][j]) * rinv * p.q_head_g[80 + e]; x2[e + 1] = bfhi(w[10 + i][j]) * rinv * p.q_head_g[80 + e + 1];
        }
      float o1[16], o2[16];
#pragma unroll
      for (int e = 0; e < 16; ++e) {
        const float c = rcp[e], sn = rsp[e];
        o1[e] = (x1[e] * c - x2[e] * sn) * QSCALE; o2[e] = (x2[e] * c + x1[e] * sn) * QSCALE;
      }
#pragma unroll
      for (int i = 0; i < 2; ++i) {
        u32x4 a, b;
#pragma unroll
        for (int j = 0; j < 4; ++j) { a[j] = cvtpk(o1[i * 8 + j * 2], o1[i * 8 + j * 2 + 1]); b[j] = cvtpk(o2[i * 8 + j * 2], o2[i * 8 + j * 2 + 1]); }
        *(u32x4*)(dst + 64 + i * 8) = a;
        *(u32x4*)(dst + 80 + i * 8) = b;
      }
    }
    __builtin_amdgcn_sched_barrier(0);
    {
      u32x4 w[8];
      const u16* src = p.K1 + (size_t)t * 512 + hh * 64;
#pragma unroll
      for (int i = 0; i < 8; ++i) w[i] = *(const u32x4*)(src + i * 8);
      f32x4 kr[8];
#pragma unroll
      for (int i = 0; i < 8; ++i) kr[i] = *(const f32x4*)(p.KR + (size_t)t * 32 + i * 4);
      float ss = 0.f;
#pragma unroll
      for (int i = 0; i < 8; ++i)
#pragma unroll
        for (int j = 0; j < 4; ++j) { const float a = bflo(w[i][j]), b = bfhi(w[i][j]); ss += a * a + b * b + kr[i][j] * kr[i][j]; }
      const float rinv = rsqrtf(ss * (1.f / 96.f) + EPS);
      u16* dst = p.Kn + obase;
#pragma unroll
      for (int i = 0; i < 8; ++i) {
        u32x4 o;
#pragma unroll
        for (int j = 0; j < 4; ++j) {
          const int d = i * 8 + j * 2;
          o[j] = cvtpk(bflo(w[i][j]) * rinv * p.k_head_g[d], bfhi(w[i][j]) * rinv * p.k_head_g[d + 1]);
        }
        *(u32x4*)(dst + i * 8) = o;
      }
      float o1[16], o2[16];
#pragma unroll
      for (int e = 0; e < 16; ++e) {
        const float a = kr[e >> 2][e & 3] * rinv * p.k_head_g[64 + e];
        const float b = kr[4 + (e >> 2)][e & 3] * rinv * p.k_head_g[80 + e];
        const float c = rcp[e], sn = rsp[e];
        o1[e] = a * c - b * sn; o2[e] = b * c + a * sn;
      }
#pragma unroll
      for (int i = 0; i < 2; ++i) {
        u32x4 a, b;
#pragma unroll
        for (int j = 0; j < 4; ++j) { a[j] = cvtpk(o1[i * 8 + j * 2], o1[i * 8 + j * 2 + 1]); b[j] = cvtpk(o2[i * 8 + j * 2], o2[i * 8 + j * 2 + 1]); }
        *(u32x4*)(dst + 64 + i * 8) = a;
        *(u32x4*)(dst + 80 + i * 8) = b;
      }
    }
  }
}

constexpr int KSTR = 208, VSTR = 136, ABUF = 64 * KSTR + 64 * VSTR;

DI void attn_tile(const Params& p, char* smem, int a) {
  WAVE_COORDS
  int q, hh, qt, S, tb;
  if (a < 1024) { q = a >> 9; hh = (a >> 6) & 7; qt = a & 63; S = 8192; tb = q << 13; }
  else { const int b = a - 1024; q = 2 + (b >> 8); hh = (b >> 5) & 7; qt = b & 31; S = 4096; tb = TP + ((q - 2) << 12); }
  const size_t qkb = ((size_t)tb * 8 + (size_t)hh * S) * 96;
  const u16* Qb = p.Qn + qkb; const u16* Kb = p.Kn + qkb;
  const u16* Vb = p.Vt + (size_t)tb * 512 + (size_t)hh * 64 * S;
  const int qrow = qt * 128 + wave * 32 + r;
  bf16x8 qf[6];
#pragma unroll
  for (int ks = 0; ks < 6; ++ks) qf[ks] = *(const bf16x8*)(Qb + (size_t)qrow * 96 + ks * 16 + h * 8);
  f32x16 o[2];
#pragma unroll
  for (int i = 0; i < 16; ++i) { o[0][i] = 0.f; o[1][i] = 0.f; }
  float mrun = -1e30f, lrun = 0.f;
  int krow_[3], kc_[3], vrow_[2], vc_[2];
#pragma unroll
  for (int i = 0; i < 3; ++i) { const int id = tid + 256 * i; krow_[i] = id / 12; kc_[i] = id - krow_[i] * 12; }
#pragma unroll
  for (int i = 0; i < 2; ++i) { const int id = tid + 256 * i; vrow_[i] = id >> 3; vc_[i] = id & 7; }
  u32x4 rk[3], rv[2];
  const int nkt = S >> 6;
#pragma unroll
  for (int i = 0; i < 3; ++i) rk[i] = *(const u32x4*)(Kb + (size_t)krow_[i] * 96 + kc_[i] * 8);
#pragma unroll
  for (int i = 0; i < 2; ++i) rv[i] = *(const u32x4*)(Vb + (size_t)vrow_[i] * S + vc_[i] * 8);
  __syncthreads();
#pragma unroll
  for (int i = 0; i < 3; ++i) *(u32x4*)(smem + krow_[i] * KSTR + kc_[i] * 16) = rk[i];
#pragma unroll
  for (int i = 0; i < 2; ++i) {
    char* d = smem + 64 * KSTR + vrow_[i] * VSTR + vc_[i] * 16;
    *(u32x2*)d = u32x2{rv[i][0], rv[i][1]}; *(u32x2*)(d + 8) = u32x2{rv[i][2], rv[i][3]};
  }
  __syncthreads();
  int cur = 0;
  for (int kt = 0; kt < nkt; ++kt) {
    const bool nxt = (kt + 1 < nkt);
    if (nxt) {
#pragma unroll
      for (int i = 0; i < 3; ++i) rk[i] = *(const u32x4*)(Kb + (size_t)((kt + 1) * 64 + krow_[i]) * 96 + kc_[i] * 8);
#pragma unroll
      for (int i = 0; i < 2; ++i) rv[i] = *(const u32x4*)(Vb + (size_t)vrow_[i] * S + (kt + 1) * 64 + vc_[i] * 8);
    }
    __builtin_amdgcn_sched_barrier(0);
    const char* Ks = smem + cur * ABUF;
    const char* Vs = Ks + 64 * KSTR;
    f32x16 sacc[2];
#pragma unroll
    for (int i = 0; i < 16; ++i) { sacc[0][i] = 0.f; sacc[1][i] = 0.f; }
#pragma unroll
    for (int t2 = 0; t2 < 2; ++t2)
#pragma unroll
      for (int ks = 0; ks < 6; ++ks) {
        const bf16x8 kf = *(const bf16x8*)(Ks + (t2 * 32 + r) * KSTR + ks * 32 + h * 16);
        sacc[t2] = MFMA(kf, qf[ks], sacc[t2]);
      }
    float mx = sacc[0][0];
#pragma unroll
    for (int i = 0; i < 16; ++i) { mx = fmaxf(mx, sacc[0][i]); mx = fmaxf(mx, sacc[1][i]); }
    mx = fmaxf(mx, __shfl_xor(mx, 32));
    const float mnew = fmaxf(mrun, mx);
    const float alpha = __builtin_amdgcn_exp2f(mrun - mnew);
    mrun = mnew;
    lrun *= alpha;
#pragma unroll
    for (int i = 0; i < 16; ++i) { o[0][i] *= alpha; o[1][i] *= alpha; }
    float ps = 0.f;
#pragma unroll
    for (int t2 = 0; t2 < 2; ++t2)
#pragma unroll
      for (int i = 0; i < 16; ++i) { const float e = __builtin_amdgcn_exp2f(sacc[t2][i] - mnew); sacc[t2][i] = e; ps += e; }
    lrun += ps;
    bf16x8 pf[4];
#pragma unroll
    for (int kk = 0; kk < 4; ++kk) {
      const int t2 = kk >> 1, s8 = (kk & 1) * 8;
      u32x4 pk = {cvtpk(sacc[t2][s8], sacc[t2][s8 + 1]), cvtpk(sacc[t2][s8 + 2], sacc[t2][s8 + 3]),
                  cvtpk(sacc[t2][s8 + 4], sacc[t2][s8 + 5]), cvtpk(sacc[t2][s8 + 6], sacc[t2][s8 + 7])};
      pf[kk] = __builtin_bit_cast(bf16x8, pk);
    }
#pragma unroll
    for (int dt = 0; dt < 2; ++dt)
#pragma unroll
      for (int kk = 0; kk < 4; ++kk) {
        const char* vp = Vs + (dt * 32 + r) * VSTR + kk * 32 + h * 8;
        const u32x2 lo = *(const u32x2*)vp, hi = *(const u32x2*)(vp + 16);
        u32x4 vv = {lo[0], lo[1], hi[0], hi[1]};
        o[dt] = MFMA(__builtin_bit_cast(bf16x8, vv), pf[kk], o[dt]);
      }
    __builtin_amdgcn_sched_barrier(0);
    if (nxt) {
      char* Kn_ = smem + (cur ^ 1) * ABUF;
#pragma unroll
      for (int i = 0; i < 3; ++i) *(u32x4*)(Kn_ + krow_[i] * KSTR + kc_[i] * 16) = rk[i];
#pragma unroll
      for (int i = 0; i < 2; ++i) {
        char* d = Kn_ + 64 * KSTR + vrow_[i] * VSTR + vc_[i] * 16;
        *(u32x2*)d = u32x2{rv[i][0], rv[i][1]}; *(u32x2*)(d + 8) = u32x2{rv[i][2], rv[i][3]};
      }
    }
    __syncthreads();
    cur ^= 1;
  }
  lrun += __shfl_xor(lrun, 32);
  const float inv = 1.f / lrun;
  float ss = 0.f;
  u16* dst = p.MIX + (size_t)(tb + qrow) * 1024 + hh * 64;
#pragma unroll
  for (int dt = 0; dt < 2; ++dt)
#pragma unroll
    for (int g4 = 0; g4 < 4; ++g4) {
      float v[4];
#pragma unroll
      for (int j = 0; j < 4; ++j) { v[j] = o[dt][4 * g4 + j] * inv; ss += v[j] * v[j]; }
      u32x2 ov = {cvtpk(v[0], v[1]), cvtpk(v[2], v[3])};
      *(u32x2*)(dst + dt * 32 + 8 * g4 + 4 * h) = ov;
    }
  ss += __shfl_xor(ss, 32);
  if (h == 0) p.SSA[(size_t)(tb + qrow) * 8 + hh] = ss;
}

constexpr int VSTR2 = 144, ABUF2 = 64 * KSTR + 64 * VSTR2;
DI float swapmax32(float v) {
  auto rr = __builtin_amdgcn_permlane32_swap(__float_as_uint(v), __float_as_uint(v), false, false);
  return fmaxf(__uint_as_float(rr[0]), __uint_as_float(rr[1]));
}
DI float swapsum32(float v) {
  auto rr = __builtin_amdgcn_permlane32_swap(__float_as_uint(v), __float_as_uint(v), false, false);
  return __uint_as_float(rr[0]) + __uint_as_float(rr[1]);
}
template <bool RUNMAX>
DI void attn_tile2(const Params& p, char* smem, int a) {
  WAVE_COORDS_L
  int q, hh, qt, S, tb;
  if (a < 512) { q = a >> 8; hh = (a >> 5) & 7; qt = a & 31; S = 8192; tb = q << 13; }
  else { const int b = a - 512; q = 2 + (b >> 7); hh = (b >> 4) & 7; qt = b & 15; S = 4096; tb = TP + ((q - 2) << 12); }
  const size_t qkb = ((size_t)tb * 8 + (size_t)hh * S) * 96;
  const u16* Qb = p.Qn + qkb; const u16* Kb = p.Kn + qkb;
  const u16* Vb = p.Vt + (size_t)tb * 512 + (size_t)hh * 64 * S;
  const int qrow0 = qt * 256 + wave * 64 + r;
  bf16x8 qf[2][6];
#pragma unroll
  for (int g = 0; g < 2; ++g)
#pragma unroll
    for (int ks = 0; ks < 6; ++ks) qf[g][ks] = *(const bf16x8*)(Qb + (size_t)(qrow0 + 32 * g) * 96 + ks * 16 + h * 8);
  f32x16 o[2][2];
#pragma unroll
  for (int i = 0; i < 16; ++i) { o[0][0][i] = 0.f; o[0][1][i] = 0.f; o[1][0][i] = 0.f; o[1][1][i] = 0.f; }
  float mrun[2] = {-1e30f, -1e30f}, lrun[2] = {0.f, 0.f};
  int klds_[3], vlds_[2];
#pragma unroll
  for (int i = 0; i < 3; ++i) { const int id = tid + 256 * i; const int kr = id / 12; klds_[i] = kr * KSTR + (id - kr * 12) * 16; }
#pragma unroll
  for (int i = 0; i < 2; ++i) { const int vc = tid & 7; vlds_[i] = 64 * KSTR + ((tid >> 3) + 32 * i) * VSTR2 + (vc >> 1) * 32 + (vc & 1) * 8; }
  const u16* Kg = Kb + tid * 8;
  const u16* Vg = Vb + (size_t)(tid >> 3) * S + (tid & 7) * 8;
  u32x4 rk[3], rv[2];
  const int nkt = S >> 6;
#pragma unroll
  for (int i = 0; i < 3; ++i) rk[i] = *(const u32x4*)(Kg + i * 2048);
#pragma unroll
  for (int i = 0; i < 2; ++i) rv[i] = *(const u32x4*)(Vg + (size_t)(32 * i) * S);
  __syncthreads();
  auto put = [&](char* base) {
#pragma unroll
    for (int i = 0; i < 3; ++i) *(u32x4*)(base + klds_[i]) = rk[i];
#pragma unroll
    for (int i = 0; i < 2; ++i) {
      char* d = base + vlds_[i];
      *(u32x2*)d = u32x2{rv[i][0], rv[i][1]}; *(u32x2*)(d + 16) = u32x2{rv[i][2], rv[i][3]};
    }
  };
  put(smem);
  __syncthreads();
  int cur = 0;
#pragma unroll 1
  for (int kt = 0; kt < nkt; ++kt) {
    const bool nxt = (kt + 1 < nkt);
    if (nxt) {
#pragma unroll
      for (int i = 0; i < 3; ++i) rk[i] = *(const u32x4*)(Kg + (size_t)(kt + 1) * 6144 + i * 2048);
#pragma unroll
      for (int i = 0; i < 2; ++i) rv[i] = *(const u32x4*)(Vg + (size_t)(32 * i) * S + (kt + 1) * 64);
    }
    __builtin_amdgcn_sched_barrier(0);
    const char* Ks = smem + cur * ABUF2;
    const char* Vs = Ks + 64 * KSTR;
#pragma unroll
    for (int t2 = 0; t2 < 2; ++t2) {
      f32x16 sacc[2];
#pragma unroll
      for (int i = 0; i < 16; ++i) { sacc[0][i] = 0.f; sacc[1][i] = 0.f; }
#pragma unroll
      for (int kb = 0; kb < 2; ++kb) {
        bf16x8 kf[3];
#pragma unroll
        for (int ks = 0; ks < 3; ++ks) kf[ks] = *(const bf16x8*)(Ks + (t2 * 32 + r) * KSTR + (kb * 3 + ks) * 32 + h * 16);
#pragma unroll
        for (int ks = 0; ks < 3; ++ks) {
          sacc[0] = MFMA(kf[ks], qf[0][kb * 3 + ks], sacc[0]);
          sacc[1] = MFMA(kf[ks], qf[1][kb * 3 + ks], sacc[1]);
        }
      }
      __builtin_amdgcn_sched_barrier(0);
      bf16x8 pf[2][2];
#pragma unroll
      for (int g = 0; g < 2; ++g) {
        float ps = 0.f;
        if (RUNMAX) {
        float mx = sacc[g][0];
#pragma unroll
        for (int i = 1; i < 16; ++i) mx = fmaxf(mx, sacc[g][i]);
        mx = swapmax32(mx);
        const float mnew = fmaxf(mrun[g], mx);
        if (__ballot(mnew > mrun[g]) != 0ull) {
          const float alpha = __builtin_amdgcn_exp2f(mrun[g] - mnew);
          lrun[g] *= alpha;
#pragma unroll
          for (int i = 0; i < 16; ++i) { o[g][0][i] *= alpha; o[g][1][i] *= alpha; }
          mrun[g] = mnew;
        }
#pragma unroll
        for (int i = 0; i < 16; ++i) { const float e = __builtin_amdgcn_exp2f(sacc[g][i] - mrun[g]); sacc[g][i] = e; ps += e; }
        } else {
#pragma unroll
          for (int i = 0; i < 16; ++i) sacc[g][i] = __builtin_amdgcn_exp2f(sacc[g][i]);
        }
#pragma unroll
        for (int s = 0; s < 2; ++s) {
          const int s8 = s * 8;
          u32x4 pk = {cvtpk(sacc[g][s8], sacc[g][s8 + 1]), cvtpk(sacc[g][s8 + 2], sacc[g][s8 + 3]),
                      cvtpk(sacc[g][s8 + 4], sacc[g][s8 + 5]), cvtpk(sacc[g][s8 + 6], sacc[g][s8 + 7])};
          pf[g][s] = __builtin_bit_cast(bf16x8, pk);
          if (!RUNMAX) {
#pragma unroll
            for (int w = 0; w < 4; ++w) ps = fdot2(pk[w], 0x3F803F80u, ps);
          }
        }
        lrun[g] += ps;
      }
      __builtin_amdgcn_sched_barrier(0);
      {
        bf16x8 vf[2][2];
#pragma unroll
        for (int dt = 0; dt < 2; ++dt)
#pragma unroll
          for (int s = 0; s < 2; ++s) vf[dt][s] = *(const bf16x8*)(Vs + (dt * 32 + r) * VSTR2 + (t2 * 2 + s) * 32 + h * 16);
#pragma unroll
        for (int s = 0; s < 2; ++s)
#pragma unroll
          for (int dt = 0; dt < 2; ++dt) {
            o[0][dt] = MFMA(vf[dt][s], pf[0][s], o[0][dt]);
            o[1][dt] = MFMA(vf[dt][s], pf[1][s], o[1][dt]);
          }
      }
    }
    __builtin_amdgcn_sched_barrier(0);
    if (nxt) put(smem + (cur ^ 1) * ABUF2);
    __syncthreads();
    cur ^= 1;
  }
#pragma unroll
  for (int g = 0; g < 2; ++g) {
    const float lsum = swapsum32(lrun[g]);
    const float inv = 1.f / lsum;
    const int qrow = qrow0 + 32 * g;
    float ss = 0.f;
    u16* dst = p.MIX + (size_t)(tb + qrow) * 1024 + hh * 64;
#pragma unroll
    for (int dt = 0; dt < 2; ++dt)
#pragma unroll
      for (int g4 = 0; g4 < 4; ++g4) {
        float v[4];
#pragma unroll
        for (int jj = 0; jj < 4; ++jj) { v[jj] = o[g][dt][4 * g4 + jj] * inv; ss += v[jj] * v[jj]; }
        u32x2 ov = {cvtpk(v[0], v[1]), cvtpk(v[2], v[3])};
        *(u32x2*)(dst + dt * 32 + 8 * g4 + 4 * h) = ov;
      }
    ss = swapsum32(ss);
    if (h == 0) p.SSA[(size_t)(tb + qrow) * 8 + hh] = ss;
  }
}

DI void attn_tile3(const Params& p, char* smem, int a) {
  WAVE_COORDS_L
  int q, hh, qt, S, tb;
  if (a < 512) { q = a >> 8; hh = (a >> 5) & 7; qt = a & 31; S = 8192; tb = q << 13; }
  else { const int b = a - 512; q = 2 + (b >> 7); hh = (b >> 4) & 7; qt = b & 15; S = 4096; tb = TP + ((q - 2) << 12); }
  const size_t qkb = ((size_t)tb * 8 + (size_t)hh * S) * 96;
  const u16* Qb = p.Qn + qkb; const u16* Kb = p.Kn + qkb;
  const u16* Vb = p.Vt + (size_t)tb * 512 + (size_t)hh * 64 * S;
  const int qrow0 = qt * 256 + wave * 64 + r;
  bf16x8 qf[2][6];
#pragma unroll
  for (int g = 0; g < 2; ++g)
#pragma unroll
    for (int ks = 0; ks < 6; ++ks) qf[g][ks] = *(const bf16x8*)(Qb + (size_t)(qrow0 + 32 * g) * 96 + ks * 16 + h * 8);
  f32x16 o[2][2];
#pragma unroll
  for (int i = 0; i < 16; ++i) { o[0][0][i] = 0.f; o[0][1][i] = 0.f; o[1][0][i] = 0.f; o[1][1][i] = 0.f; }
  float lrun[2] = {0.f, 0.f};
  int klds_[3], vlds_[2];
#pragma unroll
  for (int i = 0; i < 3; ++i) { const int id = tid + 256 * i; const int kr = id / 12; klds_[i] = kr * KSTR + (id - kr * 12) * 16; }
#pragma unroll
  for (int i = 0; i < 2; ++i) { const int vc = tid & 7; vlds_[i] = 64 * KSTR + ((tid >> 3) + 32 * i) * VSTR2 + (vc >> 1) * 32 + (vc & 1) * 8; }
  const u16* Kg = Kb + tid * 8;
  const u16* Vg = Vb + (size_t)(tid >> 3) * S + (tid & 7) * 8;
  u32x4 rk[3], rv[2];
  const int nkt = S >> 6;
#pragma unroll
  for (int i = 0; i < 3; ++i) rk[i] = *(const u32x4*)(Kg + i * 2048);
#pragma unroll
  for (int i = 0; i < 2; ++i) rv[i] = *(const u32x4*)(Vg + (size_t)(32 * i) * S);
  __syncthreads();
  auto put = [&](char* base) {
#pragma unroll
    for (int i = 0; i < 3; ++i) *(u32x4*)(base + klds_[i]) = rk[i];
#pragma unroll
    for (int i = 0; i < 2; ++i) {
      char* d = base + vlds_[i];
      *(u32x2*)d = u32x2{rv[i][0], rv[i][1]}; *(u32x2*)(d + 16) = u32x2{rv[i][2], rv[i][3]};
    }
  };
  put(smem);
  __syncthreads();
  int cur = 0;
#pragma unroll 1
  for (int kt = 0; kt < nkt; ++kt) {
    const bool nxt = (kt + 1 < nkt);
    if (nxt) {
#pragma unroll
      for (int i = 0; i < 3; ++i) rk[i] = *(const u32x4*)(Kg + (size_t)(kt + 1) * 6144 + i * 2048);
#pragma unroll
      for (int i = 0; i < 2; ++i) rv[i] = *(const u32x4*)(Vg + (size_t)(32 * i) * S + (kt + 1) * 64);
    }
    __builtin_amdgcn_sched_barrier(0);
    const char* Ks = smem + cur * ABUF2;
    const char* Vs = Ks + 64 * KSTR;
    f32x16 sacc[2][2];
#pragma unroll
    for (int i = 0; i < 16; ++i) { sacc[0][0][i] = 0.f; sacc[0][1][i] = 0.f; sacc[1][0][i] = 0.f; sacc[1][1][i] = 0.f; }
#pragma unroll
    for (int kb = 0; kb < 2; ++kb) {
      bf16x8 kf[2][3];
#pragma unroll
      for (int t2 = 0; t2 < 2; ++t2)
#pragma unroll
        for (int ks = 0; ks < 3; ++ks) kf[t2][ks] = *(const bf16x8*)(Ks + (t2 * 32 + r) * KSTR + (kb * 3 + ks) * 32 + h * 16);
#pragma unroll
      for (int ks = 0; ks < 3; ++ks)
#pragma unroll
        for (int t2 = 0; t2 < 2; ++t2) {
          sacc[t2][0] = MFMA(kf[t2][ks], qf[0][kb * 3 + ks], sacc[t2][0]);
          sacc[t2][1] = MFMA(kf[t2][ks], qf[1][kb * 3 + ks], sacc[t2][1]);
        }
    }
    __builtin_amdgcn_sched_barrier(0);
    bf16x8 pf[2][4];
#pragma unroll
    for (int g = 0; g < 2; ++g) {
      float ps = 0.f;
#pragma unroll
      for (int t2 = 0; t2 < 2; ++t2) {
#pragma unroll
        for (int i = 0; i < 16; ++i) sacc[t2][g][i] = __builtin_amdgcn_exp2f(sacc[t2][g][i]);
#pragma unroll
        for (int s = 0; s < 2; ++s) {
          const int s8 = s * 8;
          u32x4 pk = {cvtpk(sacc[t2][g][s8], sacc[t2][g][s8 + 1]), cvtpk(sacc[t2][g][s8 + 2], sacc[t2][g][s8 + 3]),
                      cvtpk(sacc[t2][g][s8 + 4], sacc[t2][g][s8 + 5]), cvtpk(sacc[t2][g][s8 + 6], sacc[t2][g][s8 + 7])};
          pf[g][t2 * 2 + s] = __builtin_bit_cast(bf16x8, pk);
#pragma unroll
          for (int w = 0; w < 4; ++w) ps = fdot2(pk[w], 0x3F803F80u, ps);
        }
      }
      lrun[g] += ps;
    }
    __builtin_amdgcn_sched_barrier(0);
#pragma unroll
    for (int kp = 0; kp < 2; ++kp) {
      bf16x8 vf[2][2];
#pragma unroll
      for (int dt = 0; dt < 2; ++dt)
#pragma unroll
        for (int s = 0; s < 2; ++s) vf[dt][s] = *(const bf16x8*)(Vs + (dt * 32 + r) * VSTR2 + (kp * 2 + s) * 32 + h * 16);
#pragma unroll
      for (int s = 0; s < 2; ++s)
#pragma unroll
        for (int dt = 0; dt < 2; ++dt) {
          o[0][dt] = MFMA(vf[dt][s], pf[0][kp * 2 + s], o[0][dt]);
          o[1][dt] = MFMA(vf[dt][s], pf[1][kp * 2 + s], o[1][dt]);
        }
    }
    __builtin_amdgcn_sched_barrier(0);
    if (nxt) put(smem + (cur ^ 1) * ABUF2);
    __syncthreads();
    cur ^= 1;
  }
#pragma unroll
  for (int g = 0; g < 2; ++g) {
    const float lsum = swapsum32(lrun[g]);
    const float inv = 1.f / lsum;
    const int qrow = qrow0 + 32 * g;
    float ss = 0.f;
    u16* dst = p.MIX + (size_t)(tb + qrow) * 1024 + hh * 64;
#pragma unroll
    for (int dt = 0; dt < 2; ++dt)
#pragma unroll
      for (int g4 = 0; g4 < 4; ++g4) {
        float v[4];
#pragma unroll
        for (int jj = 0; jj < 4; ++jj) { v[jj] = o[g][dt][4 * g4 + jj] * inv; ss += v[jj] * v[jj]; }
        u32x2 ov = {cvtpk(v[0], v[1]), cvtpk(v[2], v[3])};
        *(u32x2*)(dst + dt * 32 + 8 * g4 + 4 * h) = ov;
      }
    ss = swapsum32(ss);
    if (h == 0) p.SSA[(size_t)(tb + qrow) * 8 + hh] = ss;
  }
}

DI void phase4(const Params& p, char* smem) {
    const int G = gridDim.x;
  if (p.misc[0] > 64.f) { for (int a = vblock(); a < 1536; a += G) attn_tile2<true>(p, smem, a); }
  else { for (int a = vblock(); a < 1536; a += G) attn_tile3(p, smem, a); }
  for (int tile = vblock(); tile < 1536; tile += G) {
    WAVE_COORDS_L
    int q, g, k1, S1, tb;
    if (tile < 512) { q = tile >> 8; g = (tile >> 6) & 3; k1 = tile & 63; S1 = 64; tb = q << 13; }
    else { const int b = tile - 512; q = 2 + (b >> 7); g = (b >> 5) & 3; k1 = b & 31; S1 = 32; tb = TP + ((q - 2) << 12); }
    f32x16 acc[2][2]; zero_acc(acc);
    const u16* A = p.G1 + (size_t)tb * 1024 + ((size_t)(g * 128) * S1 + k1) * 256;
    const u16* B = p.WB;
    const int rstride = S1 * 256;
    gemm_mainloop(acc, smem, [&](int rr) { return A + (size_t)rr * rstride; }, [&](int rr) { return B + (size_t)rr * 256; }, 0, 256);
#pragma unroll
    for (int ni = 0; ni < 2; ++ni) {
      const int k2 = wn * 64 + ni * 32 + r;
      const size_t tok = (size_t)(tb + k1 + S1 * k2);
      float ss = 0.f;
#pragma unroll
      for (int mi = 0; mi < 2; ++mi)
#pragma unroll
        for (int g4 = 0; g4 < 4; ++g4) {
          const int m = wm * 64 + mi * 32 + 8 * g4 + 4 * h;
          float v[4];
#pragma unroll
          for (int j = 0; j < 4; ++j) { v[j] = acc[mi][ni][4 * g4 + j]; ss += v[j] * v[j]; }
          u32x2 ov = {cvtpk(v[0], v[1]), cvtpk(v[2], v[3])};
          *(u32x2*)(p.MIX + tok * 1024 + 512 + g * 128 + m) = ov;
        }
      ss += __shfl_xor(ss, 32);
      if (h == 0) p.SSF[tok * 8 + g * 2 + wm] = ss;
    }
  }
}

DI void phase5(const Params& p, char* smem) {
    float* rs = (float*)(smem + 65536);
  const int G = gridDim.x;
  for (int tile = vblock(); tile < 384 * 8; tile += G) {
    WAVE_COORDS_L
    const int mt = tile >> 3, nt = tile & 7, m0 = mt * 128, n0 = nt * 128;
    __syncthreads();
    if (tid < 128) {
      const float* sa = p.SSA + (size_t)(m0 + tid) * 8; const float* sf = p.SSF + (size_t)(m0 + tid) * 8;
      const float ra = rsqrtf((sa[0] + sa[1] + sa[2] + sa[3] + sa[4] + sa[5] + sa[6] + sa[7]) * (1.f / 512.f) + EPS);
      const float rf = rsqrtf((sf[0] + sf[1] + sf[2] + sf[3] + sf[4] + sf[5] + sf[6] + sf[7]) * (1.f / 512.f) + EPS);
      rs[tid] = ra / rf; rs[128 + tid] = rf;
    }
    f32x16 acc[2][2]; zero_acc(acc);
    const u16* A = p.MIX + (size_t)m0 * 1024; const u16* B = p.WoutT + (size_t)n0 * 1024;
    auto af = [&](int rr) { return A + (size_t)rr * 1024; };
    auto bfn = [&](int rr) { return B + (size_t)rr * 1024; };
    gemm_mainloop<true>(acc, smem, af, bfn, 0, 512);
    {
      const float* rb = rs + wm * 64 + 4 * h;
#pragma unroll
      for (int mi = 0; mi < 2; ++mi)
#pragma unroll
        for (int i = 0; i < 16; ++i) {
          const float sc = rb[mi * 32 + (i & 3) + 8 * (i >> 2)];
          acc[mi][0][i] *= sc; acc[mi][1][i] *= sc;
        }
    }
    gemm_mainloop<true>(acc, smem, af, bfn, 512, 1024);
    f32x4 xv[16];
#pragma unroll
    for (int j = 0; j < 16; ++j) {
      const int id = tid + 256 * j;
      xv[j] = *(const f32x4*)(xrow(p, m0 + (id >> 5)) + n0 + (id & 31) * 4);
    }
    {
      const float* rb = rs + 128 + wm * 64 + 4 * h;
      char* sb = smem + (wm * 64 + 4 * h) * 512 + (wn * 64 + r) * 4;
#pragma unroll
      for (int mi = 0; mi < 2; ++mi)
#pragma unroll
        for (int i = 0; i < 16; ++i) {
          const int ro = mi * 32 + (i & 3) + 8 * (i >> 2);
          const float sc = rb[ro];
#pragma unroll
          for (int ni = 0; ni < 2; ++ni) *(float*)(sb + ro * 512 + ni * 128) = acc[mi][ni][i] * sc;
        }
    }
    __syncthreads();
#pragma unroll
    for (int j = 0; j < 16; ++j) {
      const int id = tid + 256 * j, row = id >> 5, cc = id & 31;
      const int t = m0 + row, col = n0 + cc * 4;
      f32x4 v = *(const f32x4*)(smem + row * 512 + cc * 16);
      v[0] += xv[j][0]; v[1] += xv[j][1]; v[2] += xv[j][2]; v[3] += xv[j][3];
      *(f32x4*)(p.out + (size_t)t * 1024 + col) = v;
      u32x2 ob = {cvtpk(v[0], v[1]), cvtpk(v[2], v[3])};
      *(u32x2*)(p.X2b + (size_t)t * 1024 + col) = ob;
      float ss = v[0] * v[0] + v[1] * v[1] + v[2] * v[2] + v[3] * v[3];
      ss = red32(ss);
      if (cc == 0) p.SS2[(size_t)t * 16 + nt] = ss;
    }
  }
  const int gt = blockIdx.x * NTHR + threadIdx.x, gs = gridDim.x * NTHR;
  for (int id = gt; id < 16384 * 1024 / 16; id += gs) {
    const int d = (id & 63) * 16;
    u32x4 ou, ov;
#pragma unroll
    for (int k = 0; k < 4; ++k) {
      const f32x4 a = *(const f32x4*)(p.peer_u + (size_t)id * 16 + k * 4);
      const f32x4 g = *(const f32x4*)(p.ffn_norm_g + d + k * 4);
      const f32x4 b = *(const f32x4*)(p.peer_v + (size_t)id * 16 + k * 4);
      float u0 = fminf(fmaxf(a[0] * g[0] * USCALE, -448.f), 448.f), u1 = fminf(fmaxf(a[1] * g[1] * USCALE, -448.f), 448.f);
      float u2 = fminf(fmaxf(a[2] * g[2] * USCALE, -448.f), 448.f), u3 = fminf(fmaxf(a[3] * g[3] * USCALE, -448.f), 448.f);
      float v0 = fminf(fmaxf(b[0] * VSCALE, -448.f), 448.f), v1 = fminf(fmaxf(b[1] * VSCALE, -448.f), 448.f);
      float v2 = fminf(fmaxf(b[2] * VSCALE, -448.f), 448.f), v3 = fminf(fmaxf(b[3] * VSCALE, -448.f), 448.f);
      int pu = __builtin_amdgcn_cvt_pk_fp8_f32(u0, u1, 0, false); pu = __builtin_amdgcn_cvt_pk_fp8_f32(u2, u3, pu, true);
      int pv = __builtin_amdgcn_cvt_pk_fp8_f32(v0, v1, 0, false); pv = __builtin_amdgcn_cvt_pk_fp8_f32(v2, v3, pv, true);
      ou[k] = (unsigned)pu; ov[k] = (unsigned)pv;
    }
    {
      const int e = id >> 6, ch = id & 63;
      const size_t o = ((size_t)(ch >> 3) * 16384 + e) * 128 + (ch & 7) * 16;
      *(u32x4*)(p.U8 + o) = ou;
      *(u32x4*)(p.V8 + o) = ov;
    }
  }
}

DI void phase6(const Params& p, char* smem) {
    const int G = gridDim.x;
  u32x4 sa[4], sb[4];
  if (vblock() < 384 * 16) {
    const int t0 = vblock();
    const u16* A0 = p.X2b + (size_t)(t0 >> 4) * 128 * 1024; const u16* B0 = p.WpqT + (size_t)(t0 & 15) * 128 * 1024;
    gemm_issue(sa, sb, [&](int rr) { return A0 + (size_t)rr * 1024; }, [&](int rr) { return B0 + (size_t)rr * 1024; }, 0);
  }
  for (int tile = vblock(); tile < 384 * 16; tile += G) {
    WAVE_COORDS_L
    const int mt = tile >> 4, nt = tile & 15, m0 = mt * 128, n0 = nt * 128;
    const int nx = tile + G; const bool hasn = nx < 384 * 16;
    const u16* An = p.X2b + (size_t)(nx >> 4) * 128 * 1024; const u16* Bn = p.WpqT + (size_t)(nx & 15) * 128 * 1024;
    f32x16 acc[2][2]; zero_acc(acc);
    __syncthreads();
    const u16* A = p.X2b + (size_t)m0 * 1024; const u16* B = p.WpqT + (size_t)n0 * 1024;
    gemm_stream<true, true>(acc, smem, [&](int rr) { return A + (size_t)rr * 1024; }, [&](int rr) { return B + (size_t)rr * 1024; }, 0, 1024, sa, sb,
                      hasn, (long)(An - A), (long)(Bn - B));
    stage_bf16_t<false>(smem, acc, nullptr, wm, wn, r, h);
    __syncthreads();
#pragma unroll
    for (int j = 0; j < 8; ++j) {
      const int id = tid + 256 * j, row = id >> 4, cc = id & 15;
      *(u32x4*)(p.Qp + (size_t)(m0 + row) * 2048 + n0 + cc * 8) = *(const u32x4*)(smem + row * SROW + cc * 16);
    }
  }
}

DI void ins16(float (&top)[16], float x) {
#pragma unroll
  for (int j = 0; j < 16; ++j) { const float hi = fmaxf(top[j], x); x = fminf(top[j], x); top[j] = hi; }
}
DI float mask7(float x) { return __uint_as_float(__float_as_uint(x) & ~0x7Fu); }

#define CE16(a, b) { const float hi_ = fmaxf(a, b); b = fminf(a, b); a = hi_; }
DI void sort16_desc(float (&x)[16]) {
  CE16(x[0], x[1])
  CE16(x[3], x[2])
  CE16(x[4], x[5])
  CE16(x[7], x[6])
  CE16(x[8], x[9])
  CE16(x[11], x[10])
  CE16(x[12], x[13])
  CE16(x[15], x[14])
  CE16(x[0], x[2])
  CE16(x[1], x[3])
  CE16(x[6], x[4])
  CE16(x[7], x[5])
  CE16(x[8], x[10])
  CE16(x[9], x[11])
  CE16(x[14], x[12])
  CE16(x[15], x[13])
  CE16(x[0], x[1])
  CE16(x[2], x[3])
  CE16(x[5], x[4])
  CE16(x[7], x[6])
  CE16(x[8], x[9])
  CE16(x[10], x[11])
  CE16(x[13], x[12])
  CE16(x[15], x[14])
  CE16(x[0], x[4])
  CE16(x[1], x[5])
  CE16(x[2], x[6])
  CE16(x[3], x[7])
  CE16(x[12], x[8])
  CE16(x[13], x[9])
  CE16(x[14], x[10])
  CE16(x[15], x[11])
  CE16(x[0], x[2])
  CE16(x[1], x[3])
  CE16(x[4], x[6])
  CE16(x[5], x[7])
  CE16(x[10], x[8])
  CE16(x[11], x[9])
  CE16(x[14], x[12])
  CE16(x[15], x[13])
  CE16(x[0], x[1])
  CE16(x[2], x[3])
  CE16(x[4], x[5])
  CE16(x[6], x[7])
  CE16(x[9], x[8])
  CE16(x[11], x[10])
  CE16(x[13], x[12])
  CE16(x[15], x[14])
  CE16(x[0], x[8])
  CE16(x[1], x[9])
  CE16(x[2], x[10])
  CE16(x[3], x[11])
  CE16(x[4], x[12])
  CE16(x[5], x[13])
  CE16(x[6], x[14])
  CE16(x[7], x[15])
  CE16(x[0], x[4])
  CE16(x[1], x[5])
  CE16(x[2], x[6])
  CE16(x[3], x[7])
  CE16(x[8], x[12])
  CE16(x[9], x[13])
  CE16(x[10], x[14])
  CE16(x[11], x[15])
  CE16(x[0], x[2])
  CE16(x[1], x[3])
  CE16(x[4], x[6])
  CE16(x[5], x[7])
  CE16(x[8], x[10])
  CE16(x[9], x[11])
  CE16(x[12], x[14])
  CE16(x[13], x[15])
  CE16(x[0], x[1])
  CE16(x[2], x[3])
  CE16(x[4], x[5])
  CE16(x[6], x[7])
  CE16(x[8], x[9])
  CE16(x[10], x[11])
  CE16(x[12], x[13])
  CE16(x[14], x[15])
}
DI void bmerge16_desc(float (&x)[16]) {
  CE16(x[0], x[8])
  CE16(x[1], x[9])
  CE16(x[2], x[10])
  CE16(x[3], x[11])
  CE16(x[4], x[12])
  CE16(x[5], x[13])
  CE16(x[6], x[14])
  CE16(x[7], x[15])
  CE16(x[0], x[4])
  CE16(x[1], x[5])
  CE16(x[2], x[6])
  CE16(x[3], x[7])
  CE16(x[8], x[12])
  CE16(x[9], x[13])
  CE16(x[10], x[14])
  CE16(x[11], x[15])
  CE16(x[0], x[2])
  CE16(x[1], x[3])
  CE16(x[4], x[6])
  CE16(x[5], x[7])
  CE16(x[8], x[10])
  CE16(x[9], x[11])
  CE16(x[12], x[14])
  CE16(x[13], x[15])
  CE16(x[0], x[1])
  CE16(x[2], x[3])
  CE16(x[4], x[5])
  CE16(x[6], x[7])
  CE16(x[8], x[9])
  CE16(x[10], x[11])
  CE16(x[12], x[13])
  CE16(x[14], x[15])
}
DI void top16_merge(float (&A)[16], const float (&B)[16]) {
#pragma unroll
  for (int i = 0; i < 16; ++i) A[i] = fmaxf(A[i], B[15 - i]);
  bmerge16_desc(A);
}

DI void score_top16(const Params& p, const char* sklds, int t, int hh, int c, int r, int h, float (&top)[16]) {
  f32x16 acc[4];
#pragma unroll
  for (int n = 0; n < 4; ++n)
#pragma unroll
    for (int i = 0; i < 16; ++i) acc[n][i] = 0.f;
  const u16* qp = p.Qp + (size_t)t * 2048 + (hh * 2 + c) * 128 + h * 8;
  const char* skb = sklds + c * 32768 + r * 256;
  const int hx = h ^ (r & 15);
  bf16x8 bq[8];
#pragma unroll
  for (int ks = 0; ks < 8; ++ks) bq[ks] = *(const bf16x8*)(qp + ks * 16);
#pragma unroll
  for (int n = 0; n < 4; ++n) {
    bf16x8 fa[8];
#pragma unroll
    for (int ks = 0; ks < 8; ++ks) fa[ks] = *(const bf16x8*)(skb + n * 8192 + (((ks * 2) ^ hx) << 4));
    __builtin_amdgcn_sched_barrier(0);
#pragma unroll
    for (int ks = 0; ks < 8; ++ks) acc[n] = MFMA(fa[ks], bq[ks], acc[n]);
    __builtin_amdgcn_sched_barrier(0);
  }
  float k1[16], k2[16], k3[16];
#pragma unroll
  for (int i = 0; i < 16; ++i) {
    const unsigned ci = (unsigned)crow(i, h);
    top[i] = __uint_as_float((__float_as_uint(acc[0][i]) & ~0x7Fu) | ci);
    k1[i] = __uint_as_float((__float_as_uint(acc[1][i]) & ~0x7Fu) | (32u + ci));
    k2[i] = __uint_as_float((__float_as_uint(acc[2][i]) & ~0x7Fu) | (64u + ci));
    k3[i] = __uint_as_float((__float_as_uint(acc[3][i]) & ~0x7Fu) | (96u + ci));
  }
  sort16_desc(top); sort16_desc(k1); sort16_desc(k2); sort16_desc(k3);
  top16_merge(top, k1); top16_merge(k2, k3); top16_merge(top, k2);
  float oth[16];
#pragma unroll
  for (int j = 0; j < 16; ++j) oth[j] = __shfl_xor(top[j], 32);
  top16_merge(top, oth);
}

DI void phase7(const Params& p, char* smem) {
  WAVE_COORDS
  const int G = gridDim.x;
  volatile unsigned* lw = (volatile unsigned*)(smem + 65536 + 2048 + wave * 1024);
  volatile unsigned char* lb = (volatile unsigned char*)(smem + 65536 + 2048 + wave * 1024);
  const float NEG_INF = __uint_as_float(0xFF800000u);
  const int hh = blockIdx.x & 7, slot = blockIdx.x >> 3, nslot = G >> 3;
  __syncthreads();
  {
    const u16* src = p.SK + (size_t)hh * 2 * 16384;
#pragma unroll 2
    for (int i = 0; i < 16; ++i) {
      const int id = tid + 256 * i;
      const int row = id >> 4, ch = id & 15;
      const u32x4 v = *(const u32x4*)(src + (size_t)row * 128 + ch * 8);
      *(u32x4*)(smem + row * 256 + ((ch ^ (row & 15)) << 4)) = v;
    }
  }
  __syncthreads();
  for (int grp = slot * 4 + wave; grp < 1536; grp += nslot * 4) {
    const int tok0 = grp * 32;
    const int t = tok0 + r;
    float L0[16], L1[16];
    score_top16(p, smem, t, hh, 0, r, h, L0);
    score_top16(p, smem, t, hh, 1, r, h, L1);
    float ct[16], cb[16];
    {
      float ck[50];
    ck[0] = __uint_as_float((__float_as_uint(mask7(L0[0]) + mask7(L1[0])) & ~0xFFu) | 0u);
    ck[1] = __uint_as_float((__float_as_uint(mask7(L0[0]) + mask7(L1[1])) & ~0xFFu) | 1u);
    ck[2] = __uint_as_float((__float_as_uint(mask7(L0[0]) + mask7(L1[2])) & ~0xFFu) | 2u);
    ck[3] = __uint_as_float((__float_as_uint(mask7(L0[0]) + mask7(L1[3])) & ~0xFFu) | 3u);
    ck[4] = __uint_as_float((__float_as_uint(mask7(L0[0]) + mask7(L1[4])) & ~0xFFu) | 4u);
    ck[5] = __uint_as_float((__float_as_uint(mask7(L0[0]) + mask7(L1[5])) & ~0xFFu) | 5u);
    ck[6] = __uint_as_float((__float_as_uint(mask7(L0[0]) + mask7(L1[6])) & ~0xFFu) | 6u);
    ck[7] = __uint_as_float((__float_as_uint(mask7(L0[0]) + mask7(L1[7])) & ~0xFFu) | 7u);
    ck[8] = __uint_as_float((__float_as_uint(mask7(L0[0]) + mask7(L1[8])) & ~0xFFu) | 8u);
    ck[9] = __uint_as_float((__float_as_uint(mask7(L0[0]) + mask7(L1[9])) & ~0xFFu) | 9u);
    ck[10] = __uint_as_float((__float_as_uint(mask7(L0[0]) + mask7(L1[10])) & ~0xFFu) | 10u);
    ck[11] = __uint_as_float((__float_as_uint(mask7(L0[0]) + mask7(L1[11])) & ~0xFFu) | 11u);
    ck[12] = __uint_as_float((__float_as_uint(mask7(L0[0]) + mask7(L1[12])) & ~0xFFu) | 12u);
    ck[13] = __uint_as_float((__float_as_uint(mask7(L0[0]) + mask7(L1[13])) & ~0xFFu) | 13u);
    ck[14] = __uint_as_float((__float_as_uint(mask7(L0[0]) + mask7(L1[14])) & ~0xFFu) | 14u);
    ck[15] = __uint_as_float((__float_as_uint(mask7(L0[0]) + mask7(L1[15])) & ~0xFFu) | 15u);
    ck[16] = __uint_as_float((__float_as_uint(mask7(L0[1]) + mask7(L1[0])) & ~0xFFu) | 16u);
    ck[17] = __uint_as_float((__float_as_uint(mask7(L0[1]) + mask7(L1[1])) & ~0xFFu) | 17u);
    ck[18] = __uint_as_float((__float_as_uint(mask7(L0[1]) + mask7(L1[2])) & ~0xFFu) | 18u);
    ck[19] = __uint_as_float((__float_as_uint(mask7(L0[1]) + mask7(L1[3])) & ~0xFFu) | 19u);
    ck[20] = __uint_as_float((__float_as_uint(mask7(L0[1]) + mask7(L1[4])) & ~0xFFu) | 20u);
    ck[21] = __uint_as_float((__float_as_uint(mask7(L0[1]) + mask7(L1[5])) & ~0xFFu) | 21u);
    ck[22] = __uint_as_float((__float_as_uint(mask7(L0[1]) + mask7(L1[6])) & ~0xFFu) | 22u);
    ck[23] = __uint_as_float((__float_as_uint(mask7(L0[1]) + mask7(L1[7])) & ~0xFFu) | 23u);
    ck[24] = __uint_as_float((__float_as_uint(mask7(L0[2]) + mask7(L1[0])) & ~0xFFu) | 32u);
    ck[25] = __uint_as_float((__float_as_uint(mask7(L0[2]) + mask7(L1[1])) & ~0xFFu) | 33u);
    ck[26] = __uint_as_float((__float_as_uint(mask7(L0[2]) + mask7(L1[2])) & ~0xFFu) | 34u);
    ck[27] = __uint_as_float((__float_as_uint(mask7(L0[2]) + mask7(L1[3])) & ~0xFFu) | 35u);
    ck[28] = __uint_as_float((__float_as_uint(mask7(L0[2]) + mask7(L1[4])) & ~0xFFu) | 36u);
    ck[29] = __uint_as_float((__float_as_uint(mask7(L0[3]) + mask7(L1[0])) & ~0xFFu) | 48u);
    ck[30] = __uint_as_float((__float_as_uint(mask7(L0[3]) + mask7(L1[1])) & ~0xFFu) | 49u);
    ck[31] = __uint_as_float((__float_as_uint(mask7(L0[3]) + mask7(L1[2])) & ~0xFFu) | 50u);
    ck[32] = __uint_as_float((__float_as_uint(mask7(L0[3]) + mask7(L1[3])) & ~0xFFu) | 51u);
    ck[33] = __uint_as_float((__float_as_uint(mask7(L0[4]) + mask7(L1[0])) & ~0xFFu) | 64u);
    ck[34] = __uint_as_float((__float_as_uint(mask7(L0[4]) + mask7(L1[1])) & ~0xFFu) | 65u);
    ck[35] = __uint_as_float((__float_as_uint(mask7(L0[4]) + mask7(L1[2])) & ~0xFFu) | 66u);
    ck[36] = __uint_as_float((__float_as_uint(mask7(L0[5]) + mask7(L1[0])) & ~0xFFu) | 80u);
    ck[37] = __uint_as_float((__float_as_uint(mask7(L0[5]) + mask7(L1[1])) & ~0xFFu) | 81u);
    ck[38] = __uint_as_float((__float_as_uint(mask7(L0[6]) + mask7(L1[0])) & ~0xFFu) | 96u);
    ck[39] = __uint_as_float((__float_as_uint(mask7(L0[6]) + mask7(L1[1])) & ~0xFFu) | 97u);
    ck[40] = __uint_as_float((__float_as_uint(mask7(L0[7]) + mask7(L1[0])) & ~0xFFu) | 112u);
    ck[41] = __uint_as_float((__float_as_uint(mask7(L0[7]) + mask7(L1[1])) & ~0xFFu) | 113u);
    ck[42] = __uint_as_float((__float_as_uint(mask7(L0[8]) + mask7(L1[0])) & ~0xFFu) | 128u);
    ck[43] = __uint_as_float((__float_as_uint(mask7(L0[9]) + mask7(L1[0])) & ~0xFFu) | 144u);
    ck[44] = __uint_as_float((__float_as_uint(mask7(L0[10]) + mask7(L1[0])) & ~0xFFu) | 160u);
    ck[45] = __uint_as_float((__float_as_uint(mask7(L0[11]) + mask7(L1[0])) & ~0xFFu) | 176u);
    ck[46] = __uint_as_float((__float_as_uint(mask7(L0[12]) + mask7(L1[0])) & ~0xFFu) | 192u);
    ck[47] = __uint_as_float((__float_as_uint(mask7(L0[13]) + mask7(L1[0])) & ~0xFFu) | 208u);
    ck[48] = __uint_as_float((__float_as_uint(mask7(L0[14]) + mask7(L1[0])) & ~0xFFu) | 224u);
    ck[49] = __uint_as_float((__float_as_uint(mask7(L0[15]) + mask7(L1[0])) & ~0xFFu) | 240u);
      const float NINF = __uint_as_float(0xFF800000u);
#pragma unroll
      for (int q = 0; q < 25; ++q) {
        float a_ = ck[q], b_ = ck[25 + q];
        asm volatile("" : "+v"(a_), "+v"(b_));
        const float m = h ? b_ : a_;
        if (q < 16) ct[q] = m; else cb[q - 16] = m;
      }
#pragma unroll
      for (int q = 9; q < 16; ++q) cb[q] = NINF;
      sort16_desc(ct); sort16_desc(cb);
      top16_merge(ct, cb);
#pragma unroll
      for (int q = 0; q < 16; ++q) cb[q] = __shfl_xor(ct[q], 32);
      top16_merge(ct, cb);
    }
    if (h == 0) {
#pragma unroll
      for (int w = 0; w < 4; ++w) {
        unsigned v = 0, v2 = 0;
#pragma unroll
        for (int b = 0; b < 4; ++b) {
          v |= (__float_as_uint(L0[w * 4 + b]) & 0x7Fu) << (8 * b);
          v2 |= (__float_as_uint(L1[w * 4 + b]) & 0x7Fu) << (8 * b);
        }
        lw[r * 8 + w] = v;
        lw[r * 8 + 4 + w] = v2;
      }
    }
    __builtin_amdgcn_wave_barrier();
    const float* s2 = p.SS2 + (size_t)t * 16;
    float ssum = 0.f;
#pragma unroll
    for (int j = 0; j < 8; ++j) ssum += s2[j];
    const float r2 = rsqrtf(ssum * (1.f / 1024.f) + EPS);
    float gv[16];
    const float v0 = __uint_as_float(__float_as_uint(ct[0]) & ~0xFFu) * r2;
    float esum = 0.f;
#pragma unroll
    for (int j = 0; j < 16; ++j) {
      const float vj = __uint_as_float(__float_as_uint(ct[j]) & ~0xFFu) * r2;
      gv[j] = __builtin_amdgcn_exp2f((vj - v0) * 1.4426950408889634f);
      esum += gv[j];
    }
    const float einv = 1.f / esum;
    u32x4 oi[2]; f32x4 og[2];
#pragma unroll
    for (int jj = 0; jj < 8; ++jj) {
      float ka = ct[jj], kb = ct[8 + jj], ga = gv[jj], gb = gv[8 + jj];
      asm volatile("" : "+v"(ka), "+v"(kb), "+v"(ga), "+v"(gb));
      const float key = h ? kb : ka;
      const float g = (h ? gb : ga) * einv;
      const unsigned code = __float_as_uint(key) & 0xFFu;
      const unsigned i1 = lb[r * 32 + (code >> 4)], i2 = lb[r * 32 + 16 + (code & 15)];
      oi[jj >> 2][jj & 3] = i1 * 128 + i2;
      og[jj >> 2][jj & 3] = g;
    }
    int* ip = p.IDX + (size_t)t * 128 + hh * 16 + h * 8;
    float* gp = p.G + (size_t)t * 128 + hh * 16 + h * 8;
    *(u32x4*)ip = oi[0]; *(u32x4*)(ip + 4) = oi[1];
    *(f32x4*)gp = og[0]; *(f32x4*)(gp + 4) = og[1];
    __builtin_amdgcn_wave_barrier();
  }
}

DI float gelu_tanh(float x) {
  const float u = 0.7978845608028654f * (x + 0.044715f * x * x * x);
  const float e = __builtin_amdgcn_exp2f(u * 2.8853900817779268f);
  const float th = 1.f - 2.f * __builtin_amdgcn_rcpf(e + 1.f);
  return 0.5f * x * (1.f + th);
}
DI float dot16_fp8(const u32x4& w, const u32x4& xa, const u32x4& xb) {
  float acc = 0.f;
#pragma unroll
  for (int k = 0; k < 4; ++k) {
    const bf2_t b0 = __builtin_amdgcn_cvt_scalef32_pk_bf16_fp8(w[k], 1.0f, false);
    const bf2_t b1 = __builtin_amdgcn_cvt_scalef32_pk_bf16_fp8(w[k], 1.0f, true);
    const unsigned x0 = (k < 2) ? xa[2 * k] : xb[2 * k - 4], x1 = (k < 2) ? xa[2 * k + 1] : xb[2 * k - 3];
    acc = __builtin_amdgcn_fdot2_f32_bf16(b0, __builtin_bit_cast(bf2_t, x0), acc, false);
    acc = __builtin_amdgcn_fdot2_f32_bf16(b1, __builtin_bit_cast(bf2_t, x1), acc, false);
  }
  return acc;
}

template <int CTRL>
DI float dppf(float x) { return __uint_as_float(__builtin_amdgcn_update_dpp(0u, __float_as_uint(x), CTRL, 0xF, 0xF, false)); }
DI float swap32sum(float a, float b) {
  auto rr = __builtin_amdgcn_permlane32_swap(__float_as_uint(a), __float_as_uint(b), false, false);
  return __uint_as_float(rr[0]) + __uint_as_float(rr[1]);
}
DI float swap16sum(float a, float b) {
  auto rr = __builtin_amdgcn_permlane16_swap(__float_as_uint(a), __float_as_uint(b), false, false);
  return __uint_as_float(rr[0]) + __uint_as_float(rr[1]);
}
struct P8Buf { u32x4 w[16]; u32x4 xa, xb; };

DI void p8_load_idx(const Params& p, int t, int j, u32x4 (&ix)[4]) {
  const int* ip = p.IDX + (size_t)t * 128 + j * 16;
#pragma unroll
  for (int q = 0; q < 4; ++q) ix[q] = *(const u32x4*)(ip + q * 4);
}
DI void p8_load_rows(const unsigned char* tab, int s, int cc, const u32x4 (&ix)[4], u32x4 (&w)[16]) {
  const unsigned char* base = tab + (size_t)s * (16384 * 128) + cc * 16;
#pragma unroll
  for (int i = 0; i < 16; ++i) w[i] = *(const u32x4*)(base + (size_t)ix[i >> 2][i & 3] * 128);
}

DI void phase8(const Params& p, char* smem, const int tbase) {
  WAVE_COORDS
  const int G = gridDim.x;
  const int gw = vblock() * 4 + wave, NW = G * 4;
  const int j = lane >> 3, cc = lane & 7;
  const bool b0 = lane & 1, b1 = lane & 2, b2 = lane & 4, b3 = lane & 8, b4 = lane & 16, b5 = lane & 32;
  f32x2* part = (f32x2*)(smem + wave * 12288) + lane;
  const float* coefl = (const float*)(smem + wave * 12288);
  const int ntok_all = (T_TOK - gw + NW - 1) / NW;
  const int ntok = min(24, ntok_all - tbase);
  const int gw0 = gw + tbase * NW;
  if (ntok <= 0) return;
  for (int s = 0; s < 8; ++s) {
    u32x4 ixA[4], ixB[4];
    u32x4 wA[16], wB[16];
    u32x4 xaA, xbA, xaB, xbB;
    auto issue = [&](int i, u32x4 (&ix)[4], u32x4 (&w)[16], u32x4& xa, u32x4& xb) {
      const int t = gw0 + i * NW;
      const u16* xr = p.X2b + (size_t)t * 1024 + s * 128 + cc * 16;
      xa = *(const u32x4*)xr; xb = *(const u32x4*)(xr + 8);
      p8_load_rows(p.U8, s, cc, ix, w);
    };
    auto compute = [&](int i, u32x4 (&w)[16], u32x4& xa, u32x4& xb) {
      float d[16];
#pragma unroll
      for (int q = 0; q < 16; ++q) d[q] = dot16_fp8(w[q], xa, xb);
      float v8[8], v4[4], v2[2];
#pragma unroll
      for (int m = 0; m < 8; ++m) { const float mine = b2 ? d[m + 8] : d[m], send = b2 ? d[m] : d[m + 8]; v8[m] = mine + dppf<0x141>(send); }
#pragma unroll
      for (int m = 0; m < 4; ++m) { const float mine = b1 ? v8[m + 4] : v8[m], send = b1 ? v8[m] : v8[m + 4]; v4[m] = mine + dppf<0x4E>(send); }
#pragma unroll
      for (int m = 0; m < 2; ++m) { const float mine = b0 ? v4[m + 2] : v4[m], send = b0 ? v4[m] : v4[m + 2]; v2[m] = mine + dppf<0xB1>(send); }
      f32x2 acc = {v2[0], v2[1]};
      if (s > 0) { const f32x2 o = part[i * 64]; acc[0] += o[0]; acc[1] += o[1]; }
      part[i * 64] = acc;
    };
    p8_load_idx(p, gw0, j, ixA);
    issue(0, ixA, wA, xaA, xbA);
    if (ntok > 1) p8_load_idx(p, gw0 + NW, j, ixB);
#pragma unroll 1
    for (int i = 0; i < ntok; i += 2) {
      if (i + 1 < ntok) issue(i + 1, ixB, wB, xaB, xbB);
      if (i + 2 < ntok) p8_load_idx(p, gw0 + (i + 2) * NW, j, ixA);
      __builtin_amdgcn_sched_barrier(0);
      compute(i, wA, xaA, xbA);
      __builtin_amdgcn_sched_barrier(0);
      if (i + 1 < ntok) {
        if (i + 2 < ntok) issue(i + 2, ixA, wA, xaA, xbA);
        if (i + 3 < ntok) p8_load_idx(p, gw0 + (i + 3) * NW, j, ixB);
        __builtin_amdgcn_sched_barrier(0);
        compute(i + 1, wB, xaB, xbB);
        __builtin_amdgcn_sched_barrier(0);
      }
    }
  }
  for (int i = 0; i < ntok; ++i) {
    const int t = gw0 + i * NW;
    const float* s2 = p.SS2 + (size_t)t * 16;
    float ssum = 0.f;
#pragma unroll
    for (int q = 0; q < 8; ++q) ssum += s2[q];
    const float r2 = rsqrtf(ssum * (1.f / 1024.f) + EPS) * (1.f / USCALE);
    const f32x2 g = *(const f32x2*)(p.G + (size_t)t * 128 + lane * 2);
    f32x2 a = part[i * 64];
    a[0] = gelu_tanh(a[0] * r2) * g[0] * (1.f / VSCALE);
    a[1] = gelu_tanh(a[1] * r2) * g[1] * (1.f / VSCALE);
    part[i * 64] = a;
  }
  asm volatile("" ::: "memory");
  __builtin_amdgcn_wave_barrier();
  for (int s = 0; s < 8; ++s) {
    u32x4 ixA[4], ixB[4];
    u32x4 wA[16], wB[16];
    auto compute = [&](int i, u32x4 (&w)[16]) {
      const int t = gw0 + i * NW;
      const float* cp = coefl + i * 128 + j * 16;
      f32x4 cf[4];
#pragma unroll
      for (int q = 0; q < 4; ++q) cf[q] = *(const f32x4*)(cp + q * 4);
      f32x2 acc2[8];
#pragma unroll
      for (int e = 0; e < 8; ++e) acc2[e] = f32x2{0.f, 0.f};
#pragma unroll
      for (int q = 0; q < 16; ++q) {
        const float cq = cf[q >> 2][q & 3];
        const f32x2 c2 = {cq, cq};
#pragma unroll
        for (int k = 0; k < 4; ++k) {
          const f32x2 lo = __builtin_amdgcn_cvt_pk_f32_fp8((int)w[q][k], false);
          const f32x2 hi = __builtin_amdgcn_cvt_pk_f32_fp8((int)w[q][k], true);
          acc2[2 * k] = __builtin_elementwise_fma(lo, c2, acc2[2 * k]);
          acc2[2 * k + 1] = __builtin_elementwise_fma(hi, c2, acc2[2 * k + 1]);
        }
      }
      float acc[16];
#pragma unroll
      for (int e = 0; e < 8; ++e) { acc[2 * e] = acc2[e][0]; acc[2 * e + 1] = acc2[e][1]; }
      float v8[8], v4[4], v2[2];
#pragma unroll
      for (int m = 0; m < 8; ++m) v8[m] = swap32sum(acc[m], acc[m + 8]);
#pragma unroll
      for (int m = 0; m < 4; ++m) v4[m] = swap16sum(v8[m], v8[m + 4]);
#pragma unroll
      for (int m = 0; m < 2; ++m) { const float mine = b3 ? v4[m + 2] : v4[m], send = b3 ? v4[m] : v4[m + 2]; v2[m] = mine + dppf<0x128>(send); }
      float* op = p.out + (size_t)t * 1024 + s * 128 + cc * 16 + 2 * j;
      f32x2 o = *(f32x2*)op;
      o[0] += v2[0]; o[1] += v2[1];
      *(f32x2*)op = o;
    };
    p8_load_idx(p, gw0, j, ixA);
    p8_load_rows(p.V8, s, cc, ixA, wA);
    if (ntok > 1) p8_load_idx(p, gw0 + NW, j, ixB);
#pragma unroll 1
    for (int i = 0; i < ntok; i += 2) {
      if (i + 1 < ntok) p8_load_rows(p.V8, s, cc, ixB, wB);
      if (i + 2 < ntok) p8_load_idx(p, gw0 + (i + 2) * NW, j, ixA);
      __builtin_amdgcn_sched_barrier(0);
      compute(i, wA);
      __builtin_amdgcn_sched_barrier(0);
      if (i + 1 < ntok) {
        if (i + 2 < ntok) p8_load_rows(p.V8, s, cc, ixA, wA);
        if (i + 3 < ntok) p8_load_idx(p, gw0 + (i + 3) * NW, j, ixB);
        __builtin_amdgcn_sched_barrier(0);
        compute(i + 1, wB);
        __builtin_amdgcn_sched_barrier(0);
      }
    }
  }
  asm volatile("" ::: "memory");
  __builtin_amdgcn_wave_barrier();
}

extern __shared__ __attribute__((aligned(16))) char dyn_smem[];

DI void run_phase(const Params& p, int ph, char* smem) {
  switch (ph) {
    case 0: phase0(p); break;
    case 1: phase1(p, smem); break;
    case 2: phase2(p, smem); break;
    case 3: phase3(p, smem); break;
    case 4: phase4(p, smem); break;
    case 5: phase5(p, smem); break;
    case 6: phase6(p, smem); break;
    case 7: phase7(p, smem); break;
    default: phase8(p, smem, 0); break;
  }
}


#define XB_TMO      128
#define XB_XCNT(j)  (256  + 64 * (j))
#define XB_XSUB(j)  (1280 + 64 * (j))
#define XB_XGEN(j)  (2304 + 64 * (j))
#define XB_TOP      3328
#define XB_TOPGEN   3392
#define XCD_BAR_WORDS 3456
#define XB_SPIN_CAP (1u << 22)
#define LAS __attribute__((address_space(3)))
DI unsigned xb_ld(unsigned* p) { return __hip_atomic_load(p, __ATOMIC_RELAXED, __HIP_MEMORY_SCOPE_AGENT); }
DI unsigned xb_add(unsigned* p, unsigned v) { return __hip_atomic_fetch_add(p, v, __ATOMIC_RELAXED, __HIP_MEMORY_SCOPE_AGENT); }
DI unsigned xb_xcc_id() { return (unsigned)__builtin_amdgcn_s_getreg((3 << 11) | 20) & 0xFu; }
#define XB_SPIN(cond, bar) do { unsigned _sp = 0; while (cond) { __builtin_amdgcn_s_sleep(1); \
    if ((++_sp & 255u) == 0u) { if (xb_ld(&(bar)[XB_TMO])) break; if (_sp > XB_SPIN_CAP) { atomicAdd(&(bar)[XB_TMO], 1u); break; } } } } while (0)
struct XcdBarrier { unsigned* bar; unsigned x; volatile LAS unsigned* st; };
DI XcdBarrier xcd_barrier_post(unsigned* bar, volatile LAS unsigned* st) {
  XcdBarrier b; b.bar = bar; b.x = xb_xcc_id(); b.st = st;
  if (threadIdx.x == 0) (void)xb_add(&bar[XB_XCNT(b.x)], 1u);
  return b;
}
DI void xcd_barrier_complete(unsigned* bar, unsigned x, unsigned& nloc, unsigned& nx) {
  const unsigned G = gridDim.x * gridDim.y * gridDim.z;
  unsigned sum, cnt, mine, sp = 0u;
  for (;;) {
    sum = 0u; cnt = 0u; mine = 0u;
#pragma unroll
    for (unsigned j = 0; j < 16; ++j) { const unsigned c = xb_ld(&bar[XB_XCNT(j)]); sum += c; cnt += (c > 0u) ? 1u : 0u; mine = (j == x) ? c : mine; }
    if (sum == G) break;
    __builtin_amdgcn_s_sleep(1);
    if ((++sp & 255u) == 0u) { if (xb_ld(&bar[XB_TMO])) break; if (sp > XB_SPIN_CAP) { atomicAdd(&bar[XB_TMO], 1u); break; } }
  }
  nloc = mine > 0u ? mine : 1u; nx = cnt > 0u ? cnt : 1u;
}
DI void xcd_barrier(const XcdBarrier& b) {
  asm volatile("s_waitcnt vmcnt(0)" ::: "memory");
  __syncthreads();
  if (threadIdx.x == 0) {
    unsigned* bar = b.bar;
    __builtin_amdgcn_s_waitcnt(0);
    unsigned nloc = b.st[0], nx = b.st[1];
    if (nloc == 0u) { xcd_barrier_complete(bar, b.x, nloc, nx); b.st[0] = nloc; b.st[1] = nx; }
    const unsigned old = xb_add(&bar[XB_XSUB(b.x)], 1u);
    const unsigned gen = old / nloc;
    if (old + 1u == (gen + 1u) * nloc) {
      __builtin_amdgcn_fence(__ATOMIC_RELEASE, "agent");
      asm volatile("s_waitcnt vmcnt(0)" ::: "memory");
      const unsigned og = xb_add(&bar[XB_TOP], 1u);
      const unsigned tg = og / nx;
      if (og + 1u == (tg + 1u) * nx) xb_add(&bar[XB_TOPGEN], 1u);
      else XB_SPIN(xb_ld(&bar[XB_TOPGEN]) == tg, bar);
      __builtin_amdgcn_fence(__ATOMIC_ACQUIRE, "agent");
      xb_add(&bar[XB_XGEN(b.x)], 1u);
      asm volatile("s_waitcnt vmcnt(0)" ::: "memory");
    } else {
      XB_SPIN(xb_ld(&bar[XB_XGEN(b.x)]) == gen, bar);
      __builtin_amdgcn_fence(__ATOMIC_ACQUIRE, "agent");
      asm volatile("s_waitcnt vmcnt(0)" ::: "memory");
    }
  }
  __syncthreads();
}

#if MK_COOP
__global__ void __launch_bounds__(NTHR, 2) mega_kernel(Params p) {
  cg::grid_group grid = cg::this_grid();
#ifndef PROBE_PH
#define PROBE_PH -1
#endif
  volatile LAS unsigned* st = (volatile LAS unsigned*)(dyn_smem + 65536 + 1024);
  if (threadIdx.x < 4) st[threadIdx.x] = 0u;
  for (int i = blockIdx.x * NTHR + threadIdx.x; i < XCD_BAR_WORDS; i += gridDim.x * NTHR) p.bar[i] = 0u;
  phase0(p);
  grid.sync();
  XcdBarrier xb = xcd_barrier_post(p.bar, st);
#define RUNP(k, call) call; xcd_barrier(xb); if (PROBE_PH == k) { call; xcd_barrier(xb); }
  RUNP(1, phase1(p, dyn_smem))
  RUNP(2, phase2(p, dyn_smem))
  RUNP(3, phase3(p, dyn_smem))
  RUNP(4, phase4(p, dyn_smem))
  RUNP(5, phase5(p, dyn_smem))
  RUNP(6, phase6(p, dyn_smem))
  RUNP(7, phase7(p, dyn_smem))
  for (int tb8 = 0; tb8 * (int)gridDim.x * 4 < T_TOK; tb8 += 24) phase8(p, dyn_smem, tb8);
}
#else
template <int PH>
__global__ void __launch_bounds__(NTHR, 2) phase_kernel(Params p) { run_phase(p, PH, dyn_smem); }
#endif

extern "C" void kernel_launch(void* const* d_in, const int* in_sizes, int n_in, void* d_out, int out_size, void* d_ws,
                              size_t ws_size, hipStream_t stream) {
  Params p{};
  const float* const* in = (const float* const*)d_in;
  p.x0 = in[0]; p.x1 = in[1]; p.attn_norm_g = in[2]; p.w_in = in[3]; p.q_lat_g = in[4]; p.w_uq = in[5];
  p.kv_lat_g = in[6]; p.w_ukv = in[7]; p.q_head_g = in[8]; p.k_head_g = in[9]; p.attn_out_g = in[10];
  p.fnet_out_g = in[11]; p.w_out = in[12]; p.ffn_norm_g = in[13]; p.peer_w_q = in[14]; p.peer_sub_keys = in[15];
  p.peer_u = in[16]; p.peer_v = in[17];
  p.out = (float*)d_out;
  char* ws = (char*)d_ws;
  size_t off = 0;
  auto take = [&](size_t bytes) { char* q = ws + off; off += (bytes + 255) & ~(size_t)255; return q; };
  p.WinT = (u16*)take(1280 * 1024 * 2); p.WuqT = (u16*)take(768 * 384 * 2); p.WukvT = (u16*)take(1024 * 256 * 2);
  p.WoutT = (u16*)take(1024 * 1024 * 2); p.WpqT = (u16*)take(2048 * 1024 * 2); p.SK = (u16*)take(262144 * 2);
  p.Wc = (u16*)take(256 * 128 * 2); p.WA64 = (u16*)take(128 * 128 * 2); p.WA32 = (u16*)take(128 * 64 * 2);
  p.WB = (u16*)take(128 * 256 * 2);
  p.ropec = (float*)take(8192 * 16 * 4); p.ropes = (float*)take(8192 * 16 * 4);
  p.rstd1 = (float*)take((size_t)T_TOK * 4); p.SSP = (float*)take((size_t)T_TOK * 10 * 4);
  p.SSA = (float*)take((size_t)T_TOK * 8 * 4); p.SSF = (float*)take((size_t)T_TOK * 8 * 4);
  p.SS2 = (float*)take((size_t)T_TOK * 16 * 4); p.KR = (float*)take((size_t)T_TOK * 32 * 4);
  p.bar = (unsigned*)take(XCD_BAR_WORDS * 4);
  p.misc = (float*)take(256);
  const size_t SMALL = 28u << 20;
  char* big = ws + SMALL;
  const size_t MB = 1u << 20;
  char* dsp = (char*)d_out;
  p.Xb = (u16*)(big + 0 * MB);
  p.CQ = (u16*)(big + 96 * MB); p.CKV = (u16*)(big + 132 * MB); p.F = (u16*)(big + 156 * MB);
  p.Z1 = (u16*)(big + 204 * MB);
  p.Vt = (u16*)(big + 300 * MB);
  p.Q1 = (u16*)(dsp + 0 * MB); p.K1 = (u16*)(dsp + 72 * MB);
  p.Qn = (u16*)(big + 0 * MB); p.Kn = (u16*)(dsp + 120 * MB);
  p.G1 = (u16*)(big + 96 * MB);
  p.MIX = (u16*)(big + 204 * MB);
  p.X2b = (u16*)(big + 0 * MB);
  p.Qp = (u16*)(big + 96 * MB);
  p.IDX = (int*)(big + 300 * MB); p.G = (float*)(big + 324 * MB);
  p.U8 = (unsigned char*)(big + 348 * MB); p.V8 = (unsigned char*)(big + 364 * MB);

#if MK_COOP
  static int grid_blocks = 0;
  if (!grid_blocks) {
    int dev = 0, cus = 0, per_cu = 0;
    hipGetDevice(&dev);
    hipDeviceGetAttribute(&cus, hipDeviceAttributeMultiprocessorCount, dev);
    hipFuncSetAttribute((const void*)mega_kernel, hipFuncAttributeMaxDynamicSharedMemorySize, LDS_BYTES);
    hipOccupancyMaxActiveBlocksPerMultiprocessor(&per_cu, mega_kernel, NTHR, LDS_BYTES);
    if (per_cu > 2) per_cu = 2;
    grid_blocks = cus * per_cu;
    grid_blocks &= ~7;
  }
  void* args[] = {&p};
  hipError_t e = hipLaunchCooperativeKernel((void*)mega_kernel, dim3(grid_blocks), dim3(NTHR), args, LDS_BYTES, stream);
  if (e != hipSuccess) fprintf(stderr, "cooperative launch failed: %s (grid %d)\n", hipGetErrorString(e), grid_blocks);
#else
  const int GB = 512;
#define LAUNCH(PH)                                                                                                \
  hipFuncSetAttribute((const void*)phase_kernel<PH>, hipFuncAttributeMaxDynamicSharedMemorySize, LDS_BYTES);      \
  phase_kernel<PH><<<GB, NTHR, LDS_BYTES, stream>>>(p);
  LAUNCH(0) LAUNCH(1) LAUNCH(2) LAUNCH(3) LAUNCH(4) LAUNCH(5) LAUNCH(6) LAUNCH(7) LAUNCH(8)
#endif
}
```

```cpp
#include <hip/hip_runtime.h>
#include <hip/hip_cooperative_groups.h>
#include <stdint.h>
#include <cstdio>
namespace cg = cooperative_groups;

#ifndef MK_COOP
#define MK_COOP 1
#endif

typedef unsigned short u16;
using bf16x8 = __attribute__((ext_vector_type(8))) short;
using f32x16 = __attribute__((ext_vector_type(16))) float;
using f32x4 = __attribute__((ext_vector_type(4))) float;
using f32x2 = __attribute__((ext_vector_type(2))) float;
using u32x4 = __attribute__((ext_vector_type(4))) unsigned;
using u32x2 = __attribute__((ext_vector_type(2))) unsigned;
typedef __bf16 bf2_t __attribute__((ext_vector_type(2)));

#define DI __device__ __forceinline__
#define MFMA(a, b, c) __builtin_amdgcn_mfma_f32_32x32x16_bf16((a), (b), (c), 0, 0, 0)

constexpr int T_TOK = 49152;
constexpr int TP = 16384;
constexpr float EPS = 1e-6f;
constexpr int NTHR = 256;
constexpr int LDS_BYTES = 65536 + 6144;
constexpr int GBUF = 32768;
constexpr float USCALE = 512.f, VSCALE = 256.f;

struct Params {
  const float *x0, *x1, *attn_norm_g, *w_in, *q_lat_g, *w_uq, *kv_lat_g, *w_ukv, *q_head_g, *k_head_g,
      *attn_out_g, *fnet_out_g, *w_out, *ffn_norm_g, *peer_w_q, *peer_sub_keys, *peer_u, *peer_v;
  float* out;
  u16 *WinT, *WuqT, *WukvT, *WoutT, *WpqT, *SK, *Wc, *WA64, *WA32, *WB;
  float *ropec, *ropes, *rstd1, *SSP, *SSA, *SSF, *SS2, *KR;
  u16 *Xb, *CQ, *CKV, *F, *Z1, *Vt, *Q1, *K1, *Qn, *Kn, *G1, *MIX, *X2b, *Qp;
  unsigned char *U8, *V8;
  int* IDX;
  float* G;
  unsigned* bar;
  float* misc;
};

DI unsigned cvtpk(float lo, float hi) {
  f32x2 v = {lo, hi};
  bf2_t b = __builtin_convertvector(v, bf2_t);
  return __builtin_bit_cast(unsigned, b);
}
DI u16 f2bf(float x) { return (u16)(cvtpk(x, 0.f) & 0xffffu); }
DI float bflo(unsigned w) { return __uint_as_float(w << 16); }
DI float bfhi(unsigned w) { return __uint_as_float(w & 0xffff0000u); }
DI int crow(int i, int h) { return (i & 3) + 8 * (i >> 2) + 4 * h; }
DI float red32(float v) {
  v += __shfl_xor(v, 1); v += __shfl_xor(v, 2); v += __shfl_xor(v, 4); v += __shfl_xor(v, 8); v += __shfl_xor(v, 16);
  return v;
}
DI float wave_sum(float v) { v = red32(v); v += __shfl_xor(v, 32); return v; }
DI const float* xrow(const Params& p, int t) {
  return t < TP ? p.x0 + (size_t)t * 1024 : p.x1 + (size_t)(t - TP) * 1024;
}
DI void tok2seq(int t, int& q, int& S, int& tb) {
  if (t < TP) { q = t >> 13; S = 8192; tb = q << 13; }
  else { int u = (t - TP) >> 12; q = 2 + u; S = 4096; tb = TP + (u << 12); }
}
DI int vblock() { return (blockIdx.x & 7) * (gridDim.x >> 3) + (blockIdx.x >> 3); }
DI float fdot2(unsigned a, unsigned b, float c) {
  return __builtin_amdgcn_fdot2_f32_bf16(__builtin_bit_cast(bf2_t, a), __builtin_bit_cast(bf2_t, b), c, false);
}

DI int swz(int row, int c) { return row * 128 + ((c ^ ((row >> 1) & 7)) << 4); }

template <class AF, class BF>
DI void gemm_issue(u32x4 (&ra)[4], u32x4 (&rb)[4], AF arow, BF brow, int k0) {
  const int tid = threadIdx.x, lrow = tid >> 3, lc = tid & 7;
#pragma unroll
  for (int i = 0; i < 4; ++i) {
    ra[i] = *(const u32x4*)(arow(lrow + 32 * i) + lc * 8 + k0);
    rb[i] = *(const u32x4*)(brow(lrow + 32 * i) + lc * 8 + k0);
  }
}
template <bool BATCH = false, bool PRE = false, class AF, class BF>
DI void gemm_stream(f32x16 (&acc)[2][2], char* smem, AF arow, BF brow, int k0, int k1, u32x4 (&ra0)[4], u32x4 (&rb0)[4],
                    bool hasn, long dA, long dB) {
  const int tid = threadIdx.x, lane = tid & 63, wave = tid >> 6;
  const int wm = wave >> 1, wn = wave & 1, r = lane & 31, h = lane >> 5;
  const int lrow = tid >> 3, lc = tid & 7;
  const u16* ap[4]; const u16* bp[4];
#pragma unroll
  for (int i = 0; i < 4; ++i) { ap[i] = arow(lrow + 32 * i) + lc * 8; bp[i] = brow(lrow + 32 * i) + lc * 8; }
  u32x4 ra1[4], rb1[4];
  if (!PRE) {
#pragma unroll
    for (int i = 0; i < 4; ++i) { ra0[i] = *(const u32x4*)(ap[i] + k0); rb0[i] = *(const u32x4*)(bp[i] + k0); }
  }
#pragma unroll
  for (int i = 0; i < 4; ++i) {
    *(u32x4*)(smem + swz(lrow + 32 * i, lc)) = ra0[i];
    *(u32x4*)(smem + 16384 + swz(lrow + 32 * i, lc)) = rb0[i];
  }
  if (k0 + 64 < k1) {
#pragma unroll
    for (int i = 0; i < 4; ++i) { ra0[i] = *(const u32x4*)(ap[i] + k0 + 64); rb0[i] = *(const u32x4*)(bp[i] + k0 + 64); }
  }
  __syncthreads();
  int cur = 0;
  auto step = [&](int k, u32x4 (&xa)[4], u32x4 (&xb)[4], u32x4 (&ya)[4], u32x4 (&yb)[4]) {
    if (k + 128 < k1) {
#pragma unroll
      for (int i = 0; i < 4; ++i) { ya[i] = *(const u32x4*)(ap[i] + k + 128); yb[i] = *(const u32x4*)(bp[i] + k + 128); }
    }
    if (hasn && k + 64 >= k1) {
#pragma unroll
      for (int i = 0; i < 4; ++i) { ra0[i] = *(const u32x4*)(ap[i] + dA); rb0[i] = *(const u32x4*)(bp[i] + dB); }
    }
    __builtin_amdgcn_sched_barrier(0);
    const char* As = smem + cur * GBUF;
    const char* Bs = As + 16384;
    if (BATCH) {
      bf16x8 af[4][2], bfr[4][2];
#pragma unroll
      for (int ks = 0; ks < 4; ++ks) {
#pragma unroll
        for (int mi = 0; mi < 2; ++mi) af[ks][mi] = *(const bf16x8*)(As + swz(wm * 64 + mi * 32 + r, ks * 2 + h));
#pragma unroll
        for (int ni = 0; ni < 2; ++ni) bfr[ks][ni] = *(const bf16x8*)(Bs + swz(wn * 64 + ni * 32 + r, ks * 2 + h));
      }
      __builtin_amdgcn_sched_barrier(0);
#pragma unroll
      for (int ks = 0; ks < 4; ++ks)
#pragma unroll
        for (int mi = 0; mi < 2; ++mi)
#pragma unroll
          for (int ni = 0; ni < 2; ++ni) acc[mi][ni] = MFMA(af[ks][mi], bfr[ks][ni], acc[mi][ni]);
    } else {
#pragma unroll
      for (int ks = 0; ks < 4; ++ks) {
        bf16x8 af[2], bfr[2];
#pragma unroll
        for (int mi = 0; mi < 2; ++mi) af[mi] = *(const bf16x8*)(As + swz(wm * 64 + mi * 32 + r, ks * 2 + h));
#pragma unroll
        for (int ni = 0; ni < 2; ++ni) bfr[ni] = *(const bf16x8*)(Bs + swz(wn * 64 + ni * 32 + r, ks * 2 + h));
#pragma unroll
        for (int mi = 0; mi < 2; ++mi)
#pragma unroll
          for (int ni = 0; ni < 2; ++ni) acc[mi][ni] = MFMA(af[mi], bfr[ni], acc[mi][ni]);
      }
    }
    __builtin_amdgcn_sched_barrier(0);
    if (k + 64 < k1) {
      char* An = smem + (cur ^ 1) * GBUF;
#pragma unroll
      for (int i = 0; i < 4; ++i) {
        *(u32x4*)(An + swz(lrow + 32 * i, lc)) = xa[i];
        *(u32x4*)(An + 16384 + swz(lrow + 32 * i, lc)) = xb[i];
      }
    }
    __syncthreads();
    cur ^= 1;
  };
#pragma unroll 1
  for (int k = k0; k < k1; k += 128) {
    step(k, ra0, rb0, ra1, rb1);
    if (k + 64 < k1) step(k + 64, ra1, rb1, ra0, rb0);
  }
}
template <bool BATCH = false, class AF, class BF>
DI void gemm_mainloop(f32x16 (&acc)[2][2], char* smem, AF arow, BF brow, int k0, int k1) {
  u32x4 ra0[4], rb0[4];
  gemm_stream<BATCH, false>(acc, smem, arow, brow, k0, k1, ra0, rb0, false, 0, 0);
}
DI void zero_acc(f32x16 (&acc)[2][2]) {
#pragma unroll
  for (int a = 0; a < 2; ++a)
#pragma unroll
    for (int b = 0; b < 2; ++b)
#pragma unroll
      for (int i = 0; i < 16; ++i) acc[a][b][i] = 0.f;
}
#define WAVE_COORDS                                                        \
  const int tid = threadIdx.x, lane = tid & 63, wave = tid >> 6;           \
  const int wm = wave >> 1, wn = wave & 1, r = lane & 31, h = lane >> 5;   \
  (void)wm; (void)wn; (void)r; (void)h; (void)lane;

constexpr int SROW = 272;
template <bool SCALE>
DI void stage_bf16_t(char* smem, f32x16 (&acc)[2][2], const float* rs, int wm, int wn, int r, int h) {
  char* base = smem + (wm * 64 + 4 * h) * SROW + (wn * 64 + r) * 2;
  const float* rb = rs + wm * 64 + 4 * h;
#pragma unroll
  for (int mi = 0; mi < 2; ++mi)
#pragma unroll
    for (int i = 0; i < 16; ++i) {
      const int ro = mi * 32 + (i & 3) + 8 * (i >> 2);
      const float sc = SCALE ? rb[ro] : 1.f;
#pragma unroll
      for (int ni = 0; ni < 2; ++ni)
        *(u16*)(base + ro * SROW + ni * 64) = f2bf(acc[mi][ni][i] * sc);
    }
}
DI void stage_bf16(char* smem, f32x16 (&acc)[2][2], const float* rs, int wm, int wn, int r, int h, int) {
  if (rs) stage_bf16_t<true>(smem, acc, rs, wm, wn, r, h); else stage_bf16_t<false>(smem, acc, rs, wm, wn, r, h);
}
DI float sumsq8(const u32x4& v) {
  float ss = 0.f;
#pragma unroll
  for (int j = 0; j < 4; ++j) { const float a = bflo(v[j]), b = bfhi(v[j]); ss += a * a + b * b; }
  return ss;
}

#define WAVE_COORDS_L                                                      \
  int tid = threadIdx.x; asm volatile("" : "+v"(tid));                     \
  const int lane = tid & 63, wave = tid >> 6;                              \
  const int wm = wave >> 1, wn = wave & 1, r = lane & 31, h = lane >> 5;   \
  (void)wm; (void)wn; (void)r; (void)h; (void)lane;

template <int MODE>
DI void transpose_w(u16* dst, const float* src, const float* g0, const float* g1, int N, int K, int Nsrc, int gt, int gs) {
  const int items = N * (K >> 3);
  for (int id = gt; id < items; id += gs) {
    const int kc = id / N, n = id - kc * N;
    int col = n; bool valid = true;
    if (MODE == 1) {
      if (n < 640) col = n; else if (n < 1152) col = n + 32; else if (n < 1184) col = 640 + n - 1152; else valid = false;
    }
    float v[8];
#pragma unroll
    for (int j = 0; j < 8; ++j) {
      const int k = kc * 8 + j;
      const float g = (MODE == 2 && k >= 512) ? g1[k - 512] : g0[k];
      v[j] = valid ? src[(size_t)k * Nsrc + col] * g : 0.f;
    }
    u32x4 o = {cvtpk(v[0], v[1]), cvtpk(v[2], v[3]), cvtpk(v[4], v[5]), cvtpk(v[6], v[7])};
    *(u32x4*)(dst + (size_t)n * K + kc * 8) = o;
  }
}

DI void phase0(const Params& p) {
  const int gt = blockIdx.x * NTHR + threadIdx.x, gs = gridDim.x * NTHR;
  if (gt == 0) {
    float mq = 0.f, mk = 0.f;
    for (int d = 0; d < 96; ++d) { mq = fmaxf(mq, fabsf(p.q_head_g[d])); mk = fmaxf(mk, fabsf(p.k_head_g[d])); }
    p.misc[0] = 96.f * mq * mk * (0.10206207261596575f * 1.4426950408889634f) * 1.02f;
  }
  const int lane = threadIdx.x & 63, gw = gt >> 6, nw = gs >> 6;
  for (int t = gw; t < T_TOK; t += nw) {
    const float* xr = xrow(p, t);
    f32x4 v[4]; float ss = 0.f;
#pragma unroll
    for (int i = 0; i < 4; ++i) {
      v[i] = *(const f32x4*)(xr + i * 256 + lane * 4);
      ss += v[i][0] * v[i][0] + v[i][1] * v[i][1] + v[i][2] * v[i][2] + v[i][3] * v[i][3];
    }
    ss = wave_sum(ss);
#pragma unroll
    for (int i = 0; i < 4; ++i) {
      u32x2 o = {cvtpk(v[i][0], v[i][1]), cvtpk(v[i][2], v[i][3])};
      *(u32x2*)(p.Xb + (size_t)t * 1024 + i * 256 + lane * 4) = o;
    }
    if (lane == 0) p.rstd1[t] = rsqrtf(ss * (1.f / 1024.f) + EPS);
  }
  transpose_w<1>(p.WinT, p.w_in, p.attn_norm_g, nullptr, 1280, 1024, 1184, gt, gs);
  transpose_w<0>(p.WuqT, p.w_uq, p.q_lat_g, nullptr, 768, 384, 768, gt, gs);
  transpose_w<0>(p.WukvT, p.w_ukv, p.kv_lat_g, nullptr, 1024, 256, 1024, gt, gs);
  transpose_w<2>(p.WoutT, p.w_out, p.attn_out_g, p.fnet_out_g, 1024, 1024, 1024, gt, gs);
  transpose_w<0>(p.WpqT, p.peer_w_q, p.ffn_norm_g, nullptr, 2048, 1024, 2048, gt, gs);
  for (int id = gt; id < 262144 / 4; id += gs) {
    f32x4 v = *(const f32x4*)(p.peer_sub_keys + (size_t)id * 4);
    u32x2 o = {cvtpk(v[0], v[1]), cvtpk(v[2], v[3])};
    *(u32x2*)(p.SK + (size_t)id * 4) = o;
  }
  for (int id = gt; id < 256 * 128; id += gs) {
    const int n = id >> 7, c = id & 127, pp = n >> 7, m = n & 127;
    const float fr = (float)((m * c) & 127) * (1.f / 128.f);
    const float val = (pp == 0 ? __builtin_amdgcn_cosf(fr) : -__builtin_amdgcn_sinf(fr)) * 0.08838834764831845f;
    p.Wc[id] = f2bf(val);
  }
  for (int id = gt; id < 128 * 128; id += gs) {
    const int n = id >> 7, k = id & 127;
    const int k1 = (n >> 6) * 32 + (n & 31), pq = (n >> 5) & 1, pp = k >> 6, s1 = k & 63;
    const float fr = (float)((s1 * k1) & 63) * (1.f / 64.f);
    const float c = __builtin_amdgcn_cosf(fr), s = __builtin_amdgcn_sinf(fr);
    const float val = (pq == 0 ? (pp == 0 ? c : s) : (pp == 0 ? -s : c)) * 0.125f;
    p.WA64[id] = f2bf(val);
  }
  for (int id = gt; id < 128 * 64; id += gs) {
    const int n = id >> 6, k = id & 63;
    const int k1 = n & 31, pq = (n >> 5) & 1, pp = k >> 5, s1 = k & 31;
    const float fr = (float)((s1 * k1) & 31) * (1.f / 32.f);
    const float c = __builtin_amdgcn_cosf(fr), s = __builtin_amdgcn_sinf(fr);
    float val = (pq == 0 ? (pp == 0 ? c : s) : (pp == 0 ? -s : c)) * 0.17677669529663687f;
    if (n >= 64) val = 0.f;
    p.WA32[id] = f2bf(val);
  }
  for (int id = gt; id < 128 * 256; id += gs) {
    const int k2 = id >> 8, k = id & 255, pq = k >> 7, s2 = k & 127;
    const float fr = (float)((s2 * k2) & 127) * (1.f / 128.f);
    const float val = (pq == 0 ? __builtin_amdgcn_cosf(fr) : __builtin_amdgcn_sinf(fr)) * 0.08838834764831845f;
    p.WB[id] = f2bf(val);
  }
  for (int id = gt; id < 8192 * 16; id += gs) {
    const int pos = id >> 4, j = id & 15;
    const float freq = exp2f(-(float)j * (13.287712379549449f / 16.f));
    const double rev = (double)pos * (double)freq * 0.15915494309189535;
    const float fr = (float)(rev - floor(rev));
    p.ropec[id] = __builtin_amdgcn_cosf(fr);
    p.ropes[id] = __builtin_amdgcn_sinf(fr);
  }
}

DI void phase1(const Params& p, char* smem) {
    float* rs = (float*)(smem + 65536);
  const int G = gridDim.x;
  u32x4 sa[4], sb[4];
  if (vblock() < 384 * 10) {
    const int t0 = vblock(), mt0 = t0 / 10;
    const u16* A0 = p.Xb + (size_t)mt0 * 128 * 1024; const u16* B0 = p.WinT + (size_t)(t0 - mt0 * 10) * 128 * 1024;
    gemm_issue(sa, sb, [&](int rr) { return A0 + (size_t)rr * 1024; }, [&](int rr) { return B0 + (size_t)rr * 1024; }, 0);
  }
  for (int tile = vblock(); tile < 384 * 10; tile += G) {
    WAVE_COORDS_L
    const int mt = tile / 10, nt = tile - mt * 10, m0 = mt * 128, n0 = nt * 128;
    const int nx = tile + G; const bool hasn = nx < 384 * 10;
    const int nmt = nx / 10;
    const u16* An = p.Xb + (size_t)nmt * 128 * 1024; const u16* Bn = p.WinT + (size_t)(nx - nmt * 10) * 128 * 1024;
    __syncthreads();
    const float rsv = (tid < 128) ? p.rstd1[m0 + tid] : 0.f;
    f32x16 acc[2][2]; zero_acc(acc);
    const u16* A = p.Xb + (size_t)m0 * 1024; const u16* B = p.WinT + (size_t)n0 * 1024;
    gemm_stream<true, true>(acc, smem, [&](int rr) { return A + (size_t)rr * 1024; }, [&](int rr) { return B + (size_t)rr * 1024; }, 0, 1024, sa, sb,
                      hasn, (long)(An - A), (long)(Bn - B));
    if (tid < 128) rs[tid] = rsv;
    __syncthreads();
    if (nt == 9) {
      if (wn == 0) {
#pragma unroll
        for (int mi = 0; mi < 2; ++mi)
#pragma unroll
          for (int i = 0; i < 16; ++i) {
            const int ro = mi * 32 + (i & 3) + 8 * (i >> 2);
            p.KR[(size_t)(m0 + wm * 64 + 4 * h + ro) * 32 + r] = acc[mi][0][i] * rs[wm * 64 + 4 * h + ro];
          }
      }
    } else {
      stage_bf16_t<true>(smem, acc, rs, wm, wn, r, h);
      __syncthreads();
      u16* dbase; int dstride, cbase;
      if (nt < 3) { dbase = p.CQ; dstride = 384; cbase = n0; }
      else if (nt < 5) { dbase = p.CKV; dstride = 256; cbase = n0 - 384; }
      else { dbase = p.F; dstride = 512; cbase = n0 - 640; }
#pragma unroll
      for (int j = 0; j < 8; ++j) {
        const int id = tid + 256 * j, row = id >> 4, cc = id & 15;
        const u32x4 v = *(const u32x4*)(smem + row * SROW + cc * 16);
        *(u32x4*)(dbase + (size_t)(m0 + row) * dstride + cbase + cc * 8) = v;
        if (nt < 5) {
          float ss = sumsq8(v);
          ss += __shfl_xor(ss, 1); ss += __shfl_xor(ss, 2); ss += __shfl_xor(ss, 4); ss += __shfl_xor(ss, 8);
          if (cc == 0) p.SSP[(size_t)(m0 + row) * 10 + nt * 2] = ss;
        }
      }
    }
  }
}

DI void phase2(const Params& p, char* smem) {
    float* rs = (float*)(smem + 65536);
  const int G = gridDim.x;
  const int NUQ = 384 * 6, NUKV = 384 * 8, NCH = 384 * 8;
  for (int tile = vblock(); tile < NUQ + NUKV + NCH; tile += G) {
    WAVE_COORDS_L
    f32x16 acc[2][2]; zero_acc(acc);
    __syncthreads();
    if (tile < NUQ) {
      const int mt = tile / 6, nt = tile - mt * 6, m0 = mt * 128, n0 = nt * 128;
      float q0 = 0.f, q1 = 0.f, q2 = 0.f;
      if (tid < 128) { const float* s = p.SSP + (size_t)(m0 + tid) * 10; q0 = s[0]; q1 = s[2]; q2 = s[4]; }
      const u16* A = p.CQ + (size_t)m0 * 384; const u16* B = p.WuqT + (size_t)n0 * 384;
      gemm_mainloop(acc, smem, [&](int rr) { return A + (size_t)rr * 384; }, [&](int rr) { return B + (size_t)rr * 384; }, 0, 384);
      if (tid < 128) rs[tid] = rsqrtf((q0 + q1 + q2) * (1.f / 384.f) + EPS);
      __syncthreads();
      stage_bf16_t<true>(smem, acc, rs, wm, wn, r, h);
      __syncthreads();
#pragma unroll
      for (int j = 0; j < 8; ++j) {
        const int id = tid + 256 * j, row = id >> 4, cc = id & 15;
        *(u32x4*)(p.Q1 + (size_t)(m0 + row) * 768 + n0 + cc * 8) = *(const u32x4*)(smem + row * SROW + cc * 16);
      }
    } else if (tile < NUQ + NUKV) {
      const int tl = tile - NUQ;
      const int mt = tl >> 3, hh = tl & 7, m0 = mt * 128;
      int q, S, tb; tok2seq(m0, q, S, tb);
      float q0 = 0.f, q1 = 0.f;
      if (tid < 128) { const float* s = p.SSP + (size_t)(m0 + tid) * 10; q0 = s[6]; q1 = s[8]; }
      const u16* A = p.CKV + (size_t)m0 * 256; const u16* B = p.WukvT + (size_t)hh * 128 * 256;
      gemm_mainloop(acc, smem, [&](int rr) { return A + (size_t)rr * 256; }, [&](int rr) { return B + (size_t)rr * 256; }, 0, 256);
      if (tid < 128) rs[tid] = rsqrtf((q0 + q1) * (1.f / 256.f) + EPS);
      __syncthreads();
      if (wn == 0) {
#pragma unroll
        for (int mi = 0; mi < 2; ++mi)
#pragma unroll
          for (int i = 0; i < 16; ++i) {
            const int ro = mi * 32 + (i & 3) + 8 * (i >> 2);
            const float sc = (rs + wm * 64 + 4 * h)[ro];
#pragma unroll
            for (int ni = 0; ni < 2; ++ni) *(u16*)(smem + (wm * 64 + 4 * h) * SROW + r * 2 + ro * SROW + ni * 64) = f2bf(acc[mi][ni][i] * sc);
          }
      } else {
        const int s0 = m0 - tb;
#pragma unroll
        for (int mi = 0; mi < 2; ++mi)
#pragma unroll
          for (int g4 = 0; g4 < 4; ++g4) {
            const int row = wm * 64 + mi * 32 + 8 * g4 + 4 * h;
            const f32x4 sc = *(const f32x4*)(rs + row);
#pragma unroll
            for (int ni = 0; ni < 2; ++ni) {
              const int dv = ni * 32 + r;
              u32x2 o = {cvtpk(acc[mi][ni][4 * g4] * sc[0], acc[mi][ni][4 * g4 + 1] * sc[1]),
                         cvtpk(acc[mi][ni][4 * g4 + 2] * sc[2], acc[mi][ni][4 * g4 + 3] * sc[3])};
              *(u32x2*)(p.Vt + (size_t)tb * 512 + (size_t)(hh * 64 + dv) * S + s0 + row) = o;
            }
            __builtin_amdgcn_sched_barrier(0);
          }
      }
      __syncthreads();
#pragma unroll
      for (int j = 0; j < 4; ++j) {
        const int id = tid + 256 * j, row = id >> 3, cc = id & 7;
        *(u32x4*)(p.K1 + (size_t)(m0 + row) * 512 + hh * 64 + cc * 8) = *(const u32x4*)(smem + row * SROW + cc * 16);
      }
    } else {
      const int tl = tile - NUQ - NUKV;
      const int pp = tl & 1, g = (tl >> 1) & 3, mt = tl >> 3, m0 = mt * 128;
      int q, S, tb; tok2seq(m0, q, S, tb);
      const int S1 = (q < 2) ? 64 : 32, l1 = (q < 2) ? 6 : 5;
      const int j0 = ((m0 - tb) >> 7) * (128 >> l1);
      const u16* Fb = p.F + (size_t)g * 128;
      const u16* B = p.Wc + (size_t)pp * 128 * 128;
      gemm_mainloop(acc, smem,
                    [&](int rr) { const int s1 = rr & (S1 - 1), s2 = j0 + (rr >> l1); return Fb + (size_t)(tb + s1 * 128 + s2) * 512; },
                    [&](int rr) { return B + (size_t)rr * 128; }, 0, 128);
      u16* Zb = p.Z1 + (size_t)tb * 1024;
#pragma unroll
      for (int mi = 0; mi < 2; ++mi)
#pragma unroll
        for (int g4 = 0; g4 < 4; ++g4) {
          const int rho = wm * 64 + mi * 32 + 8 * g4 + 4 * h;
          const int s1 = rho & (S1 - 1), s2 = j0 + (rho >> l1);
#pragma unroll
          for (int ni = 0; ni < 2; ++ni) {
            const int m = wn * 64 + ni * 32 + r;
            u32x2 o = {cvtpk(acc[mi][ni][4 * g4], acc[mi][ni][4 * g4 + 1]), cvtpk(acc[mi][ni][4 * g4 + 2], acc[mi][ni][4 * g4 + 3])};
            *(u32x2*)(Zb + ((size_t)((g * 128 + m) * 128 + s2) * (2 * S1)) + pp * S1 + s1) = o;
          }
          __builtin_amdgcn_sched_barrier(0);
        }
    }
  }
}

DI void phase3(const Params& p, char* smem) {
    const int G = gridDim.x;
  for (int tile = vblock(); tile < 5120; tile += G) {
    WAVE_COORDS_L
    const int q = tile >> 9, gm = tile & 511;
    const int tb = (q < 2) ? (q << 13) : (TP + ((q - 2) << 12));
    const int S = (q < 2) ? 8192 : 4096, S1 = (q < 2) ? 64 : 32, K = 2 * S1;
    f32x16 acc[2][2]; zero_acc(acc);
    const u16* A = p.Z1 + (size_t)tb * 1024 + (size_t)gm * 128 * K;
    const u16* B = (q < 2) ? p.WA64 : p.WA32;
    gemm_mainloop(acc, smem, [&](int rr) { return A + (size_t)rr * K; }, [&](int rr) { return B + (size_t)rr * K; }, 0, K);
    if (wn * 32 < S1) {
      const int k1 = wn * 32 + r;
      const float invS = 1.f / (float)S;
      u16* Gb = p.G1 + (size_t)tb * 1024 + (size_t)(gm * S1 + k1) * 256;
#pragma unroll
      for (int mi = 0; mi < 2; ++mi)
#pragma unroll
        for (int g4 = 0; g4 < 4; ++g4) {
          const int s2b = wm * 64 + mi * 32 + 8 * g4 + 4 * h;
          float ore[4], oim[4];
#pragma unroll
          for (int j = 0; j < 4; ++j) {
            const int s2 = s2b + j;
            const float fr = (float)((s2 * k1) & (S - 1)) * invS;
            const float c = __builtin_amdgcn_cosf(fr), s = __builtin_amdgcn_sinf(fr);
            const float re = acc[mi][0][4 * g4 + j], im = acc[mi][1][4 * g4 + j];
            ore[j] = re * c + im * s; oim[j] = im * c - re * s;
          }
          u32x2 o0 = {cvtpk(ore[0], ore[1]), cvtpk(ore[2], ore[3])};
          u32x2 o1 = {cvtpk(oim[0], oim[1]), cvtpk(oim[2], oim[3])};
          *(u32x2*)(Gb + s2b) = o0;
          *(u32x2*)(Gb + 128 + s2b) = o1;
        }
    }
  }
  const float QSCALE = 0.10206207261596575f * 1.4426950408889634f;
  for (int chunk = vblock(); chunk < T_TOK * 8 / NTHR; chunk += G) {
    WAVE_COORDS_L
    const int id = chunk * NTHR + tid;
    const int t = id >> 3, hh = id & 7;
    int q, S, tb; tok2seq(t, q, S, tb);
    const int s = t - tb;
    const size_t obase = ((size_t)tb * 8 + (size_t)hh * S + s) * 96;
    const float* rcp = p.ropec + s * 16; const float* rsp = p.ropes + s * 16;
    {
      u32x4 w[12];
      const u16* src = p.Q1 + (size_t)t * 768 + hh * 96;
#pragma unroll
      for (int i = 0; i < 12; ++i) w[i] = *(const u32x4*)(src + i * 8);
      float ss = 0.f;
#pragma unroll
      for (int i = 0; i < 12; ++i)
#pragma unroll
        for (int j = 0; j < 4; ++j) { const float a = bflo(w[i][j]), b = bfhi(w[i][j]); ss += a * a + b * b; }
      const float rinv = rsqrtf(ss * (1.f / 96.f) + EPS);
      u16* dst = p.Qn + obase;
#pragma unroll
      for (int i = 0; i < 8; ++i) {
        u32x4 o;
#pragma unroll
        for (int j = 0; j < 4; ++j) {
          const int d = i * 8 + j * 2;
          o[j] = cvtpk(bflo(w[i][j]) * rinv * p.q_head_g[d] * QSCALE, bfhi(w[i][j]) * rinv * p.q_head_g[d + 1] * QSCALE);
        }
        *(u32x4*)(dst + i * 8) = o;
      }
      float x1[16], x2[16];
#pragma unroll
      for (int i = 0; i < 2; ++i)
#pragma unroll
        for (int j = 0; j < 4; ++j) {
          const int e = i * 8 + j * 2;
          x1[e] = bflo(w[8 + i][j]) * rinv * p.q_head_g[64 + e]; x1[e + 1] = bfhi(w[8 + i][j]) * rinv * p.q_head_g[64 + e + 1];
          x2[e] = bflo(w[10 + i][j]) * rinv * p.q_head_g[80 + e]; x2[e + 1] = bfhi(w[10 + i][j]) * rinv * p.q_head_g[80 + e + 1];
        }
      float o1[16], o2[16];
#pragma unroll
      for (int e = 0; e < 16; ++e) {
        const float c = rcp[e], sn = rsp[e];
        o1[e] = (x1[e] * c - x2[e] * sn) * QSCALE; o2[e] = (x2[e] * c + x1[e] * sn) * QSCALE;
      }
#pragma unroll
      for (int i = 0; i < 2; ++i) {
        u32x4 a, b;
#pragma unroll
        for (int j = 0; j < 4; ++j) { a[j] = cvtpk(o1[i * 8 + j * 2], o1[i * 8 + j * 2 + 1]); b[j] = cvtpk(o2[i * 8 + j * 2], o2[i * 8 + j * 2 + 1]); }
        *(u32x4*)(dst + 64 + i * 8) = a;
        *(u32x4*)(dst + 80 + i * 8) = b;
      }
    }
    __builtin_amdgcn_sched_barrier(0);
    {
      u32x4 w[8];
      const u16* src = p.K1 + (size_t)t * 512 + hh * 64;
#pragma unroll
      for (int i = 0; i < 8; ++i) w[i] = *(const u32x4*)(src + i * 8);
      f32x4 kr[8];
#pragma unroll
      for (int i = 0; i < 8; ++i) kr[i] = *(const f32x4*)(p.KR + (size_t)t * 32 + i * 4);
      float ss = 0.f;
#pragma unroll
      for (int i = 0; i < 8; ++i)
#pragma unroll
        for (int j = 0; j < 4; ++j) { const float a = bflo(w[i][j]), b = bfhi(w[i][j]); ss += a * a + b * b + kr[i][j] * kr[i][j]; }
      const float rinv = rsqrtf(ss * (1.f / 96.f) + EPS);
      u16* dst = p.Kn + obase;
#pragma unroll
      for (int i = 0; i < 8; ++i) {
        u32x4 o;
#pragma unroll
        for (int j = 0; j < 4; ++j) {
          const int d = i * 8 + j * 2;
          o[j] = cvtpk(bflo(w[i][j]) * rinv * p.k_head_g[d], bfhi(w[i][j]) * rinv * p.k_head_g[d + 1]);
        }
        *(u32x4*)(dst + i * 8) = o;
      }
      float o1[16], o2[16];
#pragma unroll
      for (int e = 0; e < 16; ++e) {
        const float a = kr[e >> 2][e & 3] * rinv * p.k_head_g[64 + e];
        const float b = kr[4 + (e >> 2)][e & 3] * rinv * p.k_head_g[80 + e];
        const float c = rcp[e], sn = rsp[e];
        o1[e] = a * c - b * sn; o2[e] = b * c + a * sn;
      }
#pragma unroll
      for (int i = 0; i < 2; ++i) {
        u32x4 a, b;
#pragma unroll
        for (int j = 0; j < 4; ++j) { a[j] = cvtpk(o1[i * 8 + j * 2], o1[i * 8 + j * 2 + 1]); b[j] = cvtpk(o2[i * 8 + j * 2], o2[i * 8 + j * 2 + 1]); }
        *(u32x4*)(dst + 64 + i * 8) = a;
        *(u32x4*)(dst + 80 + i * 8) = b;
      }
    }
  }
}

constexpr int KSTR = 208, VSTR = 136, ABUF = 64 * KSTR + 64 * VSTR;

DI void attn_tile(const Params& p, char* smem, int a) {
  WAVE_COORDS
  int q, hh, qt, S, tb;
  if (a < 1024) { q = a >> 9; hh = (a >> 6) & 7; qt = a & 63; S = 8192; tb = q << 13; }
  else { const int b = a - 1024; q = 2 + (b >> 8); hh = (b >> 5) & 7; qt = b & 31; S = 4096; tb = TP + ((q - 2) << 12); }
  const size_t qkb = ((size_t)tb * 8 + (size_t)hh * S) * 96;
  const u16* Qb = p.Qn + qkb; const u16* Kb = p.Kn + qkb;
  const u16* Vb = p.Vt + (size_t)tb * 512 + (size_t)hh * 64 * S;
  const int qrow = qt * 128 + wave * 32 + r;
  bf16x8 qf[6];
#pragma unroll
  for (int ks = 0; ks < 6; ++ks) qf[ks] = *(const bf16x8*)(Qb + (size_t)qrow * 96 + ks * 16 + h * 8);
  f32x16 o[2];
#pragma unroll
  for (int i = 0; i < 16; ++i) { o[0][i] = 0.f; o[1][i] = 0.f; }
  float mrun = -1e30f, lrun = 0.f;
  int krow_[3], kc_[3], vrow_[2], vc_[2];
#pragma unroll
  for (int i = 0; i < 3; ++i) { const int id = tid + 256 * i; krow_[i] = id / 12; kc_[i] = id - krow_[i] * 12; }
#pragma unroll
  for (int i = 0; i < 2; ++i) { const int id = tid + 256 * i; vrow_[i] = id >> 3; vc_[i] = id & 7; }
  u32x4 rk[3], rv[2];
  const int nkt = S >> 6;
#pragma unroll
  for (int i = 0; i < 3; ++i) rk[i] = *(const u32x4*)(Kb + (size_t)krow_[i] * 96 + kc_[i] * 8);
#pragma unroll
  for (int i = 0; i < 2; ++i) rv[i] = *(const u32x4*)(Vb + (size_t)vrow_[i] * S + vc_[i] * 8);
  __syncthreads();
#pragma unroll
  for (int i = 0; i < 3; ++i) *(u32x4*)(smem + krow_[i] * KSTR + kc_[i] * 16) = rk[i];
#pragma unroll
  for (int i = 0; i < 2; ++i) {
    char* d = smem + 64 * KSTR + vrow_[i] * VSTR + vc_[i] * 16;
    *(u32x2*)d = u32x2{rv[i][0], rv[i][1]}; *(u32x2*)(d + 8) = u32x2{rv[i][2], rv[i][3]};
  }
  __syncthreads();
  int cur = 0;
  for (int kt = 0; kt < nkt; ++kt) {
    const bool nxt = (kt + 1 < nkt);
    if (nxt) {
#pragma unroll
      for (int i = 0; i < 3; ++i) rk[i] = *(const u32x4*)(Kb + (size_t)((kt + 1) * 64 + krow_[i]) * 96 + kc_[i] * 8);
#pragma unroll
      for (int i = 0; i < 2; ++i) rv[i] = *(const u32x4*)(Vb + (size_t)vrow_[i] * S + (kt + 1) * 64 + vc_[i] * 8);
    }
    __builtin_amdgcn_sched_barrier(0);
    const char* Ks = smem + cur * ABUF;
    const char* Vs = Ks + 64 * KSTR;
    f32x16 sacc[2];
#pragma unroll
    for (int i = 0; i < 16; ++i) { sacc[0][i] = 0.f; sacc[1][i] = 0.f; }
#pragma unroll
    for (int t2 = 0; t2 < 2; ++t2)
#pragma unroll
      for (int ks = 0; ks < 6; ++ks) {
        const bf16x8 kf = *(const bf16x8*)(Ks + (t2 * 32 + r) * KSTR + ks * 32 + h * 16);
        sacc[t2] = MFMA(kf, qf[ks], sacc[t2]);
      }
    float mx = sacc[0][0];
#pragma unroll
    for (int i = 0; i < 16; ++i) { mx = fmaxf(mx, sacc[0][i]); mx = fmaxf(mx, sacc[1][i]); }
    mx = fmaxf(mx, __shfl_xor(mx, 32));
    const float mnew = fmaxf(mrun, mx);
    const float alpha = __builtin_amdgcn_exp2f(mrun - mnew);
    mrun = mnew;
    lrun *= alpha;
#pragma unroll
    for (int i = 0; i < 16; ++i) { o[0][i] *= alpha; o[1][i] *= alpha; }
    float ps = 0.f;
#pragma unroll
    for (int t2 = 0; t2 < 2; ++t2)
#pragma unroll
      for (int i = 0; i < 16; ++i) { const float e = __builtin_amdgcn_exp2f(sacc[t2][i] - mnew); sacc[t2][i] = e; ps += e; }
    lrun += ps;
    bf16x8 pf[4];
#pragma unroll
    for (int kk = 0; kk < 4; ++kk) {
      const int t2 = kk >> 1, s8 = (kk & 1) * 8;
      u32x4 pk = {cvtpk(sacc[t2][s8], sacc[t2][s8 + 1]), cvtpk(sacc[t2][s8 + 2], sacc[t2][s8 + 3]),
                  cvtpk(sacc[t2][s8 + 4], sacc[t2][s8 + 5]), cvtpk(sacc[t2][s8 + 6], sacc[t2][s8 + 7])};
      pf[kk] = __builtin_bit_cast(bf16x8, pk);
    }
#pragma unroll
    for (int dt = 0; dt < 2; ++dt)
#pragma unroll
      for (int kk = 0; kk < 4; ++kk) {
        const char* vp = Vs + (dt * 32 + r) * VSTR + kk * 32 + h * 8;
        const u32x2 lo = *(const u32x2*)vp, hi = *(const u32x2*)(vp + 16);
        u32x4 vv = {lo[0], lo[1], hi[0], hi[1]};
        o[dt] = MFMA(__builtin_bit_cast(bf16x8, vv), pf[kk], o[dt]);
      }
    __builtin_amdgcn_sched_barrier(0);
    if (nxt) {
      char* Kn_ = smem + (cur ^ 1) * ABUF;
#pragma unroll
      for (int i = 0; i < 3; ++i) *(u32x4*)(Kn_ + krow_[i] * KSTR + kc_[i] * 16) = rk[i];
#pragma unroll
      for (int i = 0; i < 2; ++i) {
        char* d = Kn_ + 64 * KSTR + vrow_[i] * VSTR + vc_[i] * 16;
        *(u32x2*)d = u32x2{rv[i][0], rv[i][1]}; *(u32x2*)(d + 8) = u32x2{rv[i][2], rv[i][3]};
      }
    }
    __syncthreads();
    cur ^= 1;
  }
  lrun += __shfl_xor(lrun, 32);
  const float inv = 1.f / lrun;
  float ss = 0.f;
  u16* dst = p.MIX + (size_t)(tb + qrow) * 1024 + hh * 64;
#pragma unroll
  for (int dt = 0; dt < 2; ++dt)
#pragma unroll
    for (int g4 = 0; g4 < 4; ++g4) {
      float v[4];
#pragma unroll
      for (int j = 0; j < 4; ++j) { v[j] = o[dt][4 * g4 + j] * inv; ss += v[j] * v[j]; }
      u32x2 ov = {cvtpk(v[0], v[1]), cvtpk(v[2], v[3])};
      *(u32x2*)(dst + dt * 32 + 8 * g4 + 4 * h) = ov;
    }
  ss += __shfl_xor(ss, 32);
  if (h == 0) p.SSA[(size_t)(tb + qrow) * 8 + hh] = ss;
}

constexpr int VSTR2 = 144, ABUF2 = 64 * KSTR + 64 * VSTR2;
DI float swapmax32(float v) {
  auto rr = __builtin_amdgcn_permlane32_swap(__float_as_uint(v), __float_as_uint(v), false, false);
  return fmaxf(__uint_as_float(rr[0]), __uint_as_float(rr[1]));
}
DI float swapsum32(float v) {
  auto rr = __builtin_amdgcn_permlane32_swap(__float_as_uint(v), __float_as_uint(v), false, false);
  return __uint_as_float(rr[0]) + __uint_as_float(rr[1]);
}
template <bool RUNMAX>
DI void attn_tile2(const Params& p, char* smem, int a) {
  WAVE_COORDS_L
  int q, hh, qt, S, tb;
  if (a < 512) { q = a >> 8; hh = (a >> 5) & 7; qt = a & 31; S = 8192; tb = q << 13; }
  else { const int b = a - 512; q = 2 + (b >> 7); hh = (b >> 4) & 7; qt = b & 15; S = 4096; tb = TP + ((q - 2) << 12); }
  const size_t qkb = ((size_t)tb * 8 + (size_t)hh * S) * 96;
  const u16* Qb = p.Qn + qkb; const u16* Kb = p.Kn + qkb;
  const u16* Vb = p.Vt + (size_t)tb * 512 + (size_t)hh * 64 * S;
  const int qrow0 = qt * 256 + wave * 64 + r;
  bf16x8 qf[2][6];
#pragma unroll
  for (int g = 0; g < 2; ++g)
#pragma unroll
    for (int ks = 0; ks < 6; ++ks) qf[g][ks] = *(const bf16x8*)(Qb + (size_t)(qrow0 + 32 * g) * 96 + ks * 16 + h * 8);
  f32x16 o[2][2];
#pragma unroll
  for (int i = 0; i < 16; ++i) { o[0][0][i] = 0.f; o[0][1][i] = 0.f; o[1][0][i] = 0.f; o[1][1][i] = 0.f; }
  float mrun[2] = {-1e30f, -1e30f}, lrun[2] = {0.f, 0.f};
  int klds_[3], vlds_[2];
#pragma unroll
  for (int i = 0; i < 3; ++i) { const int id = tid + 256 * i; const int kr = id / 12; klds_[i] = kr * KSTR + (id - kr * 12) * 16; }
#pragma unroll
  for (int i = 0; i < 2; ++i) { const int vc = tid & 7; vlds_[i] = 64 * KSTR + ((tid >> 3) + 32 * i) * VSTR2 + (vc >> 1) * 32 + (vc & 1) * 8; }
  const u16* Kg = Kb + tid * 8;
  const u16* Vg = Vb + (size_t)(tid >> 3) * S + (tid & 7) * 8;
  u32x4 rk[3], rv[2];
  const int nkt = S >> 6;
#pragma unroll
  for (int i = 0; i < 3; ++i) rk[i] = *(const u32x4*)(Kg + i * 2048);
#pragma unroll
  for (int i = 0; i < 2; ++i) rv[i] = *(const u32x4*)(Vg + (size_t)(32 * i) * S);
  __syncthreads();
  auto put = [&](char* base) {
#pragma unroll
    for (int i = 0; i < 3; ++i) *(u32x4*)(base + klds_[i]) = rk[i];
#pragma unroll
    for (int i = 0; i < 2; ++i) {
      char* d = base + vlds_[i];
      *(u32x2*)d = u32x2{rv[i][0], rv[i][1]}; *(u32x2*)(d + 16) = u32x2{rv[i][2], rv[i][3]};
    }
  };
  put(smem);
  __syncthreads();
  int cur = 0;
#pragma unroll 1
  for (int kt = 0; kt < nkt; ++kt) {
    const bool nxt = (kt + 1 < nkt);
    if (nxt) {
#pragma unroll
      for (int i = 0; i < 3; ++i) rk[i] = *(const u32x4*)(Kg + (size_t)(kt + 1) * 6144 + i * 2048);
#pragma unroll
      for (int i = 0; i < 2; ++i) rv[i] = *(const u32x4*)(Vg + (size_t)(32 * i) * S + (kt + 1) * 64);
    }
    __builtin_amdgcn_sched_barrier(0);
    const char* Ks = smem + cur * ABUF2;
    const char* Vs = Ks + 64 * KSTR;
#pragma unroll
    for (int t2 = 0; t2 < 2; ++t2) {
      f32x16 sacc[2];
#pragma unroll
      for (int i = 0; i < 16; ++i) { sacc[0][i] = 0.f; sacc[1][i] = 0.f; }
#pragma unroll
      for (int kb = 0; kb < 2; ++kb) {
        bf16x8 kf[3];
#pragma unroll
        for (int ks = 0; ks < 3; ++ks) kf[ks] = *(const bf16x8*)(Ks + (t2 * 32 + r) * KSTR + (kb * 3 + ks) * 32 + h * 16);
#pragma unroll
        for (int ks = 0; ks < 3; ++ks) {
          sacc[0] = MFMA(kf[ks], qf[0][kb * 3 + ks], sacc[0]);
          sacc[1] = MFMA(kf[ks], qf[1][kb * 3 + ks], sacc[1]);
        }
      }
      __builtin_amdgcn_sched_barrier(0);
      bf16x8 pf[2][2];
#pragma unroll
      for (int g = 0; g < 2; ++g) {
        float ps = 0.f;
        if (RUNMAX) {
        float mx = sacc[g][0];
#pragma unroll
        for (int i = 1; i < 16; ++i) mx = fmaxf(mx, sacc[g][i]);
        mx = swapmax32(mx);
        const float mnew = fmaxf(mrun[g], mx);
        if (__ballot(mnew > mrun[g]) != 0ull) {
          const float alpha = __builtin_amdgcn_exp2f(mrun[g] - mnew);
          lrun[g] *= alpha;
#pragma unroll
          for (int i = 0; i < 16; ++i) { o[g][0][i] *= alpha; o[g][1][i] *= alpha; }
          mrun[g] = mnew;
        }
#pragma unroll
        for (int i = 0; i < 16; ++i) { const float e = __builtin_amdgcn_exp2f(sacc[g][i] - mrun[g]); sacc[g][i] = e; ps += e; }
        } else {
#pragma unroll
          for (int i = 0; i < 16; ++i) sacc[g][i] = __builtin_amdgcn_exp2f(sacc[g][i]);
        }
#pragma unroll
        for (int s = 0; s < 2; ++s) {
          const int s8 = s * 8;
          u32x4 pk = {cvtpk(sacc[g][s8], sacc[g][s8 + 1]), cvtpk(sacc[g][s8 + 2], sacc[g][s8 + 3]),
                      cvtpk(sacc[g][s8 + 4], sacc[g][s8 + 5]), cvtpk(sacc[g][s8 + 6], sacc[g][s8 + 7])};
          pf[g][s] = __builtin_bit_cast(bf16x8, pk);
          if (!RUNMAX) {
#pragma unroll
            for (int w = 0; w < 4; ++w) ps = fdot2(pk[w], 0x3F803F80u, ps);
          }
        }
        lrun[g] += ps;
      }
      __builtin_amdgcn_sched_barrier(0);
      {
        bf16x8 vf[2][2];
#pragma unroll
        for (int dt = 0; dt < 2; ++dt)
#pragma unroll
          for (int s = 0; s < 2; ++s) vf[dt][s] = *(const bf16x8*)(Vs + (dt * 32 + r) * VSTR2 + (t2 * 2 + s) * 32 + h * 16);
#pragma unroll
        for (int s = 0; s < 2; ++s)
#pragma unroll
          for (int dt = 0; dt < 2; ++dt) {
            o[0][dt] = MFMA(vf[dt][s], pf[0][s], o[0][dt]);
            o[1][dt] = MFMA(vf[dt][s], pf[1][s], o[1][dt]);
          }
      }
    }
    __builtin_amdgcn_sched_barrier(0);
    if (nxt) put(smem + (cur ^ 1) * ABUF2);
    __syncthreads();
    cur ^= 1;
  }
#pragma unroll
  for (int g = 0; g < 2; ++g) {
    const float lsum = swapsum32(lrun[g]);
    const float inv = 1.f / lsum;
    const int qrow = qrow0 + 32 * g;
    float ss = 0.f;
    u16* dst = p.MIX + (size_t)(tb + qrow) * 1024 + hh * 64;
#pragma unroll
    for (int dt = 0; dt < 2; ++dt)
#pragma unroll
      for (int g4 = 0; g4 < 4; ++g4) {
        float v[4];
#pragma unroll
        for (int jj = 0; jj < 4; ++jj) { v[jj] = o[g][dt][4 * g4 + jj] * inv; ss += v[jj] * v[jj]; }
        u32x2 ov = {cvtpk(v[0], v[1]), cvtpk(v[2], v[3])};
        *(u32x2*)(dst + dt * 32 + 8 * g4 + 4 * h) = ov;
      }
    ss = swapsum32(ss);
    if (h == 0) p.SSA[(size_t)(tb + qrow) * 8 + hh] = ss;
  }
}

DI void attn_tile3(const Params& p, char* smem, int a) {
  WAVE_COORDS_L
  int q, hh, qt, S, tb;
  if (a < 512) { q = a >> 8; hh = (a >> 5) & 7; qt = a & 31; S = 8192; tb = q << 13; }
  else { const int b = a - 512; q = 2 + (b >> 7); hh = (b >> 4) & 7; qt = b & 15; S = 4096; tb = TP + ((q - 2) << 12); }
  const size_t qkb = ((size_t)tb * 8 + (size_t)hh * S) * 96;
  const u16* Qb = p.Qn + qkb; const u16* Kb = p.Kn + qkb;
  const u16* Vb = p.Vt + (size_t)tb * 512 + (size_t)hh * 64 * S;
  const int qrow0 = qt * 256 + wave * 64 + r;
  bf16x8 qf[2][6];
#pragma unroll
  for (int g = 0; g < 2; ++g)
#pragma unroll
    for (int ks = 0; ks < 6; ++ks) qf[g][ks] = *(const bf16x8*)(Qb + (size_t)(qrow0 + 32 * g) * 96 + ks * 16 + h * 8);
  f32x16 o[2][2];
#pragma unroll
  for (int i = 0; i < 16; ++i) { o[0][0][i] = 0.f; o[0][1][i] = 0.f; o[1][0][i] = 0.f; o[1][1][i] = 0.f; }
  float lrun[2] = {0.f, 0.f};
  int klds_[3], vlds_[2];
#pragma unroll
  for (int i = 0; i < 3; ++i) { const int id = tid + 256 * i; const int kr = id / 12; klds_[i] = kr * KSTR + (id - kr * 12) * 16; }
#pragma unroll
  for (int i = 0; i < 2; ++i) { const int vc = tid & 7; vlds_[i] = 64 * KSTR + ((tid >> 3) + 32 * i) * VSTR2 + (vc >> 1) * 32 + (vc & 1) * 8; }
  const u16* Kg = Kb + tid * 8;
  const u16* Vg = Vb + (size_t)(tid >> 3) * S + (tid & 7) * 8;
  u32x4 rk[3], rv[2];
  const int nkt = S >> 6;
#pragma unroll
  for (int i = 0; i < 3; ++i) rk[i] = *(const u32x4*)(Kg + i * 2048);
#pragma unroll
  for (int i = 0; i < 2; ++i) rv[i] = *(const u32x4*)(Vg + (size_t)(32 * i) * S);
  __syncthreads();
  auto put = [&](char* base) {
#pragma unroll
    for (int i = 0; i < 3; ++i) *(u32x4*)(base + klds_[i]) = rk[i];
#pragma unroll
    for (int i = 0; i < 2; ++i) {
      char* d = base + vlds_[i];
      *(u32x2*)d = u32x2{rv[i][0], rv[i][1]}; *(u32x2*)(d + 16) = u32x2{rv[i][2], rv[i][3]};
    }
  };
  put(smem);
  __syncthreads();
  int cur = 0;
#pragma unroll 1
  for (int kt = 0; kt < nkt; ++kt) {
    const bool nxt = (kt + 1 < nkt);
    if (nxt) {
#pragma unroll
      for (int i = 0; i < 3; ++i) rk[i] = *(const u32x4*)(Kg + (size_t)(kt + 1) * 6144 + i * 2048);
#pragma unroll
      for (int i = 0; i < 2; ++i) rv[i] = *(const u32x4*)(Vg + (size_t)(32 * i) * S + (kt + 1) * 64);
    }
    __builtin_amdgcn_sched_barrier(0);
    const char* Ks = smem + cur * ABUF2;
    const char* Vs = Ks + 64 * KSTR;
    f32x16 sacc[2][2];
#pragma unroll
    for (int i = 0; i < 16; ++i) { sacc[0][0][i] = 0.f; sacc[0][1][i] = 0.f; sacc[1][0][i] = 0.f; sacc[1][1][i] = 0.f; }
#pragma unroll
    for (int kb = 0; kb < 2; ++kb) {
      bf16x8 kf[2][3];
#pragma unroll
      for (int t2 = 0; t2 < 2; ++t2)
#pragma unroll
        for (int ks = 0; ks < 3; ++ks) kf[t2][ks] = *(const bf16x8*)(Ks + (t2 * 32 + r) * KSTR + (kb * 3 + ks) * 32 + h * 16);
#pragma unroll
      for (int ks = 0; ks < 3; ++ks)
#pragma unroll
        for (int t2 = 0; t2 < 2; ++t2) {
          sacc[t2][0] = MFMA(kf[t2][ks], qf[0][kb * 3 + ks], sacc[t2][0]);
          sacc[t2][1] = MFMA(kf[t2][ks], qf[1][kb * 3 + ks], sacc[t2][1]);
        }
    }
    __builtin_amdgcn_sched_barrier(0);
    bf16x8 pf[2][4];
#pragma unroll
    for (int g = 0; g < 2; ++g) {
      float ps = 0.f;
#pragma unroll
      for (int t2 = 0; t2 < 2; ++t2) {
#pragma unroll
        for (int i = 0; i < 16; ++i) sacc[t2][g][i] = __builtin_amdgcn_exp2f(sacc[t2][g][i]);
#pragma unroll
        for (int s = 0; s < 2; ++s) {
          const int s8 = s * 8;
          u32x4 pk = {cvtpk(sacc[t2][g][s8], sacc[t2][g][s8 + 1]), cvtpk(sacc[t2][g][s8 + 2], sacc[t2][g][s8 + 3]),
                      cvtpk(sacc[t2][g][s8 + 4], sacc[t2][g][s8 + 5]), cvtpk(sacc[t2][g][s8 + 6], sacc[t2][g][s8 + 7])};
          pf[g][t2 * 2 + s] = __builtin_bit_cast(bf16x8, pk);
#pragma unroll
          for (int w = 0; w < 4; ++w) ps = fdot2(pk[w], 0x3F803F80u, ps);
        }
      }
      lrun[g] += ps;
    }
    __builtin_amdgcn_sched_barrier(0);
#pragma unroll
    for (int kp = 0; kp < 2; ++kp) {
      bf16x8 vf[2][2];
#pragma unroll
      for (int dt = 0; dt < 2; ++dt)
#pragma unroll
        for (int s = 0; s < 2; ++s) vf[dt][s] = *(const bf16x8*)(Vs + (dt * 32 + r) * VSTR2 + (kp * 2 + s) * 32 + h * 16);
#pragma unroll
      for (int s = 0; s < 2; ++s)
#pragma unroll
        for (int dt = 0; dt < 2; ++dt) {
          o[0][dt] = MFMA(vf[dt][s], pf[0][kp * 2 + s], o[0][dt]);
          o[1][dt] = MFMA(vf[dt][s], pf[1][kp * 2 + s], o[1][dt]);
        }
    }
    __builtin_amdgcn_sched_barrier(0);
    if (nxt) put(smem + (cur ^ 1) * ABUF2);
    __syncthreads();
    cur ^= 1;
  }
#pragma unroll
  for (int g = 0; g < 2; ++g) {
    const float lsum = swapsum32(lrun[g]);
    const float inv = 1.f / lsum;
    const int qrow = qrow0 + 32 * g;
    float ss = 0.f;
    u16* dst = p.MIX + (size_t)(tb + qrow) * 1024 + hh * 64;
#pragma unroll
    for (int dt = 0; dt < 2; ++dt)
#pragma unroll
      for (int g4 = 0; g4 < 4; ++g4) {
        float v[4];
#pragma unroll
        for (int jj = 0; jj < 4; ++jj) { v[jj] = o[g][dt][4 * g4 + jj] * inv; ss += v[jj] * v[jj]; }
        u32x2 ov = {cvtpk(v[0], v[1]), cvtpk(v[2], v[3])};
        *(u32x2*)(dst + dt * 32 + 8 * g4 + 4 * h) = ov;
      }
    ss = swapsum32(ss);
    if (h == 0) p.SSA[(size_t)(tb + qrow) * 8 + hh] = ss;
  }
}

DI void phase4(const Params& p, char* smem) {
    const int G = gridDim.x;
  if (p.misc[0] > 64.f) { for (int a = vblock(); a < 1536; a += G) attn_tile2<true>(p, smem, a); }
  else { for (int a = vblock(); a < 1536; a += G) attn_tile3(p, smem, a); }
  for (int tile = vblock(); tile < 1536; tile += G) {
    WAVE_COORDS_L
    int q, g, k1, S1, tb;
    if (tile < 512) { q = tile >> 8; g = (tile >> 6) & 3; k1 = tile & 63; S1 = 64; tb = q << 13; }
    else { const int b = tile - 512; q = 2 + (b >> 7); g = (b >> 5) & 3; k1 = b & 31; S1 = 32; tb = TP + ((q - 2) << 12); }
    f32x16 acc[2][2]; zero_acc(acc);
    const u16* A = p.G1 + (size_t)tb * 1024 + ((size_t)(g * 128) * S1 + k1) * 256;
    const u16* B = p.WB;
    const int rstride = S1 * 256;
    gemm_mainloop(acc, smem, [&](int rr) { return A + (size_t)rr * rstride; }, [&](int rr) { return B + (size_t)rr * 256; }, 0, 256);
#pragma unroll
    for (int ni = 0; ni < 2; ++ni) {
      const int k2 = wn * 64 + ni * 32 + r;
      const size_t tok = (size_t)(tb + k1 + S1 * k2);
      float ss = 0.f;
#pragma unroll
      for (int mi = 0; mi < 2; ++mi)
#pragma unroll
        for (int g4 = 0; g4 < 4; ++g4) {
          const int m = wm * 64 + mi * 32 + 8 * g4 + 4 * h;
          float v[4];
#pragma unroll
          for (int j = 0; j < 4; ++j) { v[j] = acc[mi][ni][4 * g4 + j]; ss += v[j] * v[j]; }
          u32x2 ov = {cvtpk(v[0], v[1]), cvtpk(v[2], v[3])};
          *(u32x2*)(p.MIX + tok * 1024 + 512 + g * 128 + m) = ov;
        }
      ss += __shfl_xor(ss, 32);
      if (h == 0) p.SSF[tok * 8 + g * 2 + wm] = ss;
    }
  }
}

DI void phase5(const Params& p, char* smem) {
    float* rs = (float*)(smem + 65536);
  const int G = gridDim.x;
  for (int tile = vblock(); tile < 384 * 8; tile += G) {
    WAVE_COORDS_L
    const int mt = tile >> 3, nt = tile & 7, m0 = mt * 128, n0 = nt * 128;
    __syncthreads();
    if (tid < 128) {
      const float* sa = p.SSA + (size_t)(m0 + tid) * 8; const float* sf = p.SSF + (size_t)(m0 + tid) * 8;
      const float ra = rsqrtf((sa[0] + sa[1] + sa[2] + sa[3] + sa[4] + sa[5] + sa[6] + sa[7]) * (1.f / 512.f) + EPS);
      const float rf = rsqrtf((sf[0] + sf[1] + sf[2] + sf[3] + sf[4] + sf[5] + sf[6] + sf[7]) * (1.f / 512.f) + EPS);
      rs[tid] = ra / rf; rs[128 + tid] = rf;
    }
    f32x16 acc[2][2]; zero_acc(acc);
    const u16* A = p.MIX + (size_t)m0 * 1024; const u16* B = p.WoutT + (size_t)n0 * 1024;
    auto af = [&](int rr) { return A + (size_t)rr * 1024; };
    auto bfn = [&](int rr) { return B + (size_t)rr * 1024; };
    gemm_mainloop<true>(acc, smem, af, bfn, 0, 512);
    {
      const float* rb = rs + wm * 64 + 4 * h;
#pragma unroll
      for (int mi = 0; mi < 2; ++mi)
#pragma unroll
        for (int i = 0; i < 16; ++i) {
          const float sc = rb[mi * 32 + (i & 3) + 8 * (i >> 2)];
          acc[mi][0][i] *= sc; acc[mi][1][i] *= sc;
        }
    }
    gemm_mainloop<true>(acc, smem, af, bfn, 512, 1024);
    f32x4 xv[16];
#pragma unroll
    for (int j = 0; j < 16; ++j) {
      const int id = tid + 256 * j;
      xv[j] = *(const f32x4*)(xrow(p, m0 + (id >> 5)) + n0 + (id & 31) * 4);
    }
    {
      const float* rb = rs + 128 + wm * 64 + 4 * h;
      char* sb = smem + (wm * 64 + 4 * h) * 512 + (wn * 64 + r) * 4;
#pragma unroll
      for (int mi = 0; mi < 2; ++mi)
#pragma unroll
        for (int i = 0; i < 16; ++i) {
          const int ro = mi * 32 + (i & 3) + 8 * (i >> 2);
          const float sc = rb[ro];
#pragma unroll
          for (int ni = 0; ni < 2; ++ni) *(float*)(sb + ro * 512 + ni * 128) = acc[mi][ni][i] * sc;
        }
    }
    __syncthreads();
#pragma unroll
    for (int j = 0; j < 16; ++j) {
      const int id = tid + 256 * j, row = id >> 5, cc = id & 31;
      const int t = m0 + row, col = n0 + cc * 4;
      f32x4 v = *(const f32x4*)(smem + row * 512 + cc * 16);
      v[0] += xv[j][0]; v[1] += xv[j][1]; v[2] += xv[j][2]; v[3] += xv[j][3];
      *(f32x4*)(p.out + (size_t)t * 1024 + col) = v;
      u32x2 ob = {cvtpk(v[0], v[1]), cvtpk(v[2], v[3])};
      *(u32x2*)(p.X2b + (size_t)t * 1024 + col) = ob;
      float ss = v[0] * v[0] + v[1] * v[1] + v[2] * v[2] + v[3] * v[3];
      ss = red32(ss);
      if (cc == 0) p.SS2[(size_t)t * 16 + nt] = ss;
    }
  }
  const int gt = blockIdx.x * NTHR + threadIdx.x, gs = gridDim.x * NTHR;
  for (int id = gt; id < 16384 * 1024 / 16; id += gs) {
    const int d = (id & 63) * 16;
    u32x4 ou, ov;
#pragma unroll
    for (int k = 0; k < 4; ++k) {
      const f32x4 a = *(const f32x4*)(p.peer_u + (size_t)id * 16 + k * 4);
      const f32x4 g = *(const f32x4*)(p.ffn_norm_g + d + k * 4);
      const f32x4 b = *(const f32x4*)(p.peer_v + (size_t)id * 16 + k * 4);
      float u0 = fminf(fmaxf(a[0] * g[0] * USCALE, -448.f), 448.f), u1 = fminf(fmaxf(a[1] * g[1] * USCALE, -448.f), 448.f);
      float u2 = fminf(fmaxf(a[2] * g[2] * USCALE, -448.f), 448.f), u3 = fminf(fmaxf(a[3] * g[3] * USCALE, -448.f), 448.f);
      float v0 = fminf(fmaxf(b[0] * VSCALE, -448.f), 448.f), v1 = fminf(fmaxf(b[1] * VSCALE, -448.f), 448.f);
      float v2 = fminf(fmaxf(b[2] * VSCALE, -448.f), 448.f), v3 = fminf(fmaxf(b[3] * VSCALE, -448.f), 448.f);
      int pu = __builtin_amdgcn_cvt_pk_fp8_f32(u0, u1, 0, false); pu = __builtin_amdgcn_cvt_pk_fp8_f32(u2, u3, pu, true);
      int pv = __builtin_amdgcn_cvt_pk_fp8_f32(v0, v1, 0, false); pv = __builtin_amdgcn_cvt_pk_fp8_f32(v2, v3, pv, true);
      ou[k] = (unsigned)pu; ov[k] = (unsigned)pv;
    }
    {
      const int e = id >> 6, ch = id & 63;
      const size_t o = ((size_t)(ch >> 3) * 16384 + e) * 128 + (ch & 7) * 16;
      *(u32x4*)(p.U8 + o) = ou;
      *(u32x4*)(p.V8 + o) = ov;
    }
  }
}

DI void phase6(const Params& p, char* smem) {
    const int G = gridDim.x;
  u32x4 sa[4], sb[4];
  if (vblock() < 384 * 16) {
    const int t0 = vblock();
    const u16* A0 = p.X2b + (size_t)(t0 >> 4) * 128 * 1024; const u16* B0 = p.WpqT + (size_t)(t0 & 15) * 128 * 1024;
    gemm_issue(sa, sb, [&](int rr) { return A0 + (size_t)rr * 1024; }, [&](int rr) { return B0 + (size_t)rr * 1024; }, 0);
  }
  for (int tile = vblock(); tile < 384 * 16; tile += G) {
    WAVE_COORDS_L
    const int mt = tile >> 4, nt = tile & 15, m0 = mt * 128, n0 = nt * 128;
    const int nx = tile + G; const bool hasn = nx < 384 * 16;
    const u16* An = p.X2b + (size_t)(nx >> 4) * 128 * 1024; const u16* Bn = p.WpqT + (size_t)(nx & 15) * 128 * 1024;
    f32x16 acc[2][2]; zero_acc(acc);
    __syncthreads();
    const u16* A = p.X2b + (size_t)m0 * 1024; const u16* B = p.WpqT + (size_t)n0 * 1024;
    gemm_stream<true, true>(acc, smem, [&](int rr) { return A + (size_t)rr * 1024; }, [&](int rr) { return B + (size_t)rr * 1024; }, 0, 1024, sa, sb,
                      hasn, (long)(An - A), (long)(Bn - B));
    stage_bf16_t<false>(smem, acc, nullptr, wm, wn, r, h);
    __syncthreads();
#pragma unroll
    for (int j = 0; j < 8; ++j) {
      const int id = tid + 256 * j, row = id >> 4, cc = id & 15;
      *(u32x4*)(p.Qp + (size_t)(m0 + row) * 2048 + n0 + cc * 8) = *(const u32x4*)(smem + row * SROW + cc * 16);
    }
  }
}

DI void ins16(float (&top)[16], float x) {
#pragma unroll
  for (int j = 0; j < 16; ++j) { const float hi = fmaxf(top[j], x); x = fminf(top[j], x); top[j] = hi; }
}
DI float mask7(float x) { return __uint_as_float(__float_as_uint(x) & ~0x7Fu); }

#define CE16(a, b) { const float hi_ = fmaxf(a, b); b = fminf(a, b); a = hi_; }
DI void sort16_desc(float (&x)[16]) {
  CE16(x[0], x[1])
  CE16(x[3], x[2])
  CE16(x[4], x[5])
  CE16(x[7], x[6])
  CE16(x[8], x[9])
  CE16(x[11], x[10])
  CE16(x[12], x[13])
  CE16(x[15], x[14])
  CE16(x[0], x[2])
  CE16(x[1], x[3])
  CE16(x[6], x[4])
  CE16(x[7], x[5])
  CE16(x[8], x[10])
  CE16(x[9], x[11])
  CE16(x[14], x[12])
  CE16(x[15], x[13])
  CE16(x[0], x[1])
  CE16(x[2], x[3])
  CE16(x[5], x[4])
  CE16(x[7], x[6])
  CE16(x[8], x[9])
  CE16(x[10], x[11])
  CE16(x[13], x[12])
  CE16(x[15], x[14])
  CE16(x[0], x[4])
  CE16(x[1], x[5])
  CE16(x[2], x[6])
  CE16(x[3], x[7])
  CE16(x[12], x[8])
  CE16(x[13], x[9])
  CE16(x[14], x[10])
  CE16(x[15], x[11])
  CE16(x[0], x[2])
  CE16(x[1], x[3])
  CE16(x[4], x[6])
  CE16(x[5], x[7])
  CE16(x[10], x[8])
  CE16(x[11], x[9])
  CE16(x[14], x[12])
  CE16(x[15], x[13])
  CE16(x[0], x[1])
  CE16(x[2], x[3])
  CE16(x[4], x[5])
  CE16(x[6], x[7])
  CE16(x[9], x[8])
  CE16(x[11], x[10])
  CE16(x[13], x[12])
  CE16(x[15], x[14])
  CE16(x[0], x[8])
  CE16(x[1], x[9])
  CE16(x[2], x[10])
  CE16(x[3], x[11])
  CE16(x[4], x[12])
  CE16(x[5], x[13])
  CE16(x[6], x[14])
  CE16(x[7], x[15])
  CE16(x[0], x[4])
  CE16(x[1], x[5])
  CE16(x[2], x[6])
  CE16(x[3], x[7])
  CE16(x[8], x[12])
  CE16(x[9], x[13])
  CE16(x[10], x[14])
  CE16(x[11], x[15])
  CE16(x[0], x[2])
  CE16(x[1], x[3])
  CE16(x[4], x[6])
  CE16(x[5], x[7])
  CE16(x[8], x[10])
  CE16(x[9], x[11])
  CE16(x[12], x[14])
  CE16(x[13], x[15])
  CE16(x[0], x[1])
  CE16(x[2], x[3])
  CE16(x[4], x[5])
  CE16(x[6], x[7])
  CE16(x[8], x[9])
  CE16(x[10], x[11])
  CE16(x[12], x[13])
  CE16(x[14], x[15])
}
DI void bmerge16_desc(float (&x)[16]) {
  CE16(x[0], x[8])
  CE16(x[1], x[9])
  CE16(x[2], x[10])
  CE16(x[3], x[11])
  CE16(x[4], x[12])
  CE16(x[5], x[13])
  CE16(x[6], x[14])
  CE16(x[7], x[15])
  CE16(x[0], x[4])
  CE16(x[1], x[5])
  CE16(x[2], x[6])
  CE16(x[3], x[7])
  CE16(x[8], x[12])
  CE16(x[9], x[13])
  CE16(x[10], x[14])
  CE16(x[11], x[15])
  CE16(x[0], x[2])
  CE16(x[1], x[3])
  CE16(x[4], x[6])
  CE16(x[5], x[7])
  CE16(x[8], x[10])
  CE16(x[9], x[11])
  CE16(x[12], x[14])
  CE16(x[13], x[15])
  CE16(x[0], x[1])
  CE16(x[2], x[3])
  CE16(x[4], x[5])
  CE16(x[6], x[7])
  CE16(x[8], x[9])
  CE16(x[10], x[11])
  CE16(x[12], x[13])
  CE16(x[14], x[15])
}
DI void top16_merge(float (&A)[16], const float (&B)[16]) {
#pragma unroll
  for (int i = 0; i < 16; ++i) A[i] = fmaxf(A[i], B[15 - i]);
  bmerge16_desc(A);
}

DI void score_top16(const Params& p, const char* sklds, int t, int hh, int c, int r, int h, float (&top)[16]) {
  f32x16 acc[4];
#pragma unroll
  for (int n = 0; n < 4; ++n)
#pragma unroll
    for (int i = 0; i < 16; ++i) acc[n][i] = 0.f;
  const u16* qp = p.Qp + (size_t)t * 2048 + (hh * 2 + c) * 128 + h * 8;
  const char* skb = sklds + c * 32768 + r * 256;
  const int hx = h ^ (r & 15);
  bf16x8 bq[8];
#pragma unroll
  for (int ks = 0; ks < 8; ++ks) bq[ks] = *(const bf16x8*)(qp + ks * 16);
#pragma unroll
  for (int n = 0; n < 4; ++n) {
    bf16x8 fa[8];
#pragma unroll
    for (int ks = 0; ks < 8; ++ks) fa[ks] = *(const bf16x8*)(skb + n * 8192 + (((ks * 2) ^ hx) << 4));
    __builtin_amdgcn_sched_barrier(0);
#pragma unroll
    for (int ks = 0; ks < 8; ++ks) acc[n] = MFMA(fa[ks], bq[ks], acc[n]);
    __builtin_amdgcn_sched_barrier(0);
  }
  float k1[16], k2[16], k3[16];
#pragma unroll
  for (int i = 0; i < 16; ++i) {
    const unsigned ci = (unsigned)crow(i, h);
    top[i] = __uint_as_float((__float_as_uint(acc[0][i]) & ~0x7Fu) | ci);
    k1[i] = __uint_as_float((__float_as_uint(acc[1][i]) & ~0x7Fu) | (32u + ci));
    k2[i] = __uint_as_float((__float_as_uint(acc[2][i]) & ~0x7Fu) | (64u + ci));
    k3[i] = __uint_as_float((__float_as_uint(acc[3][i]) & ~0x7Fu) | (96u + ci));
  }
  sort16_desc(top); sort16_desc(k1); sort16_desc(k2); sort16_desc(k3);
  top16_merge(top, k1); top16_merge(k2, k3); top16_merge(top, k2);
  float oth[16];
#pragma unroll
  for (int j = 0; j < 16; ++j) oth[j] = __shfl_xor(top[j], 32);
  top16_merge(top, oth);
}

DI void phase7(const Params& p, char* smem) {
  WAVE_COORDS
  const int G = gridDim.x;
  volatile unsigned* lw = (volatile unsigned*)(smem + 65536 + 2048 + wave * 1024);
  volatile unsigned char* lb = (volatile unsigned char*)(smem + 65536 + 2048 + wave * 1024);
  const float NEG_INF = __uint_as_float(0xFF800000u);
  const int hh = blockIdx.x & 7, slot = blockIdx.x >> 3, nslot = G >> 3;
  __syncthreads();
  {
    const u16* src = p.SK + (size_t)hh * 2 * 16384;
#pragma unroll 2
    for (int i = 0; i < 16; ++i) {
      const int id = tid + 256 * i;
      const int row = id >> 4, ch = id & 15;
      const u32x4 v = *(const u32x4*)(src + (size_t)row * 128 + ch * 8);
      *(u32x4*)(smem + row * 256 + ((ch ^ (row & 15)) << 4)) = v;
    }
  }
  __syncthreads();
  for (int grp = slot * 4 + wave; grp < 1536; grp += nslot * 4) {
    const int tok0 = grp * 32;
    const int t = tok0 + r;
    float L0[16], L1[16];
    score_top16(p, smem, t, hh, 0, r, h, L0);
    score_top16(p, smem, t, hh, 1, r, h, L1);
    float ct[16], cb[16];
    {
      float ck[50];
    ck[0] = __uint_as_float((__float_as_uint(mask7(L0[0]) + mask7(L1[0])) & ~0xFFu) | 0u);
    ck[1] = __uint_as_float((__float_as_uint(mask7(L0[0]) + mask7(L1[1])) & ~0xFFu) | 1u);
    ck[2] = __uint_as_float((__float_as_uint(mask7(L0[0]) + mask7(L1[2])) & ~0xFFu) | 2u);
    ck[3] = __uint_as_float((__float_as_uint(mask7(L0[0]) + mask7(L1[3])) & ~0xFFu) | 3u);
    ck[4] = __uint_as_float((__float_as_uint(mask7(L0[0]) + mask7(L1[4])) & ~0xFFu) | 4u);
    ck[5] = __uint_as_float((__float_as_uint(mask7(L0[0]) + mask7(L1[5])) & ~0xFFu) | 5u);
    ck[6] = __uint_as_float((__float_as_uint(mask7(L0[0]) + mask7(L1[6])) & ~0xFFu) | 6u);
    ck[7] = __uint_as_float((__float_as_uint(mask7(L0[0]) + mask7(L1[7])) & ~0xFFu) | 7u);
    ck[8] = __uint_as_float((__float_as_uint(mask7(L0[0]) + mask7(L1[8])) & ~0xFFu) | 8u);
    ck[9] = __uint_as_float((__float_as_uint(mask7(L0[0]) + mask7(L1[9])) & ~0xFFu) | 9u);
    ck[10] = __uint_as_float((__float_as_uint(mask7(L0[0]) + mask7(L1[10])) & ~0xFFu) | 10u);
    ck[11] = __uint_as_float((__float_as_uint(mask7(L0[0]) + mask7(L1[11])) & ~0xFFu) | 11u);
    ck[12] = __uint_as_float((__float_as_uint(mask7(L0[0]) + mask7(L1[12])) & ~0xFFu) | 12u);
    ck[13] = __uint_as_float((__float_as_uint(mask7(L0[0]) + mask7(L1[13])) & ~0xFFu) | 13u);
    ck[14] = __uint_as_float((__float_as_uint(mask7(L0[0]) + mask7(L1[14])) & ~0xFFu) | 14u);
    ck[15] = __uint_as_float((__float_as_uint(mask7(L0[0]) + mask7(L1[15])) & ~0xFFu) | 15u);
    ck[16] = __uint_as_float((__float_as_uint(mask7(L0[1]) + mask7(L1[0])) & ~0xFFu) | 16u);
    ck[17] = __uint_as_float((__float_as_uint(mask7(L0[1]) + mask7(L1[1])) & ~0xFFu) | 17u);
    ck[18] = __uint_as_float((__float_as_uint(mask7(L0[1]) + mask7(L1[2])) & ~0xFFu) | 18u);
    ck[19] = __uint_as_float((__float_as_uint(mask7(L0[1]) + mask7(L1[3])) & ~0xFFu) | 19u);
    ck[20] = __uint_as_float((__float_as_uint(mask7(L0[1]) + mask7(L1[4])) & ~0xFFu) | 20u);
    ck[21] = __uint_as_float((__float_as_uint(mask7(L0[1]) + mask7(L1[5])) & ~0xFFu) | 21u);
    ck[22] = __uint_as_float((__float_as_uint(mask7(L0[1]) + mask7(L1[6])) & ~0xFFu) | 22u);
    ck[23] = __uint_as_float((__float_as_uint(mask7(L0[1]) + mask7(L1[7])) & ~0xFFu) | 23u);
    ck[24] = __uint_as_float((__float_as_uint(mask7(L0[2]) + mask7(L1[0])) & ~0xFFu) | 32u);
    ck[25] = __uint_as_float((__float_as_uint(mask7(L0[2]) + mask7(L1[1])) & ~0xFFu) | 33u);
    ck[26] = __uint_as_float((__float_as_uint(mask7(L0[2]) + mask7(L1[2])) & ~0xFFu) | 34u);
    ck[27] = __uint_as_float((__float_as_uint(mask7(L0[2]) + mask7(L1[3])) & ~0xFFu) | 35u);
    ck[28] = __uint_as_float((__float_as_uint(mask7(L0[2]) + mask7(L1[4])) & ~0xFFu) | 36u);
    ck[29] = __uint_as_float((__float_as_uint(mask7(L0[3]) + mask7(L1[0])) & ~0xFFu) | 48u);
    ck[30] = __uint_as_float((__float_as_uint(mask7(L0[3]) + mask7(L1[1])) & ~0xFFu) | 49u);
    ck[31] = __uint_as_float((__float_as_uint(mask7(L0[3]) + mask7(L1[2])) & ~0xFFu) | 50u);
    ck[32] = __uint_as_float((__float_as_uint(mask7(L0[3]) + mask7(L1[3])) & ~0xFFu) | 51u);
    ck[33] = __uint_as_float((__float_as_uint(mask7(L0[4]) + mask7(L1[0])) & ~0xFFu) | 64u);
    ck[34] = __uint_as_float((__float_as_uint(mask7(L0[4]) + mask7(L1[1])) & ~0xFFu) | 65u);
    ck[35] = __uint_as_float((__float_as_uint(mask7(L0[4]) + mask7(L1[2])) & ~0xFFu) | 66u);
    ck[36] = __uint_as_float((__float_as_uint(mask7(L0[5]) + mask7(L1[0])) & ~0xFFu) | 80u);
    ck[37] = __uint_as_float((__float_as_uint(mask7(L0[5]) + mask7(L1[1])) & ~0xFFu) | 81u);
    ck[38] = __uint_as_float((__float_as_uint(mask7(L0[6]) + mask7(L1[0])) & ~0xFFu) | 96u);
    ck[39] = __uint_as_float((__float_as_uint(mask7(L0[6]) + mask7(L1[1])) & ~0xFFu) | 97u);
    ck[40] = __uint_as_float((__float_as_uint(mask7(L0[7]) + mask7(L1[0])) & ~0xFFu) | 112u);
    ck[41] = __uint_as_float((__float_as_uint(mask7(L0[7]) + mask7(L1[1])) & ~0xFFu) | 113u);
    ck[42] = __uint_as_float((__float_as_uint(mask7(L0[8]) + mask7(L1[0])) & ~0xFFu) | 128u);
    ck[43] = __uint_as_float((__float_as_uint(mask7(L0[9]) + mask7(L1[0])) & ~0xFFu) | 144u);
    ck[44] = __uint_as_float((__float_as_uint(mask7(L0[10]) + mask7(L1[0])) & ~0xFFu) | 160u);
    ck[45] = __uint_as_float((__float_as_uint(mask7(L0[11]) + mask7(L1[0])) & ~0xFFu) | 176u);
    ck[46] = __uint_as_float((__float_as_uint(mask7(L0[12]) + mask7(L1[0])) & ~0xFFu) | 192u);
    ck[47] = __uint_as_float((__float_as_uint(mask7(L0[13]) + mask7(L1[0])) & ~0xFFu) | 208u);
    ck[48] = __uint_as_float((__float_as_uint(mask7(L0[14]) + mask7(L1[0])) & ~0xFFu) | 224u);
    ck[49] = __uint_as_float((__float_as_uint(mask7(L0[15]) + mask7(L1[0])) & ~0xFFu) | 240u);
      const float NINF = __uint_as_float(0xFF800000u);
#pragma unroll
      for (int q = 0; q < 25; ++q) {
        float a_ = ck[q], b_ = ck[25 + q];
        asm volatile("" : "+v"(a_), "+v"(b_));
        const float m = h ? b_ : a_;
        if (q < 16) ct[q] = m; else cb[q - 16] = m;
      }
#pragma unroll
      for (int q = 9; q < 16; ++q) cb[q] = NINF;
      sort16_desc(ct); sort16_desc(cb);
      top16_merge(ct, cb);
#pragma unroll
      for (int q = 0; q < 16; ++q) cb[q] = __shfl_xor(ct[q], 32);
      top16_merge(ct, cb);
    }
    if (h == 0) {
#pragma unroll
      for (int w = 0; w < 4; ++w) {
        unsigned v = 0, v2 = 0;
#pragma unroll
        for (int b = 0; b < 4; ++b) {
          v |= (__float_as_uint(L0[w * 4 + b]) & 0x7Fu) << (8 * b);
          v2 |= (__float_as_uint(L1[w * 4 + b]) & 0x7Fu) << (8 * b);
        }
        lw[r * 8 + w] = v;
        lw[r * 8 + 4 + w] = v2;
      }
    }
    __builtin_amdgcn_wave_barrier();
    const float* s2 = p.SS2 + (size_t)t * 16;
    float ssum = 0.f;
#pragma unroll
    for (int j = 0; j < 8; ++j) ssum += s2[j];
    const float r2 = rsqrtf(ssum * (1.f / 1024.f) + EPS);
    float gv[16];
    const float v0 = __uint_as_float(__float_as_uint(ct[0]) & ~0xFFu) * r2;
    float esum = 0.f;
#pragma unroll
    for (int j = 0; j < 16; ++j) {
      const float vj = __uint_as_float(__float_as_uint(ct[j]) & ~0xFFu) * r2;
      gv[j] = __builtin_amdgcn_exp2f((vj - v0) * 1.4426950408889634f);
      esum += gv[j];
    }
    const float einv = 1.f / esum;
    u32x4 oi[2]; f32x4 og[2];
#pragma unroll
    for (int jj = 0; jj < 8; ++jj) {
      float ka = ct[jj], kb = ct[8 + jj], ga = gv[jj], gb = gv[8 + jj];
      asm volatile("" : "+v"(ka), "+v"(kb), "+v"(ga), "+v"(gb));
      const float key = h ? kb : ka;
      const float g = (h ? gb : ga) * einv;
      const unsigned code = __float_as_uint(key) & 0xFFu;
      const unsigned i1 = lb[r * 32 + (code >> 4)], i2 = lb[r * 32 + 16 + (code & 15)];
      oi[jj >> 2][jj & 3] = i1 * 128 + i2;
      og[jj >> 2][jj & 3] = g;
    }
    int* ip = p.IDX + (size_t)t * 128 + hh * 16 + h * 8;
    float* gp = p.G + (size_t)t * 128 + hh * 16 + h * 8;
    *(u32x4*)ip = oi[0]; *(u32x4*)(ip + 4) = oi[1];
    *(f32x4*)gp = og[0]; *(f32x4*)(gp + 4) = og[1];
    __builtin_amdgcn_wave_barrier();
  }
}

DI float gelu_tanh(float x) {
  const float u = 0.7978845608028654f * (x + 0.044715f * x * x * x);
  const float e = __builtin_amdgcn_exp2f(u * 2.8853900817779268f);
  const float th = 1.f - 2.f * __builtin_amdgcn_rcpf(e + 1.f);
  return 0.5f * x * (1.f + th);
}
DI float dot16_fp8(const u32x4& w, const u32x4& xa, const u32x4& xb) {
  float acc = 0.f;
#pragma unroll
  for (int k = 0; k < 4; ++k) {
    const bf2_t b0 = __builtin_amdgcn_cvt_scalef32_pk_bf16_fp8(w[k], 1.0f, false);
    const bf2_t b1 = __builtin_amdgcn_cvt_scalef32_pk_bf16_fp8(w[k], 1.0f, true);
    const unsigned x0 = (k < 2) ? xa[2 * k] : xb[2 * k - 4], x1 = (k < 2) ? xa[2 * k + 1] : xb[2 * k - 3];
    acc = __builtin_amdgcn_fdot2_f32_bf16(b0, __builtin_bit_cast(bf2_t, x0), acc, false);
    acc = __builtin_amdgcn_fdot2_f32_bf16(b1, __builtin_bit_cast(bf2_t, x1), acc, false);
  }
  return acc;
}

template <int CTRL>
DI float dppf(float x) { return __uint_as_float(__builtin_amdgcn_update_dpp(0u, __float_as_uint(x), CTRL, 0xF, 0xF, false)); }
DI float swap32sum(float a, float b) {
  auto rr = __builtin_amdgcn_permlane32_swap(__float_as_uint(a), __float_as_uint(b), false, false);
  return __uint_as_float(rr[0]) + __uint_as_float(rr[1]);
}
DI float swap16sum(float a, float b) {
  auto rr = __builtin_amdgcn_permlane16_swap(__float_as_uint(a), __float_as_uint(b), false, false);
  return __uint_as_float(rr[0]) + __uint_as_float(rr[1]);
}
struct P8Buf { u32x4 w[16]; u32x4 xa, xb; };

DI void p8_load_idx(const Params& p, int t, int j, u32x4 (&ix)[4]) {
  const int* ip = p.IDX + (size_t)t * 128 + j * 16;
#pragma unroll
  for (int q = 0; q < 4; ++q) ix[q] = *(const u32x4*)(ip + q * 4);
}
DI void p8_load_rows(const unsigned char* tab, int s, int cc, const u32x4 (&ix)[4], u32x4 (&w)[16]) {
  const unsigned char* base = tab + (size_t)s * (16384 * 128) + cc * 16;
#pragma unroll
  for (int i = 0; i < 16; ++i) w[i] = *(const u32x4*)(base + (size_t)ix[i >> 2][i & 3] * 128);
}

DI void phase8(const Params& p, char* smem, const int tbase) {
  WAVE_COORDS
  const int G = gridDim.x;
  const int gw = vblock() * 4 + wave, NW = G * 4;
  const int j = lane >> 3, cc = lane & 7;
  const bool b0 = lane & 1, b1 = lane & 2, b2 = lane & 4, b3 = lane & 8, b4 = lane & 16, b5 = lane & 32;
  f32x2* part = (f32x2*)(smem + wave * 12288) + lane;
  const float* coefl = (const float*)(smem + wave * 12288);
  const int ntok_all = (T_TOK - gw + NW - 1) / NW;
  const int ntok = min(24, ntok_all - tbase);
  const int gw0 = gw + tbase * NW;
  if (ntok <= 0) return;
  for (int s = 0; s < 8; ++s) {
    u32x4 ixA[4], ixB[4];
    u32x4 wA[16], wB[16];
    u32x4 xaA, xbA, xaB, xbB;
    auto issue = [&](int i, u32x4 (&ix)[4], u32x4 (&w)[16], u32x4& xa, u32x4& xb) {
      const int t = gw0 + i * NW;
      const u16* xr = p.X2b + (size_t)t * 1024 + s * 128 + cc * 16;
      xa = *(const u32x4*)xr; xb = *(const u32x4*)(xr + 8);
      p8_load_rows(p.U8, s, cc, ix, w);
    };
    auto compute = [&](int i, u32x4 (&w)[16], u32x4& xa, u32x4& xb) {
      float d[16];
#pragma unroll
      for (int q = 0; q < 16; ++q) d[q] = dot16_fp8(w[q], xa, xb);
      float v8[8], v4[4], v2[2];
#pragma unroll
      for (int m = 0; m < 8; ++m) { const float mine = b2 ? d[m + 8] : d[m], send = b2 ? d[m] : d[m + 8]; v8[m] = mine + dppf<0x141>(send); }
#pragma unroll
      for (int m = 0; m < 4; ++m) { const float mine = b1 ? v8[m + 4] : v8[m], send = b1 ? v8[m] : v8[m + 4]; v4[m] = mine + dppf<0x4E>(send); }
#pragma unroll
      for (int m = 0; m < 2; ++m) { const float mine = b0 ? v4[m + 2] : v4[m], send = b0 ? v4[m] : v4[m + 2]; v2[m] = mine + dppf<0xB1>(send); }
      f32x2 acc = {v2[0], v2[1]};
      if (s > 0) { const f32x2 o = part[i * 64]; acc[0] += o[0]; acc[1] += o[1]; }
      part[i * 64] = acc;
    };
    p8_load_idx(p, gw0, j, ixA);
    issue(0, ixA, wA, xaA, xbA);
    if (ntok > 1) p8_load_idx(p, gw0 + NW, j, ixB);
#pragma unroll 1
    for (int i = 0; i < ntok; i += 2) {
      if (i + 1 < ntok) issue(i + 1, ixB, wB, xaB, xbB);
      if (i + 2 < ntok) p8_load_idx(p, gw0 + (i + 2) * NW, j, ixA);
      __builtin_amdgcn_sched_barrier(0);
      compute(i, wA, xaA, xbA);
      __builtin_amdgcn_sched_barrier(0);
      if (i + 1 < ntok) {
        if (i + 2 < ntok) issue(i + 2, ixA, wA, xaA, xbA);
        if (i + 3 < ntok) p8_load_idx(p, gw0 + (i + 3) * NW, j, ixB);
        __builtin_amdgcn_sched_barrier(0);
        compute(i + 1, wB, xaB, xbB);
        __builtin_amdgcn_sched_barrier(0);
      }
    }
  }
  for (int i = 0; i < ntok; ++i) {
    const int t = gw0 + i * NW;
    const float* s2 = p.SS2 + (size_t)t * 16;
    float ssum = 0.f;
#pragma unroll
    for (int q = 0; q < 8; ++q) ssum += s2[q];
    const float r2 = rsqrtf(ssum * (1.f / 1024.f) + EPS) * (1.f / USCALE);
    const f32x2 g = *(const f32x2*)(p.G + (size_t)t * 128 + lane * 2);
    f32x2 a = part[i * 64];
    a[0] = gelu_tanh(a[0] * r2) * g[0] * (1.f / VSCALE);
    a[1] = gelu_tanh(a[1] * r2) * g[1] * (1.f / VSCALE);
    part[i * 64] = a;
  }
  asm volatile("" ::: "memory");
  __builtin_amdgcn_wave_barrier();
  for (int s = 0; s < 8; ++s) {
    u32x4 ixA[4], ixB[4];
    u32x4 wA[16], wB[16];
    auto compute = [&](int i, u32x4 (&w)[16]) {
      const int t = gw0 + i * NW;
      const float* cp = coefl + i * 128 + j * 16;
      f32x4 cf[4];
#pragma unroll
      for (int q = 0; q < 4; ++q) cf[q] = *(const f32x4*)(cp + q * 4);
      f32x2 acc2[8];
#pragma unroll
      for (int e = 0; e < 8; ++e) acc2[e] = f32x2{0.f, 0.f};
#pragma unroll
      for (int q = 0; q < 16; ++q) {
        const float cq = cf[q >> 2][q & 3];
        const f32x2 c2 = {cq, cq};
#pragma unroll
        for (int k = 0; k < 4; ++k) {
          const f32x2 lo = __builtin_amdgcn_cvt_pk_f32_fp8((int)w[q][k], false);
          const f32x2 hi = __builtin_amdgcn_cvt_pk_f32_fp8((int)w[q][k], true);
          acc2[2 * k] = __builtin_elementwise_fma(lo, c2, acc2[2 * k]);
          acc2[2 * k + 1] = __builtin_elementwise_fma(hi, c2, acc2[2 * k + 1]);
        }
      }
      float acc[16];
#pragma unroll
      for (int e = 0; e < 8; ++e) { acc[2 * e] = acc2[e][0]; acc[2 * e + 1] = acc2[e][1]; }
      float v8[8], v4[4], v2[2];
#pragma unroll
      for (int m = 0; m < 8; ++m) v8[m] = swap32sum(acc[m], acc[m + 8]);
#pragma unroll
      for (int m = 0; m < 4; ++m) v4[m] = swap16sum(v8[m], v8[m + 4]);
#pragma unroll
      for (int m = 0; m < 2; ++m) { const float mine = b3 ? v4[m + 2] : v4[m], send = b3 ? v4[m] : v4[m + 2]; v2[m] = mine + dppf<0x128>(send); }
      float* op = p.out + (size_t)t * 1024 + s * 128 + cc * 16 + 2 * j;
      f32x2 o = *(f32x2*)op;
      o[0] += v2[0]; o[1] += v2[1];
      *(f32x2*)op = o;
    };
    p8_load_idx(p, gw0, j, ixA);
    p8_load_rows(p.V8, s, cc, ixA, wA);
    if (ntok > 1) p8_load_idx(p, gw0 + NW, j, ixB);
#pragma unroll 1
    for (int i = 0; i < ntok; i += 2) {
      if (i + 1 < ntok) p8_load_rows(p.V8, s, cc, ixB, wB);
      if (i + 2 < ntok) p8_load_idx(p, gw0 + (i + 2) * NW, j, ixA);
      __builtin_amdgcn_sched_barrier(0);
      compute(i, wA);
      __builtin_amdgcn_sched_barrier(0);
      if (i + 1 < ntok) {
        if (i + 2 < ntok) p8_load_rows(p.V8, s, cc, ixA, wA);
        if (i + 3 < ntok) p8_load_idx(p, gw0 + (i + 3) * NW, j, ixB);
        __builtin_amdgcn_sched_barrier(0);
        compute(i + 1, wB);
        __builtin_amdgcn_sched_barrier(0);
      }
    }
  }
  asm volatile("" ::: "memory");
  __builtin_amdgcn_wave_barrier();
}

extern __shared__ __attribute__((aligned(16))) char dyn_smem[];

DI void run_phase(const Params& p, int ph, char* smem) {
  switch (ph) {
    case 0: phase0(p); break;
    case 1: phase1(p, smem); break;
    case 2: phase2(p, smem); break;
    case 3: phase3(p, smem); break;
    case 4: phase4(p, smem); break;
    case 5: phase5(p, smem); break;
    case 6: phase6(p, smem); break;
    case 7: phase7(p, smem); break;
    default: phase8(p, smem, 0); break;
  }
}


#define XB_TMO      128
#define XB_XCNT(j)  (256  + 64 * (j))
#define XB_XSUB(j)  (1280 + 64 * (j))
#define XB_XGEN(j)  (2304 + 64 * (j))
#define XB_TOP      3328
#define XB_TOPGEN   3392
#define XCD_BAR_WORDS 3456
#define XB_SPIN_CAP (1u << 22)
#define LAS __attribute__((address_space(3)))
DI unsigned xb_ld(unsigned* p) { return __hip_atomic_load(p, __ATOMIC_RELAXED, __HIP_MEMORY_SCOPE_AGENT); }
DI unsigned xb_add(unsigned* p, unsigned v) { return __hip_atomic_fetch_add(p, v, __ATOMIC_RELAXED, __HIP_MEMORY_SCOPE_AGENT); }
DI unsigned xb_xcc_id() { return (unsigned)__builtin_amdgcn_s_getreg((3 << 11) | 20) & 0xFu; }
#define XB_SPIN(cond, bar) do { unsigned _sp = 0; while (cond) { __builtin_amdgcn_s_sleep(1); \
    if ((++_sp & 255u) == 0u) { if (xb_ld(&(bar)[XB_TMO])) break; if (_sp > XB_SPIN_CAP) { atomicAdd(&(bar)[XB_TMO], 1u); break; } } } } while (0)
struct XcdBarrier { unsigned* bar; unsigned x; volatile LAS unsigned* st; };
DI XcdBarrier xcd_barrier_post(unsigned* bar, volatile LAS unsigned* st) {
  XcdBarrier b; b.bar = bar; b.x = xb_xcc_id(); b.st = st;
  if (threadIdx.x == 0) (void)xb_add(&bar[XB_XCNT(b.x)], 1u);
  return b;
}
DI void xcd_barrier_complete(unsigned* bar, unsigned x, unsigned& nloc, unsigned& nx) {
  const unsigned G = gridDim.x * gridDim.y * gridDim.z;
  unsigned sum, cnt, mine, sp = 0u;
  for (;;) {
    sum = 0u; cnt = 0u; mine = 0u;
#pragma unroll
    for (unsigned j = 0; j < 16; ++j) { const unsigned c = xb_ld(&bar[XB_XCNT(j)]); sum += c; cnt += (c > 0u) ? 1u : 0u; mine = (j == x) ? c : mine; }
    if (sum == G) break;
    __builtin_amdgcn_s_sleep(1);
    if ((++sp & 255u) == 0u) { if (xb_ld(&bar[XB_TMO])) break; if (sp > XB_SPIN_CAP) { atomicAdd(&bar[XB_TMO], 1u); break; } }
  }
  nloc = mine > 0u ? mine : 1u; nx = cnt > 0u ? cnt : 1u;
}
DI void xcd_barrier(const XcdBarrier& b) {
  asm volatile("s_waitcnt vmcnt(0)" ::: "memory");
  __syncthreads();
  if (threadIdx.x == 0) {
    unsigned* bar = b.bar;
    __builtin_amdgcn_s_waitcnt(0);
    unsigned nloc = b.st[0], nx = b.st[1];
    if (nloc == 0u) { xcd_barrier_complete(bar, b.x, nloc, nx); b.st[0] = nloc; b.st[1] = nx; }
    const unsigned old = xb_add(&bar[XB_XSUB(b.x)], 1u);
    const unsigned gen = old / nloc;
    if (old + 1u == (gen + 1u) * nloc) {
      __builtin_amdgcn_fence(__ATOMIC_RELEASE, "agent");
      asm volatile("s_waitcnt vmcnt(0)" ::: "memory");
      const unsigned og = xb_add(&bar[XB_TOP], 1u);
      const unsigned tg = og / nx;
      if (og + 1u == (tg + 1u) * nx) xb_add(&bar[XB_TOPGEN], 1u);
      else XB_SPIN(xb_ld(&bar[XB_TOPGEN]) == tg, bar);
      __builtin_amdgcn_fence(__ATOMIC_ACQUIRE, "agent");
      xb_add(&bar[XB_XGEN(b.x)], 1u);
      asm volatile("s_waitcnt vmcnt(0)" ::: "memory");
    } else {
      XB_SPIN(xb_ld(&bar[XB_XGEN(b.x)]) == gen, bar);
      __builtin_amdgcn_fence(__ATOMIC_ACQUIRE, "agent");
      asm volatile("s_waitcnt vmcnt(0)" ::: "memory");
    }
  }
  __syncthreads();
}

#if MK_COOP
__global__ void __launch_bounds__(NTHR, 2) mega_kernel(Params p) {
  cg::grid_group grid = cg::this_grid();
#ifndef PROBE_PH
#define PROBE_PH -1
#endif
  volatile LAS unsigned* st = (volatile LAS unsigned*)(dyn_smem + 65536 + 1024);
  if (threadIdx.x < 4) st[threadIdx.x] = 0u;
  for (int i = blockIdx.x * NTHR + threadIdx.x; i < XCD_BAR_WORDS; i += gridDim.x * NTHR) p.bar[i] = 0u;
  phase0(p);
  grid.sync();
  XcdBarrier xb = xcd_barrier_post(p.bar, st);
#define RUNP(k, call) call; xcd_barrier(xb); if (PROBE_PH == k) { call; xcd_barrier(xb); }
  RUNP(1, phase1(p, dyn_smem))
  RUNP(2, phase2(p, dyn_smem))
  RUNP(3, phase3(p, dyn_smem))
  RUNP(4, phase4(p, dyn_smem))
  RUNP(5, phase5(p, dyn_smem))
  RUNP(6, phase6(p, dyn_smem))
  RUNP(7, phase7(p, dyn_smem))
  for (int tb8 = 0; tb8 * (int)gridDim.x * 4 < T_TOK; tb8 += 24) phase8(p, dyn_smem, tb8);
}
#else
template <int PH>
__global__ void __launch_bounds__(NTHR, 2) phase_kernel(Params p) { run_phase(p, PH, dyn_smem); }
#endif

extern "C" void kernel_launch(void* const* d_in, const int* in_sizes, int n_in, void* d_out, int out_size, void* d_ws,
                              size_t ws_size, hipStream_t stream) {
  Params p{};
  const float* const* in = (const float* const*)d_in;
  p.x0 = in[0]; p.x1 = in[1]; p.attn_norm_g = in[2]; p.w_in = in[3]; p.q_lat_g = in[4]; p.w_uq = in[5];
  p.kv_lat_g = in[6]; p.w_ukv = in[7]; p.q_head_g = in[8]; p.k_head_g = in[9]; p.attn_out_g = in[10];
  p.fnet_out_g = in[11]; p.w_out = in[12]; p.ffn_norm_g = in[13]; p.peer_w_q = in[14]; p.peer_sub_keys = in[15];
  p.peer_u = in[16]; p.peer_v = in[17];
  p.out = (float*)d_out;
  char* ws = (char*)d_ws;
  size_t off = 0;
  auto take = [&](size_t bytes) { char* q = ws + off; off += (bytes + 255) & ~(size_t)255; return q; };
  p.WinT = (u16*)take(1280 * 1024 * 2); p.WuqT = (u16*)take(768 * 384 * 2); p.WukvT = (u16*)take(1024 * 256 * 2);
  p.WoutT = (u16*)take(1024 * 1024 * 2); p.WpqT = (u16*)take(2048 * 1024 * 2); p.SK = (u16*)take(262144 * 2);
  p.Wc = (u16*)take(256 * 128 * 2); p.WA64 = (u16*)take(128 * 128 * 2); p.WA32 = (u16*)take(128 * 64 * 2);
  p.WB = (u16*)take(128 * 256 * 2);
  p.ropec = (float*)take(8192 * 16 * 4); p.ropes = (float*)take(8192 * 16 * 4);
  p.rstd1 = (float*)take((size_t)T_TOK * 4); p.SSP = (float*)take((size_t)T_TOK * 10 * 4);
  p.SSA = (float*)take((size_t)T_TOK * 8 * 4); p.SSF = (float*)take((size_t)T_TOK * 8 * 4);
  p.SS2 = (float*)take((size_t)T_TOK * 16 * 4); p.KR = (float*)take((size_t)T_TOK * 32 * 4);
  p.bar = (unsigned*)take(XCD_BAR_WORDS * 4);
  p.misc = (float*)take(256);
  const size_t SMALL = 28u << 20;
  char* big = ws + SMALL;
  const size_t MB = 1u << 20;
  char* dsp = (char*)d_out;
  p.Xb = (u16*)(big + 0 * MB);
  p.CQ = (u16*)(big + 96 * MB); p.CKV = (u16*)(big + 132 * MB); p.F = (u16*)(big + 156 * MB);
  p.Z1 = (u16*)(big + 204 * MB);
  p.Vt = (u16*)(big + 300 * MB);
  p.Q1 = (u16*)(dsp + 0 * MB); p.K1 = (u16*)(dsp + 72 * MB);
  p.Qn = (u16*)(big + 0 * MB); p.Kn = (u16*)(dsp + 120 * MB);
  p.G1 = (u16*)(big + 96 * MB);
  p.MIX = (u16*)(big + 204 * MB);
  p.X2b = (u16*)(big + 0 * MB);
  p.Qp = (u16*)(big + 96 * MB);
  p.IDX = (int*)(big + 300 * MB); p.G = (float*)(big + 324 * MB);
  p.U8 = (unsigned char*)(big + 348 * MB); p.V8 = (unsigned char*)(big + 364 * MB);

#if MK_COOP
  static int grid_blocks = 0;
  if (!grid_blocks) {
    int dev = 0, cus = 0, per_cu = 0;
    hipGetDevice(&dev);
    hipDeviceGetAttribute(&cus, hipDeviceAttributeMultiprocessorCount, dev);
    hipFuncSetAttribute((const void*)mega_kernel, hipFuncAttributeMaxDynamicSharedMemorySize, LDS_BYTES);
    hipOccupancyMaxActiveBlocksPerMultiprocessor(&per_cu, mega_kernel, NTHR, LDS_BYTES);
    if (per_cu > 2) per_cu = 2;
    grid_blocks = cus * per_cu;
    grid_blocks &= ~7;
  }
  void* args[] = {&p};
  hipError_t e = hipLaunchCooperativeKernel((void*)mega_kernel, dim3(grid_blocks), dim3(NTHR), args, LDS_BYTES, stream);
  if (e != hipSuccess) fprintf(stderr, "cooperative launch failed: %s (grid %d)\n", hipGetErrorString(e), grid_blocks);
#else
  const int GB = 512;
#define LAUNCH(PH)                                                                                                \
  hipFuncSetAttribute((const void*)phase_kernel<PH>, hipFuncAttributeMaxDynamicSharedMemorySize, LDS_BYTES);      \
  phase_kernel<PH><<<GB, NTHR, LDS_BYTES, stream>>>(p);
  LAUNCH(0) LAUNCH(1) LAUNCH(2) LAUNCH(3) LAUNCH(4) LAUNCH(5) LAUNCH(6) LAUNCH(7) LAUNCH(8)
#endif
}
```
